# Optimizing an MI355X kernel written in HIP

```python
import jax
import jax.numpy as jnp
from jax import lax
import numpy as np

D_MODEL = 4096
BATCH = 2
SEQ = 8192
DEPTH = 2

N_META = 16
CHUNK = 64
CONV_W = 4
CONV_LEFT = 2
EPS = 1e-6
NEG = -1e30

A_HEADS = 4
A_DK = D_MODEL // 16
A_DV = D_MODEL // 8
A_QK = A_HEADS * A_DK
A_V = A_HEADS * A_DV
A_GATES = 4 * A_HEADS

B_HEADS = 4
B_DK = D_MODEL // 16
B_DV = D_MODEL // 8
B_QK = B_HEADS * B_DK
B_V = B_HEADS * B_DV
B_RANK = 16
B_TAU = 16.0

EVEN_SPLITS = (A_QK, A_QK, A_V, A_V, A_GATES, B_QK, B_QK, B_V, B_V, 2 * B_RANK)
EVEN_IN = 2 * A_QK + 2 * A_V + A_GATES + 2 * B_QK + 2 * B_V + 2 * B_RANK

D_RNN = D_MODEL * 5 // 4
RNN_BLOCKS = 16
RNN_BLOCK = D_RNN // RNN_BLOCKS
RNN_C = 8.0

N_GROUPS = 4
EXPERTS_PER_GROUP = 8
TOP_K = 2
D_EXPERT = D_MODEL // 16

kernel_name = 'hybrid_mlstm_gla_rglru_hmoe_encoder'


def rmsnorm(x, g):
    xf = x.astype(jnp.float32)
    y = xf * lax.rsqrt(jnp.mean(xf * xf, axis=-1, keepdims=True) + EPS)
    return (y * g.astype(jnp.float32)).astype(x.dtype)


def head_rmsnorm(h, g):
    b, t, nh, d = h.shape
    return rmsnorm(h, g.reshape(nh, d)).reshape(b, t, nh * d)


def centred_dwconv(u, w):
    t = u.shape[1]
    up = jnp.pad(u, ((0, 0), (CONV_LEFT, CONV_W - 1 - CONV_LEFT), (0, 0)))
    out = up[:, 0:t] * w[0]
    for j in range(1, CONV_W):
        out = out + up[:, j:j + t] * w[j]
    return out


def to_chunks(u, pad_value=0.0):
    b, t = u.shape[:2]
    pad = CHUNK - N_META
    u = jnp.pad(u, ((0, 0), (pad, 0)) + ((0, 0),) * (u.ndim - 2), constant_values=pad_value)
    n = (t + pad) // CHUNK
    u = u.reshape((b, n, CHUNK) + u.shape[2:])
    return jnp.swapaxes(jnp.moveaxis(u, 1, 0), 2, 3)


def from_chunks(u):
    u = jnp.moveaxis(jnp.swapaxes(u, 2, 3), 0, 1)
    b, n = u.shape[:2]
    u = u.reshape((b, n * CHUNK) + u.shape[3:])
    return u[:, CHUNK - N_META:]


def bidirectional(scan_fn, fwd_args, bwd_args):
    flip = lambda u: jnp.flip(u, axis=(0, 3))
    return scan_fn(*fwd_args) + flip(scan_fn(*[flip(a) for a in bwd_args]))


def mlstm_scan(q, k, v, log_i, log_f):
    f32 = jnp.float32
    q, k, v = q.astype(f32), k.astype(f32), v.astype(f32)
    _, b, nh, l, dk = q.shape
    dv = v.shape[-1]
    causal = jnp.tril(jnp.ones((l, l), dtype=bool))

    def step(carry, xs):
        c, n, m = carry
        qc, kc, vc, li, lf = xs
        cum = jnp.cumsum(lf, axis=-1)
        d_mat = jnp.where(causal, cum[..., :, None] - cum[..., None, :] + li[..., None, :], NEG)
        inter = cum + m[..., None]
        m_t = jnp.maximum(inter, jnp.max(d_mat, axis=-1))
        w_inter = jnp.exp(inter - m_t)
        s = jnp.einsum('bhtd,bhsd->bhts', qc, kc) * jnp.exp(d_mat - m_t[..., None])
        num = w_inter[..., None] * jnp.einsum('bhtd,bhde->bhte', qc, c) + jnp.einsum('bhts,bhse->bhte', s, vc)
        den = w_inter * jnp.einsum('bhtd,bhd->bht', qc, n) + jnp.sum(s, axis=-1)
        h = num / jnp.maximum(jnp.abs(den), jnp.exp(-m_t))[..., None]
        tot = cum[..., -1]
        g = tot[..., None] - cum + li
        m_new = jnp.maximum(tot + m, jnp.max(g, axis=-1))
        decay = jnp.exp(tot + m - m_new)
        ws = jnp.exp(g - m_new[..., None])
        c_new = decay[..., None, None] * c + jnp.einsum('bhs,bhsd,bhse->bhde', ws, kc, vc)
        n_new = decay[..., None] * n + jnp.einsum('bhs,bhsd->bhd', ws, kc)
        return (c_new, n_new, m_new), h

    init = (jnp.zeros((b, nh, dk, dv), f32), jnp.zeros((b, nh, dk), f32), jnp.zeros((b, nh), f32))
    _, h = lax.scan(step, init, (q, k, v, log_i, log_f))
    return h


def gla_scan(q, k, v, log_a):
    f32 = jnp.float32
    q, k, v, log_a = q.astype(f32), k.astype(f32), v.astype(f32), log_a.astype(f32)
    _, b, nh, l, dk = q.shape
    dv = v.shape[-1]
    causal = jnp.tril(jnp.ones((l, l), dtype=bool))[:, :, None]

    def step(s_state, xs):
        qc, kc, vc, la = xs
        cum = jnp.cumsum(la, axis=-2)
        rel = jnp.exp(jnp.where(causal, cum[..., :, None, :] - cum[..., None, :, :], NEG))
        att = jnp.einsum('bhtc,bhsc,bhtsc->bhts', qc, kc, rel)
        o = jnp.einsum('bhtc,bhce->bhte', qc * jnp.exp(cum), s_state) + jnp.einsum('bhts,bhse->bhte', att, vc)
        tot = cum[..., -1:, :]
        s_new = jnp.exp(tot[..., 0, :])[..., None] * s_state + jnp.einsum('bhsc,bhse->bhce', kc * jnp.exp(tot - cum), vc)
        return s_new, o

    _, o = lax.scan(step, jnp.zeros((b, nh, dk, dv), f32), (q, k, v, log_a))
    return o


def even_mixer(x, w_in, gate_bias, qk_conv, lr_up, lr_bias, norm_a, norm_b, w_out):
    f32 = jnp.float32
    b, t, _ = x.shape
    idx = np.cumsum(EVEN_SPLITS)[:-1].tolist()
    qa, ka, va, oa, ga, qb, kb, vb, gb, lrb = jnp.split(x @ w_in, idx, axis=-1)

    qk = jax.nn.silu(centred_dwconv(jnp.concatenate([qa, ka], axis=-1), qk_conv))
    qa, ka = jnp.split(qk, 2, axis=-1)
    qa = qa.reshape(b, t, A_HEADS, A_DK)
    ka = ka.reshape(b, t, A_HEADS, A_DK) * (A_DK ** -0.5)
    va = va.reshape(b, t, A_HEADS, A_DV)
    gpre = ga.astype(f32).reshape(b, t, 4, A_HEADS) + gate_bias.astype(f32)
    li_f = gpre[:, :, 0]
    lf_f = jax.nn.log_sigmoid(gpre[:, :, 1])
    li_b = gpre[:, :, 2]
    lf_b = jax.nn.log_sigmoid(gpre[:, :, 3])
    qc, kc, vc = to_chunks(qa), to_chunks(ka), to_chunks(va)
    ha = bidirectional(mlstm_scan,
                       (qc, kc, vc, to_chunks(li_f, NEG), to_chunks(lf_f)),
                       (qc, kc, vc, to_chunks(li_b, NEG), to_chunks(lf_b)))
    ya = jax.nn.sigmoid(oa) * head_rmsnorm(from_chunks(ha).astype(x.dtype), norm_a)

    qb = qb.reshape(b, t, B_HEADS, B_DK) * (B_DK ** -0.5)
    kb = kb.reshape(b, t, B_HEADS, B_DK)
    vb = vb.reshape(b, t, B_HEADS, B_DV)
    lrb = lrb.astype(f32)
    la_f = (jax.nn.log_sigmoid(lrb[..., :B_RANK] @ lr_up[0].astype(f32) + lr_bias[0].astype(f32)) / B_TAU).reshape(b, t, B_HEADS, B_DK)
    la_b = (jax.nn.log_sigmoid(lrb[..., B_RANK:] @ lr_up[1].astype(f32) + lr_bias[1].astype(f32)) / B_TAU).reshape(b, t, B_HEADS, B_DK)
    qc, kc, vc = to_chunks(qb), to_chunks(kb), to_chunks(vb)
    hb = bidirectional(gla_scan, (qc, kc, vc, to_chunks(la_f)), (qc, kc, vc, to_chunks(la_b)))
    yb = jax.nn.silu(gb) * head_rmsnorm(from_chunks(hb).astype(x.dtype), norm_b)

    return jnp.concatenate([ya, yb], axis=-1) @ w_out


def _linear_combine(c1, c2):
    a1, b1 = c1
    a2, b2 = c2
    return (a1 * a2, a2 * b1 + b2)


def odd_mixer(x, w_in, conv_w, conv_b, w_r, b_r, w_i, b_i, lam, w_out):
    f32 = jnp.float32
    b, t, _ = x.shape
    gate, u = jnp.split(x @ w_in, 2, axis=-1)
    u = centred_dwconv(u, conv_w) + conv_b
    ub = u.reshape(b, t, RNN_BLOCKS, RNN_BLOCK)
    uf = u.astype(f32)

    def direction(d, reverse):
        r = jax.nn.sigmoid(jnp.einsum('btnc,ncd->btnd', ub, w_r[d]).reshape(b, t, D_RNN).astype(f32) + b_r[d].astype(f32))
        i = jax.nn.sigmoid(jnp.einsum('btnc,ncd->btnd', ub, w_i[d]).reshape(b, t, D_RNN).astype(f32) + b_i[d].astype(f32))
        log_a = -RNN_C * r * jax.nn.softplus(-lam[d].astype(f32))
        a = jnp.exp(log_a)
        inp = jnp.sqrt(-jnp.expm1(2.0 * log_a)) * (i * uf)
        _, h = lax.associative_scan(_linear_combine, (a, inp), axis=1, reverse=reverse)
        return h

    h = direction(0, False) + direction(1, True)
    return (jax.nn.gelu(gate) * h.astype(x.dtype)) @ w_out


def hier_moe(x, wg, bg, we, be, w1, w3, w2):
    f32 = jnp.float32
    b, t, d = x.shape
    xt = x.reshape(b * t, d)
    gp = jax.nn.softmax((xt @ wg).astype(f32) + bg.astype(f32), axis=-1)
    gval, gidx = lax.top_k(gp, 1)
    gmask = jax.nn.one_hot(gidx[:, 0], N_GROUPS, dtype=f32)
    el = ((xt @ we).astype(f32) + be.astype(f32)).reshape(b * t, N_GROUPS, EXPERTS_PER_GROUP)
    el_sel = jnp.einsum('nge,ng->ne', el, gmask)
    ev, eidx = lax.top_k(jax.nn.softmax(el_sel, axis=-1), TOP_K)
    ev = ev / jnp.sum(ev, axis=-1, keepdims=True)
    ew = jnp.einsum('nke,nk->ne', jax.nn.one_hot(eidx, EXPERTS_PER_GROUP, dtype=f32), ev) * gval
    comb = (gmask[:, :, None] * ew[:, None, :]).astype(x.dtype)
    y = jnp.zeros_like(xt)
    for g in range(N_GROUPS):
        hid = jax.nn.silu(jnp.einsum('nd,edf->nef', xt, w1[g])) * jnp.einsum('nd,edf->nef', xt, w3[g])
        y = y + jnp.einsum('nef,efd->nd', hid * comb[:, g, :, None], w2[g])
    return y.reshape(b, t, d)


def setup_inputs(seed: int = 0) -> dict:
    key = jax.random.key(seed)
    ks = iter(jax.random.split(key, 32))
    f32 = jnp.float32

    def nrm(shape, scale):
        return jax.random.normal(next(ks), shape, f32) * scale

    ne = (DEPTH + 1) // 2
    no = DEPTH // 2
    x = nrm((BATCH, SEQ, D_MODEL), 1.0)
    meta_tokens = nrm((N_META, D_MODEL), 1.0)
    mix_norm = 1.0 + nrm((DEPTH, D_MODEL), 0.02)
    ffn_norm = 1.0 + nrm((DEPTH, D_MODEL), 0.02)
    final_norm = 1.0 + nrm((D_MODEL,), 0.02)

    ev_w_in = nrm((ne, D_MODEL, EVEN_IN), D_MODEL ** -0.5)
    f_bias = jnp.array([0.0, 1.0, 0.0, 1.0], f32)[:, None] * jnp.linspace(3.0, 6.0, A_HEADS, dtype=f32)[None, :]
    ev_gate_bias = nrm((ne, 4, A_HEADS), 0.1) + f_bias
    ev_qk_conv = nrm((ne, CONV_W, 2 * A_QK), CONV_W ** -0.5)
    ev_lr_up = nrm((ne, 2, B_RANK, B_QK), B_RANK ** -0.5)
    ev_lr_bias = nrm((ne, 2, B_QK), 0.1)
    ev_norm_a = 1.0 + nrm((ne, A_V), 0.02)
    ev_norm_b = 1.0 + nrm((ne, B_V), 0.02)
    ev_w_out = nrm((ne, A_V + B_V, D_MODEL), (A_V + B_V) ** -0.5)

    od_w_in = nrm((no, D_MODEL, 2 * D_RNN), D_MODEL ** -0.5)
    od_conv = nrm((no, CONV_W, D_RNN), CONV_W ** -0.5)
    od_conv_bias = nrm((no, D_RNN), 0.02)
    od_w_r = nrm((no, 2, RNN_BLOCKS, RNN_BLOCK, RNN_BLOCK), RNN_BLOCK ** -0.5)
    od_b_r = nrm((no, 2, D_RNN), 0.1)
    od_w_i = nrm((no, 2, RNN_BLOCKS, RNN_BLOCK, RNN_BLOCK), RNN_BLOCK ** -0.5)
    od_b_i = nrm((no, 2, D_RNN), 0.1)
    a_c = jax.random.uniform(next(ks), (no, 2, D_RNN), f32, 0.9, 0.999)
    a0 = a_c ** (1.0 / RNN_C)
    od_lambda = jnp.log(a0) - jnp.log1p(-a0)
    od_w_out = nrm((no, D_RNN, D_MODEL), D_RNN ** -0.5)

    n_exp = N_GROUPS * EXPERTS_PER_GROUP
    moe_wg = nrm((DEPTH, D_MODEL, N_GROUPS), D_MODEL ** -0.5)
    moe_bg = nrm((DEPTH, N_GROUPS), 0.01)
    moe_we = nrm((DEPTH, D_MODEL, n_exp), D_MODEL ** -0.5)
    moe_be = nrm((DEPTH, n_exp), 0.01)
    moe_w1 = nrm((DEPTH, N_GROUPS, EXPERTS_PER_GROUP, D_MODEL, D_EXPERT), D_MODEL ** -0.5)
    moe_w3 = nrm((DEPTH, N_GROUPS, EXPERTS_PER_GROUP, D_MODEL, D_EXPERT), D_MODEL ** -0.5)
    moe_w2 = nrm((DEPTH, N_GROUPS, EXPERTS_PER_GROUP, D_EXPERT, D_MODEL), D_EXPERT ** -0.5)

    return {'x': x, 'meta_tokens': meta_tokens, 'mix_norm': mix_norm, 'ffn_norm': ffn_norm,
            'final_norm': final_norm,
            'ev_w_in': ev_w_in, 'ev_gate_bias': ev_gate_bias, 'ev_qk_conv': ev_qk_conv,
            'ev_lr_up': ev_lr_up, 'ev_lr_bias': ev_lr_bias, 'ev_norm_a': ev_norm_a,
            'ev_norm_b': ev_norm_b, 'ev_w_out': ev_w_out,
            'od_w_in': od_w_in, 'od_conv': od_conv, 'od_conv_bias': od_conv_bias,
            'od_w_r': od_w_r, 'od_b_r': od_b_r, 'od_w_i': od_w_i, 'od_b_i': od_b_i,
            'od_lambda': od_lambda, 'od_w_out': od_w_out,
            'moe_wg': moe_wg, 'moe_bg': moe_bg, 'moe_we': moe_we, 'moe_be': moe_be,
            'moe_w1': moe_w1, 'moe_w3': moe_w3, 'moe_w2': moe_w2}


def reference(x, meta_tokens, mix_norm, ffn_norm, final_norm,
              ev_w_in, ev_gate_bias, ev_qk_conv, ev_lr_up, ev_lr_bias, ev_norm_a, ev_norm_b, ev_w_out,
              od_w_in, od_conv, od_conv_bias, od_w_r, od_b_r, od_w_i, od_b_i, od_lambda, od_w_out,
              moe_wg, moe_bg, moe_we, moe_be, moe_w1, moe_w3, moe_w2):
    b = x.shape[0]
    meta = jnp.broadcast_to(meta_tokens.astype(x.dtype)[None], (b, N_META, D_MODEL))
    h = jnp.concatenate([meta, x], axis=1)
    for layer in range(DEPTH):
        hn = rmsnorm(h, mix_norm[layer])
        if layer % 2 == 0:
            e = layer // 2
            h = h + even_mixer(hn, ev_w_in[e], ev_gate_bias[e], ev_qk_conv[e], ev_lr_up[e],
                               ev_lr_bias[e], ev_norm_a[e], ev_norm_b[e], ev_w_out[e])
        else:
            o = layer // 2
            h = h + odd_mixer(hn, od_w_in[o], od_conv[o], od_conv_bias[o], od_w_r[o], od_b_r[o],
                              od_w_i[o], od_b_i[o], od_lambda[o], od_w_out[o])
        h = h + hier_moe(rmsnorm(h, ffn_norm[layer]), moe_wg[layer], moe_bg[layer], moe_we[layer],
                         moe_be[layer], moe_w1[layer], moe_w3[layer], moe_w2[layer])
    return rmsnorm(h, final_norm)[:, N_META:]
```

```cpp
#include <hip/hip_runtime.h>
#include <cstdio>
#include <cstdint>

#ifndef MK_FUSED
#define MK_FUSED 0
#endif

#define LAS __attribute__((address_space(3)))
typedef unsigned short bf16_t;
typedef short bf16x8 __attribute__((ext_vector_type(8)));
typedef short s16x4 __attribute__((ext_vector_type(4)));
typedef float f32x4 __attribute__((ext_vector_type(4)));
typedef float f32x2 __attribute__((ext_vector_type(2)));
typedef unsigned u32x4 __attribute__((ext_vector_type(4)));
typedef unsigned u32x2 __attribute__((ext_vector_type(2)));

constexpr int D = 4096, NBATCH = 2, SEQ = 8192, NMETA = 16, TP = 8256  , NCH = 129, PADF = 48;
constexpr int MR = NBATCH * TP;
constexpr int MP = 16640;
constexpr int NPROJ0 = 12288, NW0 = 12544, NPROJ1 = 10240, DR = 5120;
constexpr int NEXP = 32, DEXP = 256, SLOTS = 41216  ;
constexpr float EPS = 1e-6f;
constexpr float NEGV = -1e30f;

constexpr size_t MiB = 1u << 20;
constexpr size_t WS_CTL = 0, CTL_BYTES = 1 * MiB;
constexpr size_t WS_W = 1 * MiB;
constexpr size_t W_IN = 0, W_OUT0 = 98 * MiB, W_OUT1 = 80 * MiB, W_RI = 120 * MiB, W_UP = 134 * MiB, W_DN = 262 * MiB, W_RT = 326 * MiB;
constexpr size_t WS_H = 329 * MiB;
constexpr size_t WS_PROJ = 589 * MiB;
constexpr size_t WS_HS = 979 * MiB;
constexpr size_t WS_G = 1304 * MiB;
constexpr size_t WS_END = 1502 * MiB;
constexpr size_t XS_OFF = WS_PROJ, HID_OFF = WS_PROJ + 322 * MiB;
constexpr size_t HS_STRIDE0 = (size_t)MP * 4096 * 2, HS_STRIDE1 = (size_t)MP * DR * 2;
constexpr size_t G_STRIDE = (size_t)MP * 1024 * 2, G_ETOT = 195 * MiB;
constexpr size_t DO_XN = 0, DO_QKC = 130 * MiB, DO_SMALL = 195 * MiB, DO_LTOK = 200 * MiB, DO_LW = 205 * MiB, DO_SDST = 210 * MiB, DO_SW = 211 * MiB;
constexpr int LCAP = 16416;
constexpr int CW_BAR = 4096, CW_CNT = 16384;

constexpr int LDS_BYTES = 159744;
constexpr int LDS_XB = LDS_BYTES - 16;
constexpr int LDS_TAB = LDS_BYTES - 16 - 2048;

__device__ __forceinline__ float bf2f(unsigned short b) { return __uint_as_float(((unsigned)b) << 16); }
typedef __bf16 bf16v2 __attribute__((ext_vector_type(2)));
__device__ __forceinline__ unsigned cvt_pk_bf16(float lo, float hi) { const f32x2 v = {lo, hi}; return __builtin_bit_cast(unsigned, __builtin_convertvector(v, bf16v2)); }
__device__ __forceinline__ unsigned short f2bf(float f) { return (unsigned short)(cvt_pk_bf16(f, 0.f) & 0xffffu); }
__device__ __forceinline__ float sigmoidf_(float x) { return 1.0f / (1.0f + __expf(-x)); }
__device__ __forceinline__ float siluf_(float x) { return x * sigmoidf_(x); }
__device__ __forceinline__ float logsigf_(float x) { return fminf(x, 0.f) - log1pf(__expf(-fabsf(x))); }
__device__ __forceinline__ float softplusf_(float x) { return fmaxf(x, 0.f) + log1pf(__expf(-fabsf(x))); }
__device__ __forceinline__ float gelu_tanhf_(float x) { const float u = 0.7978845608028654f * (x + 0.044715f * x * x * x); const float t = 1.0f - 2.0f / (__expf(2.0f * u) + 1.0f); return 0.5f * x * (1.0f + t); }
__device__ __forceinline__ float wave_sum(float v) {
#pragma unroll
    for (int o = 1; o < 64; o <<= 1) v += __shfl_xor(v, o);
    return v;
}
__device__ __forceinline__ bool row_valid(int r) { if (r >= MR) return false; const int p = r >= TP ? r - TP : r; return p >= PADF; }
__device__ __forceinline__ s16x4 tr_read(unsigned lds_addr) { s16x4 r; asm volatile("ds_read_b64_tr_b16 %0, %1\n\ts_waitcnt lgkmcnt(0)" : "=&v"(r) : "v"(lds_addr) : "memory"); return r; }
__device__ __forceinline__ bf16x8 tr_frag(unsigned a0, unsigned a1) {
    s16x4 x, y; asm volatile("ds_read_b64_tr_b16 %0, %2\n\tds_read_b64_tr_b16 %1, %3\n\ts_waitcnt lgkmcnt(0)" : "=&v"(x), "=&v"(y) : "v"(a0), "v"(a1) : "memory");
    bf16x8 r; r[0] = x[0]; r[1] = x[1]; r[2] = x[2]; r[3] = x[3]; r[4] = y[0]; r[5] = y[1]; r[6] = y[2]; r[7] = y[3]; return r;
}
#define MFMA16(a, b, c) __builtin_amdgcn_mfma_f32_16x16x32_bf16((a), (b), (c), 0, 0, 0)

namespace pg8 {
constexpr int BM = 256, BK = 64, HALF = 128, HTB = HALF * BK * 2, STAGE_BYTES = 8 * HTB, NXCD = 8, WGM = 8;
__host__ __device__ __forceinline__ int lds_byte(int r, int c) { const int st = (r >> 4) * 2 + (c >> 5), rr = r & 15, cc = c & 31, ob = rr * 64 + cc * 2; return st * 1024 + (ob ^ (((ob >> 9) & 1) << 5)); }
__host__ __device__ __forceinline__ void stage_rc(int b, int& R, int& C) { const int st = b / 1024, sb = b % 1024, swz = sb ^ (((sb >> 9) & 1) << 5); R = (st >> 1) * 16 + swz / 64; C = (st & 1) * 32 + (swz % 64) / 2; }
__host__ __device__ __forceinline__ int perm32(int rho) { const int n = rho >> 4, i = rho & 15; return 8 * (i >> 2) + 4 * n + (i & 3); }
struct Unit { int pm, pn; };
struct Gemm { const bf16_t* A; const bf16_t* Bt; int lda, ldb, K; };
struct StaticOrder {
    int nM, nN, nwg, G, c;
    __device__ void init(int M, int N, int G_, int c_) { nM = M / BM; nN = N / BM; nwg = nM * nN; G = G_; c = c_; }
    __device__ bool next(int i, Unit& u) const {
        const long L = (long)i * G + c; if (L >= nwg) return false;
        int wgid = (int)L; { const int q = nwg / NXCD, r = nwg % NXCD, xcd = wgid % NXCD, off = wgid / NXCD; wgid = (xcd < r ? xcd * (q + 1) : r * (q + 1) + (xcd - r) * q) + off; }
        const int nig = WGM * nN, gid = wgid / nig, fm = gid * WGM, gsz = (nM - fm) < WGM ? (nM - fm) : WGM;
        u.pm = fm + ((wgid % nig) % gsz); u.pn = (wgid % nig) / gsz; return true;
    }
};
struct MoeOrder {
    const LAS int* tab; int npn, G, c;
    __device__ bool next(int i, Unit& u) const {
        const int NT = __builtin_amdgcn_readfirstlane(tab[0]); const int L = i * G + c; if (L >= NT * npn) return false;
        const int pm = L / npn, ct = L % npn; u.pm = pm; u.pn = __builtin_amdgcn_readfirstlane(tab[64 + pm]) * npn + ct; return true;
    }
};

template <class Epi, class Sched>
__device__ __forceinline__ void gemm_phase(LAS unsigned char* lds, const Gemm g, const Sched& S, const Epi& E) {
    const int tid = threadIdx.x, wid = __builtin_amdgcn_readfirstlane(tid >> 6), lane = tid & 63, wr = wid >> 2, wc = wid & 3, fr = lane & 15, fq = lane >> 4;
    int K = g.K; asm volatile("" : "+s"(K));
    const int nt = K / BK;
    unsigned voffA[2], voffB[2];
#pragma unroll
    for (int i = 0; i < 2; ++i) { int R, C; stage_rc(tid * 16 + i * 8192, R, C); const int Rb = Epi::PERM ? ((R & ~31) + perm32(R & 31)) : R;
        voffA[i] = (unsigned)(R * g.lda + C) * 2u; voffB[i] = (unsigned)(Rb * g.ldb + C) * 2u; }
    const size_t kstep = (size_t)(BK * 2);
    const size_t hstepA = (size_t)HALF * g.lda * 2, hstepB = (size_t)HALF * g.ldb * 2;
    const size_t tstepA = 2 * hstepA, tstepB = 2 * hstepB;
    const unsigned ldsw = (unsigned)wid * 1024u;
    const int aoff = lds_byte(wr * 64 + fr, fq * 8), boff = lds_byte(wc * 32 + fr, fq * 8);
#define PG8_SA(b, h) (((b) * 2 + (h)) * HTB)
#define PG8_SB(b, h) ((4 + (b) * 2 + (h)) * HTB)
#define PG8_STAGE(bufoff, gbase, voff) do { _Pragma("unroll") for (int _i = 0; _i < 2; ++_i) \
        __builtin_amdgcn_global_load_lds((const unsigned*)((const char*)(gbase) + (voff)[_i]), (LAS unsigned*)(lds + (bufoff) + ldsw + _i * 8192), 16, 0, 0); } while (0)
#define PG8_LDA(dst, b, h) do { _Pragma("unroll") for (int m = 0; m < 4; ++m) _Pragma("unroll") for (int k = 0; k < 2; ++k) dst[m][k] = *(const LAS bf16x8*)(lds + PG8_SA(b, h) + aoff + m * 2048 + k * 1024); } while (0)
#define PG8_LDB(dst, b, h) do { _Pragma("unroll") for (int n = 0; n < 2; ++n) _Pragma("unroll") for (int k = 0; k < 2; ++k) dst[n][k] = *(const LAS bf16x8*)(lds + PG8_SB(b, h) + boff + n * 2048 + k * 1024); } while (0)
#define PG8_MMA(ai, bj, At, Bt) do { __builtin_amdgcn_s_setprio(1); _Pragma("unroll") for (int m = 0; m < 4; ++m) _Pragma("unroll") for (int n = 0; n < 2; ++n) _Pragma("unroll") for (int k = 0; k < 2; ++k) \
        acc[ai][bj][m][n] = __builtin_amdgcn_mfma_f32_16x16x32_bf16(Bt[n][k], At[m][k], acc[ai][bj][m][n], 0, 0, 0); __builtin_amdgcn_s_setprio(0); } while (0)
#define PG8_WAIT_V(n) asm volatile("s_waitcnt vmcnt(" #n ")" ::: "memory")
#define PG8_WAIT_L(n) asm volatile("s_waitcnt lgkmcnt(" #n ")" ::: "memory")
#define PG8_BAR __builtin_amdgcn_s_barrier()
#define PG8_SCHED __builtin_amdgcn_sched_barrier(0)
    Unit cur, nxt; int ui = 0;
    if (!S.next(0, cur)) return;
    f32x4 acc[2][2][4][2];
#pragma unroll
    for (int a = 0; a < 2; ++a)
#pragma unroll
        for (int b = 0; b < 2; ++b)
#pragma unroll
            for (int m = 0; m < 4; ++m)
#pragma unroll
                for (int n = 0; n < 2; ++n) acc[a][b][m][n] = (f32x4){0.f, 0.f, 0.f, 0.f};
    bf16x8 At[4][2], B0[2][2], B1[2][2];
    const char* cA = (const char*)g.A + (size_t)cur.pm * tstepA; const char* cB = (const char*)g.Bt + (size_t)cur.pn * tstepB;
    PG8_STAGE(PG8_SB(0, 0), cB, voffB); PG8_STAGE(PG8_SA(0, 0), cA, voffA); PG8_STAGE(PG8_SB(0, 1), cB + hstepB, voffB); PG8_STAGE(PG8_SA(0, 1), cA + hstepA, voffA);
    if (wr == 1) PG8_BAR;
    PG8_WAIT_V(4); PG8_BAR;
    PG8_STAGE(PG8_SB(1, 0), cB + kstep, voffB); PG8_STAGE(PG8_SA(1, 0), cA + kstep, voffA); PG8_STAGE(PG8_SB(1, 1), cB + hstepB + kstep, voffB);
    PG8_WAIT_V(6); PG8_BAR;
    for (;;) {
        const bool has_next = S.next(ui + 1, nxt);
        const char* nA = has_next ? (const char*)g.A + (size_t)nxt.pm * tstepA : cA; const char* nB = has_next ? (const char*)g.Bt + (size_t)nxt.pn * tstepB : cB;
        for (int t = 0; t < nt; t += 2) {
            const bool last = (t == nt - 2);
            const char* a1 = cA + (size_t)(t + 1) * kstep;
            const char* a2 = last ? nA : cA + (size_t)(t + 2) * kstep; const char* b2 = last ? nB : cB + (size_t)(t + 2) * kstep;
            const char* a3 = a2 + kstep; const char* b3 = b2 + kstep;
            PG8_LDB(B0, 0, 0); PG8_SCHED; PG8_LDA(At, 0, 0); PG8_STAGE(PG8_SA(1, 1), a1 + hstepA, voffA);
            PG8_WAIT_L(8); PG8_BAR; PG8_WAIT_L(0); PG8_MMA(0, 0, At, B0); PG8_BAR; PG8_SCHED;
            PG8_LDB(B1, 0, 1); PG8_STAGE(PG8_SB(0, 0), b2, voffB);
            PG8_BAR; PG8_WAIT_L(0); PG8_MMA(0, 1, At, B1); PG8_BAR;
            PG8_LDA(At, 0, 1); PG8_STAGE(PG8_SA(0, 0), a2, voffA);
            PG8_BAR; PG8_WAIT_L(0); PG8_MMA(1, 0, At, B0); PG8_BAR; PG8_SCHED;
            PG8_STAGE(PG8_SB(0, 1), b2 + hstepB, voffB);
            PG8_WAIT_V(6); PG8_BAR; PG8_MMA(1, 1, At, B1); PG8_BAR;
            PG8_LDB(B0, 1, 0); PG8_SCHED; PG8_LDA(At, 1, 0); PG8_STAGE(PG8_SA(0, 1), a2 + hstepA, voffA);
            PG8_WAIT_L(8); PG8_BAR; PG8_WAIT_L(0); PG8_MMA(0, 0, At, B0); PG8_BAR; PG8_SCHED;
            PG8_LDB(B1, 1, 1); PG8_STAGE(PG8_SB(1, 0), b3, voffB);
            PG8_BAR; PG8_WAIT_L(0); PG8_MMA(0, 1, At, B1); PG8_BAR;
            PG8_LDA(At, 1, 1); PG8_STAGE(PG8_SA(1, 0), a3, voffA);
            PG8_BAR; PG8_WAIT_L(0); PG8_MMA(1, 0, At, B0); PG8_BAR; PG8_SCHED;
            PG8_STAGE(PG8_SB(1, 1), b3 + hstepB, voffB);
            PG8_WAIT_V(6); PG8_BAR; PG8_MMA(1, 1, At, B1); PG8_BAR;
        }
        E(acc, cur, wr, wc, fr, fq);
        if (!has_next) break;
#pragma unroll
        for (int a = 0; a < 2; ++a)
#pragma unroll
            for (int b = 0; b < 2; ++b)
#pragma unroll
                for (int m = 0; m < 4; ++m)
#pragma unroll
                    for (int n = 0; n < 2; ++n) acc[a][b][m][n] = (f32x4){0.f, 0.f, 0.f, 0.f};
        cur = nxt; cA = nA; cB = nB; ++ui;
    }
    PG8_WAIT_V(0);
    if (wr == 0) PG8_BAR;
    PG8_BAR;
#undef PG8_SA
#undef PG8_SB
#undef PG8_STAGE
#undef PG8_LDA
#undef PG8_LDB
#undef PG8_MMA
#undef PG8_WAIT_V
#undef PG8_WAIT_L
#undef PG8_BAR
#undef PG8_SCHED
}
struct EpiProj {
    static constexpr bool PERM = true;
    bf16_t* O; int ldc; int npn_main; float* side;
    __device__ __forceinline__ void operator()(const f32x4 (&acc)[2][2][4][2], const Unit& u, int wr, int wc, int fr, int fq) const {
        const int row0 = u.pm * BM + wr * 64 + fr;
        if (u.pn < npn_main) {
            const int col0 = u.pn * BM + wc * 32 + 8 * fq;
#pragma unroll
            for (int ai = 0; ai < 2; ++ai)
#pragma unroll
                for (int m = 0; m < 4; ++m) { bf16_t* rowp = O + (size_t)(row0 + ai * HALF + m * 16) * ldc + col0;
#pragma unroll
                    for (int bj = 0; bj < 2; ++bj) { const f32x4 v0 = acc[ai][bj][m][0], v1 = acc[ai][bj][m][1];
                        u32x4 w; w.x = cvt_pk_bf16(v0[0], v0[1]); w.y = cvt_pk_bf16(v0[2], v0[3]); w.z = cvt_pk_bf16(v1[0], v1[1]); w.w = cvt_pk_bf16(v1[2], v1[3]);
                        *(u32x4*)(rowp + bj * HALF) = w; } }
        } else if (wc < 2) {
            const int col0 = wc * 32 + 8 * fq;
#pragma unroll
            for (int ai = 0; ai < 2; ++ai)
#pragma unroll
                for (int m = 0; m < 4; ++m) { float* rowp = side + (size_t)(row0 + ai * HALF + m * 16) * 64 + col0;
                    *(f32x4*)(rowp) = acc[ai][0][m][0]; *(f32x4*)(rowp + 4) = acc[ai][0][m][1]; }
        }
    }
};
struct EpiResAdd {
    static constexpr bool PERM = false;
    float* C; int ldc;
    __device__ __forceinline__ void operator()(const f32x4 (&acc)[2][2][4][2], const Unit& u, int wr, int wc, int fr, int fq) const {
        const int row0 = u.pm * BM + wr * 64 + fr, col0 = u.pn * BM + wc * 32 + 4 * fq;
#pragma unroll
        for (int ai = 0; ai < 2; ++ai)
#pragma unroll
            for (int m = 0; m < 4; ++m) { float* rowp = C + (size_t)(row0 + ai * HALF + m * 16) * ldc + col0;
#pragma unroll
                for (int bj = 0; bj < 2; ++bj)
#pragma unroll
                    for (int n = 0; n < 2; ++n) { f32x4* p = (f32x4*)(rowp + bj * HALF + n * 16); *p = *p + acc[ai][bj][m][n]; } }
    }
};
struct EpiMoeUp {
    static constexpr bool PERM = true;
    bf16_t* hid; const float* sw;
    __device__ __forceinline__ void operator()(const f32x4 (&acc)[2][2][4][2], const Unit& u, int wr, int wc, int fr, int fq) const {
        const int row0 = u.pm * BM + wr * 64 + fr, col0 = (u.pn & 1) * 128 + wc * 32 + 8 * fq;
#pragma unroll
        for (int ai = 0; ai < 2; ++ai)
#pragma unroll
            for (int m = 0; m < 4; ++m) { const int slot = row0 + ai * HALF + m * 16; const float wt = sw[slot];
                float o[8];
#pragma unroll
                for (int n = 0; n < 2; ++n)
#pragma unroll
                    for (int j = 0; j < 4; ++j) o[n * 4 + j] = siluf_(acc[ai][0][m][n][j]) * acc[ai][1][m][n][j] * wt;
                u32x4 w; w.x = cvt_pk_bf16(o[0], o[1]); w.y = cvt_pk_bf16(o[2], o[3]); w.z = cvt_pk_bf16(o[4], o[5]); w.w = cvt_pk_bf16(o[6], o[7]);
                *(u32x4*)(hid + (size_t)slot * DEXP + col0) = w; }
    }
};
struct EpiMoeDn {
    static constexpr bool PERM = true;
    bf16_t* y; const int* sdst;
    __device__ __forceinline__ void operator()(const f32x4 (&acc)[2][2][4][2], const Unit& u, int wr, int wc, int fr, int fq) const {
        const int row0 = u.pm * BM + wr * 64 + fr, col0 = (u.pn & 15) * BM + wc * 32 + 8 * fq;
#pragma unroll
        for (int ai = 0; ai < 2; ++ai)
#pragma unroll
            for (int m = 0; m < 4; ++m) { const int dst = sdst[row0 + ai * HALF + m * 16];
                if (dst >= 0) { bf16_t* rowp = y + (size_t)dst * D + col0;
#pragma unroll
                    for (int bj = 0; bj < 2; ++bj) { const f32x4 v0 = acc[ai][bj][m][0], v1 = acc[ai][bj][m][1];
                        u32x4 w; w.x = cvt_pk_bf16(v0[0], v0[1]); w.y = cvt_pk_bf16(v0[2], v0[3]); w.z = cvt_pk_bf16(v1[0], v1[1]); w.w = cvt_pk_bf16(v1[2], v1[3]);
                        *(u32x4*)(rowp + bj * HALF) = w; } } }
    }
};
}

#define XB_TMO      128
#define XB_XCNT(j)  (256  + 64 * (j))
#define XB_XSUB(j)  (1280 + 64 * (j))
#define XB_XGEN(j)  (2304 + 64 * (j))
#define XB_TOP      3328
#define XB_TOPGEN   3392
#define XCD_BAR_WORDS 3456
#define XB_SPIN_CAP (1u << 18)
__device__ __forceinline__ unsigned xb_ld(unsigned* p)              { return __hip_atomic_load(p, __ATOMIC_RELAXED, __HIP_MEMORY_SCOPE_AGENT); }
__device__ __forceinline__ unsigned xb_add(unsigned* p, unsigned v) { return __hip_atomic_fetch_add(p, v, __ATOMIC_RELAXED, __HIP_MEMORY_SCOPE_AGENT); }
__device__ __forceinline__ unsigned xb_xcc_id() { return (unsigned)__builtin_amdgcn_s_getreg((3 << 11) | 20) & 0xFu; }
#define XB_SPIN(cond, bar) do { unsigned _sp = 0; while (cond) { __builtin_amdgcn_s_sleep(1); \
    if ((++_sp & 255u) == 0u) { if (xb_ld(&(bar)[XB_TMO])) break; if (_sp > XB_SPIN_CAP) { atomicAdd(&(bar)[XB_TMO], 1u); break; } } } } while (0)
struct XcdBarrier { unsigned* bar; unsigned x; volatile LAS unsigned* st; };
__device__ __forceinline__ XcdBarrier xcd_barrier_post(unsigned* bar, volatile LAS unsigned* st) {
    XcdBarrier b; b.bar = bar; b.x = xb_xcc_id(); b.st = st;
    if (threadIdx.x == 0) (void)xb_add(&bar[XB_XCNT(b.x)], 1u);
    return b;
}
__device__ __forceinline__ void xcd_barrier_complete(unsigned* bar, unsigned x, unsigned& nloc, unsigned& nx) {
    const unsigned G = gridDim.x * gridDim.y * gridDim.z;
    unsigned sum, cnt, mine, sp = 0u;
    for (;;) {
        sum = 0u; cnt = 0u; mine = 0u;
#pragma unroll
        for (unsigned j = 0; j < 16; ++j) { const unsigned c = xb_ld(&bar[XB_XCNT(j)]); sum += c; cnt += (c > 0u) ? 1u : 0u; mine = (j == x) ? c : mine; }
        if (sum == G) break;
        __builtin_amdgcn_s_sleep(1);
        if ((++sp & 255u) == 0u) { if (xb_ld(&bar[XB_TMO])) break; if (sp > XB_SPIN_CAP) { atomicAdd(&bar[XB_TMO], 1u); break; } }
    }
    nloc = mine > 0u ? mine : 1u; nx = cnt > 0u ? cnt : 1u;
}
__device__ __forceinline__ void xcd_barrier(const XcdBarrier& b) {
    asm volatile("s_waitcnt vmcnt(0)" ::: "memory");
    __syncthreads();
    if (threadIdx.x == 0) {
        unsigned* bar = b.bar;
        __builtin_amdgcn_s_waitcnt(0);
        unsigned nloc = b.st[0], nx = b.st[1];
        if (nloc == 0u) { xcd_barrier_complete(bar, b.x, nloc, nx); b.st[0] = nloc; b.st[1] = nx; }
        const unsigned old = xb_add(&bar[XB_XSUB(b.x)], 1u);
        const unsigned gen = old / nloc;
        if (old + 1u == (gen + 1u) * nloc) {
            __builtin_amdgcn_fence(__ATOMIC_RELEASE, "agent");
            asm volatile("s_waitcnt vmcnt(0)" ::: "memory");
            const unsigned og = xb_add(&bar[XB_TOP], 1u);
            const unsigned tg = og / nx;
            if (og + 1u == (tg + 1u) * nx) xb_add(&bar[XB_TOPGEN], 1u);
            else XB_SPIN(xb_ld(&bar[XB_TOPGEN]) == tg, bar);
            __builtin_amdgcn_fence(__ATOMIC_ACQUIRE, "agent");
            xb_add(&bar[XB_XGEN(b.x)], 1u);
            asm volatile("s_waitcnt vmcnt(0)" ::: "memory");
        } else {
            XB_SPIN(xb_ld(&bar[XB_XGEN(b.x)]) == gen, bar);
            __builtin_amdgcn_fence(__ATOMIC_ACQUIRE, "agent");
            asm volatile("s_waitcnt vmcnt(0)" ::: "memory");
        }
    }
    __syncthreads();
}

struct Args { const float* in[29]; float* out; unsigned char* ws; int ph_lo, ph_hi, flags, pad; };
enum { I_X = 0, I_META, I_MIXN, I_FFNN, I_FINN, I_EVWIN, I_EVGB, I_EVQKC, I_EVLRUP, I_EVLRB, I_EVNA, I_EVNB, I_EVWOUT, I_ODWIN, I_ODCONV, I_ODCONVB, I_ODWR, I_ODBR, I_ODWI, I_ODBI, I_ODLAM, I_ODWOUT,
       I_MWG, I_MBG, I_MWE, I_MBE, I_MW1, I_MW3, I_MW2 };


#define LDS_WAIT() asm volatile("s_waitcnt lgkmcnt(0)" ::: "memory")

__device__ __forceinline__ void tr_item(const float* Wc, size_t ldw, bf16_t* WT, size_t ldt, int k0, int n0, LAS float* scr, int lane) {
#pragma unroll 8
    for (int i = 0; i < 32; ++i) { const int kk = 2 * i + (lane >> 5); scr[kk * 33 + (lane & 31)] = Wc ? Wc[(size_t)(k0 + kk) * ldw] : 0.f; }
    LDS_WAIT();
    const int c = lane & 7;
#pragma unroll
    for (int j = 0; j < 4; ++j) { const int n = (lane >> 3) + 8 * j; const LAS float* s = scr + (8 * c) * 33 + n;
        u32x4 o; o.x = cvt_pk_bf16(s[0 * 33], s[1 * 33]); o.y = cvt_pk_bf16(s[2 * 33], s[3 * 33]); o.z = cvt_pk_bf16(s[4 * 33], s[5 * 33]); o.w = cvt_pk_bf16(s[6 * 33], s[7 * 33]);
        *(u32x4*)(WT + (size_t)(n0 + n) * ldt + k0 + 8 * c) = o; }
    LDS_WAIT();
}
__device__ __forceinline__ void conv_moe_items(const Args& a, int layer, int it0, int gw, int NGW, LAS float* scr, int lane) {
    unsigned char* wsw = a.ws + WS_W;
    constexpr int I_UP = 32 * 64 * 16, I_DN = 32 * 4 * 128;
    for (int it = gw; it < I_UP + I_DN; it += NGW) {
        (void)it0;
        if (it < I_UP) { const int e = it >> 10, r = it & 1023, kb = r >> 4, nb = r & 15; const int n = 32 * nb + (lane & 31);
            const float* src = ((n & 255) < 128 ? a.in[I_MW1] : a.in[I_MW3]) + ((size_t)(layer * NEXP + e)) * 4096 * 256 + ((n >> 8) * 128 + (n & 127));
            tr_item(src, 256, (bf16_t*)(wsw + W_UP) + (size_t)e * 512 * 4096, 4096, 64 * kb, 32 * nb, scr, lane);
        } else { const int r0 = it - I_UP, e = r0 >> 9, r = r0 & 511, kb = r >> 7, nb = r & 127;
            const float* src = a.in[I_MW2] + ((size_t)(layer * NEXP + e)) * 256 * 4096 + 32 * nb + (lane & 31);
            tr_item(src, 4096, (bf16_t*)(wsw + W_DN) + (size_t)e * 4096 * 256, 256, 64 * kb, 32 * nb, scr, lane); }
    }
    float* rt = (float*)(wsw + W_RT); const float* gf = a.in[I_FFNN] + layer * D;
    for (int i = gw * 64 + lane; i < 36 * D; i += NGW * 64) { const int j = i >> 12, d = i & 4095;
        const float w = j < 4 ? a.in[I_MWG][((size_t)layer * D + d) * 4 + j] : a.in[I_MWE][((size_t)layer * D + d) * 32 + (j - 4)];
        rt[i] = gf[d] * w; }
}
__device__ __forceinline__ void conv_layer0(const Args& a, int gw, int NGW, LAS float* scr, int lane) {
    unsigned char* wsw = a.ws + WS_W;
    constexpr int I_A = 64 * (NW0 / 32), I_B = 64 * 128;
    for (int it = gw; it < I_A + I_B; it += NGW) {
        if (it < I_A) { const int nblk = NW0 / 32, kb = it / nblk, nb = it % nblk; const int n = 32 * nb + (lane & 31);
            const int col = n < 6144 ? n : (n < 12288 ? n + 16 : (n < 12304 ? 6144 + (n - 12288) : (n < 12336 ? n : -1)));
            tr_item(col >= 0 ? a.in[I_EVWIN] + col : nullptr, 12336, (bf16_t*)(wsw + W_IN), 4096, 64 * kb, 32 * nb, scr, lane);
        } else { const int r = it - I_A, kb = r >> 7, nb = r & 127;
            tr_item(a.in[I_EVWOUT] + 32 * nb + (lane & 31), 4096, (bf16_t*)(wsw + W_OUT0), 4096, 64 * kb, 32 * nb, scr, lane); }
    }
    conv_moe_items(a, 0, 0, gw, NGW, scr, lane);
}
__device__ __forceinline__ void conv_layer1(const Args& a, int gw, int NGW, LAS float* scr, int lane) {
    unsigned char* wsw = a.ws + WS_W;
    constexpr int I_A = 64 * 320, I_B = 80 * 128, I_C = 64 * 50;
    for (int it = gw; it < I_A + I_B + I_C; it += NGW) {
        if (it < I_A) { const int kb = it / 320, nb = it % 320;
            tr_item(a.in[I_ODWIN] + 32 * nb + (lane & 31), NPROJ1, (bf16_t*)(wsw + W_IN), 4096, 64 * kb, 32 * nb, scr, lane);
        } else if (it < I_A + I_B) { const int r = it - I_A, kb = r >> 7, nb = r & 127;
            tr_item(a.in[I_ODWOUT] + 32 * nb + (lane & 31), 4096, (bf16_t*)(wsw + W_OUT1), DR, 64 * kb, 32 * nb, scr, lane);
        } else { const int r = it - I_A - I_B, mm = r / 50, q = r % 50, kb = q / 10, nb = q % 10;
            const float* src = ((mm & 1) ? a.in[I_ODWI] : a.in[I_ODWR]) + (size_t)(mm >> 1) * 320 * 320 + 32 * nb + (lane & 31);
            tr_item(src, 320, (bf16_t*)(wsw + W_RI) + (size_t)mm * 320 * 320, 320, 64 * kb, 32 * nb, scr, lane); }
    }
    conv_moe_items(a, 1, 0, gw, NGW, scr, lane);
}

__device__ __forceinline__ void load_row(const float* p, int lane, f32x4 (&v)[16]) {
#pragma unroll
    for (int j = 0; j < 16; ++j) v[j] = *(const f32x4*)(p + (j * 64 + lane) * 4);
}
__device__ __forceinline__ float row_ss(const f32x4 (&v)[16]) { float s = 0.f;
#pragma unroll
    for (int j = 0; j < 16; ++j) s += (v[j][0] * v[j][0] + v[j][1] * v[j][1]) + (v[j][2] * v[j][2] + v[j][3] * v[j][3]);
    return wave_sum(s); }
__device__ __forceinline__ void store_row_bf16_scaled(bf16_t* o, const f32x4 (&v)[16], float rstd, const float* g, int lane) {
#pragma unroll
    for (int j = 0; j < 16; ++j) { const f32x4 gg = *(const f32x4*)(g + (j * 64 + lane) * 4);
        u32x2 w; w.x = cvt_pk_bf16(v[j][0] * rstd * gg[0], v[j][1] * rstd * gg[1]); w.y = cvt_pk_bf16(v[j][2] * rstd * gg[2], v[j][3] * rstd * gg[3]);
        *(u32x2*)(o + (j * 64 + lane) * 4) = w; }
}
__device__ __forceinline__ void zero_row_bf16(bf16_t* o, int lane) {
#pragma unroll
    for (int j = 0; j < 8; ++j) *(u32x4*)(o + (j * 64 + lane) * 8) = (u32x4){0u, 0u, 0u, 0u};
}
__device__ __forceinline__ void add_y(f32x4 (&v)[16], const bf16_t* y, int lane) {
#pragma unroll
    for (int j = 0; j < 16; ++j) { const u32x2 w = *(const u32x2*)(y + (j * 64 + lane) * 4);
        v[j][0] += __uint_as_float(w.x << 16); v[j][1] += __uint_as_float(w.x & 0xffff0000u); v[j][2] += __uint_as_float(w.y << 16); v[j][3] += __uint_as_float(w.y & 0xffff0000u); }
}

__device__ __forceinline__ void p0_rows(const Args& a, int gw, int NGW, int lane) {
    float* H = (float*)(a.ws + WS_H); bf16_t* XN = (bf16_t*)((unsigned char*)a.out + DO_XN);
    for (int r = gw; r < MP; r += NGW) {
        if (row_valid(r)) { const int b = r >= TP ? 1 : 0, p = r - b * TP;
            const float* src = p < 64 ? a.in[I_META] + (size_t)(p - PADF) * D : a.in[I_X] + ((size_t)b * SEQ + (p - 64)) * D;
            f32x4 v[16]; load_row(src, lane, v); const float rstd = rsqrtf(row_ss(v) * (1.0f / D) + EPS);
#pragma unroll
            for (int j = 0; j < 16; ++j) *(f32x4*)(H + (size_t)r * D + (j * 64 + lane) * 4) = v[j];
            store_row_bf16_scaled(XN + (size_t)r * D, v, rstd, a.in[I_MIXN], lane);
        } else {
#pragma unroll
            for (int j = 0; j < 16; ++j) *(f32x4*)(H + (size_t)r * D + (j * 64 + lane) * 4) = (f32x4){0.f, 0.f, 0.f, 0.f};
            zero_row_bf16(XN + (size_t)r * D, lane); }
    }
}
__device__ __forceinline__ void p8_rows(const Args& a, int gw, int NGW, int lane) {
    float* H = (float*)(a.ws + WS_H); bf16_t* XN = (bf16_t*)((unsigned char*)a.out + DO_XN); const bf16_t* Y = (const bf16_t*)(a.ws + WS_HS);
    for (int r = gw; r < MP; r += NGW) {
        if (row_valid(r)) { f32x4 v[16]; load_row(H + (size_t)r * D, lane, v); add_y(v, Y + (size_t)r * D, lane); add_y(v, Y + ((size_t)MP + r) * D, lane);
            const float rstd = rsqrtf(row_ss(v) * (1.0f / D) + EPS);
#pragma unroll
            for (int j = 0; j < 16; ++j) *(f32x4*)(H + (size_t)r * D + (j * 64 + lane) * 4) = v[j];
            store_row_bf16_scaled(XN + (size_t)r * D, v, rstd, a.in[I_MIXN] + D, lane);
        } else zero_row_bf16(XN + (size_t)r * D, lane);
    }
}
__device__ __forceinline__ void pfinal_rows(const Args& a, int gw, int NGW, int lane, int addy) {
    const float* H = (const float*)(a.ws + WS_H); const bf16_t* Y = (const bf16_t*)(a.ws + WS_HS);
    for (int i = gw; i < NBATCH * SEQ; i += NGW) { const int b = i >> 13, t = i & (SEQ - 1), r = b * TP + 64 + t;
        f32x4 v[16]; load_row(H + (size_t)r * D, lane, v); if (addy) { add_y(v, Y + (size_t)r * D, lane); add_y(v, Y + ((size_t)MP + r) * D, lane); }
        const float rstd = rsqrtf(row_ss(v) * (1.0f / D) + EPS);
#pragma unroll
        for (int j = 0; j < 16; ++j) { const f32x4 gg = *(const f32x4*)(a.in[I_FINN] + (j * 64 + lane) * 4);
            *(f32x4*)(a.out + (size_t)i * D + (j * 64 + lane) * 4) = (f32x4){v[j][0] * rstd * gg[0], v[j][1] * rstd * gg[1], v[j][2] * rstd * gg[2], v[j][3] * rstd * gg[3]}; }
    }
}

__device__ __forceinline__ void route_one(const float (&lg)[36], const float* bg, const float* be, int& e1, int& e2, float& w1, float& w2) {
    float gl[4];
#pragma unroll
    for (int g = 0; g < 4; ++g) gl[g] = lg[g] + bg[g];
    int gi = 0; float gm = gl[0];
#pragma unroll
    for (int g = 1; g < 4; ++g) if (gl[g] > gm) { gm = gl[g]; gi = g; }
    float gs = 0.f;
#pragma unroll
    for (int g = 0; g < 4; ++g) gs += __expf(gl[g] - gm);
    const float gval = 1.0f / gs;
    float el[8];
#pragma unroll
    for (int e = 0; e < 8; ++e) { float x = lg[4 + e] + be[e];
#pragma unroll
        for (int g = 1; g < 4; ++g) { const float y = lg[4 + g * 8 + e] + be[g * 8 + e]; x = (gi == g) ? y : x; }
        el[e] = x; }
    int i1 = 0; float m1 = el[0];
#pragma unroll
    for (int e = 1; e < 8; ++e) if (el[e] > m1) { m1 = el[e]; i1 = e; }
    int i2 = -1; float m2 = -3.0e38f;
#pragma unroll
    for (int e = 0; e < 8; ++e) if (e != i1 && el[e] > m2) { m2 = el[e]; i2 = e; }
    const float p2 = __expf(m2 - m1), s = 1.0f / (1.0f + p2);
    e1 = gi * 8 + i1; e2 = gi * 8 + i2; w1 = s * gval; w2 = p2 * s * gval;
}
__device__ __forceinline__ void route_rows(const Args& a, LAS unsigned char* lds, int wave, int layer, int gw, int NGW, int lane) {
    const float* H = (const float*)(a.ws + WS_H); bf16_t* XN = (bf16_t*)((unsigned char*)a.out + DO_XN);
    const float* rt = (const float*)(a.ws + WS_W + W_RT); const float* gf = a.in[I_FFNN] + layer * D;
    const float* bg = a.in[I_MBG] + layer * 4; const float* be = a.in[I_MBE] + layer * 32;
    unsigned* cnt = (unsigned*)(a.ws + WS_CTL) + CW_CNT + layer * 64;
    int* ltok = (int*)((unsigned char*)a.out + DO_LTOK) + (size_t)layer * NEXP * LCAP; float* lw = (float*)((unsigned char*)a.out + DO_LW) + (size_t)layer * NEXP * LCAP;
    for (int pr = gw; pr < MP / 2; pr += NGW) {
        const int r0 = 2 * pr, r1 = r0 + 1; const bool v0 = row_valid(r0), v1 = row_valid(r1);
        if (!v0) zero_row_bf16(XN + (size_t)r0 * D, lane);
        if (!v1) zero_row_bf16(XN + (size_t)r1 * D, lane);
        if (!v0 && !v1) continue;
        f32x4 x0[16], x1[16];
        if (v0) load_row(H + (size_t)r0 * D, lane, x0); else {
#pragma unroll
            for (int j = 0; j < 16; ++j) x0[j] = (f32x4){0.f, 0.f, 0.f, 0.f}; }
        if (v1) load_row(H + (size_t)r1 * D, lane, x1); else {
#pragma unroll
            for (int j = 0; j < 16; ++j) x1[j] = (f32x4){0.f, 0.f, 0.f, 0.f}; }
        const float rs0 = rsqrtf(row_ss(x0) * (1.0f / D) + EPS), rs1 = rsqrtf(row_ss(x1) * (1.0f / D) + EPS);
        LAS float* lgs = (LAS float*)(lds + wave * 512);
#pragma unroll 1
        for (int j = 0; j < 36; ++j) { float s0 = 0.f, s1 = 0.f; const float* wr = rt + (size_t)j * D + lane * 4;
#pragma unroll
            for (int q = 0; q < 16; ++q) { const f32x4 w = *(const f32x4*)(wr + q * 256);
                s0 += (x0[q][0] * w[0] + x0[q][1] * w[1]) + (x0[q][2] * w[2] + x0[q][3] * w[3]);
                s1 += (x1[q][0] * w[0] + x1[q][1] * w[1]) + (x1[q][2] * w[2] + x1[q][3] * w[3]); }
            s0 = wave_sum(s0) * rs0; s1 = wave_sum(s1) * rs1;
            if (lane == 0) { lgs[j] = s0; lgs[36 + j] = s1; } }
        LDS_WAIT();
        if (v0) store_row_bf16_scaled(XN + (size_t)r0 * D, x0, rs0, gf, lane);
        if (v1) store_row_bf16_scaled(XN + (size_t)r1 * D, x1, rs1, gf, lane);
#pragma unroll 1
        for (int which = 0; which < 2; ++which) {
            if (!(which ? v1 : v0)) continue;
            const int r = which ? r1 : r0;
            float lg[36];
#pragma unroll
            for (int j = 0; j < 36; ++j) lg[j] = lgs[which * 36 + j];
            int e1, e2; float w1, w2; route_one(lg, bg, be, e1, e2, w1, w2);
            if (lane == 0) { const unsigned p1 = atomicAdd(&cnt[e1], 1u); ltok[(size_t)e1 * LCAP + p1] = r * 2; lw[(size_t)e1 * LCAP + p1] = w1;
                             const unsigned p2 = atomicAdd(&cnt[e2], 1u); ltok[(size_t)e2 * LCAP + p2] = r * 2 + 1; lw[(size_t)e2 * LCAP + p2] = w2; }
        }
        LDS_WAIT();
    }
}
__device__ __forceinline__ void build_tab(LAS int* tab, const unsigned* cnt) {
    if (threadIdx.x == 0) { int acc = 0;
        for (int e = 0; e < NEXP; ++e) { const int c = (int)__hip_atomic_load(cnt + e, __ATOMIC_RELAXED, __HIP_MEMORY_SCOPE_AGENT); const int nt = (c + 255) >> 8; tab[1 + e] = acc; for (int k = 0; k < nt; ++k) tab[64 + acc + k] = e; acc += nt; }
        tab[0] = acc; }
    __syncthreads();
}
__device__ __forceinline__ void gather_slots(const Args& a, int layer, LAS int* tab, int gw, int NGW, int lane) {
    const unsigned* cnt = (const unsigned*)(a.ws + WS_CTL) + CW_CNT + layer * 64;
    const int* ltok = (const int*)((unsigned char*)a.out + DO_LTOK) + (size_t)layer * NEXP * LCAP; const float* lw = (const float*)((unsigned char*)a.out + DO_LW) + (size_t)layer * NEXP * LCAP;
    const bf16_t* XN = (const bf16_t*)((unsigned char*)a.out + DO_XN); bf16_t* XS = (bf16_t*)(a.ws + XS_OFF);
    int* sdst = (int*)((unsigned char*)a.out + DO_SDST); float* sw = (float*)((unsigned char*)a.out + DO_SW);
    const int NT = tab[0];
    for (int s = gw; s < NT * 256; s += NGW) { const int e = tab[64 + (s >> 8)], pos = s - 256 * tab[1 + e]; const int c = (int)__hip_atomic_load(cnt + e, __ATOMIC_RELAXED, __HIP_MEMORY_SCOPE_AGENT);
        if (pos < c) { const int tok = ltok[(size_t)e * LCAP + pos], r = tok >> 1, k = tok & 1;
#pragma unroll
            for (int j = 0; j < 8; ++j) *(u32x4*)(XS + (size_t)s * D + (j * 64 + lane) * 8) = *(const u32x4*)(XN + (size_t)r * D + (j * 64 + lane) * 8);
            if (lane == 0) { sdst[s] = k * MP + r; sw[s] = lw[(size_t)e * LCAP + pos]; }
        } else if (lane == 0) { sdst[s] = -1; sw[s] = 0.f; }
    }
}

__device__ __forceinline__ void qkconv_rows(const Args& a, int gw, int NGW, int lane) {
    const bf16_t* P = (const bf16_t*)(a.ws + WS_PROJ); bf16_t* Q = (bf16_t*)((unsigned char*)a.out + DO_QKC); const float* cw = a.in[I_EVQKC];
    for (int r = gw; r < MP; r += NGW) {
        if (!row_valid(r)) {
#pragma unroll
            for (int k = 0; k < 4; ++k) *(u32x4*)(Q + (size_t)r * 2048 + k * 512 + lane * 8) = (u32x4){0u, 0u, 0u, 0u};
            continue; }
#pragma unroll
        for (int k = 0; k < 4; ++k) { const int c = k * 512 + lane * 8; float acc[8];
#pragma unroll
            for (int j = 0; j < 8; ++j) acc[j] = 0.f;
#pragma unroll
            for (int t = 0; t < 4; ++t) { const int rr = r + t - 2; const u32x4 raw = *(const u32x4*)(P + (size_t)rr * NPROJ0 + c);
                const f32x4 w0 = *(const f32x4*)(cw + t * 2048 + c), w1 = *(const f32x4*)(cw + t * 2048 + c + 4);
                acc[0] += __uint_as_float(raw.x << 16) * w0[0]; acc[1] += __uint_as_float(raw.x & 0xffff0000u) * w0[1]; acc[2] += __uint_as_float(raw.y << 16) * w0[2]; acc[3] += __uint_as_float(raw.y & 0xffff0000u) * w0[3];
                acc[4] += __uint_as_float(raw.z << 16) * w1[0]; acc[5] += __uint_as_float(raw.z & 0xffff0000u) * w1[1]; acc[6] += __uint_as_float(raw.w << 16) * w1[2]; acc[7] += __uint_as_float(raw.w & 0xffff0000u) * w1[3]; }
            const float sc = c >= 1024 ? 0.0625f : 1.0f;
#pragma unroll
            for (int j = 0; j < 8; ++j) acc[j] = siluf_(acc[j]) * sc;
            u32x4 o; o.x = cvt_pk_bf16(acc[0], acc[1]); o.y = cvt_pk_bf16(acc[2], acc[3]); o.z = cvt_pk_bf16(acc[4], acc[5]); o.w = cvt_pk_bf16(acc[6], acc[7]);
            *(u32x4*)(Q + (size_t)r * 2048 + c) = o; }
    }
}
__device__ __forceinline__ void gla_pre_units(const Args& a, LAS unsigned char* lds, int bid, int nblk) {
    const bf16_t* P = (const bf16_t*)(a.ws + WS_PROJ); const float* SM = (const float*)((unsigned char*)a.out + DO_SMALL);
    LAS float* lrbs = (LAS float*)lds;
    LAS float* toth = (LAS float*)(lds + 4096);
    const int tid = threadIdx.x, c = tid & 255, half = tid >> 8;
    for (int u = bid; u < NBATCH * NCH * 8; u += nblk) {
        const int dir = u & 1, hd = (u >> 1) & 3, n = (u >> 3) % NCH, b = (u >> 3) / NCH;
        bf16_t* GQ = (bf16_t*)(a.ws + WS_G + (size_t)dir * G_STRIDE); bf16_t* GK1 = (bf16_t*)(a.ws + WS_G + (size_t)(2 + dir) * G_STRIDE); bf16_t* GK2 = (bf16_t*)(a.ws + WS_G + (size_t)(4 + dir) * G_STRIDE);
        float* ET = (float*)(a.ws + WS_G + G_ETOT);
        if (tid < 256) { const int i = tid >> 2, q4 = tid & 3; const int pp = 64 * n + i, p = dir ? (TP - 1 - pp) : pp;
            *(LAS f32x4*)(lrbs + i * 16 + q4 * 4) = *(const f32x4*)(SM + (size_t)(b * TP + p) * 64 + 16 + dir * 16 + q4 * 4); }
        float up[16];
#pragma unroll
        for (int rr = 0; rr < 16; ++rr) up[rr] = a.in[I_EVLRUP][(size_t)(dir * 16 + rr) * 1024 + hd * 256 + c];
        const float bias = a.in[I_EVLRB][dir * 1024 + hd * 256 + c];
        __syncthreads();
        float cumv[32]; float run = 0.f;
#pragma unroll
        for (int ii = 0; ii < 32; ++ii) { const int i = half * 32 + ii; const int pp = 64 * n + i, p = dir ? (TP - 1 - pp) : pp;
            float x = bias;
#pragma unroll
            for (int q4 = 0; q4 < 4; ++q4) { const f32x4 l = *(const LAS f32x4*)(lrbs + i * 16 + q4 * 4); x += l[0] * up[q4 * 4] + l[1] * up[q4 * 4 + 1] + l[2] * up[q4 * 4 + 2] + l[3] * up[q4 * 4 + 3]; }
            const float la = p < PADF ? 0.f : logsigf_(x) * 0.0625f; run += la; cumv[ii] = run; }
        toth[half * 256 + c] = run;
        __syncthreads();
        const float off = half ? toth[c] : 0.f, tot = toth[c] + toth[256 + c];
#pragma unroll
        for (int ii = 0; ii < 32; ++ii) { const int i = half * 32 + ii; const int pp = 64 * n + i, p = dir ? (TP - 1 - pp) : pp; const size_t r = (size_t)(b * TP + p);
            const float cum = cumv[ii] + off;
            const float q = bf2f(P[r * NPROJ0 + 6144 + hd * 256 + c]), k = bf2f(P[r * NPROJ0 + 7168 + hd * 256 + c]);
            GQ[r * 1024 + hd * 256 + c] = f2bf(q * 0.0625f * __expf(cum)); GK1[r * 1024 + hd * 256 + c] = f2bf(k * __expf(-cum)); GK2[r * 1024 + hd * 256 + c] = f2bf(k * __expf(tot - cum)); }
        if (half == 0) ET[((size_t)((dir * 2 + b) * NCH + n)) * 1024 + hd * 256 + c] = __expf(tot);
        __syncthreads();
    }
}
__device__ __forceinline__ void headnorm_rows(const Args& a, int gw, int NGW, int lane) {
    bf16_t* HF = (bf16_t*)(a.ws + WS_HS); const bf16_t* HB = (const bf16_t*)(a.ws + WS_HS + HS_STRIDE0); const bf16_t* P = (const bf16_t*)(a.ws + WS_PROJ);
    for (int r = gw; r < MP; r += NGW) {
        if (!row_valid(r)) { zero_row_bf16(HF + (size_t)r * D, lane); continue; }
#pragma unroll
        for (int hg = 0; hg < 8; ++hg) { const int col = hg * 512 + lane * 8;
            const u32x4 f = *(const u32x4*)(HF + (size_t)r * D + col), bb = *(const u32x4*)(HB + (size_t)r * D + col);
            const u32x4 gt = *(const u32x4*)(P + (size_t)r * NPROJ0 + (hg < 4 ? 4096 + col : 10240 + (col - 2048)));
            const float* nw = hg < 4 ? a.in[I_EVNA] + col : a.in[I_EVNB] + (col - 2048);
            float s[8], gv[8];
            const unsigned fw[4] = {f.x, f.y, f.z, f.w}, bw[4] = {bb.x, bb.y, bb.z, bb.w}, gw4[4] = {gt.x, gt.y, gt.z, gt.w};
#pragma unroll
            for (int j = 0; j < 4; ++j) { s[2 * j] = __uint_as_float(fw[j] << 16) + __uint_as_float(bw[j] << 16); s[2 * j + 1] = __uint_as_float(fw[j] & 0xffff0000u) + __uint_as_float(bw[j] & 0xffff0000u);
                gv[2 * j] = __uint_as_float(gw4[j] << 16); gv[2 * j + 1] = __uint_as_float(gw4[j] & 0xffff0000u); }
            float ss = 0.f;
#pragma unroll
            for (int j = 0; j < 8; ++j) ss += s[j] * s[j];
            const float rstd = rsqrtf(wave_sum(ss) * (1.0f / 512.0f) + EPS);
            const f32x4 n0 = *(const f32x4*)nw, n1 = *(const f32x4*)(nw + 4); const float nn[8] = {n0[0], n0[1], n0[2], n0[3], n1[0], n1[1], n1[2], n1[3]};
            float o[8];
#pragma unroll
            for (int j = 0; j < 8; ++j) { const float gate = hg < 4 ? sigmoidf_(gv[j]) : siluf_(gv[j]); o[j] = gate * s[j] * rstd * nn[j]; }
            u32x4 w; w.x = cvt_pk_bf16(o[0], o[1]); w.y = cvt_pk_bf16(o[2], o[3]); w.z = cvt_pk_bf16(o[4], o[5]); w.w = cvt_pk_bf16(o[6], o[7]);
            *(u32x4*)(HF + (size_t)r * D + col) = w; }
    }
}
__device__ __forceinline__ void uconv_rows(const Args& a, int gw, int NGW, int lane) {
    const bf16_t* P = (const bf16_t*)(a.ws + WS_PROJ); bf16_t* U = (bf16_t*)(a.ws + WS_G); const float* cw = a.in[I_ODCONV]; const float* cb = a.in[I_ODCONVB];
    for (int r = gw; r < MP; r += NGW) {
        const bool v = row_valid(r);
#pragma unroll
        for (int k = 0; k < 10; ++k) { const int c = k * 512 + lane * 8;
            if (!v) { *(u32x4*)(U + (size_t)r * DR + c) = (u32x4){0u, 0u, 0u, 0u}; continue; }
            const f32x4 b0 = *(const f32x4*)(cb + c), b1 = *(const f32x4*)(cb + c + 4);
            float acc[8] = {b0[0], b0[1], b0[2], b0[3], b1[0], b1[1], b1[2], b1[3]};
#pragma unroll
            for (int t = 0; t < 4; ++t) { const int rr = r + t - 2; const u32x4 raw = *(const u32x4*)(P + (size_t)rr * NPROJ1 + DR + c);
                const f32x4 w0 = *(const f32x4*)(cw + t * DR + c), w1 = *(const f32x4*)(cw + t * DR + c + 4);
                acc[0] += __uint_as_float(raw.x << 16) * w0[0]; acc[1] += __uint_as_float(raw.x & 0xffff0000u) * w0[1]; acc[2] += __uint_as_float(raw.y << 16) * w0[2]; acc[3] += __uint_as_float(raw.y & 0xffff0000u) * w0[3];
                acc[4] += __uint_as_float(raw.z << 16) * w1[0]; acc[5] += __uint_as_float(raw.z & 0xffff0000u) * w1[1]; acc[6] += __uint_as_float(raw.w << 16) * w1[2]; acc[7] += __uint_as_float(raw.w & 0xffff0000u) * w1[3]; }
            u32x4 o; o.x = cvt_pk_bf16(acc[0], acc[1]); o.y = cvt_pk_bf16(acc[2], acc[3]); o.z = cvt_pk_bf16(acc[4], acc[5]); o.w = cvt_pk_bf16(acc[6], acc[7]);
            *(u32x4*)(U + (size_t)r * DR + c) = o; }
    }
}
__device__ __forceinline__ void rglru_combine_rows(const Args& a, int gw, int NGW, int lane) {
    bf16_t* HF = (bf16_t*)(a.ws + WS_HS); const bf16_t* HB = (const bf16_t*)(a.ws + WS_HS + HS_STRIDE1); const bf16_t* P = (const bf16_t*)(a.ws + WS_PROJ);
    for (int r = gw; r < MP; r += NGW) {
        const bool v = row_valid(r);
#pragma unroll
        for (int k = 0; k < 10; ++k) { const int c = k * 512 + lane * 8;
            if (!v) { *(u32x4*)(HF + (size_t)r * DR + c) = (u32x4){0u, 0u, 0u, 0u}; continue; }
            const u32x4 f = *(const u32x4*)(HF + (size_t)r * DR + c), bb = *(const u32x4*)(HB + (size_t)r * DR + c), gt = *(const u32x4*)(P + (size_t)r * NPROJ1 + c);
            const unsigned fw[4] = {f.x, f.y, f.z, f.w}, bw[4] = {bb.x, bb.y, bb.z, bb.w}, gw4[4] = {gt.x, gt.y, gt.z, gt.w};
            float o[8];
#pragma unroll
            for (int j = 0; j < 4; ++j) { o[2 * j] = gelu_tanhf_(__uint_as_float(gw4[j] << 16)) * (__uint_as_float(fw[j] << 16) + __uint_as_float(bw[j] << 16));
                o[2 * j + 1] = gelu_tanhf_(__uint_as_float(gw4[j] & 0xffff0000u)) * (__uint_as_float(fw[j] & 0xffff0000u) + __uint_as_float(bw[j] & 0xffff0000u)); }
            u32x4 w; w.x = cvt_pk_bf16(o[0], o[1]); w.y = cvt_pk_bf16(o[2], o[3]); w.z = cvt_pk_bf16(o[4], o[5]); w.w = cvt_pk_bf16(o[6], o[7]);
            *(u32x4*)(HF + (size_t)r * DR + c) = w; }
    }
}

constexpr int S0_K1 = 0, S0_K2 = 33792, S0_V = 67584, S0_VW = 76800, S0_SS = 86016, S0_CT = 95232, S0_NV = 129024, S0_RS = 130048, S0_ET = 130560, S0_WS = 131584;
constexpr int KPB = 528  , VPB = 144  ;

template <int KIND>
__device__ __forceinline__ void scan0_unit(const Args& a, LAS unsigned char* lds, int b, int hd, int dir, int sl, size_t hs_off) {
    const int tid = threadIdx.x, w = __builtin_amdgcn_readfirstlane(tid >> 6), lane = tid & 63, g = lane >> 4, l15 = lane & 15, q4 = l15 >> 2, p4 = lane & 3;
    const int mt = w >> 1, np = w & 1;
    const bf16_t* P = (const bf16_t*)(a.ws + WS_PROJ);
    const bf16_t *Qg, *K1g, *K2g, *Vg; int pitchQ;
    if (KIND == 0) { const bf16_t* QK = (const bf16_t*)((unsigned char*)a.out + DO_QKC); Qg = QK + hd * 256; K1g = QK + 1024 + hd * 256; K2g = K1g; pitchQ = 2048; Vg = P + 2048 + hd * 512 + sl * 64; }
    else { Qg = (const bf16_t*)(a.ws + WS_G + (size_t)dir * G_STRIDE) + hd * 256; K1g = (const bf16_t*)(a.ws + WS_G + (size_t)(2 + dir) * G_STRIDE) + hd * 256; K2g = (const bf16_t*)(a.ws + WS_G + (size_t)(4 + dir) * G_STRIDE) + hd * 256; pitchQ = 1024; Vg = P + 8192 + hd * 512 + sl * 64; }
    const float* SM = (const float*)((unsigned char*)a.out + DO_SMALL);
    const float* ETg = (const float*)(a.ws + WS_G + G_ETOT);
    bf16_t* Og = (bf16_t*)(a.ws + hs_off + (size_t)dir * HS_STRIDE0) + KIND * 2048 + hd * 512 + sl * 64;
    const unsigned ldsb = (unsigned)(size_t)lds;
    f32x4 accC[2][4];
#pragma unroll
    for (int mi = 0; mi < 2; ++mi)
#pragma unroll
        for (int ni = 0; ni < 4; ++ni) accC[mi][ni] = (f32x4){0.f, 0.f, 0.f, 0.f};
    for (int i = tid; i < 33792 / 4; i += 512) ((LAS unsigned*)(lds + S0_CT))[i] = 0u;
    if (tid < 256) ((LAS float*)(lds + S0_NV))[tid] = 0.f;
    float m_prev = 0.f;
    float gbi = 0.f, gbf = 0.f;
    if (KIND == 0) { gbi = a.in[I_EVGB][(dir ? 2 : 0) * 4 + hd]; gbf = a.in[I_EVGB][(dir ? 3 : 1) * 4 + hd]; }
    __syncthreads();
    for (int n = 0; n < NCH; ++n) {
        const int base_pp = 64 * n;
#define PROW(i) (dir ? (TP - 1 - (base_pp + (i))) : (base_pp + (i)))
#pragma unroll
        for (int k = 0; k < 4; ++k) { const int id = tid + 512 * k, i = id >> 5, c8 = id & 31; const size_t r = (size_t)(b * TP + PROW(i));
            *(LAS u32x4*)(lds + S0_K1 + i * KPB + c8 * 16) = *(const u32x4*)(K1g + r * pitchQ + c8 * 8);
            if (KIND == 1) *(LAS u32x4*)(lds + S0_K2 + i * KPB + c8 * 16) = *(const u32x4*)(K2g + r * pitchQ + c8 * 8); }
        bf16x8 Qf[8];
        { const size_t r = (size_t)(b * TP + PROW(16 * mt + l15));
#pragma unroll
            for (int ks = 0; ks < 8; ++ks) Qf[ks] = *(const bf16x8*)(Qg + r * pitchQ + 32 * ks + 8 * g); }
        float cum = 0.f, bvec = 0.f, Bt = 0.f, winter = 0.f, floorv = 0.f, wsl = 0.f, decay = 1.f, B63 = 0.f, tot = 0.f;
        if (KIND == 0) { const int p = PROW(lane); const size_t r = (size_t)(b * TP + p);
            const float gi = SM[r * 64 + (dir ? 2 : 0) * 4 + hd] + gbi, gf = SM[r * 64 + (dir ? 3 : 1) * 4 + hd] + gbf;
            const bool pad = p < PADF; const float li = pad ? NEGV : gi, lf = pad ? 0.f : logsigf_(gf);
            cum = lf;
#pragma unroll
            for (int o = 1; o < 64; o <<= 1) { const float t = __shfl_up(cum, o); if (lane >= o) cum += t; }
            bvec = li - cum; float pm = bvec;
#pragma unroll
            for (int o = 1; o < 64; o <<= 1) { const float t = __shfl_up(pm, o); if (lane >= o) pm = fmaxf(pm, t); }
            Bt = fmaxf(m_prev, pm); winter = __expf(m_prev - Bt); floorv = __expf(-(cum + Bt));
            B63 = __shfl(Bt, 63); tot = __shfl(cum, 63); decay = __expf(m_prev - B63); wsl = __expf(bvec - B63);
            if (w == 0) ((LAS float*)(lds + S0_WS))[lane] = wsl; }
        { const int i = tid >> 3, c8 = tid & 7; const size_t r = (size_t)(b * TP + PROW(i));
            const u32x4 v = *(const u32x4*)(Vg + r * NPROJ0 + c8 * 8);
            *(LAS u32x4*)(lds + S0_V + i * VPB + c8 * 16) = v;
            if (KIND == 0) { const float s = __shfl(wsl, i);
                u32x4 o; o.x = cvt_pk_bf16(__uint_as_float(v.x << 16) * s, __uint_as_float(v.x & 0xffff0000u) * s); o.y = cvt_pk_bf16(__uint_as_float(v.y << 16) * s, __uint_as_float(v.y & 0xffff0000u) * s);
                o.z = cvt_pk_bf16(__uint_as_float(v.z << 16) * s, __uint_as_float(v.z & 0xffff0000u) * s); o.w = cvt_pk_bf16(__uint_as_float(v.w << 16) * s, __uint_as_float(v.w & 0xffff0000u) * s);
                *(LAS u32x4*)(lds + S0_VW + i * VPB + c8 * 16) = o; } }
        if (KIND == 1 && tid < 256) ((LAS float*)(lds + S0_ET))[tid] = ETg[((size_t)((dir * 2 + b) * NCH + n)) * 1024 + hd * 256 + tid];
        __syncthreads();
        f32x4 sacc[2], oacc[2];
#pragma unroll
        for (int j = 0; j < 2; ++j) { sacc[j] = (f32x4){0.f, 0.f, 0.f, 0.f}; oacc[j] = (f32x4){0.f, 0.f, 0.f, 0.f}; }
#pragma unroll
        for (int ks = 0; ks < 8; ++ks)
#pragma unroll
            for (int j = 0; j < 2; ++j) { const int nt = 2 * np + j;
                const bf16x8 kf = *(const LAS bf16x8*)(lds + S0_K1 + (16 * nt + l15) * KPB + (32 * ks + 8 * g) * 2);
                sacc[j] = MFMA16(Qf[ks], kf, sacc[j]);
                const bf16x8 cf = *(const LAS bf16x8*)(lds + S0_CT + (16 * nt + l15) * KPB + (32 * ks + 8 * g) * 2);
                oacc[j] = MFMA16(Qf[ks], cf, oacc[j]); }
        float qn = 0.f;
        {
            float rs[4] = {0.f, 0.f, 0.f, 0.f};
#pragma unroll
            for (int j = 0; j < 2; ++j) { const int s = 16 * (2 * np + j) + l15; const float b_s = KIND == 0 ? __shfl(bvec, s) : 0.f;
#pragma unroll
                for (int rr = 0; rr < 4; ++rr) { const int t = 16 * mt + 4 * g + rr; float val;
                    if (KIND == 0) { const float a_t = -__shfl(Bt, t); val = s <= t ? sacc[j][rr] * __expf(a_t + b_s) : 0.f; }
                    else val = s <= t ? sacc[j][rr] : 0.f;
                    rs[rr] += val;
                    *(LAS unsigned short*)(lds + S0_SS + t * VPB + s * 2) = f2bf(val); } }
            if (KIND == 0) {
#pragma unroll
                for (int rr = 0; rr < 4; ++rr) { float v = rs[rr]; v += __shfl_xor(v, 1); v += __shfl_xor(v, 2); v += __shfl_xor(v, 4); v += __shfl_xor(v, 8);
                    if (l15 == 0) ((LAS float*)(lds + S0_RS))[np * 64 + 16 * mt + 4 * g + rr] = v; }
                float qp = 0.f;
#pragma unroll
                for (int ks = 0; ks < 8; ++ks) { const f32x4 n0 = *(const LAS f32x4*)(lds + S0_NV + (32 * ks + 8 * g) * 4), n1 = *(const LAS f32x4*)(lds + S0_NV + (32 * ks + 8 * g + 4) * 4);
                    qp += bf2f((unsigned short)Qf[ks][0]) * n0[0] + bf2f((unsigned short)Qf[ks][1]) * n0[1] + bf2f((unsigned short)Qf[ks][2]) * n0[2] + bf2f((unsigned short)Qf[ks][3]) * n0[3]
                        + bf2f((unsigned short)Qf[ks][4]) * n1[0] + bf2f((unsigned short)Qf[ks][5]) * n1[1] + bf2f((unsigned short)Qf[ks][6]) * n1[2] + bf2f((unsigned short)Qf[ks][7]) * n1[3]; }
                qp += __shfl_xor(qp, 16); qp += __shfl_xor(qp, 32); qn = qp;
            }
        }
        __syncthreads();
#pragma unroll
        for (int mi = 0; mi < 2; ++mi) {
            f32x4 sc;
            if (KIND == 0) sc = (f32x4){decay, decay, decay, decay};
            else sc = *(const LAS f32x4*)(lds + S0_ET + (16 * (2 * w + mi) + 4 * g) * 4);
#pragma unroll
            for (int ni = 0; ni < 4; ++ni) accC[mi][ni] = accC[mi][ni] * sc; }
#pragma unroll
        for (int ks = 0; ks < 2; ++ks) {
            bf16x8 af[2], bfv[4];
            const unsigned rowb = (unsigned)(32 * ks + 8 * g + q4);
#pragma unroll
            for (int mi = 0; mi < 2; ++mi) { const unsigned ad = ldsb + (KIND == 0 ? S0_K1 : S0_K2) + rowb * KPB + (16 * (2 * w + mi) + 4 * p4) * 2; af[mi] = tr_frag(ad, ad + 4 * KPB); }
#pragma unroll
            for (int ni = 0; ni < 4; ++ni) { const unsigned ad = ldsb + (KIND == 0 ? S0_VW : S0_V) + rowb * VPB + (16 * ni + 4 * p4) * 2; bfv[ni] = tr_frag(ad, ad + 4 * VPB); }
#pragma unroll
            for (int mi = 0; mi < 2; ++mi)
#pragma unroll
                for (int ni = 0; ni < 4; ++ni) accC[mi][ni] = MFMA16(af[mi], bfv[ni], accC[mi][ni]); }
#pragma unroll
        for (int mi = 0; mi < 2; ++mi)
#pragma unroll
            for (int ni = 0; ni < 4; ++ni) { u32x2 o; o.x = cvt_pk_bf16(accC[mi][ni][0], accC[mi][ni][1]); o.y = cvt_pk_bf16(accC[mi][ni][2], accC[mi][ni][3]);
                *(LAS u32x2*)(lds + S0_CT + (16 * ni + l15) * KPB + (16 * (2 * w + mi) + 4 * g) * 2) = o; }
        if (KIND == 0 && tid < 256) { float acc = decay * ((LAS float*)(lds + S0_NV))[tid];
#pragma unroll 8
            for (int s = 0; s < 64; ++s) acc += ((LAS float*)(lds + S0_WS))[s] * bf2f(*(const LAS unsigned short*)(lds + S0_K1 + s * KPB + tid * 2));
            ((LAS float*)(lds + S0_NV))[tid] = acc; }
        if (KIND == 0) {
#pragma unroll
            for (int rr = 0; rr < 4; ++rr) { const float wi = __shfl(winter, 16 * mt + 4 * g + rr);
#pragma unroll
                for (int j = 0; j < 2; ++j) oacc[j][rr] *= wi; } }
#pragma unroll
        for (int ks = 0; ks < 2; ++ks) { const bf16x8 sf = *(const LAS bf16x8*)(lds + S0_SS + (16 * mt + l15) * VPB + (32 * ks + 8 * g) * 2);
            const unsigned rowb = (unsigned)(32 * ks + 8 * g + q4);
#pragma unroll
            for (int j = 0; j < 2; ++j) { const unsigned ad = ldsb + S0_V + rowb * VPB + (16 * (2 * np + j) + 4 * p4) * 2; const bf16x8 vf = tr_frag(ad, ad + 4 * VPB);
                oacc[j] = MFMA16(sf, vf, oacc[j]); } }
#pragma unroll
        for (int rr = 0; rr < 4; ++rr) { const int t = 16 * mt + 4 * g + rr; const size_t r = (size_t)(b * TP + PROW(t));
            float inv = 1.f;
            if (KIND == 0) { const float wi = __shfl(winter, t), fl = __shfl(floorv, t), qnt = __shfl(qn, 4 * g + rr);
                const float den = wi * qnt + ((LAS float*)(lds + S0_RS))[t] + ((LAS float*)(lds + S0_RS))[64 + t];
                inv = 1.0f / fmaxf(fabsf(den), fl); }
#pragma unroll
            for (int j = 0; j < 2; ++j) Og[r * D + 16 * (2 * np + j) + l15] = f2bf(oacc[j][rr] * inv); }
        if (KIND == 0) m_prev = tot + B63;
        __syncthreads();
#undef PROW
    }
}

constexpr int S1_BT = 0, S1_A = 104960, S1_COMP = 146944, S1_HP = 149504;
constexpr int APB = 656;
__device__ __forceinline__ void scan1_unit(const Args& a, LAS unsigned char* lds, int b, int nb, int dir, int q) {
    const int tid = threadIdx.x, w = __builtin_amdgcn_readfirstlane(tid >> 6), lane = tid & 63, g = lane >> 4, l15 = lane & 15;
    const int mt = w >> 1, par = w & 1, nj = par ? 2 : 3, j0 = par * 3;
    const bf16_t* U = (const bf16_t*)(a.ws + WS_G); const bf16_t* WRI = (const bf16_t*)(a.ws + WS_W + W_RI);
    bf16_t* Og = (bf16_t*)(a.ws + WS_HS + (size_t)dir * HS_STRIDE1) + nb * 320 + q * 80;
    for (int id = tid; id < 160 * 40; id += 512) { const int row = id / 40, pc = id % 40, which = row / 80, col = 80 * q + row % 80;
        *(LAS u32x4*)(lds + S1_BT + row * APB + pc * 16) = *(const u32x4*)(WRI + ((size_t)(((dir * 16 + nb) * 2 + which) * 320 + col)) * 320 + pc * 8); }
    if (tid < 160) ((LAS float*)(lds + S1_HP))[tid] = 0.f;
    float br[3], bi[3], sp[3];
#pragma unroll
    for (int jj = 0; jj < 3; ++jj) { const int col = 16 * ((j0 + jj) < 5 ? (j0 + jj) : 4) + l15, gc = dir * DR + nb * 320 + q * 80 + col;
        br[jj] = a.in[I_ODBR][gc]; bi[jj] = a.in[I_ODBI][gc]; sp[jj] = softplusf_(-a.in[I_ODLAM][gc]); }
    __syncthreads();
    for (int ti = 0; ti < NCH; ++ti) {
        const int base_pp = 64 * ti;
#define PROW(i) (dir ? (TP - 1 - (base_pp + (i))) : (base_pp + (i)))
#pragma unroll
        for (int k = 0; k < 5; ++k) { const int id = tid + 512 * k, i = id / 40, pc = id % 40; const size_t r = (size_t)(b * TP + PROW(i));
            *(LAS u32x4*)(lds + S1_A + i * APB + pc * 16) = *(const u32x4*)(U + r * DR + nb * 320 + pc * 8); }
        __syncthreads();
        f32x4 racc[3], iacc[3];
#pragma unroll
        for (int jj = 0; jj < 3; ++jj) { racc[jj] = (f32x4){0.f, 0.f, 0.f, 0.f}; iacc[jj] = (f32x4){0.f, 0.f, 0.f, 0.f}; }
#pragma unroll
        for (int ks = 0; ks < 10; ++ks) { const bf16x8 af = *(const LAS bf16x8*)(lds + S1_A + (16 * mt + l15) * APB + (32 * ks + 8 * g) * 2);
#pragma unroll
            for (int jj = 0; jj < 3; ++jj) if (jj < nj) { const int j = j0 + jj;
                const bf16x8 bfr = *(const LAS bf16x8*)(lds + S1_BT + (16 * j + l15) * APB + (32 * ks + 8 * g) * 2);
                const bf16x8 bfi = *(const LAS bf16x8*)(lds + S1_BT + (80 + 16 * j + l15) * APB + (32 * ks + 8 * g) * 2);
                racc[jj] = MFMA16(af, bfr, racc[jj]); iacc[jj] = MFMA16(af, bfi, iacc[jj]); } }
        float Ap[3][4], Hp[3][4];
#pragma unroll
        for (int jj = 0; jj < 3; ++jj) if (jj < nj) { const int col = 16 * (j0 + jj) + l15;
            float A = 1.f, Hh = 0.f;
#pragma unroll
            for (int rr = 0; rr < 4; ++rr) { const int t = 16 * mt + 4 * g + rr; const bool pad = PROW(t) < PADF;
                const float rg = sigmoidf_(racc[jj][rr] + br[jj]), ig = sigmoidf_(iacc[jj][rr] + bi[jj]);
                const float la = -8.0f * rg * sp[jj]; float av = __expf(la); const float mult = sqrtf(fmaxf(0.f, -expm1f(2.0f * la)));
                const float uval = bf2f(*(const LAS unsigned short*)(lds + S1_A + t * APB + (80 * q + col) * 2));
                float inp = mult * ig * uval; if (pad) { av = 1.f; inp = 0.f; }
                Hh = av * Hh + inp; A = av * A; Ap[jj][rr] = A; Hp[jj][rr] = Hh; }
            const float cA = Ap[jj][3], cH = Hp[jj][3];
            float gA = 1.f, gH = 0.f, mA = 1.f, mH = 0.f;
#pragma unroll
            for (int gg = 0; gg < 4; ++gg) { const float xa = __shfl(cA, gg * 16 + l15), xh = __shfl(cH, gg * 16 + l15);
                if (gg < g) { gH = xa * gH + xh; gA = xa * gA; }
                mH = xa * mH + xh; mA = xa * mA; }
#pragma unroll
            for (int rr = 0; rr < 4; ++rr) { Hp[jj][rr] = Hp[jj][rr] + Ap[jj][rr] * gH; Ap[jj][rr] = Ap[jj][rr] * gA; }
            if (g == 0) *(LAS f32x2*)(lds + S1_COMP + (mt * 80 + col) * 8) = (f32x2){mA, mH};
        }
        __syncthreads();
#pragma unroll
        for (int jj = 0; jj < 3; ++jj) if (jj < nj) { const int col = 16 * (j0 + jj) + l15;
            float hp = ((LAS float*)(lds + S1_HP))[(ti & 1) * 80 + col];
#pragma unroll
            for (int mm = 0; mm < 3; ++mm) if (mm < mt) { const f32x2 c = *(const LAS f32x2*)(lds + S1_COMP + (mm * 80 + col) * 8); hp = c[0] * hp + c[1]; }
#pragma unroll
            for (int rr = 0; rr < 4; ++rr) { const int t = 16 * mt + 4 * g + rr; const size_t r = (size_t)(b * TP + PROW(t));
                Og[r * DR + col] = f2bf(Hp[jj][rr] + Ap[jj][rr] * hp); }
            if (mt == 3 && g == 0) { const f32x2 c = *(const LAS f32x2*)(lds + S1_COMP + (3 * 80 + col) * 8); ((LAS float*)(lds + S1_HP))[((ti + 1) & 1) * 80 + col] = c[0] * hp + c[1]; }
        }
#undef PROW
    }
    __syncthreads();
}

constexpr int NPH = 21;
__global__ void __launch_bounds__(512, 2) fwd_kernel(Args a) {
    extern __shared__ __attribute__((aligned(16))) unsigned char lds_raw[];
    LAS unsigned char* lds = (LAS unsigned char*)lds_raw;
    const int tid = threadIdx.x, lane = tid & 63, wave = __builtin_amdgcn_readfirstlane(tid >> 6);
    const int G = gridDim.x, bid = blockIdx.x, gw = bid * 8 + wave, NGW = G * 8;
    if (tid < 4) ((LAS unsigned*)(lds + LDS_XB))[tid] = 0u;
    __syncthreads();
    XcdBarrier bar; bar.bar = (unsigned*)(a.ws + WS_CTL) + CW_BAR; bar.x = 0; bar.st = nullptr;
#if MK_FUSED
    bar = xcd_barrier_post((unsigned*)(a.ws + WS_CTL) + CW_BAR, (volatile LAS unsigned*)(lds + LDS_XB));
#endif
    const int lo = a.ph_lo, hi = a.ph_hi;
#ifndef ONLY
#define ONLY -1
#endif
#define XN ((bf16_t*)((unsigned char*)a.out + DO_XN))
#define SMALL ((float*)((unsigned char*)a.out + DO_SMALL))
#define PROJ ((bf16_t*)(a.ws + WS_PROJ))
#define H ((float*)(a.ws + WS_H))
#define WIN ((const bf16_t*)(a.ws + WS_W + W_IN))
#define scr ((LAS float*)(lds + wave * 16384))
#define tab ((LAS int*)(lds + LDS_TAB))
#define IN(k) ((ONLY < 0 || ONLY == (k)) && lo <= (k) && (k) < hi)
#define SEAM(k) do { if (MK_FUSED && IN(k) && IN((k) + 1)) xcd_barrier(bar); } while (0)

    if (IN(0)) { conv_layer0(a, gw, NGW, scr, lane); p0_rows(a, gw, NGW, lane); }
    SEAM(0);
    if (IN(1)) { pg8::Gemm g{XN, WIN, D, D, D}; pg8::StaticOrder S; S.init(MP, NW0, G, bid); pg8::EpiProj E{PROJ, NPROJ0, NPROJ0 / 256, SMALL}; pg8::gemm_phase(lds, g, S, E); }
    SEAM(1);
    if (IN(2)) { qkconv_rows(a, gw, NGW, lane); gla_pre_units(a, lds, bid, G); }
    SEAM(2);
    if (IN(3)) { for (int u = bid; u < 256; u += G) { const int grp = u & 31, sl = u >> 5, kind = grp & 1, dir = (grp >> 1) & 1, hd = (grp >> 2) & 3, b = grp >> 4;
            if (kind == 0) scan0_unit<0>(a, lds, b, hd, dir, sl, (a.flags & 2) ? WS_H : WS_HS); else scan0_unit<1>(a, lds, b, hd, dir, sl, (a.flags & 2) ? WS_H : WS_HS); } }
    SEAM(3);
    if (IN(4)) headnorm_rows(a, gw, NGW, lane);
    SEAM(4);
    if (IN(5)) { pg8::Gemm g{(const bf16_t*)(a.ws + WS_HS), (const bf16_t*)(a.ws + WS_W + W_OUT0), D, D, D}; pg8::StaticOrder S; S.init(MP, D, G, bid); pg8::EpiResAdd E{H, D}; pg8::gemm_phase(lds, g, S, E); }
    SEAM(5);
#define MOE_PHASES(P, layer) \
    if (IN(P)) route_rows(a, lds, wave, layer, gw, NGW, lane); \
    SEAM(P); \
    if (IN((P) + 1)) { build_tab(tab, (const unsigned*)(a.ws + WS_CTL) + CW_CNT + (layer) * 64); gather_slots(a, layer, tab, gw, NGW, lane); } \
    SEAM((P) + 1); \
    if (IN((P) + 2)) { build_tab(tab, (const unsigned*)(a.ws + WS_CTL) + CW_CNT + (layer) * 64); \
        pg8::Gemm g{(const bf16_t*)(a.ws + XS_OFF), (const bf16_t*)(a.ws + WS_W + W_UP), D, D, D}; pg8::MoeOrder S{tab, 2, G, bid}; \
        pg8::EpiMoeUp E{(bf16_t*)(a.ws + HID_OFF), (const float*)((unsigned char*)a.out + DO_SW)}; pg8::gemm_phase(lds, g, S, E); } \
    SEAM((P) + 2); \
    if (IN((P) + 3)) { build_tab(tab, (const unsigned*)(a.ws + WS_CTL) + CW_CNT + (layer) * 64); \
        pg8::Gemm g{(const bf16_t*)(a.ws + HID_OFF), (const bf16_t*)(a.ws + WS_W + W_DN), DEXP, DEXP, DEXP}; pg8::MoeOrder S{tab, 16, G, bid}; \
        pg8::EpiMoeDn E{(bf16_t*)(a.ws + WS_HS), (const int*)((unsigned char*)a.out + DO_SDST)}; pg8::gemm_phase(lds, g, S, E); } \
    SEAM((P) + 3);
    MOE_PHASES(6, 0)
    if (IN(10)) { conv_layer1(a, gw, NGW, scr, lane); p8_rows(a, gw, NGW, lane); }
    SEAM(10);
    if (IN(11)) { pg8::Gemm g{XN, WIN, D, D, D}; pg8::StaticOrder S; S.init(MP, NPROJ1, G, bid); pg8::EpiProj E{PROJ, NPROJ1, NPROJ1 / 256, nullptr}; pg8::gemm_phase(lds, g, S, E); }
    SEAM(11);
    if (IN(12)) uconv_rows(a, gw, NGW, lane);
    SEAM(12);
    if (IN(13)) { for (int u = bid; u < 256; u += G) { const int grp = u & 63, q = u >> 6, dir = grp & 1, nb = (grp >> 1) & 15, b = grp >> 5; scan1_unit(a, lds, b, nb, dir, q); } }
    SEAM(13);
    if (IN(14)) rglru_combine_rows(a, gw, NGW, lane);
    SEAM(14);
    if (IN(15)) { pg8::Gemm g{(const bf16_t*)(a.ws + WS_HS), (const bf16_t*)(a.ws + WS_W + W_OUT1), DR, DR, DR}; pg8::StaticOrder S; S.init(MP, D, G, bid); pg8::EpiResAdd E{H, D}; pg8::gemm_phase(lds, g, S, E); }
    SEAM(15);
    MOE_PHASES(16, 1)
#ifndef PROBE
#define PROBE 0
#endif
#if PROBE == 9
    if (IN(20)) { const unsigned* s1 = (const unsigned*)(a.ws + WS_HS); const unsigned* s2 = (const unsigned*)(a.ws + WS_H); unsigned cntd = 0;
        for (size_t i = (size_t)bid * 512 + threadIdx.x; i < (size_t)MR * D; i += (size_t)G * 512) { const unsigned x = s1[i], y = s2[i]; cntd += ((x & 0xffffu) != (y & 0xffffu)) + ((x >> 16) != (y >> 16)); }
        cntd = (unsigned)wave_sum((float)cntd); if (lane == 0 && cntd) atomicAdd((unsigned*)(a.ws + WS_CTL) + 32768, cntd); }
    if (lo == 21) { const unsigned c = *((const unsigned*)(a.ws + WS_CTL) + 32768);
        for (size_t i = (size_t)bid * 512 + threadIdx.x; i < (size_t)NBATCH * SEQ * D; i += (size_t)G * 512) a.out[i] = (i == 0) ? sqrtf(67108864.0f * (float)c) : 0.f; }
#elif PROBE
    if (IN(20)) { const bf16_t* src = (const bf16_t*)(a.ws + (PROBE == 1 ? WS_PROJ : PROBE == 2 ? WS_G : PROBE == 3 ? WS_HS : PROBE == 4 ? (WS_HS + HS_STRIDE0) : PROBE == 7 ? (WS_PROJ + (size_t)134217728) : PROBE == 8 ? (WS_PROJ + (size_t)268435456) : WS_PROJ));
        for (size_t i = (size_t)bid * 512 + threadIdx.x; i < (size_t)NBATCH * SEQ * D; i += (size_t)G * 512) a.out[i] = bf2f(src[i]); }
#else
    if (IN(20)) pfinal_rows(a, gw, NGW, lane, a.flags & 1);
#endif
#undef IN
#undef SEAM
#undef MOE_PHASES
#undef XN
#undef SMALL
#undef PROJ
#undef H
#undef WIN
#undef scr
#undef tab
}

extern "C" void kernel_launch(void* const* d_in, const int* in_sizes, int n_in, void* d_out, int out_size, void* d_ws, size_t ws_size, hipStream_t stream) {
    static int grid = 0;
    if (grid == 0) {
        if (n_in != 29 || out_size != NBATCH * SEQ * D || ws_size < WS_END) { fprintf(stderr, "kernel_launch: unexpected problem: n_in %d out %d a.ws %zu (need %zu)\n", n_in, out_size, ws_size, (size_t)WS_END); grid = -1; return; }
        int dev = 0, cus = 0, per_cu = 0;
        if (hipGetDevice(&dev) != hipSuccess || hipDeviceGetAttribute(&cus, hipDeviceAttributeMultiprocessorCount, dev) != hipSuccess) { grid = -1; return; }
        if (hipFuncSetAttribute((const void*)fwd_kernel, hipFuncAttributeMaxDynamicSharedMemorySize, LDS_BYTES) != hipSuccess) { fprintf(stderr, "kernel_launch: hipFuncSetAttribute failed\n"); grid = -1; return; }
        if (hipOccupancyMaxActiveBlocksPerMultiprocessor(&per_cu, (const void*)fwd_kernel, 512, LDS_BYTES) != hipSuccess || per_cu < 1) fprintf(stderr, "kernel_launch: occupancy query says %d\n", per_cu);
        (void)hipGetLastError();
        grid = cus > 256 ? 256 : cus;
    }
    if (grid < 0) return;
    (void)in_sizes;
    if (hipMemsetAsync((char*)d_ws + WS_CTL, 0, CTL_BYTES, stream) != hipSuccess) return;
    Args a{};
    for (int i = 0; i < 29; ++i) a.in[i] = (const float*)d_in[i];
    a.out = (float*)d_out; a.ws = (unsigned char*)d_ws;
#if MK_FUSED
    a.ph_lo = 0; a.ph_hi = NPH; a.flags = 1;
    hipLaunchKernelGGL(fwd_kernel, dim3(grid), dim3(512), LDS_BYTES, stream, a);
#else
#ifndef DBG_STOP
#define DBG_STOP 20
#endif
    a.flags = (DBG_STOP >= 10) ? 1 : 0;
#if PROBE == 9
    for (int p = 0; p < 4; ++p) { a.ph_lo = p; a.ph_hi = p + 1; a.flags = 0; hipLaunchKernelGGL(fwd_kernel, dim3(grid), dim3(512), LDS_BYTES, stream, a); }
    a.ph_lo = 3; a.ph_hi = 4; a.flags = 2; hipLaunchKernelGGL(fwd_kernel, dim3(grid), dim3(512), LDS_BYTES, stream, a);
    a.ph_lo = 20; a.ph_hi = 21; a.flags = 0; hipLaunchKernelGGL(fwd_kernel, dim3(grid), dim3(512), LDS_BYTES, stream, a);
    a.ph_lo = 21; a.ph_hi = 22; hipLaunchKernelGGL(fwd_kernel, dim3(grid), dim3(512), LDS_BYTES, stream, a);
#else
    for (int p = 0; p < NPH; ++p) { if (p >= DBG_STOP && p != 20) continue; a.ph_lo = p; a.ph_hi = p + 1; hipLaunchKernelGGL(fwd_kernel, dim3(grid), dim3(512), LDS_BYTES, stream, a); }
#endif
#endif
}
```

```cpp
#include <hip/hip_runtime.h>
#include <cstdio>
#include <cstdint>

#ifndef MK_FUSED
#define MK_FUSED 1
#endif

#define LAS __attribute__((address_space(3)))
typedef unsigned short bf16_t;
typedef short bf16x8 __attribute__((ext_vector_type(8)));
typedef short s16x4 __attribute__((ext_vector_type(4)));
typedef float f32x4 __attribute__((ext_vector_type(4)));
typedef float f32x2 __attribute__((ext_vector_type(2)));
typedef unsigned u32x4 __attribute__((ext_vector_type(4)));
typedef unsigned u32x2 __attribute__((ext_vector_type(2)));

constexpr int D = 4096, NBATCH = 2, SEQ = 8192, NMETA = 16, TP = 8256  , NCH = 129, PADF = 48;
constexpr int MR = NBATCH * TP;
constexpr int MP = 16640;
constexpr int NPROJ0 = 12288, NW0 = 12544, NPROJ1 = 10240, DR = 5120;
constexpr int NEXP = 32, DEXP = 256, SLOTS = 41216  ;
constexpr float EPS = 1e-6f;
constexpr float NEGV = -1e30f;

constexpr size_t MiB = 1u << 20;
constexpr size_t WS_CTL = 0, CTL_BYTES = 1 * MiB;
constexpr size_t WS_W = 1 * MiB;
constexpr size_t W_IN = 0, W_OUT0 = 98 * MiB, W_OUT1 = 80 * MiB, W_RI = 120 * MiB, W_UP = 134 * MiB, W_DN = 262 * MiB, W_RT = 326 * MiB;
constexpr size_t WS_H = 329 * MiB;
constexpr size_t WS_PROJ = 589 * MiB;
constexpr size_t WS_HS = 979 * MiB;
constexpr size_t WS_G = 1304 * MiB;
constexpr size_t WS_END = 1502 * MiB;
constexpr size_t XS_OFF = WS_PROJ, HID_OFF = WS_PROJ + 322 * MiB;
constexpr size_t HS_STRIDE0 = (size_t)MP * 4096 * 2, HS_STRIDE1 = (size_t)MP * DR * 2;
constexpr size_t G_STRIDE = (size_t)MP * 1024 * 2, G_ETOT = 195 * MiB;
constexpr size_t DO_XN = 0, DO_QKC = 130 * MiB, DO_SMALL = 195 * MiB, DO_LTOK = 200 * MiB, DO_LW = 205 * MiB, DO_SDST = 210 * MiB, DO_SW = 211 * MiB;
constexpr int LCAP = 16416;
constexpr int CW_BAR = 4096, CW_CNT = 16384;

constexpr int LDS_BYTES = 159744;
constexpr int LDS_XB = LDS_BYTES - 16;
constexpr int LDS_TAB = LDS_BYTES - 16 - 2048;

__device__ __forceinline__ float bf2f(unsigned short b) { return __uint_as_float(((unsigned)b) << 16); }
typedef __bf16 bf16v2 __attribute__((ext_vector_type(2)));
__device__ __forceinline__ unsigned cvt_pk_bf16(float lo, float hi) { const f32x2 v = {lo, hi}; return __builtin_bit_cast(unsigned, __builtin_convertvector(v, bf16v2)); }
__device__ __forceinline__ unsigned short f2bf(float f) { return (unsigned short)(cvt_pk_bf16(f, 0.f) & 0xffffu); }
__device__ __forceinline__ float sigmoidf_(float x) { return 1.0f / (1.0f + __expf(-x)); }
__device__ __forceinline__ float siluf_(float x) { return x * sigmoidf_(x); }
__device__ __forceinline__ float logsigf_(float x) { return fminf(x, 0.f) - log1pf(__expf(-fabsf(x))); }
__device__ __forceinline__ float softplusf_(float x) { return fmaxf(x, 0.f) + log1pf(__expf(-fabsf(x))); }
__device__ __forceinline__ float gelu_tanhf_(float x) { const float u = 0.7978845608028654f * (x + 0.044715f * x * x * x); const float t = 1.0f - 2.0f / (__expf(2.0f * u) + 1.0f); return 0.5f * x * (1.0f + t); }
__device__ __forceinline__ float wave_sum(float v) {
#pragma unroll
    for (int o = 1; o < 64; o <<= 1) v += __shfl_xor(v, o);
    return v;
}
__device__ __forceinline__ bool row_valid(int r) { if (r >= MR) return false; const int p = r >= TP ? r - TP : r; return p >= PADF; }
__device__ __forceinline__ s16x4 tr_read(unsigned lds_addr) { s16x4 r; asm volatile("ds_read_b64_tr_b16 %0, %1\n\ts_waitcnt lgkmcnt(0)" : "=&v"(r) : "v"(lds_addr) : "memory"); return r; }
__device__ __forceinline__ bf16x8 tr_frag(unsigned a0, unsigned a1) {
    s16x4 x, y; asm volatile("ds_read_b64_tr_b16 %0, %2\n\tds_read_b64_tr_b16 %1, %3\n\ts_waitcnt lgkmcnt(0)" : "=&v"(x), "=&v"(y) : "v"(a0), "v"(a1) : "memory");
    bf16x8 r; r[0] = x[0]; r[1] = x[1]; r[2] = x[2]; r[3] = x[3]; r[4] = y[0]; r[5] = y[1]; r[6] = y[2]; r[7] = y[3]; return r;
}
#define MFMA16(a, b, c) __builtin_amdgcn_mfma_f32_16x16x32_bf16((a), (b), (c), 0, 0, 0)

namespace pg8 {
constexpr int BM = 256, BK = 64, HALF = 128, HTB = HALF * BK * 2, STAGE_BYTES = 8 * HTB, NXCD = 8, WGM = 8;
__host__ __device__ __forceinline__ int lds_byte(int r, int c) { const int st = (r >> 4) * 2 + (c >> 5), rr = r & 15, cc = c & 31, ob = rr * 64 + cc * 2; return st * 1024 + (ob ^ (((ob >> 9) & 1) << 5)); }
__host__ __device__ __forceinline__ void stage_rc(int b, int& R, int& C) { const int st = b / 1024, sb = b % 1024, swz = sb ^ (((sb >> 9) & 1) << 5); R = (st >> 1) * 16 + swz / 64; C = (st & 1) * 32 + (swz % 64) / 2; }
__host__ __device__ __forceinline__ int perm32(int rho) { const int n = rho >> 4, i = rho & 15; return 8 * (i >> 2) + 4 * n + (i & 3); }
struct Unit { int pm, pn; };
struct Gemm { const bf16_t* A; const bf16_t* Bt; int lda, ldb, K; };
struct StaticOrder {
    int nM, nN, nwg, G, c;
    __device__ void init(int M, int N, int G_, int c_) { nM = M / BM; nN = N / BM; nwg = nM * nN; G = G_; c = c_; }
    __device__ bool next(int i, Unit& u) const {
        const long L = (long)i * G + c; if (L >= nwg) return false;
        int wgid = (int)L; { const int q = nwg / NXCD, r = nwg % NXCD, xcd = wgid % NXCD, off = wgid / NXCD; wgid = (xcd < r ? xcd * (q + 1) : r * (q + 1) + (xcd - r) * q) + off; }
        const int nig = WGM * nN, gid = wgid / nig, fm = gid * WGM, gsz = (nM - fm) < WGM ? (nM - fm) : WGM;
        u.pm = fm + ((wgid % nig) % gsz); u.pn = (wgid % nig) / gsz; return true;
    }
};
struct MoeOrder {
    const LAS int* tab; int npn, G, c;
    __device__ bool next(int i, Unit& u) const {
        const int NT = __builtin_amdgcn_readfirstlane(tab[0]); const int L = i * G + c; if (L >= NT * npn) return false;
        const int pm = L / npn, ct = L % npn; u.pm = pm; u.pn = __builtin_amdgcn_readfirstlane(tab[64 + pm]) * npn + ct; return true;
    }
};

template <class Epi, class Sched>
__device__ __forceinline__ void gemm_phase(LAS unsigned char* lds, const Gemm g, const Sched& S, const Epi& E) {
    const int tid = threadIdx.x, wid = __builtin_amdgcn_readfirstlane(tid >> 6), lane = tid & 63, wr = wid >> 2, wc = wid & 3, fr = lane & 15, fq = lane >> 4;
    int K = g.K; asm volatile("" : "+s"(K));
    const int nt = K / BK;
    unsigned voffA[2], voffB[2];
#pragma unroll
    for (int i = 0; i < 2; ++i) { int R, C; stage_rc(tid * 16 + i * 8192, R, C); const int Rb = Epi::PERM ? ((R & ~31) + perm32(R & 31)) : R;
        voffA[i] = (unsigned)(R * g.lda + C) * 2u; voffB[i] = (unsigned)(Rb * g.ldb + C) * 2u; }
    const size_t kstep = (size_t)(BK * 2);
    const size_t hstepA = (size_t)HALF * g.lda * 2, hstepB = (size_t)HALF * g.ldb * 2;
    const size_t tstepA = 2 * hstepA, tstepB = 2 * hstepB;
    const unsigned ldsw = (unsigned)wid * 1024u;
    const int aoff = lds_byte(wr * 64 + fr, fq * 8), boff = lds_byte(wc * 32 + fr, fq * 8);
#define PG8_SA(b, h) (((b) * 2 + (h)) * HTB)
#define PG8_SB(b, h) ((4 + (b) * 2 + (h)) * HTB)
#define PG8_STAGE(bufoff, gbase, voff) do { _Pragma("unroll") for (int _i = 0; _i < 2; ++_i) \
        __builtin_amdgcn_global_load_lds((const unsigned*)((const char*)(gbase) + (voff)[_i]), (LAS unsigned*)(lds + (bufoff) + ldsw + _i * 8192), 16, 0, 0); } while (0)
#define PG8_LDA(dst, b, h) do { _Pragma("unroll") for (int m = 0; m < 4; ++m) _Pragma("unroll") for (int k = 0; k < 2; ++k) dst[m][k] = *(const LAS bf16x8*)(lds + PG8_SA(b, h) + aoff + m * 2048 + k * 1024); } while (0)
#define PG8_LDB(dst, b, h) do { _Pragma("unroll") for (int n = 0; n < 2; ++n) _Pragma("unroll") for (int k = 0; k < 2; ++k) dst[n][k] = *(const LAS bf16x8*)(lds + PG8_SB(b, h) + boff + n * 2048 + k * 1024); } while (0)
#define PG8_MMA(ai, bj, At, Bt) do { __builtin_amdgcn_s_setprio(1); _Pragma("unroll") for (int m = 0; m < 4; ++m) _Pragma("unroll") for (int n = 0; n < 2; ++n) _Pragma("unroll") for (int k = 0; k < 2; ++k) \
        acc[ai][bj][m][n] = __builtin_amdgcn_mfma_f32_16x16x32_bf16(Bt[n][k], At[m][k], acc[ai][bj][m][n], 0, 0, 0); __builtin_amdgcn_s_setprio(0); } while (0)
#define PG8_WAIT_V(n) asm volatile("s_waitcnt vmcnt(" #n ")" ::: "memory")
#define PG8_WAIT_L(n) asm volatile("s_waitcnt lgkmcnt(" #n ")" ::: "memory")
#define PG8_BAR __builtin_amdgcn_s_barrier()
#define PG8_SCHED __builtin_amdgcn_sched_barrier(0)
    Unit cur, nxt; int ui = 0;
    if (!S.next(0, cur)) return;
    f32x4 acc[2][2][4][2];
#pragma unroll
    for (int a = 0; a < 2; ++a)
#pragma unroll
        for (int b = 0; b < 2; ++b)
#pragma unroll
            for (int m = 0; m < 4; ++m)
#pragma unroll
                for (int n = 0; n < 2; ++n) acc[a][b][m][n] = (f32x4){0.f, 0.f, 0.f, 0.f};
    bf16x8 At[4][2], B0[2][2], B1[2][2];
    const char* cA = (const char*)g.A + (size_t)cur.pm * tstepA; const char* cB = (const char*)g.Bt + (size_t)cur.pn * tstepB;
    PG8_STAGE(PG8_SB(0, 0), cB, voffB); PG8_STAGE(PG8_SA(0, 0), cA, voffA); PG8_STAGE(PG8_SB(0, 1), cB + hstepB, voffB); PG8_STAGE(PG8_SA(0, 1), cA + hstepA, voffA);
    if (wr == 1) PG8_BAR;
    PG8_WAIT_V(4); PG8_BAR;
    PG8_STAGE(PG8_SB(1, 0), cB + kstep, voffB); PG8_STAGE(PG8_SA(1, 0), cA + kstep, voffA); PG8_STAGE(PG8_SB(1, 1), cB + hstepB + kstep, voffB);
    PG8_WAIT_V(6); PG8_BAR;
    for (;;) {
        const bool has_next = S.next(ui + 1, nxt);
        const char* nA = has_next ? (const char*)g.A + (size_t)nxt.pm * tstepA : cA; const char* nB = has_next ? (const char*)g.Bt + (size_t)nxt.pn * tstepB : cB;
        for (int t = 0; t < nt; t += 2) {
            const bool last = (t == nt - 2);
            const char* a1 = cA + (size_t)(t + 1) * kstep;
            const char* a2 = last ? nA : cA + (size_t)(t + 2) * kstep; const char* b2 = last ? nB : cB + (size_t)(t + 2) * kstep;
            const char* a3 = a2 + kstep; const char* b3 = b2 + kstep;
            PG8_LDB(B0, 0, 0); PG8_SCHED; PG8_LDA(At, 0, 0); PG8_STAGE(PG8_SA(1, 1), a1 + hstepA, voffA);
            PG8_WAIT_L(8); PG8_BAR; PG8_WAIT_L(0); PG8_MMA(0, 0, At, B0); PG8_BAR; PG8_SCHED;
            PG8_LDB(B1, 0, 1); PG8_STAGE(PG8_SB(0, 0), b2, voffB);
            PG8_BAR; PG8_WAIT_L(0); PG8_MMA(0, 1, At, B1); PG8_BAR;
            PG8_LDA(At, 0, 1); PG8_STAGE(PG8_SA(0, 0), a2, voffA);
            PG8_BAR; PG8_WAIT_L(0); PG8_MMA(1, 0, At, B0); PG8_BAR; PG8_SCHED;
            PG8_STAGE(PG8_SB(0, 1), b2 + hstepB, voffB);
            PG8_WAIT_V(6); PG8_BAR; PG8_MMA(1, 1, At, B1); PG8_BAR;
            PG8_LDB(B0, 1, 0); PG8_SCHED; PG8_LDA(At, 1, 0); PG8_STAGE(PG8_SA(0, 1), a2 + hstepA, voffA);
            PG8_WAIT_L(8); PG8_BAR; PG8_WAIT_L(0); PG8_MMA(0, 0, At, B0); PG8_BAR; PG8_SCHED;
            PG8_LDB(B1, 1, 1); PG8_STAGE(PG8_SB(1, 0), b3, voffB);
            PG8_BAR; PG8_WAIT_L(0); PG8_MMA(0, 1, At, B1); PG8_BAR;
            PG8_LDA(At, 1, 1); PG8_STAGE(PG8_SA(1, 0), a3, voffA);
            PG8_BAR; PG8_WAIT_L(0); PG8_MMA(1, 0, At, B0); PG8_BAR; PG8_SCHED;
            PG8_STAGE(PG8_SB(1, 1), b3 + hstepB, voffB);
            PG8_WAIT_V(6); PG8_BAR; PG8_MMA(1, 1, At, B1); PG8_BAR;
        }
        E(acc, cur, wr, wc, fr, fq);
        if (!has_next) break;
#pragma unroll
        for (int a = 0; a < 2; ++a)
#pragma unroll
            for (int b = 0; b < 2; ++b)
#pragma unroll
                for (int m = 0; m < 4; ++m)
#pragma unroll
                    for (int n = 0; n < 2; ++n) acc[a][b][m][n] = (f32x4){0.f, 0.f, 0.f, 0.f};
        cur = nxt; cA = nA; cB = nB; ++ui;
    }
    PG8_WAIT_V(0);
    if (wr == 0) PG8_BAR;
    PG8_BAR;
#undef PG8_SA
#undef PG8_SB
#undef PG8_STAGE
#undef PG8_LDA
#undef PG8_LDB
#undef PG8_MMA
#undef PG8_WAIT_V
#undef PG8_WAIT_L
#undef PG8_BAR
#undef PG8_SCHED
}
struct EpiProj {
    static constexpr bool PERM = true;
    bf16_t* O; int ldc; int npn_main; float* side;
    __device__ __forceinline__ void operator()(const f32x4 (&acc)[2][2][4][2], const Unit& u, int wr, int wc, int fr, int fq) const {
        const int row0 = u.pm * BM + wr * 64 + fr;
        if (u.pn < npn_main) {
            const int col0 = u.pn * BM + wc * 32 + 8 * fq;
#pragma unroll
            for (int ai = 0; ai < 2; ++ai)
#pragma unroll
                for (int m = 0; m < 4; ++m) { bf16_t* rowp = O + (size_t)(row0 + ai * HALF + m * 16) * ldc + col0;
#pragma unroll
                    for (int bj = 0; bj < 2; ++bj) { const f32x4 v0 = acc[ai][bj][m][0], v1 = acc[ai][bj][m][1];
                        u32x4 w; w.x = cvt_pk_bf16(v0[0], v0[1]); w.y = cvt_pk_bf16(v0[2], v0[3]); w.z = cvt_pk_bf16(v1[0], v1[1]); w.w = cvt_pk_bf16(v1[2], v1[3]);
                        *(u32x4*)(rowp + bj * HALF) = w; } }
        } else if (wc < 2) {
            const int col0 = wc * 32 + 8 * fq;
#pragma unroll
            for (int ai = 0; ai < 2; ++ai)
#pragma unroll
                for (int m = 0; m < 4; ++m) { float* rowp = side + (size_t)(row0 + ai * HALF + m * 16) * 64 + col0;
                    *(f32x4*)(rowp) = acc[ai][0][m][0]; *(f32x4*)(rowp + 4) = acc[ai][0][m][1]; }
        }
    }
};
struct EpiResAdd {
    static constexpr bool PERM = false;
    float* C; int ldc;
    __device__ __forceinline__ void operator()(const f32x4 (&acc)[2][2][4][2], const Unit& u, int wr, int wc, int fr, int fq) const {
        const int row0 = u.pm * BM + wr * 64 + fr, col0 = u.pn * BM + wc * 32 + 4 * fq;
#pragma unroll
        for (int ai = 0; ai < 2; ++ai)
#pragma unroll
            for (int m = 0; m < 4; ++m) { float* rowp = C + (size_t)(row0 + ai * HALF + m * 16) * ldc + col0;
#pragma unroll
                for (int bj = 0; bj < 2; ++bj)
#pragma unroll
                    for (int n = 0; n < 2; ++n) { f32x4* p = (f32x4*)(rowp + bj * HALF + n * 16); *p = *p + acc[ai][bj][m][n]; } }
    }
};
struct EpiMoeUp {
    static constexpr bool PERM = true;
    bf16_t* hid; const float* sw;
    __device__ __forceinline__ void operator()(const f32x4 (&acc)[2][2][4][2], const Unit& u, int wr, int wc, int fr, int fq) const {
        const int row0 = u.pm * BM + wr * 64 + fr, col0 = (u.pn & 1) * 128 + wc * 32 + 8 * fq;
#pragma unroll
        for (int ai = 0; ai < 2; ++ai)
#pragma unroll
            for (int m = 0; m < 4; ++m) { const int slot = row0 + ai * HALF + m * 16; const float wt = sw[slot];
                float o[8];
#pragma unroll
                for (int n = 0; n < 2; ++n)
#pragma unroll
                    for (int j = 0; j < 4; ++j) o[n * 4 + j] = siluf_(acc[ai][0][m][n][j]) * acc[ai][1][m][n][j] * wt;
                u32x4 w; w.x = cvt_pk_bf16(o[0], o[1]); w.y = cvt_pk_bf16(o[2], o[3]); w.z = cvt_pk_bf16(o[4], o[5]); w.w = cvt_pk_bf16(o[6], o[7]);
                *(u32x4*)(hid + (size_t)slot * DEXP + col0) = w; }
    }
};
struct EpiMoeDn {
    static constexpr bool PERM = true;
    bf16_t* y; const int* sdst;
    __device__ __forceinline__ void operator()(const f32x4 (&acc)[2][2][4][2], const Unit& u, int wr, int wc, int fr, int fq) const {
        const int row0 = u.pm * BM + wr * 64 + fr, col0 = (u.pn & 15) * BM + wc * 32 + 8 * fq;
#pragma unroll
        for (int ai = 0; ai < 2; ++ai)
#pragma unroll
            for (int m = 0; m < 4; ++m) { const int dst = sdst[row0 + ai * HALF + m * 16];
                if (dst >= 0) { bf16_t* rowp = y + (size_t)dst * D + col0;
#pragma unroll
                    for (int bj = 0; bj < 2; ++bj) { const f32x4 v0 = acc[ai][bj][m][0], v1 = acc[ai][bj][m][1];
                        u32x4 w; w.x = cvt_pk_bf16(v0[0], v0[1]); w.y = cvt_pk_bf16(v0[2], v0[3]); w.z = cvt_pk_bf16(v1[0], v1[1]); w.w = cvt_pk_bf16(v1[2], v1[3]);
                        *(u32x4*)(rowp + bj * HALF) = w; } } }
    }
};
}

#define XB_TMO      128
#define XB_XCNT(j)  (256  + 64 * (j))
#define XB_XSUB(j)  (1280 + 64 * (j))
#define XB_XGEN(j)  (2304 + 64 * (j))
#define XB_TOP      3328
#define XB_TOPGEN   3392
#define XCD_BAR_WORDS 3456
#define XB_SPIN_CAP (1u << 18)
__device__ __forceinline__ unsigned xb_ld(unsigned* p)              { return __hip_atomic_load(p, __ATOMIC_RELAXED, __HIP_MEMORY_SCOPE_AGENT); }
__device__ __forceinline__ unsigned xb_add(unsigned* p, unsigned v) { return __hip_atomic_fetch_add(p, v, __ATOMIC_RELAXED, __HIP_MEMORY_SCOPE_AGENT); }
__device__ __forceinline__ unsigned xb_xcc_id() { return (unsigned)__builtin_amdgcn_s_getreg((3 << 11) | 20) & 0xFu; }
#define XB_SPIN(cond, bar) do { unsigned _sp = 0; while (cond) { __builtin_amdgcn_s_sleep(1); \
    if ((++_sp & 255u) == 0u) { if (xb_ld(&(bar)[XB_TMO])) break; if (_sp > XB_SPIN_CAP) { atomicAdd(&(bar)[XB_TMO], 1u); break; } } } } while (0)
struct XcdBarrier { unsigned* bar; unsigned x; volatile LAS unsigned* st; };
__device__ __forceinline__ XcdBarrier xcd_barrier_post(unsigned* bar, volatile LAS unsigned* st) {
    XcdBarrier b; b.bar = bar; b.x = xb_xcc_id(); b.st = st;
    if (threadIdx.x == 0) (void)xb_add(&bar[XB_XCNT(b.x)], 1u);
    return b;
}
__device__ __forceinline__ void xcd_barrier_complete(unsigned* bar, unsigned x, unsigned& nloc, unsigned& nx) {
    const unsigned G = gridDim.x * gridDim.y * gridDim.z;
    unsigned sum, cnt, mine, sp = 0u;
    for (;;) {
        sum = 0u; cnt = 0u; mine = 0u;
#pragma unroll
        for (unsigned j = 0; j < 16; ++j) { const unsigned c = xb_ld(&bar[XB_XCNT(j)]); sum += c; cnt += (c > 0u) ? 1u : 0u; mine = (j == x) ? c : mine; }
        if (sum == G) break;
        __builtin_amdgcn_s_sleep(1);
        if ((++sp & 255u) == 0u) { if (xb_ld(&bar[XB_TMO])) break; if (sp > XB_SPIN_CAP) { atomicAdd(&bar[XB_TMO], 1u); break; } }
    }
    nloc = mine > 0u ? mine : 1u; nx = cnt > 0u ? cnt : 1u;
}
__device__ __forceinline__ void xcd_barrier(const XcdBarrier& b) {
    asm volatile("s_waitcnt vmcnt(0)" ::: "memory");
    __syncthreads();
    if (threadIdx.x == 0) {
        unsigned* bar = b.bar;
        __builtin_amdgcn_s_waitcnt(0);
        unsigned nloc = b.st[0], nx = b.st[1];
        if (nloc == 0u) { xcd_barrier_complete(bar, b.x, nloc, nx); b.st[0] = nloc; b.st[1] = nx; }
        const unsigned old = xb_add(&bar[XB_XSUB(b.x)], 1u);
        const unsigned gen = old / nloc;
        if (old + 1u == (gen + 1u) * nloc) {
            __builtin_amdgcn_fence(__ATOMIC_RELEASE, "agent");
            asm volatile("s_waitcnt vmcnt(0)" ::: "memory");
            const unsigned og = xb_add(&bar[XB_TOP], 1u);
            const unsigned tg = og / nx;
            if (og + 1u == (tg + 1u) * nx) xb_add(&bar[XB_TOPGEN], 1u);
            else XB_SPIN(xb_ld(&bar[XB_TOPGEN]) == tg, bar);
            __builtin_amdgcn_fence(__ATOMIC_ACQUIRE, "agent");
            xb_add(&bar[XB_XGEN(b.x)], 1u);
            asm volatile("s_waitcnt vmcnt(0)" ::: "memory");
        } else {
            XB_SPIN(xb_ld(&bar[XB_XGEN(b.x)]) == gen, bar);
            __builtin_amdgcn_fence(__ATOMIC_ACQUIRE, "agent");
            asm volatile("s_waitcnt vmcnt(0)" ::: "memory");
        }
    }
    __syncthreads();
}

struct Args { const float* in[29]; float* out; unsigned char* ws; int ph_lo, ph_hi, flags, pad; };
enum { I_X = 0, I_META, I_MIXN, I_FFNN, I_FINN, I_EVWIN, I_EVGB, I_EVQKC, I_EVLRUP, I_EVLRB, I_EVNA, I_EVNB, I_EVWOUT, I_ODWIN, I_ODCONV, I_ODCONVB, I_ODWR, I_ODBR, I_ODWI, I_ODBI, I_ODLAM, I_ODWOUT,
       I_MWG, I_MBG, I_MWE, I_MBE, I_MW1, I_MW3, I_MW2 };


#define LDS_WAIT() asm volatile("s_waitcnt lgkmcnt(0)" ::: "memory")

__device__ __forceinline__ void tr_item(const float* Wc, size_t ldw, bf16_t* WT, size_t ldt, int k0, int n0, LAS float* scr, int lane) {
#pragma unroll 8
    for (int i = 0; i < 32; ++i) { const int kk = 2 * i + (lane >> 5); scr[kk * 33 + (lane & 31)] = Wc ? Wc[(size_t)(k0 + kk) * ldw] : 0.f; }
    LDS_WAIT();
    const int c = lane & 7;
#pragma unroll
    for (int j = 0; j < 4; ++j) { const int n = (lane >> 3) + 8 * j; const LAS float* s = scr + (8 * c) * 33 + n;
        u32x4 o; o.x = cvt_pk_bf16(s[0 * 33], s[1 * 33]); o.y = cvt_pk_bf16(s[2 * 33], s[3 * 33]); o.z = cvt_pk_bf16(s[4 * 33], s[5 * 33]); o.w = cvt_pk_bf16(s[6 * 33], s[7 * 33]);
        *(u32x4*)(WT + (size_t)(n0 + n) * ldt + k0 + 8 * c) = o; }
    LDS_WAIT();
}
__device__ __forceinline__ void conv_moe_items(const Args& a, int layer, int it0, int gw, int NGW, LAS float* scr, int lane) {
    unsigned char* wsw = a.ws + WS_W;
    constexpr int I_UP = 32 * 64 * 16, I_DN = 32 * 4 * 128;
    for (int it = gw; it < I_UP + I_DN; it += NGW) {
        (void)it0;
        if (it < I_UP) { const int e = it >> 10, r = it & 1023, kb = r >> 4, nb = r & 15; const int n = 32 * nb + (lane & 31);
            const float* src = ((n & 255) < 128 ? a.in[I_MW1] : a.in[I_MW3]) + ((size_t)(layer * NEXP + e)) * 4096 * 256 + ((n >> 8) * 128 + (n & 127));
            tr_item(src, 256, (bf16_t*)(wsw + W_UP) + (size_t)e * 512 * 4096, 4096, 64 * kb, 32 * nb, scr, lane);
        } else { const int r0 = it - I_UP, e = r0 >> 9, r = r0 & 511, kb = r >> 7, nb = r & 127;
            const float* src = a.in[I_MW2] + ((size_t)(layer * NEXP + e)) * 256 * 4096 + 32 * nb + (lane & 31);
            tr_item(src, 4096, (bf16_t*)(wsw + W_DN) + (size_t)e * 4096 * 256, 256, 64 * kb, 32 * nb, scr, lane); }
    }
    float* rt = (float*)(wsw + W_RT); const float* gf = a.in[I_FFNN] + layer * D;
    for (int i = gw * 64 + lane; i < 36 * D; i += NGW * 64) { const int j = i >> 12, d = i & 4095;
        const float w = j < 4 ? a.in[I_MWG][((size_t)layer * D + d) * 4 + j] : a.in[I_MWE][((size_t)layer * D + d) * 32 + (j - 4)];
        rt[i] = gf[d] * w; }
}
__device__ __forceinline__ void conv_layer0(const Args& a, int gw, int NGW, LAS float* scr, int lane) {
    unsigned char* wsw = a.ws + WS_W;
    constexpr int I_A = 64 * (NW0 / 32), I_B = 64 * 128;
    for (int it = gw; it < I_A + I_B; it += NGW) {
        if (it < I_A) { const int nblk = NW0 / 32, kb = it / nblk, nb = it % nblk; const int n = 32 * nb + (lane & 31);
            const int col = n < 6144 ? n : (n < 12288 ? n + 16 : (n < 12304 ? 6144 + (n - 12288) : (n < 12336 ? n : -1)));
            tr_item(col >= 0 ? a.in[I_EVWIN] + col : nullptr, 12336, (bf16_t*)(wsw + W_IN), 4096, 64 * kb, 32 * nb, scr, lane);
        } else { const int r = it - I_A, kb = r >> 7, nb = r & 127;
            tr_item(a.in[I_EVWOUT] + 32 * nb + (lane & 31), 4096, (bf16_t*)(wsw + W_OUT0), 4096, 64 * kb, 32 * nb, scr, lane); }
    }
    conv_moe_items(a, 0, 0, gw, NGW, scr, lane);
}
__device__ __forceinline__ void conv_layer1(const Args& a, int gw, int NGW, LAS float* scr, int lane) {
    unsigned char* wsw = a.ws + WS_W;
    constexpr int I_A = 64 * 320, I_B = 80 * 128, I_C = 64 * 50;
    for (int it = gw; it < I_A + I_B + I_C; it += NGW) {
        if (it < I_A) { const int kb = it / 320, nb = it % 320;
            tr_item(a.in[I_ODWIN] + 32 * nb + (lane & 31), NPROJ1, (bf16_t*)(wsw + W_IN), 4096, 64 * kb, 32 * nb, scr, lane);
        } else if (it < I_A + I_B) { const int r = it - I_A, kb = r >> 7, nb = r & 127;
            tr_item(a.in[I_ODWOUT] + 32 * nb + (lane & 31), 4096, (bf16_t*)(wsw + W_OUT1), DR, 64 * kb, 32 * nb, scr, lane);
        } else { const int r = it - I_A - I_B, mm = r / 50, q = r % 50, kb = q / 10, nb = q % 10;
            const float* src = ((mm & 1) ? a.in[I_ODWI] : a.in[I_ODWR]) + (size_t)(mm >> 1) * 320 * 320 + 32 * nb + (lane & 31);
            tr_item(src, 320, (bf16_t*)(wsw + W_RI) + (size_t)mm * 320 * 320, 320, 64 * kb, 32 * nb, scr, lane); }
    }
    conv_moe_items(a, 1, 0, gw, NGW, scr, lane);
}

__device__ __forceinline__ void load_row(const float* p, int lane, f32x4 (&v)[16]) {
#pragma unroll
    for (int j = 0; j < 16; ++j) v[j] = *(const f32x4*)(p + (j * 64 + lane) * 4);
}
__device__ __forceinline__ float row_ss(const f32x4 (&v)[16]) { float s = 0.f;
#pragma unroll
    for (int j = 0; j < 16; ++j) s += (v[j][0] * v[j][0] + v[j][1] * v[j][1]) + (v[j][2] * v[j][2] + v[j][3] * v[j][3]);
    return wave_sum(s); }
__device__ __forceinline__ void store_row_bf16_scaled(bf16_t* o, const f32x4 (&v)[16], float rstd, const float* g, int lane) {
#pragma unroll
    for (int j = 0; j < 16; ++j) { const f32x4 gg = *(const f32x4*)(g + (j * 64 + lane) * 4);
        u32x2 w; w.x = cvt_pk_bf16(v[j][0] * rstd * gg[0], v[j][1] * rstd * gg[1]); w.y = cvt_pk_bf16(v[j][2] * rstd * gg[2], v[j][3] * rstd * gg[3]);
        *(u32x2*)(o + (j * 64 + lane) * 4) = w; }
}
__device__ __forceinline__ void zero_row_bf16(bf16_t* o, int lane) {
#pragma unroll
    for (int j = 0; j < 8; ++j) *(u32x4*)(o + (j * 64 + lane) * 8) = (u32x4){0u, 0u, 0u, 0u};
}
__device__ __forceinline__ void add_y(f32x4 (&v)[16], const bf16_t* y, int lane) {
#pragma unroll
    for (int j = 0; j < 16; ++j) { const u32x2 w = *(const u32x2*)(y + (j * 64 + lane) * 4);
        v[j][0] += __uint_as_float(w.x << 16); v[j][1] += __uint_as_float(w.x & 0xffff0000u); v[j][2] += __uint_as_float(w.y << 16); v[j][3] += __uint_as_float(w.y & 0xffff0000u); }
}

__device__ __forceinline__ void p0_rows(const Args& a, int gw, int NGW, int lane) {
    float* H = (float*)(a.ws + WS_H); bf16_t* XN = (bf16_t*)((unsigned char*)a.out + DO_XN);
    for (int r = gw; r < MP; r += NGW) {
        if (row_valid(r)) { const int b = r >= TP ? 1 : 0, p = r - b * TP;
            const float* src = p < 64 ? a.in[I_META] + (size_t)(p - PADF) * D : a.in[I_X] + ((size_t)b * SEQ + (p - 64)) * D;
            f32x4 v[16]; load_row(src, lane, v); const float rstd = rsqrtf(row_ss(v) * (1.0f / D) + EPS);
#pragma unroll
            for (int j = 0; j < 16; ++j) *(f32x4*)(H + (size_t)r * D + (j * 64 + lane) * 4) = v[j];
            store_row_bf16_scaled(XN + (size_t)r * D, v, rstd, a.in[I_MIXN], lane);
        } else {
#pragma unroll
            for (int j = 0; j < 16; ++j) *(f32x4*)(H + (size_t)r * D + (j * 64 + lane) * 4) = (f32x4){0.f, 0.f, 0.f, 0.f};
            zero_row_bf16(XN + (size_t)r * D, lane); }
    }
}
__device__ __forceinline__ void p8_rows(const Args& a, int gw, int NGW, int lane) {
    float* H = (float*)(a.ws + WS_H); bf16_t* XN = (bf16_t*)((unsigned char*)a.out + DO_XN); const bf16_t* Y = (const bf16_t*)(a.ws + WS_HS);
    for (int r = gw; r < MP; r += NGW) {
        if (row_valid(r)) { f32x4 v[16]; load_row(H + (size_t)r * D, lane, v); add_y(v, Y + (size_t)r * D, lane); add_y(v, Y + ((size_t)MP + r) * D, lane);
            const float rstd = rsqrtf(row_ss(v) * (1.0f / D) + EPS);
#pragma unroll
            for (int j = 0; j < 16; ++j) *(f32x4*)(H + (size_t)r * D + (j * 64 + lane) * 4) = v[j];
            store_row_bf16_scaled(XN + (size_t)r * D, v, rstd, a.in[I_MIXN] + D, lane);
        } else zero_row_bf16(XN + (size_t)r * D, lane);
    }
}
__device__ __forceinline__ void pfinal_rows(const Args& a, int gw, int NGW, int lane, int addy) {
    const float* H = (const float*)(a.ws + WS_H); const bf16_t* Y = (const bf16_t*)(a.ws + WS_HS);
    for (int i = gw; i < NBATCH * SEQ; i += NGW) { const int b = i >> 13, t = i & (SEQ - 1), r = b * TP + 64 + t;
        f32x4 v[16]; load_row(H + (size_t)r * D, lane, v); if (addy) { add_y(v, Y + (size_t)r * D, lane); add_y(v, Y + ((size_t)MP + r) * D, lane); }
        const float rstd = rsqrtf(row_ss(v) * (1.0f / D) + EPS);
#pragma unroll
        for (int j = 0; j < 16; ++j) { const f32x4 gg = *(const f32x4*)(a.in[I_FINN] + (j * 64 + lane) * 4);
            *(f32x4*)(a.out + (size_t)i * D + (j * 64 + lane) * 4) = (f32x4){v[j][0] * rstd * gg[0], v[j][1] * rstd * gg[1], v[j][2] * rstd * gg[2], v[j][3] * rstd * gg[3]}; }
    }
}

__device__ __forceinline__ void route_one(const float (&lg)[36], const float* bg, const float* be, int& e1, int& e2, float& w1, float& w2) {
    float gl[4];
#pragma unroll
    for (int g = 0; g < 4; ++g) gl[g] = lg[g] + bg[g];
    int gi = 0; float gm = gl[0];
#pragma unroll
    for (int g = 1; g < 4; ++g) if (gl[g] > gm) { gm = gl[g]; gi = g; }
    float gs = 0.f;
#pragma unroll
    for (int g = 0; g < 4; ++g) gs += __expf(gl[g] - gm);
    const float gval = 1.0f / gs;
    float el[8];
#pragma unroll
    for (int e = 0; e < 8; ++e) { float x = lg[4 + e] + be[e];
#pragma unroll
        for (int g = 1; g < 4; ++g) { const float y = lg[4 + g * 8 + e] + be[g * 8 + e]; x = (gi == g) ? y : x; }
        el[e] = x; }
    int i1 = 0; float m1 = el[0];
#pragma unroll
    for (int e = 1; e < 8; ++e) if (el[e] > m1) { m1 = el[e]; i1 = e; }
    int i2 = -1; float m2 = -3.0e38f;
#pragma unroll
    for (int e = 0; e < 8; ++e) if (e != i1 && el[e] > m2) { m2 = el[e]; i2 = e; }
    const float p2 = __expf(m2 - m1), s = 1.0f / (1.0f + p2);
    e1 = gi * 8 + i1; e2 = gi * 8 + i2; w1 = s * gval; w2 = p2 * s * gval;
}
__device__ __forceinline__ void route_rows(const Args& a, LAS unsigned char* lds, int wave, int layer, int gw, int NGW, int lane) {
    const float* H = (const float*)(a.ws + WS_H); bf16_t* XN = (bf16_t*)((unsigned char*)a.out + DO_XN);
    const float* rt = (const float*)(a.ws + WS_W + W_RT); const float* gf = a.in[I_FFNN] + layer * D;
    const float* bg = a.in[I_MBG] + layer * 4; const float* be = a.in[I_MBE] + layer * 32;
    unsigned* cnt = (unsigned*)(a.ws + WS_CTL) + CW_CNT + layer * 64;
    int* ltok = (int*)((unsigned char*)a.out + DO_LTOK) + (size_t)layer * NEXP * LCAP; float* lw = (float*)((unsigned char*)a.out + DO_LW) + (size_t)layer * NEXP * LCAP;
    for (int pr = gw; pr < MP / 2; pr += NGW) {
        const int r0 = 2 * pr, r1 = r0 + 1; const bool v0 = row_valid(r0), v1 = row_valid(r1);
        if (!v0) zero_row_bf16(XN + (size_t)r0 * D, lane);
        if (!v1) zero_row_bf16(XN + (size_t)r1 * D, lane);
        if (!v0 && !v1) continue;
        f32x4 x0[16], x1[16];
        if (v0) load_row(H + (size_t)r0 * D, lane, x0); else {
#pragma unroll
            for (int j = 0; j < 16; ++j) x0[j] = (f32x4){0.f, 0.f, 0.f, 0.f}; }
        if (v1) load_row(H + (size_t)r1 * D, lane, x1); else {
#pragma unroll
            for (int j = 0; j < 16; ++j) x1[j] = (f32x4){0.f, 0.f, 0.f, 0.f}; }
        const float rs0 = rsqrtf(row_ss(x0) * (1.0f / D) + EPS), rs1 = rsqrtf(row_ss(x1) * (1.0f / D) + EPS);
        LAS float* lgs = (LAS float*)(lds + wave * 512);
#pragma unroll 1
        for (int j = 0; j < 36; ++j) { float s0 = 0.f, s1 = 0.f; const float* wr = rt + (size_t)j * D + lane * 4;
#pragma unroll
            for (int q = 0; q < 16; ++q) { const f32x4 w = *(const f32x4*)(wr + q * 256);
                s0 += (x0[q][0] * w[0] + x0[q][1] * w[1]) + (x0[q][2] * w[2] + x0[q][3] * w[3]);
                s1 += (x1[q][0] * w[0] + x1[q][1] * w[1]) + (x1[q][2] * w[2] + x1[q][3] * w[3]); }
            s0 = wave_sum(s0) * rs0; s1 = wave_sum(s1) * rs1;
            if (lane == 0) { lgs[j] = s0; lgs[36 + j] = s1; } }
        LDS_WAIT();
        if (v0) store_row_bf16_scaled(XN + (size_t)r0 * D, x0, rs0, gf, lane);
        if (v1) store_row_bf16_scaled(XN + (size_t)r1 * D, x1, rs1, gf, lane);
#pragma unroll 1
        for (int which = 0; which < 2; ++which) {
            if (!(which ? v1 : v0)) continue;
            const int r = which ? r1 : r0;
            float lg[36];
#pragma unroll
            for (int j = 0; j < 36; ++j) lg[j] = lgs[which * 36 + j];
            int e1, e2; float w1, w2; route_one(lg, bg, be, e1, e2, w1, w2);
            if (lane == 0) { const unsigned p1 = atomicAdd(&cnt[e1], 1u); ltok[(size_t)e1 * LCAP + p1] = r * 2; lw[(size_t)e1 * LCAP + p1] = w1;
                             const unsigned p2 = atomicAdd(&cnt[e2], 1u); ltok[(size_t)e2 * LCAP + p2] = r * 2 + 1; lw[(size_t)e2 * LCAP + p2] = w2; }
        }
        LDS_WAIT();
    }
}
__device__ __forceinline__ void build_tab(LAS int* tab, const unsigned* cnt) {
    if (threadIdx.x == 0) { int acc = 0;
        for (int e = 0; e < NEXP; ++e) { const int c = (int)__hip_atomic_load(cnt + e, __ATOMIC_RELAXED, __HIP_MEMORY_SCOPE_AGENT); const int nt = (c + 255) >> 8; tab[1 + e] = acc; for (int k = 0; k < nt; ++k) tab[64 + acc + k] = e; acc += nt; }
        tab[0] = acc; }
    __syncthreads();
}
__device__ __forceinline__ void gather_slots(const Args& a, int layer, LAS int* tab, int gw, int NGW, int lane) {
    const unsigned* cnt = (const unsigned*)(a.ws + WS_CTL) + CW_CNT + layer * 64;
    const int* ltok = (const int*)((unsigned char*)a.out + DO_LTOK) + (size_t)layer * NEXP * LCAP; const float* lw = (const float*)((unsigned char*)a.out + DO_LW) + (size_t)layer * NEXP * LCAP;
    const bf16_t* XN = (const bf16_t*)((unsigned char*)a.out + DO_XN); bf16_t* XS = (bf16_t*)(a.ws + XS_OFF);
    int* sdst = (int*)((unsigned char*)a.out + DO_SDST); float* sw = (float*)((unsigned char*)a.out + DO_SW);
    const int NT = tab[0];
    for (int s = gw; s < NT * 256; s += NGW) { const int e = tab[64 + (s >> 8)], pos = s - 256 * tab[1 + e]; const int c = (int)__hip_atomic_load(cnt + e, __ATOMIC_RELAXED, __HIP_MEMORY_SCOPE_AGENT);
        if (pos < c) { const int tok = ltok[(size_t)e * LCAP + pos], r = tok >> 1, k = tok & 1;
#pragma unroll
            for (int j = 0; j < 8; ++j) *(u32x4*)(XS + (size_t)s * D + (j * 64 + lane) * 8) = *(const u32x4*)(XN + (size_t)r * D + (j * 64 + lane) * 8);
            if (lane == 0) { sdst[s] = k * MP + r; sw[s] = lw[(size_t)e * LCAP + pos]; }
        } else if (lane == 0) { sdst[s] = -1; sw[s] = 0.f; }
    }
}

__device__ __forceinline__ void qkconv_rows(const Args& a, int gw, int NGW, int lane) {
    const bf16_t* P = (const bf16_t*)(a.ws + WS_PROJ); bf16_t* Q = (bf16_t*)((unsigned char*)a.out + DO_QKC); const float* cw = a.in[I_EVQKC];
    for (int r = gw; r < MP; r += NGW) {
        if (!row_valid(r)) {
#pragma unroll
            for (int k = 0; k < 4; ++k) *(u32x4*)(Q + (size_t)r * 2048 + k * 512 + lane * 8) = (u32x4){0u, 0u, 0u, 0u};
            continue; }
#pragma unroll
        for (int k = 0; k < 4; ++k) { const int c = k * 512 + lane * 8; float acc[8];
#pragma unroll
            for (int j = 0; j < 8; ++j) acc[j] = 0.f;
#pragma unroll
            for (int t = 0; t < 4; ++t) { const int rr = r + t - 2; const u32x4 raw = *(const u32x4*)(P + (size_t)rr * NPROJ0 + c);
                const f32x4 w0 = *(const f32x4*)(cw + t * 2048 + c), w1 = *(const f32x4*)(cw + t * 2048 + c + 4);
                acc[0] += __uint_as_float(raw.x << 16) * w0[0]; acc[1] += __uint_as_float(raw.x & 0xffff0000u) * w0[1]; acc[2] += __uint_as_float(raw.y << 16) * w0[2]; acc[3] += __uint_as_float(raw.y & 0xffff0000u) * w0[3];
                acc[4] += __uint_as_float(raw.z << 16) * w1[0]; acc[5] += __uint_as_float(raw.z & 0xffff0000u) * w1[1]; acc[6] += __uint_as_float(raw.w << 16) * w1[2]; acc[7] += __uint_as_float(raw.w & 0xffff0000u) * w1[3]; }
            const float sc = c >= 1024 ? 0.0625f : 1.0f;
#pragma unroll
            for (int j = 0; j < 8; ++j) acc[j] = siluf_(acc[j]) * sc;
            u32x4 o; o.x = cvt_pk_bf16(acc[0], acc[1]); o.y = cvt_pk_bf16(acc[2], acc[3]); o.z = cvt_pk_bf16(acc[4], acc[5]); o.w = cvt_pk_bf16(acc[6], acc[7]);
            *(u32x4*)(Q + (size_t)r * 2048 + c) = o; }
    }
}
__device__ __forceinline__ void gla_pre_units(const Args& a, LAS unsigned char* lds, int bid, int nblk) {
    const bf16_t* P = (const bf16_t*)(a.ws + WS_PROJ); const float* SM = (const float*)((unsigned char*)a.out + DO_SMALL);
    LAS float* lrbs = (LAS float*)lds;
    LAS float* toth = (LAS float*)(lds + 4096);
    const int tid = threadIdx.x, c = tid & 255, half = tid >> 8;
    for (int u = bid; u < NBATCH * NCH * 8; u += nblk) {
        const int dir = u & 1, hd = (u >> 1) & 3, n = (u >> 3) % NCH, b = (u >> 3) / NCH;
        bf16_t* GQ = (bf16_t*)(a.ws + WS_G + (size_t)dir * G_STRIDE); bf16_t* GK1 = (bf16_t*)(a.ws + WS_G + (size_t)(2 + dir) * G_STRIDE); bf16_t* GK2 = (bf16_t*)(a.ws + WS_G + (size_t)(4 + dir) * G_STRIDE);
        float* ET = (float*)(a.ws + WS_G + G_ETOT);
        if (tid < 256) { const int i = tid >> 2, q4 = tid & 3; const int pp = 64 * n + i, p = dir ? (TP - 1 - pp) : pp;
            *(LAS f32x4*)(lrbs + i * 16 + q4 * 4) = *(const f32x4*)(SM + (size_t)(b * TP + p) * 64 + 16 + dir * 16 + q4 * 4); }
        float up[16];
#pragma unroll
        for (int rr = 0; rr < 16; ++rr) up[rr] = a.in[I_EVLRUP][(size_t)(dir * 16 + rr) * 1024 + hd * 256 + c];
        const float bias = a.in[I_EVLRB][dir * 1024 + hd * 256 + c];
        __syncthreads();
        float cumv[32]; float run = 0.f;
#pragma unroll
        for (int ii = 0; ii < 32; ++ii) { const int i = half * 32 + ii; const int pp = 64 * n + i, p = dir ? (TP - 1 - pp) : pp;
            float x = bias;
#pragma unroll
            for (int q4 = 0; q4 < 4; ++q4) { const f32x4 l = *(const LAS f32x4*)(lrbs + i * 16 + q4 * 4); x += l[0] * up[q4 * 4] + l[1] * up[q4 * 4 + 1] + l[2] * up[q4 * 4 + 2] + l[3] * up[q4 * 4 + 3]; }
            const float la = p < PADF ? 0.f : logsigf_(x) * 0.0625f; run += la; cumv[ii] = run; }
        toth[half * 256 + c] = run;
        __syncthreads();
        const float off = half ? toth[c] : 0.f, tot = toth[c] + toth[256 + c];
#pragma unroll
        for (int ii = 0; ii < 32; ++ii) { const int i = half * 32 + ii; const int pp = 64 * n + i, p = dir ? (TP - 1 - pp) : pp; const size_t r = (size_t)(b * TP + p);
            const float cum = cumv[ii] + off;
            const float q = bf2f(P[r * NPROJ0 + 6144 + hd * 256 + c]), k = bf2f(P[r * NPROJ0 + 7168 + hd * 256 + c]);
            GQ[r * 1024 + hd * 256 + c] = f2bf(q * 0.0625f * __expf(cum)); GK1[r * 1024 + hd * 256 + c] = f2bf(k * __expf(-cum)); GK2[r * 1024 + hd * 256 + c] = f2bf(k * __expf(tot - cum)); }
        if (half == 0) ET[((size_t)((dir * 2 + b) * NCH + n)) * 1024 + hd * 256 + c] = __expf(tot);
        __syncthreads();
    }
}
__device__ __forceinline__ void headnorm_rows(const Args& a, int gw, int NGW, int lane) {
    bf16_t* HF = (bf16_t*)(a.ws + WS_HS); const bf16_t* HB = (const bf16_t*)(a.ws + WS_HS + HS_STRIDE0); const bf16_t* P = (const bf16_t*)(a.ws + WS_PROJ);
    for (int r = gw; r < MP; r += NGW) {
        if (!row_valid(r)) { zero_row_bf16(HF + (size_t)r * D, lane); continue; }
#pragma unroll
        for (int hg = 0; hg < 8; ++hg) { const int col = hg * 512 + lane * 8;
            const u32x4 f = *(const u32x4*)(HF + (size_t)r * D + col), bb = *(const u32x4*)(HB + (size_t)r * D + col);
            const u32x4 gt = *(const u32x4*)(P + (size_t)r * NPROJ0 + (hg < 4 ? 4096 + col : 10240 + (col - 2048)));
            const float* nw = hg < 4 ? a.in[I_EVNA] + col : a.in[I_EVNB] + (col - 2048);
            float s[8], gv[8];
            const unsigned fw[4] = {f.x, f.y, f.z, f.w}, bw[4] = {bb.x, bb.y, bb.z, bb.w}, gw4[4] = {gt.x, gt.y, gt.z, gt.w};
#pragma unroll
            for (int j = 0; j < 4; ++j) { s[2 * j] = __uint_as_float(fw[j] << 16) + __uint_as_float(bw[j] << 16); s[2 * j + 1] = __uint_as_float(fw[j] & 0xffff0000u) + __uint_as_float(bw[j] & 0xffff0000u);
                gv[2 * j] = __uint_as_float(gw4[j] << 16); gv[2 * j + 1] = __uint_as_float(gw4[j] & 0xffff0000u); }
            float ss = 0.f;
#pragma unroll
            for (int j = 0; j < 8; ++j) ss += s[j] * s[j];
            const float rstd = rsqrtf(wave_sum(ss) * (1.0f / 512.0f) + EPS);
            const f32x4 n0 = *(const f32x4*)nw, n1 = *(const f32x4*)(nw + 4); const float nn[8] = {n0[0], n0[1], n0[2], n0[3], n1[0], n1[1], n1[2], n1[3]};
            float o[8];
#pragma unroll
            for (int j = 0; j < 8; ++j) { const float gate = hg < 4 ? sigmoidf_(gv[j]) : siluf_(gv[j]); o[j] = gate * s[j] * rstd * nn[j]; }
            u32x4 w; w.x = cvt_pk_bf16(o[0], o[1]); w.y = cvt_pk_bf16(o[2], o[3]); w.z = cvt_pk_bf16(o[4], o[5]); w.w = cvt_pk_bf16(o[6], o[7]);
            *(u32x4*)(HF + (size_t)r * D + col) = w; }
    }
}
__device__ __forceinline__ void uconv_rows(const Args& a, int gw, int NGW, int lane) {
    const bf16_t* P = (const bf16_t*)(a.ws + WS_PROJ); bf16_t* U = (bf16_t*)(a.ws + WS_G); const float* cw = a.in[I_ODCONV]; const float* cb = a.in[I_ODCONVB];
    for (int r = gw; r < MP; r += NGW) {
        const bool v = row_valid(r);
#pragma unroll
        for (int k = 0; k < 10; ++k) { const int c = k * 512 + lane * 8;
            if (!v) { *(u32x4*)(U + (size_t)r * DR + c) = (u32x4){0u, 0u, 0u, 0u}; continue; }
            const f32x4 b0 = *(const f32x4*)(cb + c), b1 = *(const f32x4*)(cb + c + 4);
            float acc[8] = {b0[0], b0[1], b0[2], b0[3], b1[0], b1[1], b1[2], b1[3]};
#pragma unroll
            for (int t = 0; t < 4; ++t) { const int rr = r + t - 2; const u32x4 raw = *(const u32x4*)(P + (size_t)rr * NPROJ1 + DR + c);
                const f32x4 w0 = *(const f32x4*)(cw + t * DR + c), w1 = *(const f32x4*)(cw + t * DR + c + 4);
                acc[0] += __uint_as_float(raw.x << 16) * w0[0]; acc[1] += __uint_as_float(raw.x & 0xffff0000u) * w0[1]; acc[2] += __uint_as_float(raw.y << 16) * w0[2]; acc[3] += __uint_as_float(raw.y & 0xffff0000u) * w0[3];
                acc[4] += __uint_as_float(raw.z << 16) * w1[0]; acc[5] += __uint_as_float(raw.z & 0xffff0000u) * w1[1]; acc[6] += __uint_as_float(raw.w << 16) * w1[2]; acc[7] += __uint_as_float(raw.w & 0xffff0000u) * w1[3]; }
            u32x4 o; o.x = cvt_pk_bf16(acc[0], acc[1]); o.y = cvt_pk_bf16(acc[2], acc[3]); o.z = cvt_pk_bf16(acc[4], acc[5]); o.w = cvt_pk_bf16(acc[6], acc[7]);
            *(u32x4*)(U + (size_t)r * DR + c) = o; }
    }
}
__device__ __forceinline__ void rglru_combine_rows(const Args& a, int gw, int NGW, int lane) {
    bf16_t* HF = (bf16_t*)(a.ws + WS_HS); const bf16_t* HB = (const bf16_t*)(a.ws + WS_HS + HS_STRIDE1); const bf16_t* P = (const bf16_t*)(a.ws + WS_PROJ);
    for (int r = gw; r < MP; r += NGW) {
        const bool v = row_valid(r);
#pragma unroll
        for (int k = 0; k < 10; ++k) { const int c = k * 512 + lane * 8;
            if (!v) { *(u32x4*)(HF + (size_t)r * DR + c) = (u32x4){0u, 0u, 0u, 0u}; continue; }
            const u32x4 f = *(const u32x4*)(HF + (size_t)r * DR + c), bb = *(const u32x4*)(HB + (size_t)r * DR + c), gt = *(const u32x4*)(P + (size_t)r * NPROJ1 + c);
            const unsigned fw[4] = {f.x, f.y, f.z, f.w}, bw[4] = {bb.x, bb.y, bb.z, bb.w}, gw4[4] = {gt.x, gt.y, gt.z, gt.w};
            float o[8];
#pragma unroll
            for (int j = 0; j < 4; ++j) { o[2 * j] = gelu_tanhf_(__uint_as_float(gw4[j] << 16)) * (__uint_as_float(fw[j] << 16) + __uint_as_float(bw[j] << 16));
                o[2 * j + 1] = gelu_tanhf_(__uint_as_float(gw4[j] & 0xffff0000u)) * (__uint_as_float(fw[j] & 0xffff0000u) + __uint_as_float(bw[j] & 0xffff0000u)); }
            u32x4 w; w.x = cvt_pk_bf16(o[0], o[1]); w.y = cvt_pk_bf16(o[2], o[3]); w.z = cvt_pk_bf16(o[4], o[5]); w.w = cvt_pk_bf16(o[6], o[7]);
            *(u32x4*)(HF + (size_t)r * DR + c) = w; }
    }
}

constexpr int S0_K1 = 0, S0_K2 = 33792, S0_V = 67584, S0_VW = 76800, S0_SS = 86016, S0_CT = 95232, S0_NV = 129024, S0_RS = 130048, S0_ET = 130560, S0_WS = 131584;
constexpr int KPB = 528  , VPB = 144  ;

template <int KIND>
__device__ __forceinline__ void scan0_unit(const Args& a, LAS unsigned char* lds, int b, int hd, int dir, int sl, size_t hs_off) {
    const int tid = threadIdx.x, w = __builtin_amdgcn_readfirstlane(tid >> 6), lane = tid & 63, g = lane >> 4, l15 = lane & 15, q4 = l15 >> 2, p4 = lane & 3;
    const int mt = w >> 1, np = w & 1;
    const bf16_t* P = (const bf16_t*)(a.ws + WS_PROJ);
    const bf16_t *Qg, *K1g, *K2g, *Vg; int pitchQ;
    if (KIND == 0) { const bf16_t* QK = (const bf16_t*)((unsigned char*)a.out + DO_QKC); Qg = QK + hd * 256; K1g = QK + 1024 + hd * 256; K2g = K1g; pitchQ = 2048; Vg = P + 2048 + hd * 512 + sl * 64; }
    else { Qg = (const bf16_t*)(a.ws + WS_G + (size_t)dir * G_STRIDE) + hd * 256; K1g = (const bf16_t*)(a.ws + WS_G + (size_t)(2 + dir) * G_STRIDE) + hd * 256; K2g = (const bf16_t*)(a.ws + WS_G + (size_t)(4 + dir) * G_STRIDE) + hd * 256; pitchQ = 1024; Vg = P + 8192 + hd * 512 + sl * 64; }
    const float* SM = (const float*)((unsigned char*)a.out + DO_SMALL);
    const float* ETg = (const float*)(a.ws + WS_G + G_ETOT);
    bf16_t* Og = (bf16_t*)(a.ws + hs_off + (size_t)dir * HS_STRIDE0) + KIND * 2048 + hd * 512 + sl * 64;
    const unsigned ldsb = (unsigned)(size_t)lds;
    f32x4 accC[2][4];
#pragma unroll
    for (int mi = 0; mi < 2; ++mi)
#pragma unroll
        for (int ni = 0; ni < 4; ++ni) accC[mi][ni] = (f32x4){0.f, 0.f, 0.f, 0.f};
    for (int i = tid; i < 33792 / 4; i += 512) ((LAS unsigned*)(lds + S0_CT))[i] = 0u;
    if (tid < 256) ((LAS float*)(lds + S0_NV))[tid] = 0.f;
    float m_prev = 0.f;
    float gbi = 0.f, gbf = 0.f;
    if (KIND == 0) { gbi = a.in[I_EVGB][(dir ? 2 : 0) * 4 + hd]; gbf = a.in[I_EVGB][(dir ? 3 : 1) * 4 + hd]; }
    __syncthreads();
    for (int n = 0; n < NCH; ++n) {
        const int base_pp = 64 * n;
#define PROW(i) (dir ? (TP - 1 - (base_pp + (i))) : (base_pp + (i)))
#pragma unroll
        for (int k = 0; k < 4; ++k) { const int id = tid + 512 * k, i = id >> 5, c8 = id & 31; const size_t r = (size_t)(b * TP + PROW(i));
            *(LAS u32x4*)(lds + S0_K1 + i * KPB + c8 * 16) = *(const u32x4*)(K1g + r * pitchQ + c8 * 8);
            if (KIND == 1) *(LAS u32x4*)(lds + S0_K2 + i * KPB + c8 * 16) = *(const u32x4*)(K2g + r * pitchQ + c8 * 8); }
        bf16x8 Qf[8];
        { const size_t r = (size_t)(b * TP + PROW(16 * mt + l15));
#pragma unroll
            for (int ks = 0; ks < 8; ++ks) Qf[ks] = *(const bf16x8*)(Qg + r * pitchQ + 32 * ks + 8 * g); }
        float cum = 0.f, bvec = 0.f, Bt = 0.f, winter = 0.f, floorv = 0.f, wsl = 0.f, decay = 1.f, B63 = 0.f, tot = 0.f;
        if (KIND == 0) { const int p = PROW(lane); const size_t r = (size_t)(b * TP + p);
            const float gi = SM[r * 64 + (dir ? 2 : 0) * 4 + hd] + gbi, gf = SM[r * 64 + (dir ? 3 : 1) * 4 + hd] + gbf;
            const bool pad = p < PADF; const float li = pad ? NEGV : gi, lf = pad ? 0.f : logsigf_(gf);
            cum = lf;
#pragma unroll
            for (int o = 1; o < 64; o <<= 1) { const float t = __shfl_up(cum, o); if (lane >= o) cum += t; }
            bvec = li - cum; float pm = bvec;
#pragma unroll
            for (int o = 1; o < 64; o <<= 1) { const float t = __shfl_up(pm, o); if (lane >= o) pm = fmaxf(pm, t); }
            Bt = fmaxf(m_prev, pm); winter = __expf(m_prev - Bt); floorv = __expf(-(cum + Bt));
            B63 = __shfl(Bt, 63); tot = __shfl(cum, 63); decay = __expf(m_prev - B63); wsl = __expf(bvec - B63);
            if (w == 0) ((LAS float*)(lds + S0_WS))[lane] = wsl; }
        { const int i = tid >> 3, c8 = tid & 7; const size_t r = (size_t)(b * TP + PROW(i));
            const u32x4 v = *(const u32x4*)(Vg + r * NPROJ0 + c8 * 8);
            *(LAS u32x4*)(lds + S0_V + i * VPB + c8 * 16) = v;
            if (KIND == 0) { const float s = __shfl(wsl, i);
                u32x4 o; o.x = cvt_pk_bf16(__uint_as_float(v.x << 16) * s, __uint_as_float(v.x & 0xffff0000u) * s); o.y = cvt_pk_bf16(__uint_as_float(v.y << 16) * s, __uint_as_float(v.y & 0xffff0000u) * s);
                o.z = cvt_pk_bf16(__uint_as_float(v.z << 16) * s, __uint_as_float(v.z & 0xffff0000u) * s); o.w = cvt_pk_bf16(__uint_as_float(v.w << 16) * s, __uint_as_float(v.w & 0xffff0000u) * s);
                *(LAS u32x4*)(lds + S0_VW + i * VPB + c8 * 16) = o; } }
        if (KIND == 1 && tid < 256) ((LAS float*)(lds + S0_ET))[tid] = ETg[((size_t)((dir * 2 + b) * NCH + n)) * 1024 + hd * 256 + tid];
        __syncthreads();
        f32x4 sacc[2], oacc[2];
#pragma unroll
        for (int j = 0; j < 2; ++j) { sacc[j] = (f32x4){0.f, 0.f, 0.f, 0.f}; oacc[j] = (f32x4){0.f, 0.f, 0.f, 0.f}; }
#pragma unroll
        for (int ks = 0; ks < 8; ++ks)
#pragma unroll
            for (int j = 0; j < 2; ++j) { const int nt = 2 * np + j;
                const bf16x8 kf = *(const LAS bf16x8*)(lds + S0_K1 + (16 * nt + l15) * KPB + (32 * ks + 8 * g) * 2);
                sacc[j] = MFMA16(Qf[ks], kf, sacc[j]);
                const bf16x8 cf = *(const LAS bf16x8*)(lds + S0_CT + (16 * nt + l15) * KPB + (32 * ks + 8 * g) * 2);
                oacc[j] = MFMA16(Qf[ks], cf, oacc[j]); }
        float qn = 0.f;
        {
            float rs[4] = {0.f, 0.f, 0.f, 0.f};
#pragma unroll
            for (int j = 0; j < 2; ++j) { const int s = 16 * (2 * np + j) + l15; const float b_s = KIND == 0 ? __shfl(bvec, s) : 0.f;
#pragma unroll
                for (int rr = 0; rr < 4; ++rr) { const int t = 16 * mt + 4 * g + rr; float val;
                    if (KIND == 0) { const float a_t = -__shfl(Bt, t); val = s <= t ? sacc[j][rr] * __expf(a_t + b_s) : 0.f; }
                    else val = s <= t ? sacc[j][rr] : 0.f;
                    rs[rr] += val;
                    *(LAS unsigned short*)(lds + S0_SS + t * VPB + s * 2) = f2bf(val); } }
            if (KIND == 0) {
#pragma unroll
                for (int rr = 0; rr < 4; ++rr) { float v = rs[rr]; v += __shfl_xor(v, 1); v += __shfl_xor(v, 2); v += __shfl_xor(v, 4); v += __shfl_xor(v, 8);
                    if (l15 == 0) ((LAS float*)(lds + S0_RS))[np * 64 + 16 * mt + 4 * g + rr] = v; }
                float qp = 0.f;
#pragma unroll
                for (int ks = 0; ks < 8; ++ks) { const f32x4 n0 = *(const LAS f32x4*)(lds + S0_NV + (32 * ks + 8 * g) * 4), n1 = *(const LAS f32x4*)(lds + S0_NV + (32 * ks + 8 * g + 4) * 4);
                    qp += bf2f((unsigned short)Qf[ks][0]) * n0[0] + bf2f((unsigned short)Qf[ks][1]) * n0[1] + bf2f((unsigned short)Qf[ks][2]) * n0[2] + bf2f((unsigned short)Qf[ks][3]) * n0[3]
                        + bf2f((unsigned short)Qf[ks][4]) * n1[0] + bf2f((unsigned short)Qf[ks][5]) * n1[1] + bf2f((unsigned short)Qf[ks][6]) * n1[2] + bf2f((unsigned short)Qf[ks][7]) * n1[3]; }
                qp += __shfl_xor(qp, 16); qp += __shfl_xor(qp, 32); qn = qp;
            }
        }
        __syncthreads();
#pragma unroll
        for (int mi = 0; mi < 2; ++mi) {
            f32x4 sc;
            if (KIND == 0) sc = (f32x4){decay, decay, decay, decay};
            else sc = *(const LAS f32x4*)(lds + S0_ET + (16 * (2 * w + mi) + 4 * g) * 4);
#pragma unroll
            for (int ni = 0; ni < 4; ++ni) accC[mi][ni] = accC[mi][ni] * sc; }
#pragma unroll
        for (int ks = 0; ks < 2; ++ks) {
            bf16x8 af[2], bfv[4];
            const unsigned rowb = (unsigned)(32 * ks + 8 * g + q4);
#pragma unroll
            for (int mi = 0; mi < 2; ++mi) { const unsigned ad = ldsb + (KIND == 0 ? S0_K1 : S0_K2) + rowb * KPB + (16 * (2 * w + mi) + 4 * p4) * 2; af[mi] = tr_frag(ad, ad + 4 * KPB); }
#pragma unroll
            for (int ni = 0; ni < 4; ++ni) { const unsigned ad = ldsb + (KIND == 0 ? S0_VW : S0_V) + rowb * VPB + (16 * ni + 4 * p4) * 2; bfv[ni] = tr_frag(ad, ad + 4 * VPB); }
#pragma unroll
            for (int mi = 0; mi < 2; ++mi)
#pragma unroll
                for (int ni = 0; ni < 4; ++ni) accC[mi][ni] = MFMA16(af[mi], bfv[ni], accC[mi][ni]); }
#pragma unroll
        for (int mi = 0; mi < 2; ++mi)
#pragma unroll
            for (int ni = 0; ni < 4; ++ni) { u32x2 o; o.x = cvt_pk_bf16(accC[mi][ni][0], accC[mi][ni][1]); o.y = cvt_pk_bf16(accC[mi][ni][2], accC[mi][ni][3]);
                *(LAS u32x2*)(lds + S0_CT + (16 * ni + l15) * KPB + (16 * (2 * w + mi) + 4 * g) * 2) = o; }
        if (KIND == 0 && tid < 256) { float acc = decay * ((LAS float*)(lds + S0_NV))[tid];
#pragma unroll 8
            for (int s = 0; s < 64; ++s) acc += ((LAS float*)(lds + S0_WS))[s] * bf2f(*(const LAS unsigned short*)(lds + S0_K1 + s * KPB + tid * 2));
            ((LAS float*)(lds + S0_NV))[tid] = acc; }
        if (KIND == 0) {
#pragma unroll
            for (int rr = 0; rr < 4; ++rr) { const float wi = __shfl(winter, 16 * mt + 4 * g + rr);
#pragma unroll
                for (int j = 0; j < 2; ++j) oacc[j][rr] *= wi; } }
#pragma unroll
        for (int ks = 0; ks < 2; ++ks) { const bf16x8 sf = *(const LAS bf16x8*)(lds + S0_SS + (16 * mt + l15) * VPB + (32 * ks + 8 * g) * 2);
            const unsigned rowb = (unsigned)(32 * ks + 8 * g + q4);
#pragma unroll
            for (int j = 0; j < 2; ++j) { const unsigned ad = ldsb + S0_V + rowb * VPB + (16 * (2 * np + j) + 4 * p4) * 2; const bf16x8 vf = tr_frag(ad, ad + 4 * VPB);
                oacc[j] = MFMA16(sf, vf, oacc[j]); } }
#pragma unroll
        for (int rr = 0; rr < 4; ++rr) { const int t = 16 * mt + 4 * g + rr; const size_t r = (size_t)(b * TP + PROW(t));
            float inv = 1.f;
            if (KIND == 0) { const float wi = __shfl(winter, t), fl = __shfl(floorv, t), qnt = __shfl(qn, 4 * g + rr);
                const float den = wi * qnt + ((LAS float*)(lds + S0_RS))[t] + ((LAS float*)(lds + S0_RS))[64 + t];
                inv = 1.0f / fmaxf(fabsf(den), fl); }
#pragma unroll
            for (int j = 0; j < 2; ++j) Og[r * D + 16 * (2 * np + j) + l15] = f2bf(oacc[j][rr] * inv); }
        if (KIND == 0) m_prev = tot + B63;
        __syncthreads();
#undef PROW
    }
}

constexpr int S1_BT = 0, S1_A = 104960, S1_COMP = 146944, S1_HP = 149504;
constexpr int APB = 656;
__device__ __forceinline__ void scan1_unit(const Args& a, LAS unsigned char* lds, int b, int nb, int dir, int q) {
    const int tid = threadIdx.x, w = __builtin_amdgcn_readfirstlane(tid >> 6), lane = tid & 63, g = lane >> 4, l15 = lane & 15;
    const int mt = w >> 1, par = w & 1, nj = par ? 2 : 3, j0 = par * 3;
    const bf16_t* U = (const bf16_t*)(a.ws + WS_G); const bf16_t* WRI = (const bf16_t*)(a.ws + WS_W + W_RI);
    bf16_t* Og = (bf16_t*)(a.ws + WS_HS + (size_t)dir * HS_STRIDE1) + nb * 320 + q * 80;
    for (int id = tid; id < 160 * 40; id += 512) { const int row = id / 40, pc = id % 40, which = row / 80, col = 80 * q + row % 80;
        *(LAS u32x4*)(lds + S1_BT + row * APB + pc * 16) = *(const u32x4*)(WRI + ((size_t)(((dir * 16 + nb) * 2 + which) * 320 + col)) * 320 + pc * 8); }
    if (tid < 160) ((LAS float*)(lds + S1_HP))[tid] = 0.f;
    float br[3], bi[3], sp[3];
#pragma unroll
    for (int jj = 0; jj < 3; ++jj) { const int col = 16 * ((j0 + jj) < 5 ? (j0 + jj) : 4) + l15, gc = dir * DR + nb * 320 + q * 80 + col;
        br[jj] = a.in[I_ODBR][gc]; bi[jj] = a.in[I_ODBI][gc]; sp[jj] = softplusf_(-a.in[I_ODLAM][gc]); }
    __syncthreads();
    for (int ti = 0; ti < NCH; ++ti) {
        const int base_pp = 64 * ti;
#define PROW(i) (dir ? (TP - 1 - (base_pp + (i))) : (base_pp + (i)))
#pragma unroll
        for (int k = 0; k < 5; ++k) { const int id = tid + 512 * k, i = id / 40, pc = id % 40; const size_t r = (size_t)(b * TP + PROW(i));
            *(LAS u32x4*)(lds + S1_A + i * APB + pc * 16) = *(const u32x4*)(U + r * DR + nb * 320 + pc * 8); }
        __syncthreads();
        f32x4 racc[3], iacc[3];
#pragma unroll
        for (int jj = 0; jj < 3; ++jj) { racc[jj] = (f32x4){0.f, 0.f, 0.f, 0.f}; iacc[jj] = (f32x4){0.f, 0.f, 0.f, 0.f}; }
#pragma unroll
        for (int ks = 0; ks < 10; ++ks) { const bf16x8 af = *(const LAS bf16x8*)(lds + S1_A + (16 * mt + l15) * APB + (32 * ks + 8 * g) * 2);
#pragma unroll
            for (int jj = 0; jj < 3; ++jj) if (jj < nj) { const int j = j0 + jj;
                const bf16x8 bfr = *(const LAS bf16x8*)(lds + S1_BT + (16 * j + l15) * APB + (32 * ks + 8 * g) * 2);
                const bf16x8 bfi = *(const LAS bf16x8*)(lds + S1_BT + (80 + 16 * j + l15) * APB + (32 * ks + 8 * g) * 2);
                racc[jj] = MFMA16(af, bfr, racc[jj]); iacc[jj] = MFMA16(af, bfi, iacc[jj]); } }
        float Ap[3][4], Hp[3][4];
#pragma unroll
        for (int jj = 0; jj < 3; ++jj) if (jj < nj) { const int col = 16 * (j0 + jj) + l15;
            float A = 1.f, Hh = 0.f;
#pragma unroll
            for (int rr = 0; rr < 4; ++rr) { const int t = 16 * mt + 4 * g + rr; const bool pad = PROW(t) < PADF;
                const float rg = sigmoidf_(racc[jj][rr] + br[jj]), ig = sigmoidf_(iacc[jj][rr] + bi[jj]);
                const float la = -8.0f * rg * sp[jj]; float av = __expf(la); const float mult = sqrtf(fmaxf(0.f, -expm1f(2.0f * la)));
                const float uval = bf2f(*(const LAS unsigned short*)(lds + S1_A + t * APB + (80 * q + col) * 2));
                float inp = mult * ig * uval; if (pad) { av = 1.f; inp = 0.f; }
                Hh = av * Hh + inp; A = av * A; Ap[jj][rr] = A; Hp[jj][rr] = Hh; }
            const float cA = Ap[jj][3], cH = Hp[jj][3];
            float gA = 1.f, gH = 0.f, mA = 1.f, mH = 0.f;
#pragma unroll
            for (int gg = 0; gg < 4; ++gg) { const float xa = __shfl(cA, gg * 16 + l15), xh = __shfl(cH, gg * 16 + l15);
                if (gg < g) { gH = xa * gH + xh; gA = xa * gA; }
                mH = xa * mH + xh; mA = xa * mA; }
#pragma unroll
            for (int rr = 0; rr < 4; ++rr) { Hp[jj][rr] = Hp[jj][rr] + Ap[jj][rr] * gH; Ap[jj][rr] = Ap[jj][rr] * gA; }
            if (g == 0) *(LAS f32x2*)(lds + S1_COMP + (mt * 80 + col) * 8) = (f32x2){mA, mH};
        }
        __syncthreads();
#pragma unroll
        for (int jj = 0; jj < 3; ++jj) if (jj < nj) { const int col = 16 * (j0 + jj) + l15;
            float hp = ((LAS float*)(lds + S1_HP))[(ti & 1) * 80 + col];
#pragma unroll
            for (int mm = 0; mm < 3; ++mm) if (mm < mt) { const f32x2 c = *(const LAS f32x2*)(lds + S1_COMP + (mm * 80 + col) * 8); hp = c[0] * hp + c[1]; }
#pragma unroll
            for (int rr = 0; rr < 4; ++rr) { const int t = 16 * mt + 4 * g + rr; const size_t r = (size_t)(b * TP + PROW(t));
                Og[r * DR + col] = f2bf(Hp[jj][rr] + Ap[jj][rr] * hp); }
            if (mt == 3 && g == 0) { const f32x2 c = *(const LAS f32x2*)(lds + S1_COMP + (3 * 80 + col) * 8); ((LAS float*)(lds + S1_HP))[((ti + 1) & 1) * 80 + col] = c[0] * hp + c[1]; }
        }
#undef PROW
    }
    __syncthreads();
}

constexpr int NPH = 21;
__global__ void __launch_bounds__(512, 2) fwd_kernel(Args a) {
    extern __shared__ __attribute__((aligned(16))) unsigned char lds_raw[];
    LAS unsigned char* lds = (LAS unsigned char*)lds_raw;
    const int tid = threadIdx.x, lane = tid & 63, wave = __builtin_amdgcn_readfirstlane(tid >> 6);
    const int G = gridDim.x, bid = blockIdx.x, gw = bid * 8 + wave, NGW = G * 8;
    if (tid < 4) ((LAS unsigned*)(lds + LDS_XB))[tid] = 0u;
    __syncthreads();
    XcdBarrier bar; bar.bar = (unsigned*)(a.ws + WS_CTL) + CW_BAR; bar.x = 0; bar.st = nullptr;
#if MK_FUSED
    bar = xcd_barrier_post((unsigned*)(a.ws + WS_CTL) + CW_BAR, (volatile LAS unsigned*)(lds + LDS_XB));
#endif
    const int lo = a.ph_lo, hi = a.ph_hi;
#ifndef ONLY
#define ONLY -1
#endif
#define XN ((bf16_t*)((unsigned char*)a.out + DO_XN))
#define SMALL ((float*)((unsigned char*)a.out + DO_SMALL))
#define PROJ ((bf16_t*)(a.ws + WS_PROJ))
#define H ((float*)(a.ws + WS_H))
#define WIN ((const bf16_t*)(a.ws + WS_W + W_IN))
#define scr ((LAS float*)(lds + wave * 16384))
#define tab ((LAS int*)(lds + LDS_TAB))
#define IN(k) ((ONLY < 0 || ONLY == (k)) && lo <= (k) && (k) < hi)
#define SEAM(k) do { if (MK_FUSED && IN(k) && IN((k) + 1)) xcd_barrier(bar); } while (0)

    if (IN(0)) { conv_layer0(a, gw, NGW, scr, lane); p0_rows(a, gw, NGW, lane); }
    SEAM(0);
    if (IN(1)) { pg8::Gemm g{XN, WIN, D, D, D}; pg8::StaticOrder S; S.init(MP, NW0, G, bid); pg8::EpiProj E{PROJ, NPROJ0, NPROJ0 / 256, SMALL}; pg8::gemm_phase(lds, g, S, E); }
    SEAM(1);
    if (IN(2)) { qkconv_rows(a, gw, NGW, lane); gla_pre_units(a, lds, bid, G); }
    SEAM(2);
    if (IN(3)) { for (int u = bid; u < 256; u += G) { const int grp = u & 31, sl = u >> 5, kind = grp & 1, dir = (grp >> 1) & 1, hd = (grp >> 2) & 3, b = grp >> 4;
            if (kind == 0) scan0_unit<0>(a, lds, b, hd, dir, sl, (a.flags & 2) ? WS_H : WS_HS); else scan0_unit<1>(a, lds, b, hd, dir, sl, (a.flags & 2) ? WS_H : WS_HS); } }
    SEAM(3);
    if (IN(4)) headnorm_rows(a, gw, NGW, lane);
    SEAM(4);
    if (IN(5)) { pg8::Gemm g{(const bf16_t*)(a.ws + WS_HS), (const bf16_t*)(a.ws + WS_W + W_OUT0), D, D, D}; pg8::StaticOrder S; S.init(MP, D, G, bid); pg8::EpiResAdd E{H, D}; pg8::gemm_phase(lds, g, S, E); }
    SEAM(5);
#define MOE_PHASES(P, layer) \
    if (IN(P)) route_rows(a, lds, wave, layer, gw, NGW, lane); \
    SEAM(P); \
    if (IN((P) + 1)) { build_tab(tab, (const unsigned*)(a.ws + WS_CTL) + CW_CNT + (layer) * 64); gather_slots(a, layer, tab, gw, NGW, lane); } \
    SEAM((P) + 1); \
    if (IN((P) + 2)) { build_tab(tab, (const unsigned*)(a.ws + WS_CTL) + CW_CNT + (layer) * 64); \
        pg8::Gemm g{(const bf16_t*)(a.ws + XS_OFF), (const bf16_t*)(a.ws + WS_W + W_UP), D, D, D}; pg8::MoeOrder S{tab, 2, G, bid}; \
        pg8::EpiMoeUp E{(bf16_t*)(a.ws + HID_OFF), (const float*)((unsigned char*)a.out + DO_SW)}; pg8::gemm_phase(lds, g, S, E); } \
    SEAM((P) + 2); \
    if (IN((P) + 3)) { build_tab(tab, (const unsigned*)(a.ws + WS_CTL) + CW_CNT + (layer) * 64); \
        pg8::Gemm g{(const bf16_t*)(a.ws + HID_OFF), (const bf16_t*)(a.ws + WS_W + W_DN), DEXP, DEXP, DEXP}; pg8::MoeOrder S{tab, 16, G, bid}; \
        pg8::EpiMoeDn E{(bf16_t*)(a.ws + WS_HS), (const int*)((unsigned char*)a.out + DO_SDST)}; pg8::gemm_phase(lds, g, S, E); } \
    SEAM((P) + 3);
    MOE_PHASES(6, 0)
    if (IN(10)) { conv_layer1(a, gw, NGW, scr, lane); p8_rows(a, gw, NGW, lane); }
    SEAM(10);
    if (IN(11)) { pg8::Gemm g{XN, WIN, D, D, D}; pg8::StaticOrder S; S.init(MP, NPROJ1, G, bid); pg8::EpiProj E{PROJ, NPROJ1, NPROJ1 / 256, nullptr}; pg8::gemm_phase(lds, g, S, E); }
    SEAM(11);
    if (IN(12)) uconv_rows(a, gw, NGW, lane);
    SEAM(12);
    if (IN(13)) { for (int u = bid; u < 256; u += G) { const int grp = u & 63, q = u >> 6, dir = grp & 1, nb = (grp >> 1) & 15, b = grp >> 5; scan1_unit(a, lds, b, nb, dir, q); } }
    SEAM(13);
    if (IN(14)) rglru_combine_rows(a, gw, NGW, lane);
    SEAM(14);
    if (IN(15)) { pg8::Gemm g{(const bf16_t*)(a.ws + WS_HS), (const bf16_t*)(a.ws + WS_W + W_OUT1), DR, DR, DR}; pg8::StaticOrder S; S.init(MP, D, G, bid); pg8::EpiResAdd E{H, D}; pg8::gemm_phase(lds, g, S, E); }
    SEAM(15);
    MOE_PHASES(16, 1)
#ifndef PROBE
#define PROBE 0
#endif
#if PROBE == 9
    if (IN(20)) { const unsigned* s1 = (const unsigned*)(a.ws + WS_HS); const unsigned* s2 = (const unsigned*)(a.ws + WS_H); unsigned cntd = 0;
        for (size_t i = (size_t)bid * 512 + threadIdx.x; i < (size_t)MR * D; i += (size_t)G * 512) { const unsigned x = s1[i], y = s2[i]; cntd += ((x & 0xffffu) != (y & 0xffffu)) + ((x >> 16) != (y >> 16)); }
        cntd = (unsigned)wave_sum((float)cntd); if (lane == 0 && cntd) atomicAdd((unsigned*)(a.ws + WS_CTL) + 32768, cntd); }
    if (lo == 21) { const unsigned c = *((const unsigned*)(a.ws + WS_CTL) + 32768);
        for (size_t i = (size_t)bid * 512 + threadIdx.x; i < (size_t)NBATCH * SEQ * D; i += (size_t)G * 512) a.out[i] = (i == 0) ? sqrtf(67108864.0f * (float)c) : 0.f; }
#elif PROBE
    if (IN(20)) { const bf16_t* src = (const bf16_t*)(a.ws + (PROBE == 1 ? WS_PROJ : PROBE == 2 ? WS_G : PROBE == 3 ? WS_HS : PROBE == 4 ? (WS_HS + HS_STRIDE0) : PROBE == 7 ? (WS_PROJ + (size_t)134217728) : PROBE == 8 ? (WS_PROJ + (size_t)268435456) : WS_PROJ));
        for (size_t i = (size_t)bid * 512 + threadIdx.x; i < (size_t)NBATCH * SEQ * D; i += (size_t)G * 512) a.out[i] = bf2f(src[i]); }
#else
    if (IN(20)) pfinal_rows(a, gw, NGW, lane, a.flags & 1);
#endif
#undef IN
#undef SEAM
#undef MOE_PHASES
#undef XN
#undef SMALL
#undef PROJ
#undef H
#undef WIN
#undef scr
#undef tab
}

extern "C" void kernel_launch(void* const* d_in, const int* in_sizes, int n_in, void* d_out, int out_size, void* d_ws, size_t ws_size, hipStream_t stream) {
    static int grid = 0;
    if (grid == 0) {
        if (n_in != 29 || out_size != NBATCH * SEQ * D || ws_size < WS_END) { fprintf(stderr, "kernel_launch: unexpected problem: n_in %d out %d a.ws %zu (need %zu)\n", n_in, out_size, ws_size, (size_t)WS_END); grid = -1; return; }
        int dev = 0, cus = 0, per_cu = 0;
        if (hipGetDevice(&dev) != hipSuccess || hipDeviceGetAttribute(&cus, hipDeviceAttributeMultiprocessorCount, dev) != hipSuccess) { grid = -1; return; }
        if (hipFuncSetAttribute((const void*)fwd_kernel, hipFuncAttributeMaxDynamicSharedMemorySize, LDS_BYTES) != hipSuccess) { fprintf(stderr, "kernel_launch: hipFuncSetAttribute failed\n"); grid = -1; return; }
        if (hipOccupancyMaxActiveBlocksPerMultiprocessor(&per_cu, (const void*)fwd_kernel, 512, LDS_BYTES) != hipSuccess || per_cu < 1) fprintf(stderr, "kernel_launch: occupancy query says %d\n", per_cu);
        (void)hipGetLastError();
        grid = cus > 256 ? 256 : cus;
    }
    if (grid < 0) return;
    (void)in_sizes;
    if (hipMemsetAsync((char*)d_ws + WS_CTL, 0, CTL_BYTES, stream) != hipSuccess) return;
    Args a{};
    for (int i = 0; i < 29; ++i) a.in[i] = (const float*)d_in[i];
    a.out = (float*)d_out; a.ws = (unsigned char*)d_ws;
#if MK_FUSED
    a.ph_lo = 0; a.ph_hi = NPH; a.flags = 1;
    hipLaunchKernelGGL(fwd_kernel, dim3(grid), dim3(512), LDS_BYTES, stream, a);
#else
#ifndef DBG_STOP
#define DBG_STOP 20
#endif
    a.flags = (DBG_STOP >= 10) ? 1 : 0;
#if PROBE == 9
    for (int p = 0; p < 4; ++p) { a.ph_lo = p; a.ph_hi = p + 1; a.flags = 0; hipLaunchKernelGGL(fwd_kernel, dim3(grid), dim3(512), LDS_BYTES, stream, a); }
    a.ph_lo = 3; a.ph_hi = 4; a.flags = 2; hipLaunchKernelGGL(fwd_kernel, dim3(grid), dim3(512), LDS_BYTES, stream, a);
    a.ph_lo = 20; a.ph_hi = 21; a.flags = 0; hipLaunchKernelGGL(fwd_kernel, dim3(grid), dim3(512), LDS_BYTES, stream, a);
    a.ph_lo = 21; a.ph_hi = 22; hipLaunchKernelGGL(fwd_kernel, dim3(grid), dim3(512), LDS_BYTES, stream, a);
#else
    for (int p = 0; p < NPH; ++p) { if (p >= DBG_STOP && p != 20) continue; a.ph_lo = p; a.ph_hi = p + 1; hipLaunchKernelGGL(fwd_kernel, dim3(grid), dim3(512), LDS_BYTES, stream, a); }
#endif
#endif
}
```

```cpp
#include <hip/hip_runtime.h>
#include <cstdio>
#include <cstdint>

#ifndef MK_FUSED
#define MK_FUSED 1
#endif

#define LAS __attribute__((address_space(3)))
typedef unsigned short bf16_t;
typedef short bf16x8 __attribute__((ext_vector_type(8)));
typedef short s16x4 __attribute__((ext_vector_type(4)));
typedef float f32x4 __attribute__((ext_vector_type(4)));
typedef float f32x2 __attribute__((ext_vector_type(2)));
typedef unsigned u32x4 __attribute__((ext_vector_type(4)));
typedef unsigned u32x2 __attribute__((ext_vector_type(2)));

constexpr int D = 4096, NBATCH = 2, SEQ = 8192, NMETA = 16, TP = 8256  , NCH = 129, PADF = 48;
constexpr int MR = NBATCH * TP;
constexpr int MP = 16640;
constexpr int NPROJ0 = 12288, NW0 = 12544, NPROJ1 = 10240, DR = 5120;
constexpr int NEXP = 32, DEXP = 256, SLOTS = 41216  ;
constexpr float EPS = 1e-6f;
constexpr float NEGV = -1e30f;

constexpr size_t MiB = 1u << 20;
constexpr size_t WS_CTL = 0, CTL_BYTES = 1 * MiB;
constexpr size_t WS_W = 1 * MiB;
constexpr size_t W_IN = 0, W_OUT0 = 98 * MiB, W_OUT1 = 80 * MiB, W_RI = 120 * MiB, W_UP = 134 * MiB, W_DN = 262 * MiB, W_RT = 326 * MiB;
constexpr size_t WS_H = 329 * MiB;
constexpr size_t WS_PROJ = 589 * MiB;
constexpr size_t WS_HS = 979 * MiB;
constexpr size_t WS_G = 1304 * MiB;
constexpr size_t WS_END = 1502 * MiB;
constexpr size_t XS_OFF = WS_PROJ, HID_OFF = WS_PROJ + 322 * MiB;
constexpr size_t HS_STRIDE0 = (size_t)MP * 4096 * 2, HS_STRIDE1 = (size_t)MP * DR * 2;
constexpr size_t G_STRIDE = (size_t)MP * 1024 * 2, G_ETOT = 195 * MiB;
constexpr size_t DO_XN = 0, DO_QKC = 130 * MiB, DO_SMALL = 195 * MiB, DO_LTOK = 200 * MiB, DO_LW = 205 * MiB, DO_SDST = 210 * MiB, DO_SW = 211 * MiB, DO_LRS = 212 * MiB, DO_SRS = 217 * MiB, DO_PART = 218 * MiB;
constexpr int LCAP = 16416;
constexpr int CW_BAR = 4096, CW_CNT = 16384, CW_TKT = 20480;

constexpr int LDS_BYTES = 159744;
constexpr int LDS_XB = LDS_BYTES - 16;
constexpr int LDS_TAB = LDS_BYTES - 16 - 2048;

__device__ __forceinline__ float bf2f(unsigned short b) { return __uint_as_float(((unsigned)b) << 16); }
typedef __bf16 bf16v2 __attribute__((ext_vector_type(2)));
__device__ __forceinline__ unsigned cvt_pk_bf16(float lo, float hi) { const f32x2 v = {lo, hi}; return __builtin_bit_cast(unsigned, __builtin_convertvector(v, bf16v2)); }
__device__ __forceinline__ unsigned short f2bf(float f) { return (unsigned short)(cvt_pk_bf16(f, 0.f) & 0xffffu); }
__device__ __forceinline__ float sigmoidf_(float x) { return __builtin_amdgcn_rcpf(1.0f + __expf(-x)); }
__device__ __forceinline__ float siluf_(float x) { return x * sigmoidf_(x); }
__device__ __forceinline__ float logsigf_(float x) { return fminf(x, 0.f) - log1pf(__expf(-fabsf(x))); }
__device__ __forceinline__ float softplusf_(float x) { return fmaxf(x, 0.f) + log1pf(__expf(-fabsf(x))); }
__device__ __forceinline__ float gelu_tanhf_(float x) { const float u = 0.7978845608028654f * (x + 0.044715f * x * x * x); const float t = 1.0f - 2.0f * __builtin_amdgcn_rcpf(__expf(2.0f * u) + 1.0f); return 0.5f * x * (1.0f + t); }
__device__ __forceinline__ float wave_sum(float v) {
#pragma unroll
    for (int o = 1; o < 64; o <<= 1) v += __shfl_xor(v, o);
    return v;
}
__device__ __forceinline__ bool row_valid(int r) { if (r >= MR) return false; const int p = r >= TP ? r - TP : r; return p >= PADF; }
__device__ __forceinline__ s16x4 tr_read(unsigned lds_addr) { s16x4 r; asm volatile("ds_read_b64_tr_b16 %0, %1\n\ts_waitcnt lgkmcnt(0)" : "=&v"(r) : "v"(lds_addr) : "memory"); return r; }
__device__ __forceinline__ bf16x8 tr_frag(unsigned a0, unsigned a1) {
    s16x4 x, y; asm volatile("ds_read_b64_tr_b16 %0, %2\n\tds_read_b64_tr_b16 %1, %3\n\ts_waitcnt lgkmcnt(0)" : "=&v"(x), "=&v"(y) : "v"(a0), "v"(a1) : "memory");
    bf16x8 r; r[0] = x[0]; r[1] = x[1]; r[2] = x[2]; r[3] = x[3]; r[4] = y[0]; r[5] = y[1]; r[6] = y[2]; r[7] = y[3]; return r;
}
#define MFMA16(a, b, c) __builtin_amdgcn_mfma_f32_16x16x32_bf16((a), (b), (c), 0, 0, 0)

namespace pg8 {
constexpr int BM = 256, BK = 64, HALF = 128, HTB = HALF * BK * 2, STAGE_BYTES = 8 * HTB, NXCD = 8, WGM = 8;
__host__ __device__ __forceinline__ int lds_byte(int r, int c) { const int st = (r >> 4) * 2 + (c >> 5), rr = r & 15, cc = c & 31, ob = rr * 64 + cc * 2; return st * 1024 + (ob ^ (((ob >> 9) & 1) << 5)); }
__host__ __device__ __forceinline__ void stage_rc(int b, int& R, int& C) { const int st = b / 1024, sb = b % 1024, swz = sb ^ (((sb >> 9) & 1) << 5); R = (st >> 1) * 16 + swz / 64; C = (st & 1) * 32 + (swz % 64) / 2; }
__host__ __device__ __forceinline__ int perm32(int rho) { const int n = rho >> 4, i = rho & 15; return 8 * (i >> 2) + 4 * n + (i & 3); }
struct Unit { int pm, pn, kq; };
constexpr int KSPLIT = 8;
struct Gemm { const bf16_t* A; const bf16_t* Bt; int lda, ldb, K; };
struct StaticOrder {
    int nM, nN, nwg, G, c;
    __device__ void init(int M, int N, int G_, int c_) { nM = M / BM; nN = N / BM; nwg = nM * nN; G = G_; c = c_; }
    __device__ bool next(int i, Unit& u) const {
        const long L = (long)i * G + c; if (L >= nwg) return false;
        int wgid = (int)L; { const int q = nwg / NXCD, r = nwg % NXCD, xcd = wgid % NXCD, off = wgid / NXCD; wgid = (xcd < r ? xcd * (q + 1) : r * (q + 1) + (xcd - r) * q) + off; }
        const int nig = WGM * nN, gid = wgid / nig, fm = gid * WGM, gsz = (nM - fm) < WGM ? (nM - fm) : WGM;
        u.pm = fm + ((wgid % nig) % gsz); u.pn = (wgid % nig) / gsz; u.kq = -1; return true;
    }
};
struct TailSplitOrder {
    StaticOrder so; int G, c;
    __device__ void init(int G_, int c_) { so.init(64 * BM, 16 * BM, G_, c_); G = G_; c = c_; }
    __device__ bool next(int i, Unit& u) const {
        if (so.next(i, u)) return true;
        const int L = i * G + c - so.nwg; if (L < 0 || L >= 16 * KSPLIT) return false;
        u.pm = 64; u.pn = L / KSPLIT; u.kq = L % KSPLIT; return true;
    }
};
struct MoeOrder {
    const LAS int* tab; int npn, G, c;
    __device__ bool next(int i, Unit& u) const {
        const int NT = __builtin_amdgcn_readfirstlane(tab[0]); const int L = i * G + c; if (L >= NT * npn) return false;
        const int pm = L / npn, ct = L % npn; u.pm = pm; u.pn = __builtin_amdgcn_readfirstlane(tab[64 + pm]) * npn + ct; u.kq = -1; return true;
    }
};

template <class Epi, class Sched>
__device__ __forceinline__ void gemm_phase(LAS unsigned char* lds, const Gemm g, const Sched& S, const Epi& E) {
    const int tid = threadIdx.x, wid = __builtin_amdgcn_readfirstlane(tid >> 6), lane = tid & 63, wr = wid >> 2, wc = wid & 3, fr = lane & 15, fq = lane >> 4;
    int K = g.K; asm volatile("" : "+s"(K));
    const int ntfull = K / BK, ntsplit = K / (BK * KSPLIT); const size_t ksl = (size_t)(K / KSPLIT) * 2;
    unsigned voffA[2], voffB[2];
#pragma unroll
    for (int i = 0; i < 2; ++i) { int R, C; stage_rc(tid * 16 + i * 8192, R, C); const int Rb = Epi::PERM ? ((R & ~31) + perm32(R & 31)) : R;
        voffA[i] = (unsigned)(R * g.lda + C) * 2u; voffB[i] = (unsigned)(Rb * g.ldb + C) * 2u; }
    const size_t kstep = (size_t)(BK * 2);
    const size_t hstepA = (size_t)HALF * g.lda * 2, hstepB = (size_t)HALF * g.ldb * 2;
    const size_t tstepA = 2 * hstepA, tstepB = 2 * hstepB;
    const unsigned ldsw = (unsigned)wid * 1024u;
    const int aoff = lds_byte(wr * 64 + fr, fq * 8), boff = lds_byte(wc * 32 + fr, fq * 8);
#define PG8_SA(b, h) (((b) * 2 + (h)) * HTB)
#define PG8_SB(b, h) ((4 + (b) * 2 + (h)) * HTB)
#define PG8_STAGE(bufoff, gbase, voff) do { _Pragma("unroll") for (int _i = 0; _i < 2; ++_i) \
        __builtin_amdgcn_global_load_lds((const unsigned*)((const char*)(gbase) + (voff)[_i]), (LAS unsigned*)(lds + (bufoff) + ldsw + _i * 8192), 16, 0, 0); } while (0)
#define PG8_LDA(dst, b, h) do { _Pragma("unroll") for (int m = 0; m < 4; ++m) _Pragma("unroll") for (int k = 0; k < 2; ++k) dst[m][k] = *(const LAS bf16x8*)(lds + PG8_SA(b, h) + aoff + m * 2048 + k * 1024); } while (0)
#define PG8_LDB(dst, b, h) do { _Pragma("unroll") for (int n = 0; n < 2; ++n) _Pragma("unroll") for (int k = 0; k < 2; ++k) dst[n][k] = *(const LAS bf16x8*)(lds + PG8_SB(b, h) + boff + n * 2048 + k * 1024); } while (0)
#define PG8_MMA(ai, bj, At, Bt) do { __builtin_amdgcn_s_setprio(1); _Pragma("unroll") for (int m = 0; m < 4; ++m) _Pragma("unroll") for (int n = 0; n < 2; ++n) _Pragma("unroll") for (int k = 0; k < 2; ++k) \
        acc[ai][bj][m][n] = __builtin_amdgcn_mfma_f32_16x16x32_bf16(Bt[n][k], At[m][k], acc[ai][bj][m][n], 0, 0, 0); __builtin_amdgcn_s_setprio(0); } while (0)
#define PG8_WAIT_V(n) asm volatile("s_waitcnt vmcnt(" #n ")" ::: "memory")
#define PG8_WAIT_L(n) asm volatile("s_waitcnt lgkmcnt(" #n ")" ::: "memory")
#define PG8_BAR __builtin_amdgcn_s_barrier()
#define PG8_SCHED __builtin_amdgcn_sched_barrier(0)
    Unit cur, nxt; int ui = 0;
    if (!S.next(0, cur)) return;
    f32x4 acc[2][2][4][2];
#pragma unroll
    for (int a = 0; a < 2; ++a)
#pragma unroll
        for (int b = 0; b < 2; ++b)
#pragma unroll
            for (int m = 0; m < 4; ++m)
#pragma unroll
                for (int n = 0; n < 2; ++n) acc[a][b][m][n] = (f32x4){0.f, 0.f, 0.f, 0.f};
    bf16x8 At[4][2], B0[2][2], B1[2][2];
    const char* cA = (const char*)g.A + (size_t)cur.pm * tstepA + (cur.kq < 0 ? (size_t)0 : cur.kq * ksl); const char* cB = (const char*)g.Bt + (size_t)cur.pn * tstepB + (cur.kq < 0 ? (size_t)0 : cur.kq * ksl);
    PG8_STAGE(PG8_SB(0, 0), cB, voffB); PG8_STAGE(PG8_SA(0, 0), cA, voffA); PG8_STAGE(PG8_SB(0, 1), cB + hstepB, voffB); PG8_STAGE(PG8_SA(0, 1), cA + hstepA, voffA);
    if (wr == 1) PG8_BAR;
    PG8_WAIT_V(4); PG8_BAR;
    PG8_STAGE(PG8_SB(1, 0), cB + kstep, voffB); PG8_STAGE(PG8_SA(1, 0), cA + kstep, voffA); PG8_STAGE(PG8_SB(1, 1), cB + hstepB + kstep, voffB);
    PG8_WAIT_V(6); PG8_BAR;
    for (;;) {
        const bool has_next = S.next(ui + 1, nxt);
        const char* nA = has_next ? (const char*)g.A + (size_t)nxt.pm * tstepA + (nxt.kq < 0 ? (size_t)0 : nxt.kq * ksl) : cA; const char* nB = has_next ? (const char*)g.Bt + (size_t)nxt.pn * tstepB + (nxt.kq < 0 ? (size_t)0 : nxt.kq * ksl) : cB;
        const int nt = cur.kq < 0 ? ntfull : ntsplit;
        for (int t = 0; t < nt; t += 2) {
            const bool last = (t == nt - 2);
            const char* a1 = cA + (size_t)(t + 1) * kstep;
            const char* a2 = last ? nA : cA + (size_t)(t + 2) * kstep; const char* b2 = last ? nB : cB + (size_t)(t + 2) * kstep;
            const char* a3 = a2 + kstep; const char* b3 = b2 + kstep;
            PG8_LDB(B0, 0, 0); PG8_SCHED; PG8_LDA(At, 0, 0); PG8_STAGE(PG8_SA(1, 1), a1 + hstepA, voffA);
            PG8_WAIT_L(8); PG8_BAR; PG8_WAIT_L(0); PG8_MMA(0, 0, At, B0); PG8_BAR; PG8_SCHED;
            PG8_LDB(B1, 0, 1); PG8_STAGE(PG8_SB(0, 0), b2, voffB);
            PG8_BAR; PG8_WAIT_L(0); PG8_MMA(0, 1, At, B1); PG8_BAR;
            PG8_LDA(At, 0, 1); PG8_STAGE(PG8_SA(0, 0), a2, voffA);
            PG8_BAR; PG8_WAIT_L(0); PG8_MMA(1, 0, At, B0); PG8_BAR; PG8_SCHED;
            PG8_STAGE(PG8_SB(0, 1), b2 + hstepB, voffB);
            PG8_WAIT_V(6); PG8_BAR; PG8_MMA(1, 1, At, B1); PG8_BAR;
            PG8_LDB(B0, 1, 0); PG8_SCHED; PG8_LDA(At, 1, 0); PG8_STAGE(PG8_SA(0, 1), a2 + hstepA, voffA);
            PG8_WAIT_L(8); PG8_BAR; PG8_WAIT_L(0); PG8_MMA(0, 0, At, B0); PG8_BAR; PG8_SCHED;
            PG8_LDB(B1, 1, 1); PG8_STAGE(PG8_SB(1, 0), b3, voffB);
            PG8_BAR; PG8_WAIT_L(0); PG8_MMA(0, 1, At, B1); PG8_BAR;
            PG8_LDA(At, 1, 1); PG8_STAGE(PG8_SA(1, 0), a3, voffA);
            PG8_BAR; PG8_WAIT_L(0); PG8_MMA(1, 0, At, B0); PG8_BAR; PG8_SCHED;
            PG8_STAGE(PG8_SB(1, 1), b3 + hstepB, voffB);
            PG8_WAIT_V(6); PG8_BAR; PG8_MMA(1, 1, At, B1); PG8_BAR;
        }
        E(acc, cur, wr, wc, fr, fq);
        if (!has_next) break;
#pragma unroll
        for (int a = 0; a < 2; ++a)
#pragma unroll
            for (int b = 0; b < 2; ++b)
#pragma unroll
                for (int m = 0; m < 4; ++m)
#pragma unroll
                    for (int n = 0; n < 2; ++n) acc[a][b][m][n] = (f32x4){0.f, 0.f, 0.f, 0.f};
        cur = nxt; cA = nA; cB = nB; ++ui;
    }
    PG8_WAIT_V(0);
    if (wr == 0) PG8_BAR;
    PG8_BAR;
#undef PG8_SA
#undef PG8_SB
#undef PG8_STAGE
#undef PG8_LDA
#undef PG8_LDB
#undef PG8_MMA
#undef PG8_WAIT_V
#undef PG8_WAIT_L
#undef PG8_BAR
#undef PG8_SCHED
}
struct EpiProj {
    static constexpr bool PERM = true;
    bf16_t* O; int ldc; int npn_main; float* side;
    __device__ __forceinline__ void operator()(const f32x4 (&acc)[2][2][4][2], const Unit& u, int wr, int wc, int fr, int fq) const {
        const int row0 = u.pm * BM + wr * 64 + fr;
        if (u.pn < npn_main) {
            const int col0 = u.pn * BM + wc * 32 + 8 * fq;
#pragma unroll
            for (int ai = 0; ai < 2; ++ai)
#pragma unroll
                for (int m = 0; m < 4; ++m) { bf16_t* rowp = O + (size_t)(row0 + ai * HALF + m * 16) * ldc + col0;
#pragma unroll
                    for (int bj = 0; bj < 2; ++bj) { const f32x4 v0 = acc[ai][bj][m][0], v1 = acc[ai][bj][m][1];
                        u32x4 w; w.x = cvt_pk_bf16(v0[0], v0[1]); w.y = cvt_pk_bf16(v0[2], v0[3]); w.z = cvt_pk_bf16(v1[0], v1[1]); w.w = cvt_pk_bf16(v1[2], v1[3]);
                        *(u32x4*)(rowp + bj * HALF) = w; } }
        } else if (wc < 2) {
            const int col0 = wc * 32 + 8 * fq;
#pragma unroll
            for (int ai = 0; ai < 2; ++ai)
#pragma unroll
                for (int m = 0; m < 4; ++m) { float* rowp = side + (size_t)(row0 + ai * HALF + m * 16) * 64 + col0;
                    *(f32x4*)(rowp) = acc[ai][0][m][0]; *(f32x4*)(rowp + 4) = acc[ai][0][m][1]; }
        }
    }
};
struct EpiResAdd {
    static constexpr bool PERM = false;
    float* C; int ldc; float* part;
    __device__ __forceinline__ void operator()(const f32x4 (&acc)[2][2][4][2], const Unit& u, int wr, int wc, int fr, int fq) const {
        const int col0 = u.pn * BM + wc * 32 + 4 * fq;
        if (u.kq < 0) { const int row0 = u.pm * BM + wr * 64 + fr;
#pragma unroll
            for (int ai = 0; ai < 2; ++ai)
#pragma unroll
                for (int m = 0; m < 4; ++m) { float* rowp = C + (size_t)(row0 + ai * HALF + m * 16) * ldc + col0;
#pragma unroll
                    for (int bj = 0; bj < 2; ++bj)
#pragma unroll
                        for (int n = 0; n < 2; ++n) { f32x4* p = (f32x4*)(rowp + bj * HALF + n * 16); *p = *p + acc[ai][bj][m][n]; } }
        } else { const int row0 = u.kq * BM + wr * 64 + fr;
#pragma unroll
            for (int ai = 0; ai < 2; ++ai)
#pragma unroll
                for (int m = 0; m < 4; ++m) { float* rowp = part + (size_t)(row0 + ai * HALF + m * 16) * ldc + col0;
#pragma unroll
                    for (int bj = 0; bj < 2; ++bj)
#pragma unroll
                        for (int n = 0; n < 2; ++n) *(f32x4*)(rowp + bj * HALF + n * 16) = acc[ai][bj][m][n]; }
        }
    }
};
struct EpiMoeUp {
    static constexpr bool PERM = true;
    bf16_t* hid; const float* sw; const float* srs;
    __device__ __forceinline__ void operator()(const f32x4 (&acc)[2][2][4][2], const Unit& u, int wr, int wc, int fr, int fq) const {
        const int row0 = u.pm * BM + wr * 64 + fr, col0 = (u.pn & 1) * 128 + wc * 32 + 8 * fq;
#pragma unroll
        for (int ai = 0; ai < 2; ++ai)
#pragma unroll
            for (int m = 0; m < 4; ++m) { const int slot = row0 + ai * HALF + m * 16; const float rs = srs[slot], wt = sw[slot] * rs;
                float o[8];
#pragma unroll
                for (int n = 0; n < 2; ++n)
#pragma unroll
                    for (int j = 0; j < 4; ++j) o[n * 4 + j] = siluf_(acc[ai][0][m][n][j] * rs) * acc[ai][1][m][n][j] * wt;
                u32x4 w; w.x = cvt_pk_bf16(o[0], o[1]); w.y = cvt_pk_bf16(o[2], o[3]); w.z = cvt_pk_bf16(o[4], o[5]); w.w = cvt_pk_bf16(o[6], o[7]);
                *(u32x4*)(hid + (size_t)slot * DEXP + col0) = w; }
    }
};
struct EpiMoeDn {
    static constexpr bool PERM = true;
    bf16_t* y; const int* sdst;
    __device__ __forceinline__ void operator()(const f32x4 (&acc)[2][2][4][2], const Unit& u, int wr, int wc, int fr, int fq) const {
        const int row0 = u.pm * BM + wr * 64 + fr, col0 = (u.pn & 15) * BM + wc * 32 + 8 * fq;
#pragma unroll
        for (int ai = 0; ai < 2; ++ai)
#pragma unroll
            for (int m = 0; m < 4; ++m) { const int dst = sdst[row0 + ai * HALF + m * 16];
                if (dst >= 0) { bf16_t* rowp = y + (size_t)dst * D + col0;
#pragma unroll
                    for (int bj = 0; bj < 2; ++bj) { const f32x4 v0 = acc[ai][bj][m][0], v1 = acc[ai][bj][m][1];
                        u32x4 w; w.x = cvt_pk_bf16(v0[0], v0[1]); w.y = cvt_pk_bf16(v0[2], v0[3]); w.z = cvt_pk_bf16(v1[0], v1[1]); w.w = cvt_pk_bf16(v1[2], v1[3]);
                        *(u32x4*)(rowp + bj * HALF) = w; } } }
    }
};
}

#define XB_TMO      128
#define XB_XCNT(j)  (256  + 64 * (j))
#define XB_XSUB(j)  (1280 + 64 * (j))
#define XB_XGEN(j)  (2304 + 64 * (j))
#define XB_TOP      3328
#define XB_TOPGEN   3392
#define XCD_BAR_WORDS 3456
#define XB_SPIN_CAP (1u << 18)
__device__ __forceinline__ unsigned xb_ld(unsigned* p)              { return __hip_atomic_load(p, __ATOMIC_RELAXED, __HIP_MEMORY_SCOPE_AGENT); }
__device__ __forceinline__ unsigned xb_add(unsigned* p, unsigned v) { return __hip_atomic_fetch_add(p, v, __ATOMIC_RELAXED, __HIP_MEMORY_SCOPE_AGENT); }
__device__ __forceinline__ unsigned xb_xcc_id() { return (unsigned)__builtin_amdgcn_s_getreg((3 << 11) | 20) & 0xFu; }
#define XB_SPIN(cond, bar) do { unsigned _sp = 0; while (cond) { __builtin_amdgcn_s_sleep(1); \
    if ((++_sp & 255u) == 0u) { if (xb_ld(&(bar)[XB_TMO])) break; if (_sp > XB_SPIN_CAP) { atomicAdd(&(bar)[XB_TMO], 1u); break; } } } } while (0)
struct XcdBarrier { unsigned* bar; unsigned x; volatile LAS unsigned* st; };
__device__ __forceinline__ XcdBarrier xcd_barrier_post(unsigned* bar, volatile LAS unsigned* st) {
    XcdBarrier b; b.bar = bar; b.x = xb_xcc_id(); b.st = st;
    if (threadIdx.x == 0) (void)xb_add(&bar[XB_XCNT(b.x)], 1u);
    return b;
}
__device__ __forceinline__ void xcd_barrier_complete(unsigned* bar, unsigned x, unsigned& nloc, unsigned& nx) {
    const unsigned G = gridDim.x * gridDim.y * gridDim.z;
    unsigned sum, cnt, mine, sp = 0u;
    for (;;) {
        sum = 0u; cnt = 0u; mine = 0u;
#pragma unroll
        for (unsigned j = 0; j < 16; ++j) { const unsigned c = xb_ld(&bar[XB_XCNT(j)]); sum += c; cnt += (c > 0u) ? 1u : 0u; mine = (j == x) ? c : mine; }
        if (sum == G) break;
        __builtin_amdgcn_s_sleep(1);
        if ((++sp & 255u) == 0u) { if (xb_ld(&bar[XB_TMO])) break; if (sp > XB_SPIN_CAP) { atomicAdd(&bar[XB_TMO], 1u); break; } }
    }
    nloc = mine > 0u ? mine : 1u; nx = cnt > 0u ? cnt : 1u;
}
__device__ __forceinline__ void xcd_barrier(const XcdBarrier& b) {
    asm volatile("s_waitcnt vmcnt(0)" ::: "memory");
    __syncthreads();
    if (threadIdx.x == 0) {
        unsigned* bar = b.bar;
        __builtin_amdgcn_s_waitcnt(0);
        unsigned nloc = b.st[0], nx = b.st[1];
        if (nloc == 0u) { xcd_barrier_complete(bar, b.x, nloc, nx); b.st[0] = nloc; b.st[1] = nx; }
        const unsigned old = xb_add(&bar[XB_XSUB(b.x)], 1u);
        const unsigned gen = old / nloc;
        if (old + 1u == (gen + 1u) * nloc) {
            __builtin_amdgcn_fence(__ATOMIC_RELEASE, "agent");
            asm volatile("s_waitcnt vmcnt(0)" ::: "memory");
            const unsigned og = xb_add(&bar[XB_TOP], 1u);
            const unsigned tg = og / nx;
            if (og + 1u == (tg + 1u) * nx) xb_add(&bar[XB_TOPGEN], 1u);
            else XB_SPIN(xb_ld(&bar[XB_TOPGEN]) == tg, bar);
            __builtin_amdgcn_fence(__ATOMIC_ACQUIRE, "agent");
            xb_add(&bar[XB_XGEN(b.x)], 1u);
            asm volatile("s_waitcnt vmcnt(0)" ::: "memory");
        } else {
            XB_SPIN(xb_ld(&bar[XB_XGEN(b.x)]) == gen, bar);
            __builtin_amdgcn_fence(__ATOMIC_ACQUIRE, "agent");
            asm volatile("s_waitcnt vmcnt(0)" ::: "memory");
        }
    }
    __syncthreads();
}

struct Args { const float* in[29]; float* out; unsigned char* ws; int ph_lo, ph_hi, flags, pad; };
enum { I_X = 0, I_META, I_MIXN, I_FFNN, I_FINN, I_EVWIN, I_EVGB, I_EVQKC, I_EVLRUP, I_EVLRB, I_EVNA, I_EVNB, I_EVWOUT, I_ODWIN, I_ODCONV, I_ODCONVB, I_ODWR, I_ODBR, I_ODWI, I_ODBI, I_ODLAM, I_ODWOUT,
       I_MWG, I_MBG, I_MWE, I_MBE, I_MW1, I_MW3, I_MW2 };


#define LDS_WAIT() asm volatile("s_waitcnt lgkmcnt(0)" ::: "memory")

__device__ __forceinline__ void tr_item(const float* Wc, size_t ldw, bf16_t* WT, size_t ldt, int k0, int n0, LAS float* scr, int lane) {
    const int c4 = (lane & 15) * 4;
#pragma unroll 8
    for (int i = 0; i < 16; ++i) { const int kk = 4 * i + (lane >> 4); const f32x4 v = Wc ? *(const f32x4*)(Wc + (size_t)(k0 + kk) * ldw) : (f32x4){0.f, 0.f, 0.f, 0.f};
        LAS float* d = scr + kk * 65 + c4; d[0] = v[0]; d[1] = v[1]; d[2] = v[2]; d[3] = v[3]; }
    LDS_WAIT();
    const int c = lane & 7;
#pragma unroll
    for (int j = 0; j < 8; ++j) { const int n = (lane >> 3) + 8 * j; const LAS float* s = scr + (8 * c) * 65 + n;
        u32x4 o; o.x = cvt_pk_bf16(s[0 * 65], s[1 * 65]); o.y = cvt_pk_bf16(s[2 * 65], s[3 * 65]); o.z = cvt_pk_bf16(s[4 * 65], s[5 * 65]); o.w = cvt_pk_bf16(s[6 * 65], s[7 * 65]);
        *(u32x4*)(WT + (size_t)(n0 + n) * ldt + k0 + 8 * c) = o; }
    LDS_WAIT();
}
__device__ __forceinline__ void conv_moe_items(const Args& a, int layer, int gw, int NGW, LAS float* scr, int lane) {
    unsigned char* wsw = a.ws + WS_W;
    constexpr int I_UP = 32 * 64 * 8, I_DN = 32 * 4 * 64;
    const int c4 = (lane & 15) * 4;
    for (int it = gw; it < I_UP + I_DN; it += NGW) {
        if (it < I_UP) { const int e = it >> 9, r = it & 511, kb = r >> 3, nb = r & 7; const int n = 64 * nb;
            const float* src = ((n & 255) < 128 ? a.in[I_MW1] : a.in[I_MW3]) + ((size_t)(layer * NEXP + e)) * 4096 * 256 + ((n >> 8) * 128 + (n & 127)) + c4;
            tr_item(src, 256, (bf16_t*)(wsw + W_UP) + (size_t)e * 512 * 4096, 4096, 64 * kb, 64 * nb, scr, lane);
        } else { const int r0 = it - I_UP, e = r0 >> 8, r = r0 & 255, kb = r >> 6, nb = r & 63;
            const float* src = a.in[I_MW2] + ((size_t)(layer * NEXP + e)) * 256 * 4096 + 64 * nb + c4;
            tr_item(src, 4096, (bf16_t*)(wsw + W_DN) + (size_t)e * 4096 * 256, 256, 64 * kb, 64 * nb, scr, lane); }
    }
    bf16_t* rth = (bf16_t*)(wsw + W_RT); bf16_t* rtl = rth + 48 * D; const float* gf = a.in[I_FFNN] + layer * D;
    for (int i = gw * 64 + lane; i < 48 * D; i += NGW * 64) { const int j = i >> 12, d = i & 4095;
        const float w = j < 4 ? a.in[I_MWG][((size_t)layer * D + d) * 4 + j] : (j < 36 ? a.in[I_MWE][((size_t)layer * D + d) * 32 + (j - 4)] : 0.f);
        const float v = gf[d] * w; const unsigned short hi = f2bf(v); rth[i] = hi; rtl[i] = f2bf(v - bf2f(hi)); }
}
__device__ __forceinline__ void conv_layer0(const Args& a, int gw, int NGW, LAS float* scr, int lane) {
    unsigned char* wsw = a.ws + WS_W;
    constexpr int NBLK = NW0 / 64, I_A = 64 * NBLK, I_B = 64 * 64;
    const int c4 = (lane & 15) * 4;
    for (int it = gw; it < I_A + I_B; it += NGW) {
        if (it < I_A) { const int kb = it / NBLK, nb = it % NBLK; const int n = 64 * nb + c4;
            const int col = n < 6144 ? n : (n < 12288 ? n + 16 : (n < 12304 ? 6144 + (n - 12288) : (n < 12336 ? n : -1)));
            tr_item(col >= 0 ? a.in[I_EVWIN] + col : nullptr, 12336, (bf16_t*)(wsw + W_IN), 4096, 64 * kb, 64 * nb, scr, lane);
        } else { const int r = it - I_A, kb = r >> 6, nb = r & 63;
            tr_item(a.in[I_EVWOUT] + 64 * nb + c4, 4096, (bf16_t*)(wsw + W_OUT0), 4096, 64 * kb, 64 * nb, scr, lane); }
    }
    conv_moe_items(a, 0, gw, NGW, scr, lane);
}
__device__ __forceinline__ void conv_layer1(const Args& a, int gw, int NGW, LAS float* scr, int lane) {
    unsigned char* wsw = a.ws + WS_W;
    constexpr int I_A = 64 * 160, I_B = 80 * 64, I_C = 64 * 25;
    const int c4 = (lane & 15) * 4;
    for (int it = gw; it < I_A + I_B + I_C; it += NGW) {
        if (it < I_A) { const int kb = it / 160, nb = it % 160;
            tr_item(a.in[I_ODWIN] + 64 * nb + c4, NPROJ1, (bf16_t*)(wsw + W_IN), 4096, 64 * kb, 64 * nb, scr, lane);
        } else if (it < I_A + I_B) { const int r = it - I_A, kb = r >> 6, nb = r & 63;
            tr_item(a.in[I_ODWOUT] + 64 * nb + c4, 4096, (bf16_t*)(wsw + W_OUT1), DR, 64 * kb, 64 * nb, scr, lane);
        } else { const int r = it - I_A - I_B, mm = r / 25, q = r % 25, kb = q / 5, nb = q % 5;
            const float* src = ((mm & 1) ? a.in[I_ODWI] : a.in[I_ODWR]) + (size_t)(mm >> 1) * 320 * 320 + 64 * nb + c4;
            tr_item(src, 320, (bf16_t*)(wsw + W_RI) + (size_t)mm * 320 * 320, 320, 64 * kb, 64 * nb, scr, lane); }
    }
    conv_moe_items(a, 1, gw, NGW, scr, lane);
}

__device__ __forceinline__ void load_row(const float* p, int lane, f32x4 (&v)[16]) {
#pragma unroll
    for (int j = 0; j < 16; ++j) v[j] = *(const f32x4*)(p + (j * 64 + lane) * 4);
}
__device__ __forceinline__ float row_ss(const f32x4 (&v)[16]) { float s = 0.f;
#pragma unroll
    for (int j = 0; j < 16; ++j) s += (v[j][0] * v[j][0] + v[j][1] * v[j][1]) + (v[j][2] * v[j][2] + v[j][3] * v[j][3]);
    return wave_sum(s); }
__device__ __forceinline__ void store_row_bf16_scaled(bf16_t* o, const f32x4 (&v)[16], float rstd, const float* g, int lane) {
#pragma unroll
    for (int j = 0; j < 16; ++j) { const f32x4 gg = *(const f32x4*)(g + (j * 64 + lane) * 4);
        u32x2 w; w.x = cvt_pk_bf16(v[j][0] * rstd * gg[0], v[j][1] * rstd * gg[1]); w.y = cvt_pk_bf16(v[j][2] * rstd * gg[2], v[j][3] * rstd * gg[3]);
        *(u32x2*)(o + (j * 64 + lane) * 4) = w; }
}
__device__ __forceinline__ void zero_row_bf16(bf16_t* o, int lane) {
#pragma unroll
    for (int j = 0; j < 8; ++j) *(u32x4*)(o + (j * 64 + lane) * 8) = (u32x4){0u, 0u, 0u, 0u};
}
__device__ __forceinline__ void add_y(f32x4 (&v)[16], const bf16_t* y, int lane) {
#pragma unroll
    for (int j = 0; j < 16; ++j) { const u32x2 w = *(const u32x2*)(y + (j * 64 + lane) * 4);
        v[j][0] += __uint_as_float(w.x << 16); v[j][1] += __uint_as_float(w.x & 0xffff0000u); v[j][2] += __uint_as_float(w.y << 16); v[j][3] += __uint_as_float(w.y & 0xffff0000u); }
}

__device__ __forceinline__ void p0_rows(const Args& a, int gw, int NGW, int lane) {
    float* H = (float*)(a.ws + WS_H); bf16_t* XN = (bf16_t*)((unsigned char*)a.out + DO_XN);
    for (int r = gw; r < MP; r += NGW) {
        if (row_valid(r)) { const int b = r >= TP ? 1 : 0, p = r - b * TP;
            const float* src = p < 64 ? a.in[I_META] + (size_t)(p - PADF) * D : a.in[I_X] + ((size_t)b * SEQ + (p - 64)) * D;
            f32x4 v[16]; load_row(src, lane, v); const float rstd = rsqrtf(row_ss(v) * (1.0f / D) + EPS);
#pragma unroll
            for (int j = 0; j < 16; ++j) *(f32x4*)(H + (size_t)r * D + (j * 64 + lane) * 4) = v[j];
            store_row_bf16_scaled(XN + (size_t)r * D, v, rstd, a.in[I_MIXN], lane);
        } else {
#pragma unroll
            for (int j = 0; j < 16; ++j) *(f32x4*)(H + (size_t)r * D + (j * 64 + lane) * 4) = (f32x4){0.f, 0.f, 0.f, 0.f};
            zero_row_bf16(XN + (size_t)r * D, lane); }
    }
}
__device__ __forceinline__ void p8_rows(const Args& a, int gw, int NGW, int lane) {
    float* H = (float*)(a.ws + WS_H); bf16_t* XN = (bf16_t*)((unsigned char*)a.out + DO_XN); const bf16_t* Y = (const bf16_t*)(a.ws + WS_HS);
    for (int r = gw; r < MP; r += NGW) {
        if (row_valid(r)) { f32x4 v[16]; load_row(H + (size_t)r * D, lane, v); add_y(v, Y + (size_t)r * D, lane); add_y(v, Y + ((size_t)MP + r) * D, lane);
            const float rstd = rsqrtf(row_ss(v) * (1.0f / D) + EPS);
#pragma unroll
            for (int j = 0; j < 16; ++j) *(f32x4*)(H + (size_t)r * D + (j * 64 + lane) * 4) = v[j];
            store_row_bf16_scaled(XN + (size_t)r * D, v, rstd, a.in[I_MIXN] + D, lane);
        } else zero_row_bf16(XN + (size_t)r * D, lane);
    }
}
__device__ __forceinline__ void pfinal_rows(const Args& a, int gw, int NGW, int lane, int addy) {
    const float* H = (const float*)(a.ws + WS_H); const bf16_t* Y = (const bf16_t*)(a.ws + WS_HS);
    for (int i = gw; i < NBATCH * SEQ; i += NGW) { const int b = i >> 13, t = i & (SEQ - 1), r = b * TP + 64 + t;
        f32x4 v[16]; load_row(H + (size_t)r * D, lane, v); if (addy) { add_y(v, Y + (size_t)r * D, lane); add_y(v, Y + ((size_t)MP + r) * D, lane); }
        const float rstd = rsqrtf(row_ss(v) * (1.0f / D) + EPS);
#pragma unroll
        for (int j = 0; j < 16; ++j) { const f32x4 gg = *(const f32x4*)(a.in[I_FINN] + (j * 64 + lane) * 4);
            *(f32x4*)(a.out + (size_t)i * D + (j * 64 + lane) * 4) = (f32x4){v[j][0] * rstd * gg[0], v[j][1] * rstd * gg[1], v[j][2] * rstd * gg[2], v[j][3] * rstd * gg[3]}; }
    }
}

__device__ __forceinline__ void route_one(const float (&lg)[36], const float* bg, const float* be, int& e1, int& e2, float& w1, float& w2) {
    float gl[4];
#pragma unroll
    for (int g = 0; g < 4; ++g) gl[g] = lg[g] + bg[g];
    int gi = 0; float gm = gl[0];
#pragma unroll
    for (int g = 1; g < 4; ++g) if (gl[g] > gm) { gm = gl[g]; gi = g; }
    float gs = 0.f;
#pragma unroll
    for (int g = 0; g < 4; ++g) gs += __expf(gl[g] - gm);
    const float gval = 1.0f / gs;
    float el[8];
#pragma unroll
    for (int e = 0; e < 8; ++e) { float x = lg[4 + e] + be[e];
#pragma unroll
        for (int g = 1; g < 4; ++g) { const float y = lg[4 + g * 8 + e] + be[g * 8 + e]; x = (gi == g) ? y : x; }
        el[e] = x; }
    int i1 = 0; float m1 = el[0];
#pragma unroll
    for (int e = 1; e < 8; ++e) if (el[e] > m1) { m1 = el[e]; i1 = e; }
    int i2 = -1; float m2 = -3.0e38f;
#pragma unroll
    for (int e = 0; e < 8; ++e) if (e != i1 && el[e] > m2) { m2 = el[e]; i2 = e; }
    const float p2 = __expf(m2 - m1), s = 1.0f / (1.0f + p2);
    e1 = gi * 8 + i1; e2 = gi * 8 + i2; w1 = s * gval; w2 = p2 * s * gval;
}
__device__ __forceinline__ void route_rows(const Args& a, LAS unsigned char* lds, int wave, int layer, int gw, int NGW, int lane) {
    const float* H = (const float*)(a.ws + WS_H); bf16_t* XN = (bf16_t*)((unsigned char*)a.out + DO_XN);
    const bf16_t* rth = (const bf16_t*)(a.ws + WS_W + W_RT); const bf16_t* rtl = rth + 48 * D; const float* gf = a.in[I_FFNN] + layer * D;
    const float* bg = a.in[I_MBG] + layer * 4; const float* be = a.in[I_MBE] + layer * 32;
    unsigned* cnt = (unsigned*)(a.ws + WS_CTL) + CW_CNT + layer * 64;
    int* ltok = (int*)((unsigned char*)a.out + DO_LTOK) + (size_t)layer * NEXP * LCAP; float* lw = (float*)((unsigned char*)a.out + DO_LW) + (size_t)layer * NEXP * LCAP;
    float* lrs = (float*)((unsigned char*)a.out + DO_LRS) + (size_t)layer * NEXP * LCAP;
    const int g = lane >> 4, l15 = lane & 15;
    LAS float* lgs = (LAS float*)(lds + wave * 4096);
    for (int task = gw; task < MP / 16; task += NGW) {
        const int row = task * 16 + l15;
        const float* hp = H + (size_t)row * D + 8 * g; bf16_t* xp = XN + (size_t)row * D + 8 * g;
        const bf16_t* bh = rth + (size_t)l15 * D + 8 * g; const bf16_t* bl = rtl + (size_t)l15 * D + 8 * g;
        f32x4 acc[3]; acc[0] = acc[1] = acc[2] = (f32x4){0.f, 0.f, 0.f, 0.f};
        float ss = 0.f;
#pragma unroll 4
        for (int ks = 0; ks < 128; ++ks) {
            const f32x4 h0 = *(const f32x4*)(hp + 32 * ks), h1 = *(const f32x4*)(hp + 32 * ks + 4);
            const f32x4 g0 = *(const f32x4*)(gf + 32 * ks + 8 * g), g1 = *(const f32x4*)(gf + 32 * ks + 8 * g + 4);
            ss += (h0[0] * h0[0] + h0[1] * h0[1]) + (h0[2] * h0[2] + h0[3] * h0[3]) + (h1[0] * h1[0] + h1[1] * h1[1]) + (h1[2] * h1[2] + h1[3] * h1[3]);
            u32x4 xo; xo.x = cvt_pk_bf16(h0[0] * g0[0], h0[1] * g0[1]); xo.y = cvt_pk_bf16(h0[2] * g0[2], h0[3] * g0[3]); xo.z = cvt_pk_bf16(h1[0] * g1[0], h1[1] * g1[1]); xo.w = cvt_pk_bf16(h1[2] * g1[2], h1[3] * g1[3]);
            *(u32x4*)(xp + 32 * ks) = xo;
            u32x4 hi; hi.x = cvt_pk_bf16(h0[0], h0[1]); hi.y = cvt_pk_bf16(h0[2], h0[3]); hi.z = cvt_pk_bf16(h1[0], h1[1]); hi.w = cvt_pk_bf16(h1[2], h1[3]);
            u32x4 lo; lo.x = cvt_pk_bf16(h0[0] - __uint_as_float(hi.x << 16), h0[1] - __uint_as_float(hi.x & 0xffff0000u)); lo.y = cvt_pk_bf16(h0[2] - __uint_as_float(hi.y << 16), h0[3] - __uint_as_float(hi.y & 0xffff0000u));
            lo.z = cvt_pk_bf16(h1[0] - __uint_as_float(hi.z << 16), h1[1] - __uint_as_float(hi.z & 0xffff0000u)); lo.w = cvt_pk_bf16(h1[2] - __uint_as_float(hi.w << 16), h1[3] - __uint_as_float(hi.w & 0xffff0000u));
            const bf16x8 ahi = __builtin_bit_cast(bf16x8, hi), alo = __builtin_bit_cast(bf16x8, lo);
#pragma unroll
            for (int nt = 0; nt < 3; ++nt) { const bf16x8 wh = *(const bf16x8*)(bh + (size_t)nt * 16 * D + 32 * ks), wl = *(const bf16x8*)(bl + (size_t)nt * 16 * D + 32 * ks);
                acc[nt] = MFMA16(ahi, wh, acc[nt]); acc[nt] = MFMA16(ahi, wl, acc[nt]); acc[nt] = MFMA16(alo, wh, acc[nt]); }
        }
        ss += __shfl_xor(ss, 16); ss += __shfl_xor(ss, 32);
        const float rstd = rsqrtf(ss * (1.0f / D) + EPS);
        if (g == 0) lgs[800 + l15] = rstd;
#pragma unroll
        for (int nt = 0; nt < 3; ++nt)
#pragma unroll
            for (int rr = 0; rr < 4; ++rr) lgs[(4 * g + rr) * 49 + 16 * nt + l15] = acc[nt][rr];
        LDS_WAIT();
        if (lane < 16) { const int r = task * 16 + lane;
            if (row_valid(r)) { const float rs = lgs[800 + lane]; float lg[36];
#pragma unroll
                for (int j = 0; j < 36; ++j) lg[j] = lgs[lane * 49 + j] * rs;
                int e1, e2; float w1, w2; route_one(lg, bg, be, e1, e2, w1, w2);
                const unsigned p1 = atomicAdd(&cnt[e1], 1u); ltok[(size_t)e1 * LCAP + p1] = r * 2; lw[(size_t)e1 * LCAP + p1] = w1; lrs[(size_t)e1 * LCAP + p1] = rs;
                const unsigned p2 = atomicAdd(&cnt[e2], 1u); ltok[(size_t)e2 * LCAP + p2] = r * 2 + 1; lw[(size_t)e2 * LCAP + p2] = w2; lrs[(size_t)e2 * LCAP + p2] = rs; } }
        LDS_WAIT();
    }
}
__device__ __forceinline__ void build_tab(LAS int* tab, const unsigned* cnt) {
    if (threadIdx.x == 0) { int acc = 0;
        for (int e = 0; e < NEXP; ++e) { const int c = (int)__hip_atomic_load(cnt + e, __ATOMIC_RELAXED, __HIP_MEMORY_SCOPE_AGENT); const int nt = (c + 255) >> 8; tab[1 + e] = acc; for (int k = 0; k < nt; ++k) tab[64 + acc + k] = e; acc += nt; }
        tab[0] = acc; }
    __syncthreads();
}
__device__ __forceinline__ void gather_slots(const Args& a, int layer, LAS int* tab, int gw, int NGW, int lane) {
    const unsigned* cnt = (const unsigned*)(a.ws + WS_CTL) + CW_CNT + layer * 64;
    const int* ltok = (const int*)((unsigned char*)a.out + DO_LTOK) + (size_t)layer * NEXP * LCAP; const float* lw = (const float*)((unsigned char*)a.out + DO_LW) + (size_t)layer * NEXP * LCAP;
    const bf16_t* XN = (const bf16_t*)((unsigned char*)a.out + DO_XN); bf16_t* XS = (bf16_t*)(a.ws + XS_OFF);
    int* sdst = (int*)((unsigned char*)a.out + DO_SDST); float* sw = (float*)((unsigned char*)a.out + DO_SW); float* srs = (float*)((unsigned char*)a.out + DO_SRS);
    const float* lrs = (const float*)((unsigned char*)a.out + DO_LRS) + (size_t)layer * NEXP * LCAP;
    const int NT = tab[0];
    for (int s = gw; s < NT * 256; s += NGW) { const int e = tab[64 + (s >> 8)], pos = s - 256 * tab[1 + e]; const int c = (int)__hip_atomic_load(cnt + e, __ATOMIC_RELAXED, __HIP_MEMORY_SCOPE_AGENT);
        if (pos < c) { const int tok = ltok[(size_t)e * LCAP + pos], r = tok >> 1, k = tok & 1;
#pragma unroll
            for (int j = 0; j < 8; ++j) *(u32x4*)(XS + (size_t)s * D + (j * 64 + lane) * 8) = *(const u32x4*)(XN + (size_t)r * D + (j * 64 + lane) * 8);
            if (lane == 0) { sdst[s] = k * MP + r; sw[s] = lw[(size_t)e * LCAP + pos]; srs[s] = lrs[(size_t)e * LCAP + pos]; }
        } else if (lane == 0) { sdst[s] = -1; sw[s] = 0.f; srs[s] = 0.f; }
    }
}

__device__ __forceinline__ void qkconv_rows(const Args& a, int gw, int NGW, int lane) {
    const bf16_t* P = (const bf16_t*)(a.ws + WS_PROJ); bf16_t* Q = (bf16_t*)((unsigned char*)a.out + DO_QKC); const float* cw = a.in[I_EVQKC];
    for (int r = gw; r < MP; r += NGW) {
        if (!row_valid(r)) {
#pragma unroll
            for (int k = 0; k < 4; ++k) *(u32x4*)(Q + (size_t)r * 2048 + k * 512 + lane * 8) = (u32x4){0u, 0u, 0u, 0u};
            continue; }
#pragma unroll
        for (int k = 0; k < 4; ++k) { const int c = k * 512 + lane * 8; float acc[8];
#pragma unroll
            for (int j = 0; j < 8; ++j) acc[j] = 0.f;
#pragma unroll
            for (int t = 0; t < 4; ++t) { const int rr = r + t - 2; const u32x4 raw = *(const u32x4*)(P + (size_t)rr * NPROJ0 + c);
                const f32x4 w0 = *(const f32x4*)(cw + t * 2048 + c), w1 = *(const f32x4*)(cw + t * 2048 + c + 4);
                acc[0] += __uint_as_float(raw.x << 16) * w0[0]; acc[1] += __uint_as_float(raw.x & 0xffff0000u) * w0[1]; acc[2] += __uint_as_float(raw.y << 16) * w0[2]; acc[3] += __uint_as_float(raw.y & 0xffff0000u) * w0[3];
                acc[4] += __uint_as_float(raw.z << 16) * w1[0]; acc[5] += __uint_as_float(raw.z & 0xffff0000u) * w1[1]; acc[6] += __uint_as_float(raw.w << 16) * w1[2]; acc[7] += __uint_as_float(raw.w & 0xffff0000u) * w1[3]; }
            const float sc = c >= 1024 ? 0.0625f : 1.0f;
#pragma unroll
            for (int j = 0; j < 8; ++j) acc[j] = siluf_(acc[j]) * sc;
            u32x4 o; o.x = cvt_pk_bf16(acc[0], acc[1]); o.y = cvt_pk_bf16(acc[2], acc[3]); o.z = cvt_pk_bf16(acc[4], acc[5]); o.w = cvt_pk_bf16(acc[6], acc[7]);
            *(u32x4*)(Q + (size_t)r * 2048 + c) = o; }
    }
}
__device__ __forceinline__ void gla_pre_units(const Args& a, LAS unsigned char* lds, int bid, int nblk) {
    const bf16_t* P = (const bf16_t*)(a.ws + WS_PROJ); const float* SM = (const float*)((unsigned char*)a.out + DO_SMALL);
    LAS float* lrbs = (LAS float*)lds;
    LAS float* toth = (LAS float*)(lds + 4096);
    const int tid = threadIdx.x, c = tid & 255, half = tid >> 8;
    for (int u = bid; u < NBATCH * NCH * 8; u += nblk) {
        const int dir = u & 1, hd = (u >> 1) & 3, n = (u >> 3) % NCH, b = (u >> 3) / NCH;
        bf16_t* GQ = (bf16_t*)(a.ws + WS_G + (size_t)dir * G_STRIDE); bf16_t* GK1 = (bf16_t*)(a.ws + WS_G + (size_t)(2 + dir) * G_STRIDE); bf16_t* GK2 = (bf16_t*)(a.ws + WS_G + (size_t)(4 + dir) * G_STRIDE);
        float* ET = (float*)(a.ws + WS_G + G_ETOT);
        if (tid < 256) { const int i = tid >> 2, q4 = tid & 3; const int pp = 64 * n + i, p = dir ? (TP - 1 - pp) : pp;
            *(LAS f32x4*)(lrbs + i * 16 + q4 * 4) = *(const f32x4*)(SM + (size_t)(b * TP + p) * 64 + 16 + dir * 16 + q4 * 4); }
        float up[16];
#pragma unroll
        for (int rr = 0; rr < 16; ++rr) up[rr] = a.in[I_EVLRUP][(size_t)(dir * 16 + rr) * 1024 + hd * 256 + c];
        const float bias = a.in[I_EVLRB][dir * 1024 + hd * 256 + c];
        __syncthreads();
        float cumv[32]; float run = 0.f;
#pragma unroll
        for (int ii = 0; ii < 32; ++ii) { const int i = half * 32 + ii; const int pp = 64 * n + i, p = dir ? (TP - 1 - pp) : pp;
            float x = bias;
#pragma unroll
            for (int q4 = 0; q4 < 4; ++q4) { const f32x4 l = *(const LAS f32x4*)(lrbs + i * 16 + q4 * 4); x += l[0] * up[q4 * 4] + l[1] * up[q4 * 4 + 1] + l[2] * up[q4 * 4 + 2] + l[3] * up[q4 * 4 + 3]; }
            const float la = p < PADF ? 0.f : logsigf_(x) * 0.0625f; run += la; cumv[ii] = run; }
        toth[half * 256 + c] = run;
        __syncthreads();
        const float off = half ? toth[c] : 0.f, tot = toth[c] + toth[256 + c];
#pragma unroll
        for (int ii = 0; ii < 32; ++ii) { const int i = half * 32 + ii; const int pp = 64 * n + i, p = dir ? (TP - 1 - pp) : pp; const size_t r = (size_t)(b * TP + p);
            const float cum = cumv[ii] + off;
            const float q = bf2f(P[r * NPROJ0 + 6144 + hd * 256 + c]), k = bf2f(P[r * NPROJ0 + 7168 + hd * 256 + c]);
            GQ[r * 1024 + hd * 256 + c] = f2bf(q * 0.0625f * __expf(cum)); GK1[r * 1024 + hd * 256 + c] = f2bf(k * __expf(-cum)); GK2[r * 1024 + hd * 256 + c] = f2bf(k * __expf(tot - cum)); }
        if (half == 0) ET[((size_t)((dir * 2 + b) * NCH + n)) * 1024 + hd * 256 + c] = __expf(tot);
        __syncthreads();
    }
}
__device__ __forceinline__ void headnorm_rows(const Args& a, int gw, int NGW, int lane) {
    bf16_t* HF = (bf16_t*)(a.ws + WS_HS); const bf16_t* HB = (const bf16_t*)(a.ws + WS_HS + HS_STRIDE0); const bf16_t* P = (const bf16_t*)(a.ws + WS_PROJ);
    for (int r = gw; r < MP; r += NGW) {
        if (!row_valid(r)) { zero_row_bf16(HF + (size_t)r * D, lane); continue; }
#pragma unroll
        for (int hg = 0; hg < 8; ++hg) { const int col = hg * 512 + lane * 8;
            const u32x4 f = *(const u32x4*)(HF + (size_t)r * D + col), bb = *(const u32x4*)(HB + (size_t)r * D + col);
            const u32x4 gt = *(const u32x4*)(P + (size_t)r * NPROJ0 + (hg < 4 ? 4096 + col : 10240 + (col - 2048)));
            const float* nw = hg < 4 ? a.in[I_EVNA] + col : a.in[I_EVNB] + (col - 2048);
            float s[8], gv[8];
            const unsigned fw[4] = {f.x, f.y, f.z, f.w}, bw[4] = {bb.x, bb.y, bb.z, bb.w}, gw4[4] = {gt.x, gt.y, gt.z, gt.w};
#pragma unroll
            for (int j = 0; j < 4; ++j) { s[2 * j] = __uint_as_float(fw[j] << 16) + __uint_as_float(bw[j] << 16); s[2 * j + 1] = __uint_as_float(fw[j] & 0xffff0000u) + __uint_as_float(bw[j] & 0xffff0000u);
                gv[2 * j] = __uint_as_float(gw4[j] << 16); gv[2 * j + 1] = __uint_as_float(gw4[j] & 0xffff0000u); }
            float ss = 0.f;
#pragma unroll
            for (int j = 0; j < 8; ++j) ss += s[j] * s[j];
            const float rstd = rsqrtf(wave_sum(ss) * (1.0f / 512.0f) + EPS);
            const f32x4 n0 = *(const f32x4*)nw, n1 = *(const f32x4*)(nw + 4); const float nn[8] = {n0[0], n0[1], n0[2], n0[3], n1[0], n1[1], n1[2], n1[3]};
            float o[8];
#pragma unroll
            for (int j = 0; j < 8; ++j) { const float gate = hg < 4 ? sigmoidf_(gv[j]) : siluf_(gv[j]); o[j] = gate * s[j] * rstd * nn[j]; }
            u32x4 w; w.x = cvt_pk_bf16(o[0], o[1]); w.y = cvt_pk_bf16(o[2], o[3]); w.z = cvt_pk_bf16(o[4], o[5]); w.w = cvt_pk_bf16(o[6], o[7]);
            *(u32x4*)(HF + (size_t)r * D + col) = w; }
    }
}
__device__ __forceinline__ void uconv_rows(const Args& a, int gw, int NGW, int lane) {
    const bf16_t* P = (const bf16_t*)(a.ws + WS_PROJ); bf16_t* U = (bf16_t*)(a.ws + WS_G); const float* cw = a.in[I_ODCONV]; const float* cb = a.in[I_ODCONVB];
    for (int r = gw; r < MP; r += NGW) {
        const bool v = row_valid(r);
#pragma unroll
        for (int k = 0; k < 10; ++k) { const int c = k * 512 + lane * 8;
            if (!v) { *(u32x4*)(U + (size_t)r * DR + c) = (u32x4){0u, 0u, 0u, 0u}; continue; }
            const f32x4 b0 = *(const f32x4*)(cb + c), b1 = *(const f32x4*)(cb + c + 4);
            float acc[8] = {b0[0], b0[1], b0[2], b0[3], b1[0], b1[1], b1[2], b1[3]};
#pragma unroll
            for (int t = 0; t < 4; ++t) { const int rr = r + t - 2; const u32x4 raw = *(const u32x4*)(P + (size_t)rr * NPROJ1 + DR + c);
                const f32x4 w0 = *(const f32x4*)(cw + t * DR + c), w1 = *(const f32x4*)(cw + t * DR + c + 4);
                acc[0] += __uint_as_float(raw.x << 16) * w0[0]; acc[1] += __uint_as_float(raw.x & 0xffff0000u) * w0[1]; acc[2] += __uint_as_float(raw.y << 16) * w0[2]; acc[3] += __uint_as_float(raw.y & 0xffff0000u) * w0[3];
                acc[4] += __uint_as_float(raw.z << 16) * w1[0]; acc[5] += __uint_as_float(raw.z & 0xffff0000u) * w1[1]; acc[6] += __uint_as_float(raw.w << 16) * w1[2]; acc[7] += __uint_as_float(raw.w & 0xffff0000u) * w1[3]; }
            u32x4 o; o.x = cvt_pk_bf16(acc[0], acc[1]); o.y = cvt_pk_bf16(acc[2], acc[3]); o.z = cvt_pk_bf16(acc[4], acc[5]); o.w = cvt_pk_bf16(acc[6], acc[7]);
            *(u32x4*)(U + (size_t)r * DR + c) = o; }
    }
}
__device__ __forceinline__ void rglru_combine_rows(const Args& a, int gw, int NGW, int lane) {
    bf16_t* HF = (bf16_t*)(a.ws + WS_HS); const bf16_t* HB = (const bf16_t*)(a.ws + WS_HS + HS_STRIDE1); const bf16_t* P = (const bf16_t*)(a.ws + WS_PROJ);
    for (int r = gw; r < MP; r += NGW) {
        const bool v = row_valid(r);
#pragma unroll
        for (int k = 0; k < 10; ++k) { const int c = k * 512 + lane * 8;
            if (!v) { *(u32x4*)(HF + (size_t)r * DR + c) = (u32x4){0u, 0u, 0u, 0u}; continue; }
            const u32x4 f = *(const u32x4*)(HF + (size_t)r * DR + c), bb = *(const u32x4*)(HB + (size_t)r * DR + c), gt = *(const u32x4*)(P + (size_t)r * NPROJ1 + c);
            const unsigned fw[4] = {f.x, f.y, f.z, f.w}, bw[4] = {bb.x, bb.y, bb.z, bb.w}, gw4[4] = {gt.x, gt.y, gt.z, gt.w};
            float o[8];
#pragma unroll
            for (int j = 0; j < 4; ++j) { o[2 * j] = gelu_tanhf_(__uint_as_float(gw4[j] << 16)) * (__uint_as_float(fw[j] << 16) + __uint_as_float(bw[j] << 16));
                o[2 * j + 1] = gelu_tanhf_(__uint_as_float(gw4[j] & 0xffff0000u)) * (__uint_as_float(fw[j] & 0xffff0000u) + __uint_as_float(bw[j] & 0xffff0000u)); }
            u32x4 w; w.x = cvt_pk_bf16(o[0], o[1]); w.y = cvt_pk_bf16(o[2], o[3]); w.z = cvt_pk_bf16(o[4], o[5]); w.w = cvt_pk_bf16(o[6], o[7]);
            *(u32x4*)(HF + (size_t)r * DR + c) = w; }
    }
}

__device__ __forceinline__ void tail_reduce(const Args& a, LAS unsigned char* lds, int bid, int G, unsigned* tickets) {
    const int L = 4 * G + bid - 1024;
    if (G != 256 || L < 0 || L >= 16 * pg8::KSPLIT) return;
    const int ct = L / pg8::KSPLIT;
    LAS unsigned* flag = (LAS unsigned*)(lds + 64);
    asm volatile("s_waitcnt vmcnt(0)" ::: "memory");
    __syncthreads();
    if (threadIdx.x == 0) {
        __builtin_amdgcn_fence(__ATOMIC_RELEASE, "agent");
        asm volatile("s_waitcnt vmcnt(0)" ::: "memory");
        const unsigned t = __hip_atomic_fetch_add(tickets + 64 * ct, 1u, __ATOMIC_RELAXED, __HIP_MEMORY_SCOPE_AGENT);
        if (t == (unsigned)(pg8::KSPLIT - 1)) { __builtin_amdgcn_fence(__ATOMIC_ACQUIRE, "agent"); asm volatile("s_waitcnt vmcnt(0)" ::: "memory"); }
        flag[0] = t;
    }
    __syncthreads();
    if (flag[0] != (unsigned)(pg8::KSPLIT - 1)) return;
    float* H = (float*)(a.ws + WS_H); const float* PART = (const float*)((unsigned char*)a.out + DO_PART);
    for (int i = threadIdx.x; i < 256 * 64; i += 512) { const int r = i >> 6, c4 = (i & 63) * 4 + ct * 256;
        f32x4 h = *(const f32x4*)(H + (size_t)(16384 + r) * D + c4);
#pragma unroll
        for (int s = 0; s < pg8::KSPLIT; ++s) h = h + *(const f32x4*)(PART + ((size_t)(s * 256 + r)) * D + c4);
        *(f32x4*)(H + (size_t)(16384 + r) * D + c4) = h; }
}

constexpr int S0_K1 = 0, S0_K2 = 33792, S0_V = 67584, S0_VW = 78848, S0_SS = 90112, S0_CT = 99328, S0_ET = 141568, S0_GV = 142592;
constexpr int KPB = 528  , VPB = 176  , SPB = 144  ;
template <int OFF> __device__ __forceinline__ void tr_frags2(const unsigned (&ad)[2], bf16x8 (&fr)[2]) {
    s16x4 x0, y0, x1, y1;
    asm volatile("ds_read_b64_tr_b16 %0, %4\n\tds_read_b64_tr_b16 %1, %4 offset:%6\n\tds_read_b64_tr_b16 %2, %5\n\tds_read_b64_tr_b16 %3, %5 offset:%6\n\ts_waitcnt lgkmcnt(0)"
                 : "=&v"(x0), "=&v"(y0), "=&v"(x1), "=&v"(y1) : "v"(ad[0]), "v"(ad[1]), "i"(OFF) : "memory");
    fr[0] = __builtin_shufflevector(x0, y0, 0, 1, 2, 3, 4, 5, 6, 7); fr[1] = __builtin_shufflevector(x1, y1, 0, 1, 2, 3, 4, 5, 6, 7);
}
template <int OFF> __device__ __forceinline__ void tr_frags3(const unsigned (&ad)[3], bf16x8 (&fr)[3]) {
    s16x4 x0, y0, x1, y1, x2, y2;
    asm volatile("ds_read_b64_tr_b16 %0, %6\n\tds_read_b64_tr_b16 %1, %6 offset:%9\n\tds_read_b64_tr_b16 %2, %7\n\tds_read_b64_tr_b16 %3, %7 offset:%9\n\tds_read_b64_tr_b16 %4, %8\n\tds_read_b64_tr_b16 %5, %8 offset:%9\n\ts_waitcnt lgkmcnt(0)"
                 : "=&v"(x0), "=&v"(y0), "=&v"(x1), "=&v"(y1), "=&v"(x2), "=&v"(y2) : "v"(ad[0]), "v"(ad[1]), "v"(ad[2]), "i"(OFF) : "memory");
    fr[0] = __builtin_shufflevector(x0, y0, 0, 1, 2, 3, 4, 5, 6, 7); fr[1] = __builtin_shufflevector(x1, y1, 0, 1, 2, 3, 4, 5, 6, 7); fr[2] = __builtin_shufflevector(x2, y2, 0, 1, 2, 3, 4, 5, 6, 7);
}

template <int CTRL, int ROWMASK> __device__ __forceinline__ float dpp_f(float old, float src) {
    return __int_as_float(__builtin_amdgcn_update_dpp(__float_as_int(old), __float_as_int(src), CTRL, ROWMASK, 0xf, false)); }
__device__ __forceinline__ float wave_scan_sum(float v) {
    v += dpp_f<0x111, 0xf>(0.f, v); v += dpp_f<0x112, 0xf>(0.f, v); v += dpp_f<0x114, 0xf>(0.f, v); v += dpp_f<0x118, 0xf>(0.f, v);
    v += dpp_f<0x142, 0xa>(0.f, v); v += dpp_f<0x143, 0xc>(0.f, v); return v; }
__device__ __forceinline__ float wave_scan_max(float v) {
    const float ID = -3.0e38f;
    v = fmaxf(v, dpp_f<0x111, 0xf>(ID, v)); v = fmaxf(v, dpp_f<0x112, 0xf>(ID, v)); v = fmaxf(v, dpp_f<0x114, 0xf>(ID, v)); v = fmaxf(v, dpp_f<0x118, 0xf>(ID, v));
    v = fmaxf(v, dpp_f<0x142, 0xa>(ID, v)); v = fmaxf(v, dpp_f<0x143, 0xc>(ID, v)); return v; }
template <int NV> __device__ __forceinline__ void tr_state_frags(unsigned ka0, unsigned ka1, unsigned va, bf16x8 (&af)[2], bf16x8 (&bv)[5]) {
    s16x4 x0, y0, x1, y1, p0, q0, p1, q1, p2, q2, p3, q3, p4, q4;
    if (NV == 5)
        asm volatile("ds_read_b64_tr_b16 %0, %14\n\tds_read_b64_tr_b16 %1, %14 offset:2112\n\tds_read_b64_tr_b16 %2, %15\n\tds_read_b64_tr_b16 %3, %15 offset:2112\n\t"
                     "ds_read_b64_tr_b16 %4, %16\n\tds_read_b64_tr_b16 %5, %16 offset:704\n\tds_read_b64_tr_b16 %6, %16 offset:32\n\tds_read_b64_tr_b16 %7, %16 offset:736\n\t"
                     "ds_read_b64_tr_b16 %8, %16 offset:64\n\tds_read_b64_tr_b16 %9, %16 offset:768\n\tds_read_b64_tr_b16 %10, %16 offset:96\n\tds_read_b64_tr_b16 %11, %16 offset:800\n\t"
                     "ds_read_b64_tr_b16 %12, %16 offset:128\n\tds_read_b64_tr_b16 %13, %16 offset:832\n\ts_waitcnt lgkmcnt(0)"
                     : "=&v"(x0), "=&v"(y0), "=&v"(x1), "=&v"(y1), "=&v"(p0), "=&v"(q0), "=&v"(p1), "=&v"(q1), "=&v"(p2), "=&v"(q2), "=&v"(p3), "=&v"(q3), "=&v"(p4), "=&v"(q4)
                     : "v"(ka0), "v"(ka1), "v"(va) : "memory");
    else {
        asm volatile("ds_read_b64_tr_b16 %0, %12\n\tds_read_b64_tr_b16 %1, %12 offset:2112\n\tds_read_b64_tr_b16 %2, %13\n\tds_read_b64_tr_b16 %3, %13 offset:2112\n\t"
                     "ds_read_b64_tr_b16 %4, %14\n\tds_read_b64_tr_b16 %5, %14 offset:704\n\tds_read_b64_tr_b16 %6, %14 offset:32\n\tds_read_b64_tr_b16 %7, %14 offset:736\n\t"
                     "ds_read_b64_tr_b16 %8, %14 offset:64\n\tds_read_b64_tr_b16 %9, %14 offset:768\n\tds_read_b64_tr_b16 %10, %14 offset:96\n\tds_read_b64_tr_b16 %11, %14 offset:800\n\ts_waitcnt lgkmcnt(0)"
                     : "=&v"(x0), "=&v"(y0), "=&v"(x1), "=&v"(y1), "=&v"(p0), "=&v"(q0), "=&v"(p1), "=&v"(q1), "=&v"(p2), "=&v"(q2), "=&v"(p3), "=&v"(q3)
                     : "v"(ka0), "v"(ka1), "v"(va) : "memory");
        p4 = p3; q4 = q3; }
    af[0] = __builtin_shufflevector(x0, y0, 0, 1, 2, 3, 4, 5, 6, 7); af[1] = __builtin_shufflevector(x1, y1, 0, 1, 2, 3, 4, 5, 6, 7);
    bv[0] = __builtin_shufflevector(p0, q0, 0, 1, 2, 3, 4, 5, 6, 7); bv[1] = __builtin_shufflevector(p1, q1, 0, 1, 2, 3, 4, 5, 6, 7); bv[2] = __builtin_shufflevector(p2, q2, 0, 1, 2, 3, 4, 5, 6, 7);
    bv[3] = __builtin_shufflevector(p3, q3, 0, 1, 2, 3, 4, 5, 6, 7); bv[4] = __builtin_shufflevector(p4, q4, 0, 1, 2, 3, 4, 5, 6, 7);
}
static_assert(4 * KPB == 2112 && 4 * VPB == 704, "tr_state_frags hard-codes the row-group strides");

template <int KIND>
__device__ __forceinline__ void scan0_unit(const Args& a, LAS unsigned char* lds, int b, int hd, int dir, int sl, size_t hs_off) {
    constexpr int NE = KIND == 0 ? 5 : 4;
    const int tid0 = threadIdx.x, w = __builtin_amdgcn_readfirstlane(tid0 >> 6);
    const int mt = w >> 1, np = w & 1;
    const bf16_t* P = (const bf16_t*)(a.ws + WS_PROJ);
    const bf16_t *Qg, *K1g, *K2g, *Vg; int pitchQ;
    if (KIND == 0) { const bf16_t* QK = (const bf16_t*)((unsigned char*)a.out + DO_QKC); Qg = QK + hd * 256; K1g = QK + 1024 + hd * 256; K2g = K1g; pitchQ = 2048; Vg = P + 2048 + hd * 512 + sl * 64; }
    else { Qg = (const bf16_t*)(a.ws + WS_G + (size_t)dir * G_STRIDE) + hd * 256; K1g = (const bf16_t*)(a.ws + WS_G + (size_t)(2 + dir) * G_STRIDE) + hd * 256; K2g = (const bf16_t*)(a.ws + WS_G + (size_t)(4 + dir) * G_STRIDE) + hd * 256; pitchQ = 1024; Vg = P + 8192 + hd * 512 + sl * 64; }
    const float* SM = (const float*)((unsigned char*)a.out + DO_SMALL);
    const float* ETg = (const float*)(a.ws + WS_G + G_ETOT) + ((size_t)((dir * 2 + b) * NCH)) * 1024 + hd * 256;
    bf16_t* Og = (bf16_t*)(a.ws + hs_off + (size_t)dir * HS_STRIDE0) + KIND * 2048 + hd * 512 + sl * 64;
    const unsigned ldsb = (unsigned)(size_t)lds;
    f32x4 accC[2][NE];
#pragma unroll
    for (int mi = 0; mi < 2; ++mi)
#pragma unroll
        for (int ni = 0; ni < NE; ++ni) accC[mi][ni] = (f32x4){0.f, 0.f, 0.f, 0.f};
    for (int i = tid0; i < 42240 / 4; i += 512) ((LAS unsigned*)(lds + S0_CT))[i] = 0u;
    float m_prev = 0.f;
    float gbi = 0.f, gbf = 0.f;
    if (KIND == 0) { gbi = a.in[I_EVGB][(dir ? 2 : 0) * 4 + hd]; gbf = a.in[I_EVGB][(dir ? 3 : 1) * 4 + hd]; }
    const int gci = (dir ? 2 : 0) * 4 + hd, gcf = (dir ? 3 : 1) * 4 + hd;
#define PROWN(nn, i) (dir ? (TP - 1 - (64 * (nn) + (i))) : (64 * (nn) + (i)))
    u32x4 pk1[4], pk2[4], pv; float pgi = 0.f, pgf = 0.f, pet = 0.f; bf16x8 Qf[8];
#define PREFETCH_KV(nn) do { const size_t crow = (size_t)(b * TP + (dir ? TP - 64 - 64 * (nn) : 64 * (nn))); \
        const char* kb1 = (const char*)K1g + crow * pitchQ * 2; const char* kb2 = (const char*)K2g + crow * pitchQ * 2; \
        _Pragma("unroll") for (int k = 0; k < 4; ++k) { pk1[k] = *(const u32x4*)(kb1 + voK[k]); if (KIND == 1) pk2[k] = *(const u32x4*)(kb2 + voK[k]); } \
        pv = *(const u32x4*)((const char*)Vg + crow * NPROJ0 * 2 + voV); \
        if (KIND == 0) { const char* gb = (const char*)SM + crow * 256; pgi = *(const float*)(gb + voG + gci * 4); pgf = *(const float*)(gb + voG + gcf * 4); } \
        if (KIND == 1 && tid < 256) pet = ETg[(size_t)(nn) * 1024 + tid]; \
    } while (0)
#define PREFETCH_Q(nn) do { const size_t crow = (size_t)(b * TP + (dir ? TP - 64 - 64 * (nn) : 64 * (nn))); const char* qb = (const char*)Qg + crow * pitchQ * 2; \
        _Pragma("unroll") for (int ks = 0; ks < 8; ++ks) Qf[ks] = *(const bf16x8*)(qb + voQ + 64 * ks); } while (0)
    __syncthreads();
    for (int n = 0; n < NCH; ++n) {
        int tidv = tid0; asm volatile("" : "+v"(tidv));
        const int tid = tidv, lane = tid & 63, g = lane >> 4, l15 = lane & 15, q4 = l15 >> 2, p4 = lane & 3;
    unsigned voK[4];
#pragma unroll
    for (int k = 0; k < 4; ++k) { const int id = tid + 512 * k, i = id >> 5, c8 = id & 31; voK[k] = (unsigned)((dir ? 63 - i : i) * pitchQ * 2 + c8 * 16); }
    const unsigned voV = (unsigned)((dir ? 63 - (tid >> 3) : (tid >> 3)) * NPROJ0 * 2 + (tid & 7) * 16);
    const unsigned voG = (unsigned)((dir ? 63 - lane : lane) * 256);
    const unsigned voQ = (unsigned)((dir ? 63 - (16 * mt + l15) : (16 * mt + l15)) * pitchQ * 2 + 16 * g);
        if (n == 0) { PREFETCH_KV(0); PREFETCH_Q(0); }
        LAS float* gv = (LAS float*)(lds + S0_GV + w * 1024);
        float Bt = 0.f, bvec = 0.f, winter = 0.f, floorv = 0.f, wsl = 0.f, decay = 1.f, B63 = 0.f, tot = 0.f;
        if (KIND == 0) { const int p = PROWN(n, lane);
            const bool pad = p < PADF; const float li = pad ? NEGV : pgi + gbi, lf = pad ? 0.f : logsigf_(pgf + gbf);
            const float cum = wave_scan_sum(lf);
            bvec = li - cum; const float pm = wave_scan_max(bvec);
            Bt = fmaxf(m_prev, pm); winter = __expf(m_prev - Bt); floorv = __expf(-(cum + Bt));
            gv[lane] = Bt; gv[64 + lane] = bvec; gv[128 + lane] = winter; gv[192 + lane] = floorv;
            B63 = __shfl(Bt, 63); tot = __shfl(cum, 63); decay = __expf(m_prev - B63); wsl = __expf(bvec - B63); }
#pragma unroll
        for (int k = 0; k < 4; ++k) { const int id = tid + 512 * k, i = id >> 5, c8 = id & 31;
            *(LAS u32x4*)(lds + S0_K1 + i * KPB + c8 * 16) = pk1[k];
            if (KIND == 1) *(LAS u32x4*)(lds + S0_K2 + i * KPB + c8 * 16) = pk2[k]; }
        { const int i = tid >> 3, c8 = tid & 7;
            *(LAS u32x4*)(lds + S0_V + i * VPB + c8 * 16) = pv;
            if (KIND == 0) { const float s = __shfl(wsl, i);
                u32x4 o; o.x = cvt_pk_bf16(__uint_as_float(pv.x << 16) * s, __uint_as_float(pv.x & 0xffff0000u) * s); o.y = cvt_pk_bf16(__uint_as_float(pv.y << 16) * s, __uint_as_float(pv.y & 0xffff0000u) * s);
                o.z = cvt_pk_bf16(__uint_as_float(pv.z << 16) * s, __uint_as_float(pv.z & 0xffff0000u) * s); o.w = cvt_pk_bf16(__uint_as_float(pv.w << 16) * s, __uint_as_float(pv.w & 0xffff0000u) * s);
                *(LAS u32x4*)(lds + S0_VW + i * VPB + c8 * 16) = o;
                if (c8 < 2) { const float s1 = c8 == 0 ? 1.0f : 0.f;
                    *(LAS u32x4*)(lds + S0_V + i * VPB + 128 + c8 * 16) = (u32x4){cvt_pk_bf16(s1, 0.f), 0u, 0u, 0u};
                    *(LAS u32x4*)(lds + S0_VW + i * VPB + 128 + c8 * 16) = (u32x4){cvt_pk_bf16(s1 * s, 0.f), 0u, 0u, 0u}; } } }
        if (KIND == 1 && tid < 256) ((LAS float*)(lds + S0_ET))[tid] = pet;
        __syncthreads();
        { const int nn = n + 1 < NCH ? n + 1 : n; PREFETCH_KV(nn); }
        f32x4 sacc[2], oacc[3];
#pragma unroll
        for (int j = 0; j < 2; ++j) sacc[j] = (f32x4){0.f, 0.f, 0.f, 0.f};
#pragma unroll
        for (int j = 0; j < 3; ++j) oacc[j] = (f32x4){0.f, 0.f, 0.f, 0.f};
#pragma unroll
        for (int ks = 0; ks < 8; ++ks) {
#pragma unroll
            for (int j = 0; j < 2; ++j) { const int nt = 2 * np + j;
                const bf16x8 kf = *(const LAS bf16x8*)(lds + S0_K1 + (16 * nt + l15) * KPB + (32 * ks + 8 * g) * 2);
                sacc[j] = MFMA16(Qf[ks], kf, sacc[j]);
                const bf16x8 cf = *(const LAS bf16x8*)(lds + S0_CT + (16 * nt + l15) * KPB + (32 * ks + 8 * g) * 2);
                oacc[j] = MFMA16(Qf[ks], cf, oacc[j]); }
            if (KIND == 0) { const bf16x8 cf = *(const LAS bf16x8*)(lds + S0_CT + (64 + l15) * KPB + (32 * ks + 8 * g) * 2); oacc[2] = MFMA16(Qf[ks], cf, oacc[2]); }
            if (ks == 3) __builtin_amdgcn_sched_barrier(0); }
        __builtin_amdgcn_sched_barrier(0);
        { const int nn = n + 1 < NCH ? n + 1 : n; PREFETCH_Q(nn); }
        __builtin_amdgcn_sched_barrier(0);
#pragma unroll
        for (int j = 0; j < 2; ++j) { const int s = 16 * (2 * np + j) + l15; const float b_s = KIND == 0 ? gv[64 + s] : 0.f;
            f32x4 bt4 = (f32x4){0.f, 0.f, 0.f, 0.f}; if (KIND == 0) bt4 = *(const LAS f32x4*)(gv + 16 * mt + 4 * g);
#pragma unroll
            for (int rr = 0; rr < 4; ++rr) { const int t = 16 * mt + 4 * g + rr; float val;
                if (KIND == 0) val = s <= t ? sacc[j][rr] * __expf(b_s - bt4[rr]) : 0.f;
                else val = s <= t ? sacc[j][rr] : 0.f;
                *(LAS unsigned short*)(lds + S0_SS + t * SPB + s * 2) = f2bf(val); } }
        __syncthreads();
#pragma unroll
        for (int mi = 0; mi < 2; ++mi) {
            f32x4 sc;
            if (KIND == 0) sc = (f32x4){decay, decay, decay, decay};
            else sc = *(const LAS f32x4*)(lds + S0_ET + (16 * (2 * w + mi) + 4 * g) * 4);
#pragma unroll
            for (int ni = 0; ni < NE; ++ni) accC[mi][ni] = accC[mi][ni] * sc; }
#pragma unroll
        for (int ks = 0; ks < 2; ++ks) {
            const unsigned rowb = (unsigned)(32 * ks + 8 * g + q4);
            bf16x8 af[2], bv[5];
            { const unsigned kb = ldsb + (KIND == 0 ? S0_K1 : S0_K2) + rowb * KPB + 8 * p4; const unsigned vb = ldsb + (KIND == 0 ? S0_VW : S0_V) + rowb * VPB + 8 * p4;
                tr_state_frags<NE>(kb + 32 * (2 * w), kb + 32 * (2 * w + 1), vb, af, bv); }
#pragma unroll
            for (int mi = 0; mi < 2; ++mi)
#pragma unroll
                for (int ni = 0; ni < NE; ++ni) accC[mi][ni] = MFMA16(af[mi], bv[ni], accC[mi][ni]);
            __builtin_amdgcn_sched_barrier(0); }
#pragma unroll
        for (int mi = 0; mi < 2; ++mi)
#pragma unroll
            for (int ni = 0; ni < NE; ++ni) { u32x2 o; o.x = cvt_pk_bf16(accC[mi][ni][0], accC[mi][ni][1]); o.y = cvt_pk_bf16(accC[mi][ni][2], accC[mi][ni][3]);
                *(LAS u32x2*)(lds + S0_CT + (16 * ni + l15) * KPB + (16 * (2 * w + mi) + 4 * g) * 2) = o; }
        if (KIND == 0) { const f32x4 wi4 = *(const LAS f32x4*)(gv + 128 + 16 * mt + 4 * g);
#pragma unroll
            for (int j = 0; j < 3; ++j) oacc[j] = oacc[j] * wi4; }
#pragma unroll
        for (int ks = 0; ks < 2; ++ks) { const bf16x8 sf = *(const LAS bf16x8*)(lds + S0_SS + (16 * mt + l15) * SPB + (32 * ks + 8 * g) * 2);
            const unsigned vb = ldsb + S0_V + (unsigned)(32 * ks + 8 * g + q4) * VPB + 8 * p4;
            if (KIND == 0) { bf16x8 vf[3]; const unsigned ad[3] = {vb + 32 * (2 * np), vb + 32 * (2 * np + 1), vb + 128}; tr_frags3<4 * VPB>(ad, vf);
                oacc[0] = MFMA16(sf, vf[0], oacc[0]); oacc[1] = MFMA16(sf, vf[1], oacc[1]); oacc[2] = MFMA16(sf, vf[2], oacc[2]); }
            else { bf16x8 vf[2]; const unsigned ad[2] = {vb + 32 * (2 * np), vb + 32 * (2 * np + 1)}; tr_frags2<4 * VPB>(ad, vf);
                oacc[0] = MFMA16(sf, vf[0], oacc[0]); oacc[1] = MFMA16(sf, vf[1], oacc[1]); } }
#pragma unroll
        for (int rr = 0; rr < 4; ++rr) { const int t = 16 * mt + 4 * g + rr; const size_t r = (size_t)(b * TP + PROWN(n, t));
            float inv = 1.f;
            if (KIND == 0) { const float fl = gv[192 + t], den = __shfl(oacc[2][rr], g * 16); inv = __builtin_amdgcn_rcpf(fmaxf(fabsf(den), fl)); }
#pragma unroll
            for (int j = 0; j < 2; ++j) Og[r * D + 16 * (2 * np + j) + l15] = f2bf(oacc[j][rr] * inv); }
        if (KIND == 0) m_prev = tot + B63;
        __syncthreads();
    }
#undef PREFETCH_KV
#undef PREFETCH_Q
#undef PROWN
}

constexpr int S1_BT = 0, S1_A = 104960, S1_COMP = 146944, S1_HP = 149504;
constexpr int APB = 656;
__device__ __forceinline__ void scan1_unit(const Args& a, LAS unsigned char* lds, int b, int nb, int dir, int q) {
    const int tid0 = threadIdx.x, w = __builtin_amdgcn_readfirstlane(tid0 >> 6);
    const int mt = w >> 1, par = (w ^ (w >> 2)) & 1, nj = par ? 2 : 3, j0 = par * 3;
    const bf16_t* U = (const bf16_t*)(a.ws + WS_G) + nb * 320; const bf16_t* WRI = (const bf16_t*)(a.ws + WS_W + W_RI);
    bf16_t* Og = (bf16_t*)(a.ws + WS_HS + (size_t)dir * HS_STRIDE1) + nb * 320 + q * 80;
    for (int id = tid0; id < 160 * 40; id += 512) { const int row = id / 40, pc = id % 40, which = row / 80, col = 80 * q + row % 80;
        *(LAS u32x4*)(lds + S1_BT + row * APB + pc * 16) = *(const u32x4*)(WRI + ((size_t)(((dir * 16 + nb) * 2 + which) * 320 + col)) * 320 + pc * 8); }
    if (tid0 < 160) ((LAS float*)(lds + S1_HP))[tid0] = 0.f;
    float br[3], bi[3], sp[3];
    { const int l15 = tid0 & 15;
#pragma unroll
        for (int jj = 0; jj < 3; ++jj) { const int col = 16 * ((j0 + jj) < 5 ? (j0 + jj) : 4) + l15, gc = dir * DR + nb * 320 + q * 80 + col;
            br[jj] = a.in[I_ODBR][gc]; bi[jj] = a.in[I_ODBI][gc]; sp[jj] = -8.0f * softplusf_(-a.in[I_ODLAM][gc]); } }
    u32x4 pa[5];
#define PROW1(tt, i) (dir ? (TP - 1 - (64 * (tt) + (i))) : (64 * (tt) + (i)))
#define PREF1(tt) do { const size_t crow = (size_t)(b * TP + (dir ? TP - 64 - 64 * (tt) : 64 * (tt))); const char* ub = (const char*)U + crow * DR * 2; \
        _Pragma("unroll") for (int k = 0; k < 5; ++k) pa[k] = *(const u32x4*)(ub + voA[k]); } while (0)
    __syncthreads();
    for (int ti = 0; ti < NCH; ++ti) {
        int tidv = tid0; asm volatile("" : "+v"(tidv));
        const int tid = tidv, lane = tid & 63, g = lane >> 4, l15 = lane & 15;
        unsigned voA[5];
#pragma unroll
        for (int k = 0; k < 5; ++k) { const int id = tid + 512 * k, i = id / 40, pc = id % 40; voA[k] = (unsigned)((dir ? 63 - i : i) * DR * 2 + pc * 16); }
        if (ti == 0) PREF1(0);
#pragma unroll
        for (int k = 0; k < 5; ++k) { const int id = tid + 512 * k, i = id / 40, pc = id % 40; *(LAS u32x4*)(lds + S1_A + i * APB + pc * 16) = pa[k]; }
        __syncthreads();
        { const int tn = ti + 1 < NCH ? ti + 1 : ti; PREF1(tn); }
        f32x4 racc[3], iacc[3];
#pragma unroll
        for (int jj = 0; jj < 3; ++jj) { racc[jj] = (f32x4){0.f, 0.f, 0.f, 0.f}; iacc[jj] = (f32x4){0.f, 0.f, 0.f, 0.f}; }
#pragma unroll
        for (int ks = 0; ks < 10; ++ks) { const bf16x8 af = *(const LAS bf16x8*)(lds + S1_A + (16 * mt + l15) * APB + (32 * ks + 8 * g) * 2);
#pragma unroll
            for (int jj = 0; jj < 3; ++jj) if (jj < nj) { const int j = j0 + jj;
                const bf16x8 bfr = *(const LAS bf16x8*)(lds + S1_BT + (16 * j + l15) * APB + (32 * ks + 8 * g) * 2);
                const bf16x8 bfi = *(const LAS bf16x8*)(lds + S1_BT + (80 + 16 * j + l15) * APB + (32 * ks + 8 * g) * 2);
                racc[jj] = MFMA16(af, bfr, racc[jj]); iacc[jj] = MFMA16(af, bfi, iacc[jj]); }
            if (ks & 1) __builtin_amdgcn_sched_barrier(0); }
        float Ap[3][4], Hp[3][4];
#pragma unroll
        for (int jj = 0; jj < 3; ++jj) if (jj < nj) { const int col = 16 * (j0 + jj) + l15;
            float A = 1.f, Hh = 0.f;
#pragma unroll
            for (int rr = 0; rr < 4; ++rr) { const int t = 16 * mt + 4 * g + rr; const bool pad = PROW1(ti, t) < PADF;
                const float rg = sigmoidf_(racc[jj][rr] + br[jj]), ig = sigmoidf_(iacc[jj][rr] + bi[jj]);
                const float la = rg * sp[jj]; float av = __expf(la);
                const float x2 = 2.0f * la; const float m2 = x2 > -0.03f ? -x2 * (1.0f + x2 * (0.5f + x2 * (1.0f / 6.0f))) : 1.0f - av * av;
                const float mult = __builtin_amdgcn_sqrtf(fmaxf(0.f, m2));
                const float uval = bf2f(*(const LAS unsigned short*)(lds + S1_A + t * APB + (80 * q + col) * 2));
                float inp = mult * ig * uval; if (pad) { av = 1.f; inp = 0.f; }
                Hh = av * Hh + inp; A = av * A; Ap[jj][rr] = A; Hp[jj][rr] = Hh; }
            const float cA = Ap[jj][3], cH = Hp[jj][3];
            float gA = 1.f, gH = 0.f, mA = 1.f, mH = 0.f;
#pragma unroll
            for (int gg = 0; gg < 4; ++gg) { const float xa = __shfl(cA, gg * 16 + l15), xh = __shfl(cH, gg * 16 + l15);
                if (gg < g) { gH = xa * gH + xh; gA = xa * gA; }
                mH = xa * mH + xh; mA = xa * mA; }
#pragma unroll
            for (int rr = 0; rr < 4; ++rr) { Hp[jj][rr] = Hp[jj][rr] + Ap[jj][rr] * gH; Ap[jj][rr] = Ap[jj][rr] * gA; }
            if (g == 0) *(LAS f32x2*)(lds + S1_COMP + (mt * 80 + col) * 8) = (f32x2){mA, mH};
        }
        __syncthreads();
#pragma unroll
        for (int jj = 0; jj < 3; ++jj) if (jj < nj) { const int col = 16 * (j0 + jj) + l15;
            float hp = ((LAS float*)(lds + S1_HP))[(ti & 1) * 80 + col];
#pragma unroll
            for (int mm = 0; mm < 3; ++mm) if (mm < mt) { const f32x2 c = *(const LAS f32x2*)(lds + S1_COMP + (mm * 80 + col) * 8); hp = c[0] * hp + c[1]; }
#pragma unroll
            for (int rr = 0; rr < 4; ++rr) { const int t = 16 * mt + 4 * g + rr; const size_t r = (size_t)(b * TP + PROW1(ti, t));
                Og[r * DR + col] = f2bf(Hp[jj][rr] + Ap[jj][rr] * hp); }
            if (mt == 3 && g == 0) { const f32x2 c = *(const LAS f32x2*)(lds + S1_COMP + (3 * 80 + col) * 8); ((LAS float*)(lds + S1_HP))[((ti + 1) & 1) * 80 + col] = c[0] * hp + c[1]; }
        }
    }
#undef PROW1
#undef PREF1
    __syncthreads();
}

constexpr int NPH = 21;
__global__ void __launch_bounds__(512, 2) fwd_kernel(Args a) {
    extern __shared__ __attribute__((aligned(16))) unsigned char lds_raw[];
    LAS unsigned char* lds = (LAS unsigned char*)lds_raw;
    const int tid = threadIdx.x, lane = tid & 63, wave = __builtin_amdgcn_readfirstlane(tid >> 6);
    const int G = gridDim.x, bid = blockIdx.x, gw = bid * 8 + wave, NGW = G * 8;
    if (tid < 4) ((LAS unsigned*)(lds + LDS_XB))[tid] = 0u;
    __syncthreads();
    XcdBarrier bar; bar.bar = (unsigned*)(a.ws + WS_CTL) + CW_BAR; bar.x = 0; bar.st = nullptr;
#if MK_FUSED
    bar = xcd_barrier_post((unsigned*)(a.ws + WS_CTL) + CW_BAR, (volatile LAS unsigned*)(lds + LDS_XB));
#endif
    const int lo = a.ph_lo, hi = a.ph_hi;
#ifndef ONLY
#define ONLY -1
#endif
#define XN ((bf16_t*)((unsigned char*)a.out + DO_XN))
#define SMALL ((float*)((unsigned char*)a.out + DO_SMALL))
#define PROJ ((bf16_t*)(a.ws + WS_PROJ))
#define H ((float*)(a.ws + WS_H))
#define WIN ((const bf16_t*)(a.ws + WS_W + W_IN))
#define scr ((LAS float*)(lds + wave * 16896))
#define tab ((LAS int*)(lds + LDS_TAB))
#define IN(k) ((ONLY < 0 || ONLY == (k)) && lo <= (k) && (k) < hi)
#define SEAM(k) do { if (MK_FUSED && IN(k) && IN((k) + 1)) xcd_barrier(bar); } while (0)

    if (IN(0)) { conv_layer0(a, gw, NGW, scr, lane); p0_rows(a, gw, NGW, lane); }
    SEAM(0);
    if (IN(1)) { pg8::Gemm g{XN, WIN, D, D, D}; pg8::StaticOrder S; S.init(MP, NW0, G, bid); pg8::EpiProj E{PROJ, NPROJ0, NPROJ0 / 256, SMALL}; pg8::gemm_phase(lds, g, S, E); }
    SEAM(1);
    if (IN(2)) { qkconv_rows(a, gw, NGW, lane); gla_pre_units(a, lds, bid, G); }
    SEAM(2);
    if (IN(3)) { for (int u = bid; u < 256; u += G) { const int grp = u & 31, sl = u >> 5, kind = grp & 1, dir = (grp >> 1) & 1, hd = (grp >> 2) & 3, b = grp >> 4;
            if (kind == 0) scan0_unit<0>(a, lds, b, hd, dir, sl, (a.flags & 2) ? WS_H : WS_HS); else scan0_unit<1>(a, lds, b, hd, dir, sl, (a.flags & 2) ? WS_H : WS_HS); } }
    SEAM(3);
    if (IN(4)) headnorm_rows(a, gw, NGW, lane);
    SEAM(4);
    if (IN(5)) { pg8::Gemm g{(const bf16_t*)(a.ws + WS_HS), (const bf16_t*)(a.ws + WS_W + W_OUT0), D, D, D}; pg8::TailSplitOrder S; S.init(G, bid); pg8::EpiResAdd E{H, D, (float*)((unsigned char*)a.out + DO_PART)}; pg8::gemm_phase(lds, g, S, E);
        tail_reduce(a, lds, bid, G, (unsigned*)(a.ws + WS_CTL) + CW_TKT); }
    SEAM(5);
#define MOE_PHASES(P, layer) \
    if (IN(P)) route_rows(a, lds, wave, layer, gw, NGW, lane); \
    SEAM(P); \
    if (IN((P) + 1)) { build_tab(tab, (const unsigned*)(a.ws + WS_CTL) + CW_CNT + (layer) * 64); gather_slots(a, layer, tab, gw, NGW, lane); } \
    SEAM((P) + 1); \
    if (IN((P) + 2)) { build_tab(tab, (const unsigned*)(a.ws + WS_CTL) + CW_CNT + (layer) * 64); \
        pg8::Gemm g{(const bf16_t*)(a.ws + XS_OFF), (const bf16_t*)(a.ws + WS_W + W_UP), D, D, D}; pg8::MoeOrder S{tab, 2, G, bid}; \
        pg8::EpiMoeUp E{(bf16_t*)(a.ws + HID_OFF), (const float*)((unsigned char*)a.out + DO_SW), (const float*)((unsigned char*)a.out + DO_SRS)}; pg8::gemm_phase(lds, g, S, E); } \
    SEAM((P) + 2); \
    if (IN((P) + 3)) { build_tab(tab, (const unsigned*)(a.ws + WS_CTL) + CW_CNT + (layer) * 64); \
        pg8::Gemm g{(const bf16_t*)(a.ws + HID_OFF), (const bf16_t*)(a.ws + WS_W + W_DN), DEXP, DEXP, DEXP}; pg8::MoeOrder S{tab, 16, G, bid}; \
        pg8::EpiMoeDn E{(bf16_t*)(a.ws + WS_HS), (const int*)((unsigned char*)a.out + DO_SDST)}; pg8::gemm_phase(lds, g, S, E); } \
    SEAM((P) + 3);
    MOE_PHASES(6, 0)
    if (IN(10)) { conv_layer1(a, gw, NGW, scr, lane); p8_rows(a, gw, NGW, lane); }
    SEAM(10);
    if (IN(11)) { pg8::Gemm g{XN, WIN, D, D, D}; pg8::StaticOrder S; S.init(MP, NPROJ1, G, bid); pg8::EpiProj E{PROJ, NPROJ1, NPROJ1 / 256, nullptr}; pg8::gemm_phase(lds, g, S, E); }
    SEAM(11);
    if (IN(12)) uconv_rows(a, gw, NGW, lane);
    SEAM(12);
    if (IN(13)) { for (int u = bid; u < 256; u += G) { const int grp = u & 63, q = u >> 6, dir = grp & 1, nb = (grp >> 1) & 15, b = grp >> 5; scan1_unit(a, lds, b, nb, dir, q); } }
    SEAM(13);
    if (IN(14)) rglru_combine_rows(a, gw, NGW, lane);
    SEAM(14);
    if (IN(15)) { pg8::Gemm g{(const bf16_t*)(a.ws + WS_HS), (const bf16_t*)(a.ws + WS_W + W_OUT1), DR, DR, DR}; pg8::TailSplitOrder S; S.init(G, bid); pg8::EpiResAdd E{H, D, (float*)((unsigned char*)a.out + DO_PART)}; pg8::gemm_phase(lds, g, S, E);
        tail_reduce(a, lds, bid, G, (unsigned*)(a.ws + WS_CTL) + CW_TKT + 16 * 64); }
    SEAM(15);
    MOE_PHASES(16, 1)
#ifndef PROBE
#define PROBE 0
#endif
#if PROBE == 9
    if (IN(20)) { const unsigned* s1 = (const unsigned*)(a.ws + WS_HS); const unsigned* s2 = (const unsigned*)(a.ws + WS_H); unsigned cntd = 0;
        for (size_t i = (size_t)bid * 512 + threadIdx.x; i < (size_t)MR * D; i += (size_t)G * 512) { const unsigned x = s1[i], y = s2[i]; cntd += ((x & 0xffffu) != (y & 0xffffu)) + ((x >> 16) != (y >> 16)); }
        cntd = (unsigned)wave_sum((float)cntd); if (lane == 0 && cntd) atomicAdd((unsigned*)(a.ws + WS_CTL) + 32768, cntd); }
    if (lo == 21) { const unsigned c = *((const unsigned*)(a.ws + WS_CTL) + 32768);
        for (size_t i = (size_t)bid * 512 + threadIdx.x; i < (size_t)NBATCH * SEQ * D; i += (size_t)G * 512) a.out[i] = (i == 0) ? sqrtf(67108864.0f * (float)c) : 0.f; }
#elif PROBE
    if (IN(20)) { const bf16_t* src = (const bf16_t*)(a.ws + (PROBE == 1 ? WS_PROJ : PROBE == 2 ? WS_G : PROBE == 3 ? WS_HS : PROBE == 4 ? (WS_HS + HS_STRIDE0) : PROBE == 7 ? (WS_PROJ + (size_t)134217728) : PROBE == 8 ? (WS_PROJ + (size_t)268435456) : WS_PROJ));
        for (size_t i = (size_t)bid * 512 + threadIdx.x; i < (size_t)NBATCH * SEQ * D; i += (size_t)G * 512) a.out[i] = bf2f(src[i]); }
#else
    if (IN(20)) pfinal_rows(a, gw, NGW, lane, a.flags & 1);
#endif
#undef IN
#undef SEAM
#undef MOE_PHASES
#undef XN
#undef SMALL
#undef PROJ
#undef H
#undef WIN
#undef scr
#undef tab
}

extern "C" void kernel_launch(void* const* d_in, const int* in_sizes, int n_in, void* d_out, int out_size, void* d_ws, size_t ws_size, hipStream_t stream) {
    static int grid = 0;
    if (grid == 0) {
        if (n_in != 29 || out_size != NBATCH * SEQ * D || ws_size < WS_END) { fprintf(stderr, "kernel_launch: unexpected problem: n_in %d out %d a.ws %zu (need %zu)\n", n_in, out_size, ws_size, (size_t)WS_END); grid = -1; return; }
        int dev = 0, cus = 0, per_cu = 0;
        if (hipGetDevice(&dev) != hipSuccess || hipDeviceGetAttribute(&cus, hipDeviceAttributeMultiprocessorCount, dev) != hipSuccess) { grid = -1; return; }
        if (hipFuncSetAttribute((const void*)fwd_kernel, hipFuncAttributeMaxDynamicSharedMemorySize, LDS_BYTES) != hipSuccess) { fprintf(stderr, "kernel_launch: hipFuncSetAttribute failed\n"); grid = -1; return; }
        if (hipOccupancyMaxActiveBlocksPerMultiprocessor(&per_cu, (const void*)fwd_kernel, 512, LDS_BYTES) != hipSuccess || per_cu < 1) fprintf(stderr, "kernel_launch: occupancy query says %d\n", per_cu);
        (void)hipGetLastError();
        grid = cus > 256 ? 256 : cus;
    }
    if (grid < 0) return;
    (void)in_sizes;
    if (hipMemsetAsync((char*)d_ws + WS_CTL, 0, CTL_BYTES, stream) != hipSuccess) return;
    Args a{};
    for (int i = 0; i < 29; ++i) a.in[i] = (const float*)d_in[i];
    a.out = (float*)d_out; a.ws = (unsigned char*)d_ws;
#if MK_FUSED
    a.ph_lo = 0; a.ph_hi = NPH; a.flags = 1;
    hipLaunchKernelGGL(fwd_kernel, dim3(grid), dim3(512), LDS_BYTES, stream, a);
#else
#ifndef DBG_STOP
#define DBG_STOP 20
#endif
    a.flags = (DBG_STOP >= 10) ? 1 : 0;
#if PROBE == 9
    for (int p = 0; p < 4; ++p) { a.ph_lo = p; a.ph_hi = p + 1; a.flags = 0; hipLaunchKernelGGL(fwd_kernel, dim3(grid), dim3(512), LDS_BYTES, stream, a); }
    a.ph_lo = 3; a.ph_hi = 4; a.flags = 2; hipLaunchKernelGGL(fwd_kernel, dim3(grid), dim3(512), LDS_BYTES, stream, a);
    a.ph_lo = 20; a.ph_hi = 21; a.flags = 0; hipLaunchKernelGGL(fwd_kernel, dim3(grid), dim3(512), LDS_BYTES, stream, a);
    a.ph_lo = 21; a.ph_hi = 22; hipLaunchKernelGGL(fwd_kernel, dim3(grid), dim3(512), LDS_BYTES, stream, a);
#else
#ifndef DUP
#define DUP -1
#endif
    for (int p = 0; p < NPH; ++p) { if (p >= DBG_STOP && p != 20) continue; a.ph_lo = p; a.ph_hi = p + 1; hipLaunchKernelGGL(fwd_kernel, dim3(grid), dim3(512), LDS_BYTES, stream, a);
        if (p == DUP) hipLaunchKernelGGL(fwd_kernel, dim3(grid), dim3(512), LDS_BYTES, stream, a); }
#endif
#endif
}
```

```cpp
#include <hip/hip_runtime.h>
#include <cstdio>
#include <cstdint>

#ifndef MK_FUSED
#define MK_FUSED 1
#endif

#define LAS __attribute__((address_space(3)))
typedef unsigned short bf16_t;
typedef short bf16x8 __attribute__((ext_vector_type(8)));
typedef short s16x4 __attribute__((ext_vector_type(4)));
typedef float f32x4 __attribute__((ext_vector_type(4)));
typedef float f32x2 __attribute__((ext_vector_type(2)));
typedef unsigned u32x4 __attribute__((ext_vector_type(4)));
typedef unsigned u32x2 __attribute__((ext_vector_type(2)));

constexpr int D = 4096, NBATCH = 2, SEQ = 8192, NMETA = 16, TP = 8256  , NCH = 129, PADF = 48;
constexpr int MR = NBATCH * TP;
constexpr int MP = 16640;
constexpr int NPROJ0 = 12288, NW0 = 12544, NPROJ1 = 10240, DR = 5120;
constexpr int NEXP = 32, DEXP = 256, SLOTS = 41216  , LCAP = 16416  ;
constexpr float EPS = 1e-6f;
constexpr float NEGV = -1e30f;

constexpr size_t MiB = 1u << 20;
constexpr size_t WS_CTL = 0, CTL_BYTES = 1 * MiB;
constexpr size_t WS_W = 1 * MiB;
constexpr size_t W_IN = 0, W_OUT0 = 98 * MiB, W_OUT1 = 80 * MiB, W_RI = 120 * MiB, W_UP = 134 * MiB, W_DN = 262 * MiB, W_RT = 326 * MiB;
constexpr size_t WS_H = 329 * MiB;
constexpr size_t WS_PROJ = 589 * MiB;
constexpr size_t WS_HS = 979 * MiB;
constexpr size_t WS_G = 1304 * MiB;
constexpr size_t WS_END = 1502 * MiB;
constexpr size_t XS_OFF = WS_PROJ, HID_OFF = WS_PROJ + 322 * MiB;
constexpr size_t HS_STRIDE0 = (size_t)MP * 4096 * 2, HS_STRIDE1 = (size_t)MP * DR * 2;
constexpr size_t G_STRIDE = (size_t)MP * 1024 * 2, G_ETOT = 195 * MiB;
constexpr size_t DO_XN = 0, DO_QKC = 130 * MiB, DO_SMALL = 195 * MiB, DO_LTOK = 200 * MiB, DO_LW = 205 * MiB, DO_SDST = 210 * MiB, DO_SW = 211 * MiB, DO_LRS = 212 * MiB, DO_SRS = 217 * MiB, DO_PART = 218 * MiB;
constexpr int CW_BAR = 4096, CW_CNT = 16384, CW_TKT = 20480, CW_TK2 = 32768  ;

constexpr int LDS_BYTES = 159744;
constexpr int LDS_XB = LDS_BYTES - 16;
constexpr int LDS_TAB = LDS_BYTES - 16 - 2048;

__device__ __forceinline__ float bf2f(unsigned short b) { return __uint_as_float(((unsigned)b) << 16); }
typedef __bf16 bf16v2 __attribute__((ext_vector_type(2)));
__device__ __forceinline__ unsigned cvt_pk_bf16(float lo, float hi) { const f32x2 v = {lo, hi}; return __builtin_bit_cast(unsigned, __builtin_convertvector(v, bf16v2)); }
__device__ __forceinline__ unsigned short f2bf(float f) { return (unsigned short)(cvt_pk_bf16(f, 0.f) & 0xffffu); }
__device__ __forceinline__ float sigmoidf_(float x) { return __builtin_amdgcn_rcpf(1.0f + __expf(-x)); }
__device__ __forceinline__ float siluf_(float x) { return x * sigmoidf_(x); }
__device__ __forceinline__ float logsigf_(float x) { return fminf(x, 0.f) - log1pf(__expf(-fabsf(x))); }
__device__ __forceinline__ float softplusf_(float x) { return fmaxf(x, 0.f) + log1pf(__expf(-fabsf(x))); }
__device__ __forceinline__ float gelu_tanhf_(float x) { const float u = 0.7978845608028654f * (x + 0.044715f * x * x * x); const float t = 1.0f - 2.0f * __builtin_amdgcn_rcpf(__expf(2.0f * u) + 1.0f); return 0.5f * x * (1.0f + t); }
__device__ __forceinline__ float wave_sum(float v) {
#pragma unroll
    for (int o = 1; o < 64; o <<= 1) v += __shfl_xor(v, o);
    return v;
}
__device__ __forceinline__ bool row_valid(int r) { if (r >= MR) return false; const int p = r >= TP ? r - TP : r; return p >= PADF; }
__device__ __forceinline__ s16x4 tr_read(unsigned lds_addr) { s16x4 r; asm volatile("ds_read_b64_tr_b16 %0, %1\n\ts_waitcnt lgkmcnt(0)" : "=&v"(r) : "v"(lds_addr) : "memory"); return r; }
__device__ __forceinline__ bf16x8 tr_frag(unsigned a0, unsigned a1) {
    s16x4 x, y; asm volatile("ds_read_b64_tr_b16 %0, %2\n\tds_read_b64_tr_b16 %1, %3\n\ts_waitcnt lgkmcnt(0)" : "=&v"(x), "=&v"(y) : "v"(a0), "v"(a1) : "memory");
    bf16x8 r; r[0] = x[0]; r[1] = x[1]; r[2] = x[2]; r[3] = x[3]; r[4] = y[0]; r[5] = y[1]; r[6] = y[2]; r[7] = y[3]; return r;
}
#define MFMA16(a, b, c) __builtin_amdgcn_mfma_f32_16x16x32_bf16((a), (b), (c), 0, 0, 0)

namespace pg8 {
constexpr int BM = 256, BK = 64, HALF = 128, HTB = HALF * BK * 2, STAGE_BYTES = 8 * HTB, NXCD = 8, WGM = 8;
__host__ __device__ __forceinline__ int lds_byte(int r, int c) { const int st = (r >> 4) * 2 + (c >> 5), rr = r & 15, cc = c & 31, ob = rr * 64 + cc * 2; return st * 1024 + (ob ^ (((ob >> 9) & 1) << 5)); }
__host__ __device__ __forceinline__ void stage_rc(int b, int& R, int& C) { const int st = b / 1024, sb = b % 1024, swz = sb ^ (((sb >> 9) & 1) << 5); R = (st >> 1) * 16 + swz / 64; C = (st & 1) * 32 + (swz % 64) / 2; }
__host__ __device__ __forceinline__ int perm32(int rho) { const int n = rho >> 4, i = rho & 15; return 8 * (i >> 2) + 4 * n + (i & 3); }
struct Unit { int pm, pn, kq, ex, pos0, sidx; };
constexpr int KSPLIT = 8;
struct Gemm { const bf16_t* A; const bf16_t* Bt; int lda, ldb, K; float* slab; };
struct StaticOrder {
    int nM, nN, nwg, G, c;
    __device__ __forceinline__ int arow(const Unit&, int) const { return 0; }
    __device__ void init(int M, int N, int G_, int c_) { nM = M / BM; nN = N / BM; nwg = nM * nN; G = G_; c = c_; }
    __device__ int count() const { return nwg; }
    __device__ bool next(int i, Unit& u) const { const long L = (long)i * G + c; if (L >= nwg) return false; unit_of((int)L, u); return true; }
    __device__ void unit_of(int L, Unit& u) const {
        int wgid = L; { const int q = nwg / NXCD, r = nwg % NXCD, xcd = wgid % NXCD, off = wgid / NXCD; wgid = (xcd < r ? xcd * (q + 1) : r * (q + 1) + (xcd - r) * q) + off; }
        const int nig = WGM * nN, gid = wgid / nig, fm = gid * WGM, gsz = (nM - fm) < WGM ? (nM - fm) : WGM;
        u.pm = fm + ((wgid % nig) % gsz); u.pn = (wgid % nig) / gsz; u.kq = -1; u.sidx = 0;
    }
};
struct TailSplitOrder {
    StaticOrder so; int G, c;
    __device__ void init(int G_, int c_) { so.init(64 * BM, 16 * BM, G_, c_); G = G_; c = c_; }
    __device__ bool next(int i, Unit& u) const {
        if (so.next(i, u)) return true;
        const int L = i * G + c - so.nwg; if (L < 0 || L >= 16 * KSPLIT) return false;
        u.pm = 64; u.pn = L / KSPLIT; u.kq = L % KSPLIT; u.sidx = 0; return true;
    }
};
struct MoeOrder {
    const LAS int* tab; int npn, G, c; const int* ltok; const unsigned* cnt;
    __device__ int count() const { return __builtin_amdgcn_readfirstlane(tab[0]) * npn; }
    __device__ bool next(int i, Unit& u) const { const int L = i * G + c; if (L >= count()) return false; unit_of(L, u); return true; }
    __device__ void unit_of(int L, Unit& u) const {
        const int pm = L / npn, ct = L % npn, ex = __builtin_amdgcn_readfirstlane(tab[64 + pm]);
        u.pm = pm; u.pn = ex * npn + ct; u.kq = -1; u.sidx = 0; u.ex = ex; u.pos0 = (pm - __builtin_amdgcn_readfirstlane(tab[1 + ex])) * BM;
    }
    __device__ __forceinline__ int arow(const Unit& u, int s) const { const int pos = u.pos0 + s; return pos < (int)cnt[u.ex] ? (ltok[(size_t)u.ex * LCAP + pos] >> 1) : 0; }
};
struct NoGather { };

template <class Base> struct SplitTail {
    Base base; int U, F, G, c;
    __device__ void init(const Base& b, int G_, int c_, bool enable) { base = b; G = G_; c = c_; U = b.count(); F = enable ? (U / G) * G : U; }
    __device__ bool next(int i, Unit& u) const {
        const int L = i * G + c;
        if (L < F) { base.unit_of(L, u); return true; }
        const int Ls = L - F; if (Ls >= (U - F) * KSPLIT) return false;
        base.unit_of(F + Ls / KSPLIT, u); u.kq = Ls % KSPLIT; u.sidx = Ls / KSPLIT; return true;
    }
    __device__ __forceinline__ int arow(const Unit& u, int s) const { return base.arow(u, s); }
};
template <class Epi, class Sched, bool GATHER = false>
__device__ __forceinline__ void gemm_phase(LAS unsigned char* lds, const Gemm g, const Sched& S, const Epi& E) {
    const int tid = threadIdx.x, wid = __builtin_amdgcn_readfirstlane(tid >> 6), lane = tid & 63, wr = wid >> 2, wc = wid & 3, fr = lane & 15, fq = lane >> 4;
    int K = g.K; asm volatile("" : "+s"(K));
    const int ntfull = K / BK, ntsplit = K / (BK * KSPLIT); const size_t ksl = (size_t)(K / KSPLIT) * 2;
    unsigned voffA[2], voffB[2]; int pR[2], pC[2];
#pragma unroll
    for (int i = 0; i < 2; ++i) { int R, C; stage_rc(tid * 16 + i * 8192, R, C); const int Rb = Epi::PERM ? ((R & ~31) + perm32(R & 31)) : R; pR[i] = R; pC[i] = C;
        voffA[i] = (unsigned)(R * g.lda + C) * 2u; voffB[i] = (unsigned)(Rb * g.ldb + C) * 2u; }
    unsigned gvo[2][2], ngvo[2][2];
#define PG8_GVO(dst, unit) do { _Pragma("unroll") for (int _h = 0; _h < 2; ++_h) _Pragma("unroll") for (int _i = 0; _i < 2; ++_i) dst[_h][_i] = (unsigned)(S.arow(unit, _h * HALF + pR[_i]) * g.lda + pC[_i]) * 2u; \
        asm volatile("" : "+v"(dst[0][0]), "+v"(dst[0][1]), "+v"(dst[1][0]), "+v"(dst[1][1])); } while (0)
    const size_t kstep = (size_t)(BK * 2);
    const size_t hstepA = (size_t)HALF * g.lda * 2, hstepB = (size_t)HALF * g.ldb * 2;
    const size_t tstepA = 2 * hstepA, tstepB = 2 * hstepB;
    const unsigned ldsw = (unsigned)wid * 1024u;
    const int aoff = lds_byte(wr * 64 + fr, fq * 8), boff = lds_byte(wc * 32 + fr, fq * 8);
#define PG8_SA(b, h) (((b) * 2 + (h)) * HTB)
#define PG8_SB(b, h) ((4 + (b) * 2 + (h)) * HTB)
#define PG8_STAGE(bufoff, gbase, voff) do { _Pragma("unroll") for (int _i = 0; _i < 2; ++_i) \
        __builtin_amdgcn_global_load_lds((const unsigned*)((const char*)(gbase) + (voff)[_i]), (LAS unsigned*)(lds + (bufoff) + ldsw + _i * 8192), 16, 0, 0); } while (0)
#define PG8_LDA(dst, b, h) do { _Pragma("unroll") for (int m = 0; m < 4; ++m) _Pragma("unroll") for (int k = 0; k < 2; ++k) dst[m][k] = *(const LAS bf16x8*)(lds + PG8_SA(b, h) + aoff + m * 2048 + k * 1024); } while (0)
#define PG8_LDB(dst, b, h) do { _Pragma("unroll") for (int n = 0; n < 2; ++n) _Pragma("unroll") for (int k = 0; k < 2; ++k) dst[n][k] = *(const LAS bf16x8*)(lds + PG8_SB(b, h) + boff + n * 2048 + k * 1024); } while (0)
#define PG8_MMA(ai, bj, At, Bt) do { __builtin_amdgcn_s_setprio(1); _Pragma("unroll") for (int m = 0; m < 4; ++m) _Pragma("unroll") for (int n = 0; n < 2; ++n) _Pragma("unroll") for (int k = 0; k < 2; ++k) \
        acc[ai][bj][m][n] = __builtin_amdgcn_mfma_f32_16x16x32_bf16(Bt[n][k], At[m][k], acc[ai][bj][m][n], 0, 0, 0); __builtin_amdgcn_s_setprio(0); } while (0)
#define PG8_WAIT_V(n) asm volatile("s_waitcnt vmcnt(" #n ")" ::: "memory")
#define PG8_WAIT_L(n) asm volatile("s_waitcnt lgkmcnt(" #n ")" ::: "memory")
#define PG8_BAR __builtin_amdgcn_s_barrier()
#define PG8_SCHED __builtin_amdgcn_sched_barrier(0)
    Unit cur, nxt; int ui = 0;
    if (!S.next(0, cur)) return;
    f32x4 acc[2][2][4][2];
#pragma unroll
    for (int a = 0; a < 2; ++a)
#pragma unroll
        for (int b = 0; b < 2; ++b)
#pragma unroll
            for (int m = 0; m < 4; ++m)
#pragma unroll
                for (int n = 0; n < 2; ++n) acc[a][b][m][n] = (f32x4){0.f, 0.f, 0.f, 0.f};
    bf16x8 At[4][2], B0[2][2], B1[2][2];
    const char* cA = (const char*)g.A + (size_t)cur.pm * tstepA + (cur.kq < 0 ? (size_t)0 : cur.kq * ksl); const char* cB = (const char*)g.Bt + (size_t)cur.pn * tstepB + (cur.kq < 0 ? (size_t)0 : cur.kq * ksl);
    const char* gA = (const char*)g.A + (cur.kq < 0 ? (size_t)0 : cur.kq * ksl);
    if constexpr (GATHER) { PG8_GVO(gvo, cur); }
    PG8_STAGE(PG8_SB(0, 0), cB, voffB); if constexpr (GATHER) PG8_STAGE(PG8_SA(0, 0), gA, gvo[0]); else PG8_STAGE(PG8_SA(0, 0), cA, voffA);
    PG8_STAGE(PG8_SB(0, 1), cB + hstepB, voffB); if constexpr (GATHER) PG8_STAGE(PG8_SA(0, 1), gA, gvo[1]); else PG8_STAGE(PG8_SA(0, 1), cA + hstepA, voffA);
    if (wr == 1) PG8_BAR;
    PG8_WAIT_V(4); PG8_BAR;
    PG8_STAGE(PG8_SB(1, 0), cB + kstep, voffB); if constexpr (GATHER) PG8_STAGE(PG8_SA(1, 0), gA + kstep, gvo[0]); else PG8_STAGE(PG8_SA(1, 0), cA + kstep, voffA);
    PG8_STAGE(PG8_SB(1, 1), cB + hstepB + kstep, voffB);
    PG8_WAIT_V(6); PG8_BAR;
    for (;;) {
        const bool has_next = S.next(ui + 1, nxt);
        const char* nA = has_next ? (const char*)g.A + (size_t)nxt.pm * tstepA + (nxt.kq < 0 ? (size_t)0 : nxt.kq * ksl) : cA; const char* nB = has_next ? (const char*)g.Bt + (size_t)nxt.pn * tstepB + (nxt.kq < 0 ? (size_t)0 : nxt.kq * ksl) : cB;
        const int nt = cur.kq < 0 ? ntfull : ntsplit;
        const char* ngA = (const char*)g.A + ((has_next && nxt.kq >= 0) ? nxt.kq * ksl : (size_t)0); if (!has_next) ngA = gA;
        if constexpr (GATHER) { if (has_next) { PG8_GVO(ngvo, nxt); } else {
#pragma unroll
            for (int _h = 0; _h < 2; ++_h) { ngvo[_h][0] = gvo[_h][0]; ngvo[_h][1] = gvo[_h][1]; } } }
        for (int t = 0; t < nt; t += 2) {
            const bool last = (t == nt - 2);
            const char* a1 = cA + (size_t)(t + 1) * kstep;
            const char* a2 = last ? nA : cA + (size_t)(t + 2) * kstep; const char* b2 = last ? nB : cB + (size_t)(t + 2) * kstep;
            const char* a3 = a2 + kstep; const char* b3 = b2 + kstep;
            PG8_LDB(B0, 0, 0); PG8_SCHED; PG8_LDA(At, 0, 0); if constexpr (GATHER) PG8_STAGE(PG8_SA(1, 1), gA + (size_t)(t + 1) * kstep, gvo[1]); else PG8_STAGE(PG8_SA(1, 1), a1 + hstepA, voffA);
            PG8_WAIT_L(8); PG8_BAR; PG8_WAIT_L(0); PG8_MMA(0, 0, At, B0); PG8_BAR; PG8_SCHED;
            PG8_LDB(B1, 0, 1); PG8_STAGE(PG8_SB(0, 0), b2, voffB);
            PG8_BAR; PG8_WAIT_L(0); PG8_MMA(0, 1, At, B1); PG8_BAR;
            PG8_LDA(At, 0, 1); if constexpr (GATHER) { const unsigned v2[2] = {last ? ngvo[0][0] : gvo[0][0], last ? ngvo[0][1] : gvo[0][1]}; PG8_STAGE(PG8_SA(0, 0), last ? ngA : gA + (size_t)(t + 2) * kstep, v2); } else PG8_STAGE(PG8_SA(0, 0), a2, voffA);
            PG8_BAR; PG8_WAIT_L(0); PG8_MMA(1, 0, At, B0); PG8_BAR; PG8_SCHED;
            PG8_STAGE(PG8_SB(0, 1), b2 + hstepB, voffB);
            PG8_WAIT_V(6); PG8_BAR; PG8_MMA(1, 1, At, B1); PG8_BAR;
            PG8_LDB(B0, 1, 0); PG8_SCHED; PG8_LDA(At, 1, 0); if constexpr (GATHER) { const unsigned v2[2] = {last ? ngvo[1][0] : gvo[1][0], last ? ngvo[1][1] : gvo[1][1]}; PG8_STAGE(PG8_SA(0, 1), last ? ngA : gA + (size_t)(t + 2) * kstep, v2); } else PG8_STAGE(PG8_SA(0, 1), a2 + hstepA, voffA);
            PG8_WAIT_L(8); PG8_BAR; PG8_WAIT_L(0); PG8_MMA(0, 0, At, B0); PG8_BAR; PG8_SCHED;
            PG8_LDB(B1, 1, 1); PG8_STAGE(PG8_SB(1, 0), b3, voffB);
            PG8_BAR; PG8_WAIT_L(0); PG8_MMA(0, 1, At, B1); PG8_BAR;
            PG8_LDA(At, 1, 1); if constexpr (GATHER) { const unsigned v2[2] = {last ? ngvo[0][0] : gvo[0][0], last ? ngvo[0][1] : gvo[0][1]}; PG8_STAGE(PG8_SA(1, 0), (last ? ngA : gA + (size_t)(t + 2) * kstep) + kstep, v2); } else PG8_STAGE(PG8_SA(1, 0), a3, voffA);
            PG8_BAR; PG8_WAIT_L(0); PG8_MMA(1, 0, At, B0); PG8_BAR; PG8_SCHED;
            PG8_STAGE(PG8_SB(1, 1), b3 + hstepB, voffB);
            PG8_WAIT_V(6); PG8_BAR; PG8_MMA(1, 1, At, B1); PG8_BAR;
        }
        if (g.slab != nullptr && cur.kq >= 0) {
            float* sl = g.slab + ((size_t)cur.sidx * KSPLIT + cur.kq) * 65536 + tid * 4;
#pragma unroll
            for (int a = 0; a < 2; ++a)
#pragma unroll
                for (int b = 0; b < 2; ++b)
#pragma unroll
                    for (int m = 0; m < 4; ++m)
#pragma unroll
                        for (int n = 0; n < 2; ++n) *(f32x4*)(sl + (((a * 2 + b) * 4 + m) * 2 + n) * 2048) = acc[a][b][m][n];
        } else E(acc, cur, wr, wc, fr, fq);
        if (!has_next) break;
#pragma unroll
        for (int a = 0; a < 2; ++a)
#pragma unroll
            for (int b = 0; b < 2; ++b)
#pragma unroll
                for (int m = 0; m < 4; ++m)
#pragma unroll
                    for (int n = 0; n < 2; ++n) acc[a][b][m][n] = (f32x4){0.f, 0.f, 0.f, 0.f};
        cur = nxt; cA = nA; cB = nB; gA = ngA; ++ui;
        if constexpr (GATHER) {
#pragma unroll
            for (int _h = 0; _h < 2; ++_h) { gvo[_h][0] = ngvo[_h][0]; gvo[_h][1] = ngvo[_h][1]; } }
    }
    PG8_WAIT_V(0);
    if (wr == 0) PG8_BAR;
    PG8_BAR;
#undef PG8_GVO
#undef PG8_SA
#undef PG8_SB
#undef PG8_STAGE
#undef PG8_LDA
#undef PG8_LDB
#undef PG8_MMA
#undef PG8_WAIT_V
#undef PG8_WAIT_L
#undef PG8_BAR
#undef PG8_SCHED
}
template <class Epi, class Sched>
__device__ __forceinline__ void split_reduce(LAS unsigned char* lds, const Gemm g, const Sched& S, const Epi& E, unsigned* tickets) {
    const int tid = threadIdx.x, wid = __builtin_amdgcn_readfirstlane(tid >> 6), lane = tid & 63, wr = wid >> 2, wc = wid & 3, fr = lane & 15, fq = lane >> 4;
    LAS unsigned* flag = (LAS unsigned*)(lds + 64);
    for (int i = 0; ; ++i) { Unit u; if (!S.next(i, u)) break; if (u.kq < 0) continue;
        asm volatile("s_waitcnt vmcnt(0)" ::: "memory");
        __syncthreads();
        if (tid == 0) {
            __builtin_amdgcn_fence(__ATOMIC_RELEASE, "agent");
            asm volatile("s_waitcnt vmcnt(0)" ::: "memory");
            const unsigned t = __hip_atomic_fetch_add(tickets + 64 * u.sidx, 1u, __ATOMIC_RELAXED, __HIP_MEMORY_SCOPE_AGENT);
            if (t == (unsigned)(KSPLIT - 1)) { __builtin_amdgcn_fence(__ATOMIC_ACQUIRE, "agent"); asm volatile("s_waitcnt vmcnt(0)" ::: "memory"); }
            flag[0] = t;
        }
        __syncthreads();
        const bool lastone = flag[0] == (unsigned)(KSPLIT - 1);
        __syncthreads();
        if (!lastone) continue;
        f32x4 acc[2][2][4][2];
#pragma unroll
        for (int a = 0; a < 2; ++a)
#pragma unroll
            for (int b = 0; b < 2; ++b)
#pragma unroll
                for (int m = 0; m < 4; ++m)
#pragma unroll
                    for (int n = 0; n < 2; ++n) acc[a][b][m][n] = (f32x4){0.f, 0.f, 0.f, 0.f};
#pragma unroll 1
        for (int s = 0; s < KSPLIT; ++s) { const float* sl = g.slab + ((size_t)u.sidx * KSPLIT + s) * 65536 + tid * 4;
#pragma unroll
            for (int a = 0; a < 2; ++a)
#pragma unroll
                for (int b = 0; b < 2; ++b) { f32x4 t[4][2];
#pragma unroll
                    for (int m = 0; m < 4; ++m)
#pragma unroll
                        for (int n = 0; n < 2; ++n) t[m][n] = *(const f32x4*)(sl + (((a * 2 + b) * 4 + m) * 2 + n) * 2048);
#pragma unroll
                    for (int m = 0; m < 4; ++m)
#pragma unroll
                        for (int n = 0; n < 2; ++n) acc[a][b][m][n] = acc[a][b][m][n] + t[m][n]; } }
        u.kq = -1;
        E(acc, u, wr, wc, fr, fq);
    }
}
struct EpiProj {
    static constexpr bool PERM = true;
    bf16_t* O; int ldc; int npn_main; float* side;
    __device__ __forceinline__ void operator()(const f32x4 (&acc)[2][2][4][2], const Unit& u, int wr, int wc, int fr, int fq) const {
        const int row0 = u.pm * BM + wr * 64 + fr;
        if (u.pn < npn_main) {
            const int col0 = u.pn * BM + wc * 32 + 8 * fq;
#pragma unroll
            for (int ai = 0; ai < 2; ++ai)
#pragma unroll
                for (int m = 0; m < 4; ++m) { bf16_t* rowp = O + (size_t)(row0 + ai * HALF + m * 16) * ldc + col0;
#pragma unroll
                    for (int bj = 0; bj < 2; ++bj) { const f32x4 v0 = acc[ai][bj][m][0], v1 = acc[ai][bj][m][1];
                        u32x4 w; w.x = cvt_pk_bf16(v0[0], v0[1]); w.y = cvt_pk_bf16(v0[2], v0[3]); w.z = cvt_pk_bf16(v1[0], v1[1]); w.w = cvt_pk_bf16(v1[2], v1[3]);
                        *(u32x4*)(rowp + bj * HALF) = w; } }
        } else if (wc < 2) {
            const int col0 = wc * 32 + 8 * fq;
#pragma unroll
            for (int ai = 0; ai < 2; ++ai)
#pragma unroll
                for (int m = 0; m < 4; ++m) { float* rowp = side + (size_t)(row0 + ai * HALF + m * 16) * 64 + col0;
                    *(f32x4*)(rowp) = acc[ai][0][m][0]; *(f32x4*)(rowp + 4) = acc[ai][0][m][1]; }
        }
    }
};
struct EpiResAdd {
    static constexpr bool PERM = false;
    float* C; int ldc; float* part;
    __device__ __forceinline__ void operator()(const f32x4 (&acc)[2][2][4][2], const Unit& u, int wr, int wc, int fr, int fq) const {
        const int col0 = u.pn * BM + wc * 32 + 4 * fq;
        if (u.kq < 0) { const int row0 = u.pm * BM + wr * 64 + fr;
#pragma unroll
            for (int ai = 0; ai < 2; ++ai)
#pragma unroll
                for (int m = 0; m < 4; ++m) { float* rowp = C + (size_t)(row0 + ai * HALF + m * 16) * ldc + col0;
#pragma unroll
                    for (int bj = 0; bj < 2; ++bj)
#pragma unroll
                        for (int n = 0; n < 2; ++n) { f32x4* p = (f32x4*)(rowp + bj * HALF + n * 16); *p = *p + acc[ai][bj][m][n]; } }
        } else { const int row0 = u.kq * BM + wr * 64 + fr;
#pragma unroll
            for (int ai = 0; ai < 2; ++ai)
#pragma unroll
                for (int m = 0; m < 4; ++m) { float* rowp = part + (size_t)(row0 + ai * HALF + m * 16) * ldc + col0;
#pragma unroll
                    for (int bj = 0; bj < 2; ++bj)
#pragma unroll
                        for (int n = 0; n < 2; ++n) *(f32x4*)(rowp + bj * HALF + n * 16) = acc[ai][bj][m][n]; }
        }
    }
};
struct EpiMoeUp {
    static constexpr bool PERM = true;
    bf16_t* hid; const float* lw; const float* lrs; const unsigned* cnt;
    __device__ __forceinline__ void operator()(const f32x4 (&acc)[2][2][4][2], const Unit& u, int wr, int wc, int fr, int fq) const {
        const int r0 = wr * 64 + fr, col0 = (u.pn & 1) * 128 + wc * 32 + 8 * fq; const int n_e = (int)cnt[u.ex];
#pragma unroll
        for (int ai = 0; ai < 2; ++ai)
#pragma unroll
            for (int m = 0; m < 4; ++m) { const int s = r0 + ai * HALF + m * 16, pos = u.pos0 + s; const bool ok = pos < n_e;
                const float rs = ok ? lrs[(size_t)u.ex * LCAP + pos] : 0.f, wt = ok ? lw[(size_t)u.ex * LCAP + pos] * rs : 0.f;
                float o[8];
#pragma unroll
                for (int n = 0; n < 2; ++n)
#pragma unroll
                    for (int j = 0; j < 4; ++j) o[n * 4 + j] = siluf_(acc[ai][0][m][n][j] * rs) * acc[ai][1][m][n][j] * wt;
                u32x4 w; w.x = cvt_pk_bf16(o[0], o[1]); w.y = cvt_pk_bf16(o[2], o[3]); w.z = cvt_pk_bf16(o[4], o[5]); w.w = cvt_pk_bf16(o[6], o[7]);
                *(u32x4*)(hid + (size_t)(u.pm * BM + s) * DEXP + col0) = w; }
    }
};
struct EpiMoeDn {
    static constexpr bool PERM = true;
    bf16_t* y; const int* ltok; const unsigned* cnt;
    __device__ __forceinline__ void operator()(const f32x4 (&acc)[2][2][4][2], const Unit& u, int wr, int wc, int fr, int fq) const {
        const int r0 = wr * 64 + fr, col0 = (u.pn & 15) * BM + wc * 32 + 8 * fq; const int n_e = (int)cnt[u.ex];
#pragma unroll
        for (int ai = 0; ai < 2; ++ai)
#pragma unroll
            for (int m = 0; m < 4; ++m) { const int pos = u.pos0 + r0 + ai * HALF + m * 16;
                if (pos < n_e) { const int tok = ltok[(size_t)u.ex * LCAP + pos]; bf16_t* rowp = y + ((size_t)(tok & 1) * MP + (tok >> 1)) * D + col0;
#pragma unroll
                    for (int bj = 0; bj < 2; ++bj) { const f32x4 v0 = acc[ai][bj][m][0], v1 = acc[ai][bj][m][1];
                        u32x4 w; w.x = cvt_pk_bf16(v0[0], v0[1]); w.y = cvt_pk_bf16(v0[2], v0[3]); w.z = cvt_pk_bf16(v1[0], v1[1]); w.w = cvt_pk_bf16(v1[2], v1[3]);
                        *(u32x4*)(rowp + bj * HALF) = w; } } }
    }
};
}

#define XB_TMO      128
#define XB_XCNT(j)  (256  + 64 * (j))
#define XB_XSUB(j)  (1280 + 64 * (j))
#define XB_XGEN(j)  (2304 + 64 * (j))
#define XB_TOP      3328
#define XB_TOPGEN   3392
#define XCD_BAR_WORDS 3456
#define XB_SPIN_CAP (1u << 18)
__device__ __forceinline__ unsigned xb_ld(unsigned* p)              { return __hip_atomic_load(p, __ATOMIC_RELAXED, __HIP_MEMORY_SCOPE_AGENT); }
__device__ __forceinline__ unsigned xb_add(unsigned* p, unsigned v) { return __hip_atomic_fetch_add(p, v, __ATOMIC_RELAXED, __HIP_MEMORY_SCOPE_AGENT); }
__device__ __forceinline__ unsigned xb_xcc_id() { return (unsigned)__builtin_amdgcn_s_getreg((3 << 11) | 20) & 0xFu; }
#define XB_SPIN(cond, bar) do { unsigned _sp = 0; while (cond) { __builtin_amdgcn_s_sleep(1); \
    if ((++_sp & 255u) == 0u) { if (xb_ld(&(bar)[XB_TMO])) break; if (_sp > XB_SPIN_CAP) { atomicAdd(&(bar)[XB_TMO], 1u); break; } } } } while (0)
struct XcdBarrier { unsigned* bar; unsigned x; volatile LAS unsigned* st; };
__device__ __forceinline__ XcdBarrier xcd_barrier_post(unsigned* bar, volatile LAS unsigned* st) {
    XcdBarrier b; b.bar = bar; b.x = xb_xcc_id(); b.st = st;
    if (threadIdx.x == 0) (void)xb_add(&bar[XB_XCNT(b.x)], 1u);
    return b;
}
__device__ __forceinline__ void xcd_barrier_complete(unsigned* bar, unsigned x, unsigned& nloc, unsigned& nx) {
    const unsigned G = gridDim.x * gridDim.y * gridDim.z;
    unsigned sum, cnt, mine, sp = 0u;
    for (;;) {
        sum = 0u; cnt = 0u; mine = 0u;
#pragma unroll
        for (unsigned j = 0; j < 16; ++j) { const unsigned c = xb_ld(&bar[XB_XCNT(j)]); sum += c; cnt += (c > 0u) ? 1u : 0u; mine = (j == x) ? c : mine; }
        if (sum == G) break;
        __builtin_amdgcn_s_sleep(1);
        if ((++sp & 255u) == 0u) { if (xb_ld(&bar[XB_TMO])) break; if (sp > XB_SPIN_CAP) { atomicAdd(&bar[XB_TMO], 1u); break; } }
    }
    nloc = mine > 0u ? mine : 1u; nx = cnt > 0u ? cnt : 1u;
}
__device__ __forceinline__ void xcd_barrier(const XcdBarrier& b) {
    asm volatile("s_waitcnt vmcnt(0)" ::: "memory");
    __syncthreads();
    if (threadIdx.x == 0) {
        unsigned* bar = b.bar;
        __builtin_amdgcn_s_waitcnt(0);
        unsigned nloc = b.st[0], nx = b.st[1];
        if (nloc == 0u) { xcd_barrier_complete(bar, b.x, nloc, nx); b.st[0] = nloc; b.st[1] = nx; }
        const unsigned old = xb_add(&bar[XB_XSUB(b.x)], 1u);
        const unsigned gen = old / nloc;
        if (old + 1u == (gen + 1u) * nloc) {
            __builtin_amdgcn_fence(__ATOMIC_RELEASE, "agent");
            asm volatile("s_waitcnt vmcnt(0)" ::: "memory");
            const unsigned og = xb_add(&bar[XB_TOP], 1u);
            const unsigned tg = og / nx;
            if (og + 1u == (tg + 1u) * nx) xb_add(&bar[XB_TOPGEN], 1u);
            else XB_SPIN(xb_ld(&bar[XB_TOPGEN]) == tg, bar);
            __builtin_amdgcn_fence(__ATOMIC_ACQUIRE, "agent");
            xb_add(&bar[XB_XGEN(b.x)], 1u);
            asm volatile("s_waitcnt vmcnt(0)" ::: "memory");
        } else {
            XB_SPIN(xb_ld(&bar[XB_XGEN(b.x)]) == gen, bar);
            __builtin_amdgcn_fence(__ATOMIC_ACQUIRE, "agent");
            asm volatile("s_waitcnt vmcnt(0)" ::: "memory");
        }
    }
    __syncthreads();
}

struct Args { const float* in[29]; float* out; unsigned char* ws; int ph_lo, ph_hi, flags, pad; };
enum { I_X = 0, I_META, I_MIXN, I_FFNN, I_FINN, I_EVWIN, I_EVGB, I_EVQKC, I_EVLRUP, I_EVLRB, I_EVNA, I_EVNB, I_EVWOUT, I_ODWIN, I_ODCONV, I_ODCONVB, I_ODWR, I_ODBR, I_ODWI, I_ODBI, I_ODLAM, I_ODWOUT,
       I_MWG, I_MBG, I_MWE, I_MBE, I_MW1, I_MW3, I_MW2 };


#define LDS_WAIT() asm volatile("s_waitcnt lgkmcnt(0)" ::: "memory")

__device__ __forceinline__ void tr_item(const float* Wc, size_t ldw, bf16_t* WT, size_t ldt, int k0, int n0, LAS float* scr, int lane) {
    const int c4 = (lane & 15) * 4;
#pragma unroll 8
    for (int i = 0; i < 16; ++i) { const int kk = 4 * i + (lane >> 4); const f32x4 v = Wc ? *(const f32x4*)(Wc + (size_t)(k0 + kk) * ldw) : (f32x4){0.f, 0.f, 0.f, 0.f};
        LAS float* d = scr + kk * 65 + c4; d[0] = v[0]; d[1] = v[1]; d[2] = v[2]; d[3] = v[3]; }
    LDS_WAIT();
    const int c = lane & 7;
#pragma unroll
    for (int j = 0; j < 8; ++j) { const int n = (lane >> 3) + 8 * j; const LAS float* s = scr + (8 * c) * 65 + n;
        u32x4 o; o.x = cvt_pk_bf16(s[0 * 65], s[1 * 65]); o.y = cvt_pk_bf16(s[2 * 65], s[3 * 65]); o.z = cvt_pk_bf16(s[4 * 65], s[5 * 65]); o.w = cvt_pk_bf16(s[6 * 65], s[7 * 65]);
        *(u32x4*)(WT + (size_t)(n0 + n) * ldt + k0 + 8 * c) = o; }
    LDS_WAIT();
}
__device__ __forceinline__ void conv_moe_items(const Args& a, int layer, int gw, int NGW, LAS float* scr, int lane) {
    unsigned char* wsw = a.ws + WS_W;
    constexpr int I_UP = 32 * 64 * 8, I_DN = 32 * 4 * 64;
    const int c4 = (lane & 15) * 4;
    for (int it = gw; it < I_UP + I_DN; it += NGW) {
        if (it < I_UP) { const int e = it >> 9, r = it & 511, kb = r >> 3, nb = r & 7; const int n = 64 * nb;
            const float* src = ((n & 255) < 128 ? a.in[I_MW1] : a.in[I_MW3]) + ((size_t)(layer * NEXP + e)) * 4096 * 256 + ((n >> 8) * 128 + (n & 127)) + c4;
            tr_item(src, 256, (bf16_t*)(wsw + W_UP) + (size_t)e * 512 * 4096, 4096, 64 * kb, 64 * nb, scr, lane);
        } else { const int r0 = it - I_UP, e = r0 >> 8, r = r0 & 255, kb = r >> 6, nb = r & 63;
            const float* src = a.in[I_MW2] + ((size_t)(layer * NEXP + e)) * 256 * 4096 + 64 * nb + c4;
            tr_item(src, 4096, (bf16_t*)(wsw + W_DN) + (size_t)e * 4096 * 256, 256, 64 * kb, 64 * nb, scr, lane); }
    }
    bf16_t* rth = (bf16_t*)(wsw + W_RT); bf16_t* rtl = rth + 48 * D; const float* gf = a.in[I_FFNN] + layer * D;
    for (int i = gw * 64 + lane; i < 48 * D; i += NGW * 64) { const int j = i >> 12, d = i & 4095;
        const float w = j < 4 ? a.in[I_MWG][((size_t)layer * D + d) * 4 + j] : (j < 36 ? a.in[I_MWE][((size_t)layer * D + d) * 32 + (j - 4)] : 0.f);
        const float v = gf[d] * w; const unsigned short hi = f2bf(v); rth[i] = hi; rtl[i] = f2bf(v - bf2f(hi)); }
}
__device__ __forceinline__ void conv_layer0(const Args& a, int gw, int NGW, LAS float* scr, int lane) {
    unsigned char* wsw = a.ws + WS_W;
    constexpr int NBLK = NW0 / 64, I_A = 64 * NBLK, I_B = 64 * 64;
    const int c4 = (lane & 15) * 4;
    for (int it = gw; it < I_A + I_B; it += NGW) {
        if (it < I_A) { const int kb = it / NBLK, nb = it % NBLK; const int n = 64 * nb + c4;
            const int col = n < 6144 ? n : (n < 12288 ? n + 16 : (n < 12304 ? 6144 + (n - 12288) : (n < 12336 ? n : -1)));
            tr_item(col >= 0 ? a.in[I_EVWIN] + col : nullptr, 12336, (bf16_t*)(wsw + W_IN), 4096, 64 * kb, 64 * nb, scr, lane);
        } else { const int r = it - I_A, kb = r >> 6, nb = r & 63;
            tr_item(a.in[I_EVWOUT] + 64 * nb + c4, 4096, (bf16_t*)(wsw + W_OUT0), 4096, 64 * kb, 64 * nb, scr, lane); }
    }
    conv_moe_items(a, 0, gw, NGW, scr, lane);
}
__device__ __forceinline__ void conv_layer1(const Args& a, int gw, int NGW, LAS float* scr, int lane) {
    unsigned char* wsw = a.ws + WS_W;
    constexpr int I_A = 64 * 160, I_B = 80 * 64, I_C = 64 * 25;
    const int c4 = (lane & 15) * 4;
    for (int it = gw; it < I_A + I_B + I_C; it += NGW) {
        if (it < I_A) { const int kb = it / 160, nb = it % 160;
            tr_item(a.in[I_ODWIN] + 64 * nb + c4, NPROJ1, (bf16_t*)(wsw + W_IN), 4096, 64 * kb, 64 * nb, scr, lane);
        } else if (it < I_A + I_B) { const int r = it - I_A, kb = r >> 6, nb = r & 63;
            tr_item(a.in[I_ODWOUT] + 64 * nb + c4, 4096, (bf16_t*)(wsw + W_OUT1), DR, 64 * kb, 64 * nb, scr, lane);
        } else { const int r = it - I_A - I_B, mm = r / 25, q = r % 25, kb = q / 5, nb = q % 5;
            const float* src = ((mm & 1) ? a.in[I_ODWI] : a.in[I_ODWR]) + (size_t)(mm >> 1) * 320 * 320 + 64 * nb + c4;
            tr_item(src, 320, (bf16_t*)(wsw + W_RI) + (size_t)mm * 320 * 320, 320, 64 * kb, 64 * nb, scr, lane); }
    }
    conv_moe_items(a, 1, gw, NGW, scr, lane);
}

__device__ __forceinline__ void load_row(const float* p, int lane, f32x4 (&v)[16]) {
#pragma unroll
    for (int j = 0; j < 16; ++j) v[j] = *(const f32x4*)(p + (j * 64 + lane) * 4);
}
__device__ __forceinline__ float row_ss(const f32x4 (&v)[16]) { float s = 0.f;
#pragma unroll
    for (int j = 0; j < 16; ++j) s += (v[j][0] * v[j][0] + v[j][1] * v[j][1]) + (v[j][2] * v[j][2] + v[j][3] * v[j][3]);
    return wave_sum(s); }
__device__ __forceinline__ void store_row_bf16_scaled(bf16_t* o, const f32x4 (&v)[16], float rstd, const float* g, int lane) {
#pragma unroll
    for (int j = 0; j < 16; ++j) { const f32x4 gg = *(const f32x4*)(g + (j * 64 + lane) * 4);
        u32x2 w; w.x = cvt_pk_bf16(v[j][0] * rstd * gg[0], v[j][1] * rstd * gg[1]); w.y = cvt_pk_bf16(v[j][2] * rstd * gg[2], v[j][3] * rstd * gg[3]);
        *(u32x2*)(o + (j * 64 + lane) * 4) = w; }
}
__device__ __forceinline__ void zero_row_bf16(bf16_t* o, int lane) {
#pragma unroll
    for (int j = 0; j < 8; ++j) *(u32x4*)(o + (j * 64 + lane) * 8) = (u32x4){0u, 0u, 0u, 0u};
}
__device__ __forceinline__ void add_y(f32x4 (&v)[16], const bf16_t* y, int lane) {
#pragma unroll
    for (int j = 0; j < 16; ++j) { const u32x2 w = *(const u32x2*)(y + (j * 64 + lane) * 4);
        v[j][0] += __uint_as_float(w.x << 16); v[j][1] += __uint_as_float(w.x & 0xffff0000u); v[j][2] += __uint_as_float(w.y << 16); v[j][3] += __uint_as_float(w.y & 0xffff0000u); }
}

__device__ __forceinline__ void p0_rows(const Args& a, int gw, int NGW, int lane) {
    float* H = (float*)(a.ws + WS_H); bf16_t* XN = (bf16_t*)((unsigned char*)a.out + DO_XN);
    for (int r = gw; r < MP; r += NGW) {
        if (row_valid(r)) { const int b = r >= TP ? 1 : 0, p = r - b * TP;
            const float* src = p < 64 ? a.in[I_META] + (size_t)(p - PADF) * D : a.in[I_X] + ((size_t)b * SEQ + (p - 64)) * D;
            f32x4 v[16]; load_row(src, lane, v); const float rstd = rsqrtf(row_ss(v) * (1.0f / D) + EPS);
#pragma unroll
            for (int j = 0; j < 16; ++j) *(f32x4*)(H + (size_t)r * D + (j * 64 + lane) * 4) = v[j];
            store_row_bf16_scaled(XN + (size_t)r * D, v, rstd, a.in[I_MIXN], lane);
        } else {
#pragma unroll
            for (int j = 0; j < 16; ++j) *(f32x4*)(H + (size_t)r * D + (j * 64 + lane) * 4) = (f32x4){0.f, 0.f, 0.f, 0.f};
            zero_row_bf16(XN + (size_t)r * D, lane); }
    }
}
__device__ __forceinline__ void p8_rows(const Args& a, int gw, int NGW, int lane) {
    float* H = (float*)(a.ws + WS_H); bf16_t* XN = (bf16_t*)((unsigned char*)a.out + DO_XN); const bf16_t* Y = (const bf16_t*)(a.ws + WS_HS);
    for (int r = gw; r < MP; r += NGW) {
        if (row_valid(r)) { f32x4 v[16]; load_row(H + (size_t)r * D, lane, v); add_y(v, Y + (size_t)r * D, lane); add_y(v, Y + ((size_t)MP + r) * D, lane);
            const float rstd = rsqrtf(row_ss(v) * (1.0f / D) + EPS);
#pragma unroll
            for (int j = 0; j < 16; ++j) *(f32x4*)(H + (size_t)r * D + (j * 64 + lane) * 4) = v[j];
            store_row_bf16_scaled(XN + (size_t)r * D, v, rstd, a.in[I_MIXN] + D, lane);
        } else zero_row_bf16(XN + (size_t)r * D, lane);
    }
}
__device__ __forceinline__ void pfinal_rows(const Args& a, int gw, int NGW, int lane, int addy) {
    const float* H = (const float*)(a.ws + WS_H); const bf16_t* Y = (const bf16_t*)(a.ws + WS_HS);
    for (int i = gw; i < NBATCH * SEQ; i += NGW) { const int b = i >> 13, t = i & (SEQ - 1), r = b * TP + 64 + t;
        f32x4 v[16]; load_row(H + (size_t)r * D, lane, v); if (addy) { add_y(v, Y + (size_t)r * D, lane); add_y(v, Y + ((size_t)MP + r) * D, lane); }
        const float rstd = rsqrtf(row_ss(v) * (1.0f / D) + EPS);
#pragma unroll
        for (int j = 0; j < 16; ++j) { const f32x4 gg = *(const f32x4*)(a.in[I_FINN] + (j * 64 + lane) * 4);
            *(f32x4*)(a.out + (size_t)i * D + (j * 64 + lane) * 4) = (f32x4){v[j][0] * rstd * gg[0], v[j][1] * rstd * gg[1], v[j][2] * rstd * gg[2], v[j][3] * rstd * gg[3]}; }
    }
}

__device__ __forceinline__ void route_one(const float (&lg)[36], const float* bg, const float* be, int& e1, int& e2, float& w1, float& w2) {
    float gl[4];
#pragma unroll
    for (int g = 0; g < 4; ++g) gl[g] = lg[g] + bg[g];
    int gi = 0; float gm = gl[0];
#pragma unroll
    for (int g = 1; g < 4; ++g) if (gl[g] > gm) { gm = gl[g]; gi = g; }
    float gs = 0.f;
#pragma unroll
    for (int g = 0; g < 4; ++g) gs += __expf(gl[g] - gm);
    const float gval = 1.0f / gs;
    float el[8];
#pragma unroll
    for (int e = 0; e < 8; ++e) { float x = lg[4 + e] + be[e];
#pragma unroll
        for (int g = 1; g < 4; ++g) { const float y = lg[4 + g * 8 + e] + be[g * 8 + e]; x = (gi == g) ? y : x; }
        el[e] = x; }
    int i1 = 0; float m1 = el[0];
#pragma unroll
    for (int e = 1; e < 8; ++e) if (el[e] > m1) { m1 = el[e]; i1 = e; }
    int i2 = -1; float m2 = -3.0e38f;
#pragma unroll
    for (int e = 0; e < 8; ++e) if (e != i1 && el[e] > m2) { m2 = el[e]; i2 = e; }
    const float p2 = __expf(m2 - m1), s = 1.0f / (1.0f + p2);
    e1 = gi * 8 + i1; e2 = gi * 8 + i2; w1 = s * gval; w2 = p2 * s * gval;
}
__device__ __forceinline__ void route_rows(const Args& a, LAS unsigned char* lds, int wave, int layer, int gw, int NGW, int lane) {
    const float* H = (const float*)(a.ws + WS_H); bf16_t* XN = (bf16_t*)((unsigned char*)a.out + DO_XN);
    const bf16_t* rth = (const bf16_t*)(a.ws + WS_W + W_RT); const bf16_t* rtl = rth + 48 * D; const float* gf = a.in[I_FFNN] + layer * D;
    const float* bg = a.in[I_MBG] + layer * 4; const float* be = a.in[I_MBE] + layer * 32;
    unsigned* cnt = (unsigned*)(a.ws + WS_CTL) + CW_CNT + layer * 64;
    int* ltok = (int*)((unsigned char*)a.out + DO_LTOK) + (size_t)layer * NEXP * LCAP; float* lw = (float*)((unsigned char*)a.out + DO_LW) + (size_t)layer * NEXP * LCAP;
    float* lrs = (float*)((unsigned char*)a.out + DO_LRS) + (size_t)layer * NEXP * LCAP;
    const int g = lane >> 4, l15 = lane & 15;
    LAS float* lgs = (LAS float*)(lds + wave * 4096);
    for (int task = gw; task < MP / 16; task += NGW) {
        const int row = task * 16 + l15;
        const float* hp = H + (size_t)row * D + 8 * g; bf16_t* xp = XN + (size_t)row * D + 8 * g;
        const bf16_t* bh = rth + (size_t)l15 * D + 8 * g; const bf16_t* bl = rtl + (size_t)l15 * D + 8 * g;
        f32x4 acc[3]; acc[0] = acc[1] = acc[2] = (f32x4){0.f, 0.f, 0.f, 0.f};
        float ss = 0.f;
#pragma unroll 4
        for (int ks = 0; ks < 128; ++ks) {
            const f32x4 h0 = *(const f32x4*)(hp + 32 * ks), h1 = *(const f32x4*)(hp + 32 * ks + 4);
            const f32x4 g0 = *(const f32x4*)(gf + 32 * ks + 8 * g), g1 = *(const f32x4*)(gf + 32 * ks + 8 * g + 4);
            ss += (h0[0] * h0[0] + h0[1] * h0[1]) + (h0[2] * h0[2] + h0[3] * h0[3]) + (h1[0] * h1[0] + h1[1] * h1[1]) + (h1[2] * h1[2] + h1[3] * h1[3]);
            u32x4 xo; xo.x = cvt_pk_bf16(h0[0] * g0[0], h0[1] * g0[1]); xo.y = cvt_pk_bf16(h0[2] * g0[2], h0[3] * g0[3]); xo.z = cvt_pk_bf16(h1[0] * g1[0], h1[1] * g1[1]); xo.w = cvt_pk_bf16(h1[2] * g1[2], h1[3] * g1[3]);
            *(u32x4*)(xp + 32 * ks) = xo;
            u32x4 hi; hi.x = cvt_pk_bf16(h0[0], h0[1]); hi.y = cvt_pk_bf16(h0[2], h0[3]); hi.z = cvt_pk_bf16(h1[0], h1[1]); hi.w = cvt_pk_bf16(h1[2], h1[3]);
            u32x4 lo; lo.x = cvt_pk_bf16(h0[0] - __uint_as_float(hi.x << 16), h0[1] - __uint_as_float(hi.x & 0xffff0000u)); lo.y = cvt_pk_bf16(h0[2] - __uint_as_float(hi.y << 16), h0[3] - __uint_as_float(hi.y & 0xffff0000u));
            lo.z = cvt_pk_bf16(h1[0] - __uint_as_float(hi.z << 16), h1[1] - __uint_as_float(hi.z & 0xffff0000u)); lo.w = cvt_pk_bf16(h1[2] - __uint_as_float(hi.w << 16), h1[3] - __uint_as_float(hi.w & 0xffff0000u));
            const bf16x8 ahi = __builtin_bit_cast(bf16x8, hi), alo = __builtin_bit_cast(bf16x8, lo);
#pragma unroll
            for (int nt = 0; nt < 3; ++nt) { const bf16x8 wh = *(const bf16x8*)(bh + (size_t)nt * 16 * D + 32 * ks), wl = *(const bf16x8*)(bl + (size_t)nt * 16 * D + 32 * ks);
                acc[nt] = MFMA16(ahi, wh, acc[nt]); acc[nt] = MFMA16(ahi, wl, acc[nt]); acc[nt] = MFMA16(alo, wh, acc[nt]); }
        }
        ss += __shfl_xor(ss, 16); ss += __shfl_xor(ss, 32);
        const float rstd = rsqrtf(ss * (1.0f / D) + EPS);
        if (g == 0) lgs[800 + l15] = rstd;
#pragma unroll
        for (int nt = 0; nt < 3; ++nt)
#pragma unroll
            for (int rr = 0; rr < 4; ++rr) lgs[(4 * g + rr) * 49 + 16 * nt + l15] = acc[nt][rr];
        LDS_WAIT();
        if (lane < 16) { const int r = task * 16 + lane;
            if (row_valid(r)) { const float rs = lgs[800 + lane]; float lg[36];
#pragma unroll
                for (int j = 0; j < 36; ++j) lg[j] = lgs[lane * 49 + j] * rs;
                int e1, e2; float w1, w2; route_one(lg, bg, be, e1, e2, w1, w2);
                const unsigned p1 = atomicAdd(&cnt[e1], 1u); ltok[(size_t)e1 * LCAP + p1] = r * 2; lw[(size_t)e1 * LCAP + p1] = w1; lrs[(size_t)e1 * LCAP + p1] = rs;
                const unsigned p2 = atomicAdd(&cnt[e2], 1u); ltok[(size_t)e2 * LCAP + p2] = r * 2 + 1; lw[(size_t)e2 * LCAP + p2] = w2; lrs[(size_t)e2 * LCAP + p2] = rs; } }
        LDS_WAIT();
    }
}
__device__ __forceinline__ void build_tab(LAS int* tab, const unsigned* cnt) {
    if (threadIdx.x == 0) { int acc = 0;
        for (int e = 0; e < NEXP; ++e) { const int c = (int)__hip_atomic_load(cnt + e, __ATOMIC_RELAXED, __HIP_MEMORY_SCOPE_AGENT); const int nt = (c + 255) >> 8; tab[1 + e] = acc; for (int k = 0; k < nt; ++k) tab[64 + acc + k] = e; acc += nt; }
        tab[0] = acc; }
    __syncthreads();
}
__device__ __forceinline__ void gather_slots(const Args& a, int layer, LAS int* tab, int gw, int NGW, int lane) {
    const unsigned* cnt = (const unsigned*)(a.ws + WS_CTL) + CW_CNT + layer * 64;
    const int* ltok = (const int*)((unsigned char*)a.out + DO_LTOK) + (size_t)layer * NEXP * LCAP; const float* lw = (const float*)((unsigned char*)a.out + DO_LW) + (size_t)layer * NEXP * LCAP;
    const bf16_t* XN = (const bf16_t*)((unsigned char*)a.out + DO_XN); bf16_t* XS = (bf16_t*)(a.ws + XS_OFF);
    int* sdst = (int*)((unsigned char*)a.out + DO_SDST); float* sw = (float*)((unsigned char*)a.out + DO_SW); float* srs = (float*)((unsigned char*)a.out + DO_SRS);
    const float* lrs = (const float*)((unsigned char*)a.out + DO_LRS) + (size_t)layer * NEXP * LCAP;
    const int NT = tab[0];
    for (int s = gw; s < NT * 256; s += NGW) { const int e = tab[64 + (s >> 8)], pos = s - 256 * tab[1 + e]; const int c = (int)__hip_atomic_load(cnt + e, __ATOMIC_RELAXED, __HIP_MEMORY_SCOPE_AGENT);
        if (pos < c) { const int tok = ltok[(size_t)e * LCAP + pos], r = tok >> 1, k = tok & 1;
#pragma unroll
            for (int j = 0; j < 8; ++j) *(u32x4*)(XS + (size_t)s * D + (j * 64 + lane) * 8) = *(const u32x4*)(XN + (size_t)r * D + (j * 64 + lane) * 8);
            if (lane == 0) { sdst[s] = k * MP + r; sw[s] = lw[(size_t)e * LCAP + pos]; srs[s] = lrs[(size_t)e * LCAP + pos]; }
        } else if (lane == 0) { sdst[s] = -1; sw[s] = 0.f; srs[s] = 0.f; }
    }
}

__device__ __forceinline__ void qkconv_rows(const Args& a, int gw, int NGW, int lane) {
    const bf16_t* P = (const bf16_t*)(a.ws + WS_PROJ); bf16_t* Q = (bf16_t*)((unsigned char*)a.out + DO_QKC); const float* cw = a.in[I_EVQKC];
    for (int r = gw; r < MP; r += NGW) {
        if (!row_valid(r)) {
#pragma unroll
            for (int k = 0; k < 4; ++k) *(u32x4*)(Q + (size_t)r * 2048 + k * 512 + lane * 8) = (u32x4){0u, 0u, 0u, 0u};
            continue; }
#pragma unroll
        for (int k = 0; k < 4; ++k) { const int c = k * 512 + lane * 8; float acc[8];
#pragma unroll
            for (int j = 0; j < 8; ++j) acc[j] = 0.f;
#pragma unroll
            for (int t = 0; t < 4; ++t) { const int rr = r + t - 2; const u32x4 raw = *(const u32x4*)(P + (size_t)rr * NPROJ0 + c);
                const f32x4 w0 = *(const f32x4*)(cw + t * 2048 + c), w1 = *(const f32x4*)(cw + t * 2048 + c + 4);
                acc[0] += __uint_as_float(raw.x << 16) * w0[0]; acc[1] += __uint_as_float(raw.x & 0xffff0000u) * w0[1]; acc[2] += __uint_as_float(raw.y << 16) * w0[2]; acc[3] += __uint_as_float(raw.y & 0xffff0000u) * w0[3];
                acc[4] += __uint_as_float(raw.z << 16) * w1[0]; acc[5] += __uint_as_float(raw.z & 0xffff0000u) * w1[1]; acc[6] += __uint_as_float(raw.w << 16) * w1[2]; acc[7] += __uint_as_float(raw.w & 0xffff0000u) * w1[3]; }
            const float sc = c >= 1024 ? 0.0625f : 1.0f;
#pragma unroll
            for (int j = 0; j < 8; ++j) acc[j] = siluf_(acc[j]) * sc;
            u32x4 o; o.x = cvt_pk_bf16(acc[0], acc[1]); o.y = cvt_pk_bf16(acc[2], acc[3]); o.z = cvt_pk_bf16(acc[4], acc[5]); o.w = cvt_pk_bf16(acc[6], acc[7]);
            *(u32x4*)(Q + (size_t)r * 2048 + c) = o; }
    }
}
__device__ __forceinline__ void gla_pre_units(const Args& a, LAS unsigned char* lds, int bid, int nblk) {
    const bf16_t* P = (const bf16_t*)(a.ws + WS_PROJ); const float* SM = (const float*)((unsigned char*)a.out + DO_SMALL);
    LAS float* lrbs = (LAS float*)lds;
    LAS float* toth = (LAS float*)(lds + 4096);
    const int tid = threadIdx.x, c = tid & 255, half = tid >> 8;
    for (int u = bid; u < NBATCH * NCH * 8; u += nblk) {
        const int dir = u & 1, hd = (u >> 1) & 3, n = (u >> 3) % NCH, b = (u >> 3) / NCH;
        bf16_t* GQ = (bf16_t*)(a.ws + WS_G + (size_t)dir * G_STRIDE); bf16_t* GK1 = (bf16_t*)(a.ws + WS_G + (size_t)(2 + dir) * G_STRIDE); bf16_t* GK2 = (bf16_t*)(a.ws + WS_G + (size_t)(4 + dir) * G_STRIDE);
        float* ET = (float*)(a.ws + WS_G + G_ETOT);
        if (tid < 256) { const int i = tid >> 2, q4 = tid & 3; const int pp = 64 * n + i, p = dir ? (TP - 1 - pp) : pp;
            *(LAS f32x4*)(lrbs + i * 16 + q4 * 4) = *(const f32x4*)(SM + (size_t)(b * TP + p) * 64 + 16 + dir * 16 + q4 * 4); }
        float up[16];
#pragma unroll
        for (int rr = 0; rr < 16; ++rr) up[rr] = a.in[I_EVLRUP][(size_t)(dir * 16 + rr) * 1024 + hd * 256 + c];
        const float bias = a.in[I_EVLRB][dir * 1024 + hd * 256 + c];
        __syncthreads();
        float cumv[32]; float run = 0.f;
#pragma unroll
        for (int ii = 0; ii < 32; ++ii) { const int i = half * 32 + ii; const int pp = 64 * n + i, p = dir ? (TP - 1 - pp) : pp;
            float x = bias;
#pragma unroll
            for (int q4 = 0; q4 < 4; ++q4) { const f32x4 l = *(const LAS f32x4*)(lrbs + i * 16 + q4 * 4); x += l[0] * up[q4 * 4] + l[1] * up[q4 * 4 + 1] + l[2] * up[q4 * 4 + 2] + l[3] * up[q4 * 4 + 3]; }
            const float la = p < PADF ? 0.f : logsigf_(x) * 0.0625f; run += la; cumv[ii] = run; }
        toth[half * 256 + c] = run;
        __syncthreads();
        const float off = half ? toth[c] : 0.f, tot = toth[c] + toth[256 + c];
#pragma unroll
        for (int ii = 0; ii < 32; ++ii) { const int i = half * 32 + ii; const int pp = 64 * n + i, p = dir ? (TP - 1 - pp) : pp; const size_t r = (size_t)(b * TP + p);
            const float cum = cumv[ii] + off;
            const float q = bf2f(P[r * NPROJ0 + 6144 + hd * 256 + c]), k = bf2f(P[r * NPROJ0 + 7168 + hd * 256 + c]);
            GQ[r * 1024 + hd * 256 + c] = f2bf(q * 0.0625f * __expf(cum)); GK1[r * 1024 + hd * 256 + c] = f2bf(k * __expf(-cum)); GK2[r * 1024 + hd * 256 + c] = f2bf(k * __expf(tot - cum)); }
        if (half == 0) ET[((size_t)((dir * 2 + b) * NCH + n)) * 1024 + hd * 256 + c] = __expf(tot);
        __syncthreads();
    }
}
__device__ __forceinline__ void headnorm_rows(const Args& a, int gw, int NGW, int lane) {
    bf16_t* HF = (bf16_t*)(a.ws + WS_HS); const bf16_t* HB = (const bf16_t*)(a.ws + WS_HS + HS_STRIDE0); const bf16_t* P = (const bf16_t*)(a.ws + WS_PROJ);
    for (int r = gw; r < MP; r += NGW) {
        if (!row_valid(r)) { zero_row_bf16(HF + (size_t)r * D, lane); continue; }
#pragma unroll
        for (int hg = 0; hg < 8; ++hg) { const int col = hg * 512 + lane * 8;
            const u32x4 f = *(const u32x4*)(HF + (size_t)r * D + col), bb = *(const u32x4*)(HB + (size_t)r * D + col);
            const u32x4 gt = *(const u32x4*)(P + (size_t)r * NPROJ0 + (hg < 4 ? 4096 + col : 10240 + (col - 2048)));
            const float* nw = hg < 4 ? a.in[I_EVNA] + col : a.in[I_EVNB] + (col - 2048);
            float s[8], gv[8];
            const unsigned fw[4] = {f.x, f.y, f.z, f.w}, bw[4] = {bb.x, bb.y, bb.z, bb.w}, gw4[4] = {gt.x, gt.y, gt.z, gt.w};
#pragma unroll
            for (int j = 0; j < 4; ++j) { s[2 * j] = __uint_as_float(fw[j] << 16) + __uint_as_float(bw[j] << 16); s[2 * j + 1] = __uint_as_float(fw[j] & 0xffff0000u) + __uint_as_float(bw[j] & 0xffff0000u);
                gv[2 * j] = __uint_as_float(gw4[j] << 16); gv[2 * j + 1] = __uint_as_float(gw4[j] & 0xffff0000u); }
            float ss = 0.f;
#pragma unroll
            for (int j = 0; j < 8; ++j) ss += s[j] * s[j];
            const float rstd = rsqrtf(wave_sum(ss) * (1.0f / 512.0f) + EPS);
            const f32x4 n0 = *(const f32x4*)nw, n1 = *(const f32x4*)(nw + 4); const float nn[8] = {n0[0], n0[1], n0[2], n0[3], n1[0], n1[1], n1[2], n1[3]};
            float o[8];
#pragma unroll
            for (int j = 0; j < 8; ++j) { const float gate = hg < 4 ? sigmoidf_(gv[j]) : siluf_(gv[j]); o[j] = gate * s[j] * rstd * nn[j]; }
            u32x4 w; w.x = cvt_pk_bf16(o[0], o[1]); w.y = cvt_pk_bf16(o[2], o[3]); w.z = cvt_pk_bf16(o[4], o[5]); w.w = cvt_pk_bf16(o[6], o[7]);
            *(u32x4*)(HF + (size_t)r * D + col) = w; }
    }
}
__device__ __forceinline__ void uconv_rows(const Args& a, int gw, int NGW, int lane) {
    const bf16_t* P = (const bf16_t*)(a.ws + WS_PROJ); bf16_t* U = (bf16_t*)(a.ws + WS_G); const float* cw = a.in[I_ODCONV]; const float* cb = a.in[I_ODCONVB];
    for (int r = gw; r < MP; r += NGW) {
        const bool v = row_valid(r);
#pragma unroll
        for (int k = 0; k < 10; ++k) { const int c = k * 512 + lane * 8;
            if (!v) { *(u32x4*)(U + (size_t)r * DR + c) = (u32x4){0u, 0u, 0u, 0u}; continue; }
            const f32x4 b0 = *(const f32x4*)(cb + c), b1 = *(const f32x4*)(cb + c + 4);
            float acc[8] = {b0[0], b0[1], b0[2], b0[3], b1[0], b1[1], b1[2], b1[3]};
#pragma unroll
            for (int t = 0; t < 4; ++t) { const int rr = r + t - 2; const u32x4 raw = *(const u32x4*)(P + (size_t)rr * NPROJ1 + DR + c);
                const f32x4 w0 = *(const f32x4*)(cw + t * DR + c), w1 = *(const f32x4*)(cw + t * DR + c + 4);
                acc[0] += __uint_as_float(raw.x << 16) * w0[0]; acc[1] += __uint_as_float(raw.x & 0xffff0000u) * w0[1]; acc[2] += __uint_as_float(raw.y << 16) * w0[2]; acc[3] += __uint_as_float(raw.y & 0xffff0000u) * w0[3];
                acc[4] += __uint_as_float(raw.z << 16) * w1[0]; acc[5] += __uint_as_float(raw.z & 0xffff0000u) * w1[1]; acc[6] += __uint_as_float(raw.w << 16) * w1[2]; acc[7] += __uint_as_float(raw.w & 0xffff0000u) * w1[3]; }
            u32x4 o; o.x = cvt_pk_bf16(acc[0], acc[1]); o.y = cvt_pk_bf16(acc[2], acc[3]); o.z = cvt_pk_bf16(acc[4], acc[5]); o.w = cvt_pk_bf16(acc[6], acc[7]);
            *(u32x4*)(U + (size_t)r * DR + c) = o; }
    }
}
__device__ __forceinline__ void rglru_combine_rows(const Args& a, int gw, int NGW, int lane) {
    bf16_t* HF = (bf16_t*)(a.ws + WS_HS); const bf16_t* HB = (const bf16_t*)(a.ws + WS_HS + HS_STRIDE1); const bf16_t* P = (const bf16_t*)(a.ws + WS_PROJ);
    for (int r = gw; r < MP; r += NGW) {
        const bool v = row_valid(r);
#pragma unroll
        for (int k = 0; k < 10; ++k) { const int c = k * 512 + lane * 8;
            if (!v) { *(u32x4*)(HF + (size_t)r * DR + c) = (u32x4){0u, 0u, 0u, 0u}; continue; }
            const u32x4 f = *(const u32x4*)(HF + (size_t)r * DR + c), bb = *(const u32x4*)(HB + (size_t)r * DR + c), gt = *(const u32x4*)(P + (size_t)r * NPROJ1 + c);
            const unsigned fw[4] = {f.x, f.y, f.z, f.w}, bw[4] = {bb.x, bb.y, bb.z, bb.w}, gw4[4] = {gt.x, gt.y, gt.z, gt.w};
            float o[8];
#pragma unroll
            for (int j = 0; j < 4; ++j) { o[2 * j] = gelu_tanhf_(__uint_as_float(gw4[j] << 16)) * (__uint_as_float(fw[j] << 16) + __uint_as_float(bw[j] << 16));
                o[2 * j + 1] = gelu_tanhf_(__uint_as_float(gw4[j] & 0xffff0000u)) * (__uint_as_float(fw[j] & 0xffff0000u) + __uint_as_float(bw[j] & 0xffff0000u)); }
            u32x4 w; w.x = cvt_pk_bf16(o[0], o[1]); w.y = cvt_pk_bf16(o[2], o[3]); w.z = cvt_pk_bf16(o[4], o[5]); w.w = cvt_pk_bf16(o[6], o[7]);
            *(u32x4*)(HF + (size_t)r * DR + c) = w; }
    }
}

__device__ __forceinline__ void tail_reduce(const Args& a, LAS unsigned char* lds, int bid, int G, unsigned* tickets) {
    const int L = 4 * G + bid - 1024;
    if (G != 256 || L < 0 || L >= 16 * pg8::KSPLIT) return;
    const int ct = L / pg8::KSPLIT;
    LAS unsigned* flag = (LAS unsigned*)(lds + 64);
    asm volatile("s_waitcnt vmcnt(0)" ::: "memory");
    __syncthreads();
    if (threadIdx.x == 0) {
        __builtin_amdgcn_fence(__ATOMIC_RELEASE, "agent");
        asm volatile("s_waitcnt vmcnt(0)" ::: "memory");
        const unsigned t = __hip_atomic_fetch_add(tickets + 64 * ct, 1u, __ATOMIC_RELAXED, __HIP_MEMORY_SCOPE_AGENT);
        if (t == (unsigned)(pg8::KSPLIT - 1)) { __builtin_amdgcn_fence(__ATOMIC_ACQUIRE, "agent"); asm volatile("s_waitcnt vmcnt(0)" ::: "memory"); }
        flag[0] = t;
    }
    __syncthreads();
    if (flag[0] != (unsigned)(pg8::KSPLIT - 1)) return;
    float* H = (float*)(a.ws + WS_H); const float* PART = (const float*)((unsigned char*)a.out + DO_PART);
    for (int i = threadIdx.x; i < 256 * 64; i += 512) { const int r = i >> 6, c4 = (i & 63) * 4 + ct * 256;
        f32x4 h = *(const f32x4*)(H + (size_t)(16384 + r) * D + c4);
#pragma unroll
        for (int s = 0; s < pg8::KSPLIT; ++s) h = h + *(const f32x4*)(PART + ((size_t)(s * 256 + r)) * D + c4);
        *(f32x4*)(H + (size_t)(16384 + r) * D + c4) = h; }
}

constexpr int S0_K1 = 0, S0_K2 = 33792, S0_V = 67584, S0_VW = 78848, S0_SS = 90112, S0_CT = 99328, S0_ET = 141568, S0_GV = 142592;
constexpr int KPB = 528  , VPB = 176  , SPB = 144  ;
template <int OFF> __device__ __forceinline__ void tr_frags2(const unsigned (&ad)[2], bf16x8 (&fr)[2]) {
    s16x4 x0, y0, x1, y1;
    asm volatile("ds_read_b64_tr_b16 %0, %4\n\tds_read_b64_tr_b16 %1, %4 offset:%6\n\tds_read_b64_tr_b16 %2, %5\n\tds_read_b64_tr_b16 %3, %5 offset:%6\n\ts_waitcnt lgkmcnt(0)"
                 : "=&v"(x0), "=&v"(y0), "=&v"(x1), "=&v"(y1) : "v"(ad[0]), "v"(ad[1]), "i"(OFF) : "memory");
    fr[0] = __builtin_shufflevector(x0, y0, 0, 1, 2, 3, 4, 5, 6, 7); fr[1] = __builtin_shufflevector(x1, y1, 0, 1, 2, 3, 4, 5, 6, 7);
}
template <int OFF> __device__ __forceinline__ void tr_frags3(const unsigned (&ad)[3], bf16x8 (&fr)[3]) {
    s16x4 x0, y0, x1, y1, x2, y2;
    asm volatile("ds_read_b64_tr_b16 %0, %6\n\tds_read_b64_tr_b16 %1, %6 offset:%9\n\tds_read_b64_tr_b16 %2, %7\n\tds_read_b64_tr_b16 %3, %7 offset:%9\n\tds_read_b64_tr_b16 %4, %8\n\tds_read_b64_tr_b16 %5, %8 offset:%9\n\ts_waitcnt lgkmcnt(0)"
                 : "=&v"(x0), "=&v"(y0), "=&v"(x1), "=&v"(y1), "=&v"(x2), "=&v"(y2) : "v"(ad[0]), "v"(ad[1]), "v"(ad[2]), "i"(OFF) : "memory");
    fr[0] = __builtin_shufflevector(x0, y0, 0, 1, 2, 3, 4, 5, 6, 7); fr[1] = __builtin_shufflevector(x1, y1, 0, 1, 2, 3, 4, 5, 6, 7); fr[2] = __builtin_shufflevector(x2, y2, 0, 1, 2, 3, 4, 5, 6, 7);
}

template <int CTRL, int ROWMASK> __device__ __forceinline__ float dpp_f(float old, float src) {
    return __int_as_float(__builtin_amdgcn_update_dpp(__float_as_int(old), __float_as_int(src), CTRL, ROWMASK, 0xf, false)); }
__device__ __forceinline__ float wave_scan_sum(float v) {
    v += dpp_f<0x111, 0xf>(0.f, v); v += dpp_f<0x112, 0xf>(0.f, v); v += dpp_f<0x114, 0xf>(0.f, v); v += dpp_f<0x118, 0xf>(0.f, v);
    v += dpp_f<0x142, 0xa>(0.f, v); v += dpp_f<0x143, 0xc>(0.f, v); return v; }
__device__ __forceinline__ float wave_scan_max(float v) {
    const float ID = -3.0e38f;
    v = fmaxf(v, dpp_f<0x111, 0xf>(ID, v)); v = fmaxf(v, dpp_f<0x112, 0xf>(ID, v)); v = fmaxf(v, dpp_f<0x114, 0xf>(ID, v)); v = fmaxf(v, dpp_f<0x118, 0xf>(ID, v));
    v = fmaxf(v, dpp_f<0x142, 0xa>(ID, v)); v = fmaxf(v, dpp_f<0x143, 0xc>(ID, v)); return v; }
template <int NV> __device__ __forceinline__ void tr_state_frags(unsigned ka0, unsigned ka1, unsigned va, bf16x8 (&af)[2], bf16x8 (&bv)[5]) {
    s16x4 x0, y0, x1, y1, p0, q0, p1, q1, p2, q2, p3, q3, p4, q4;
    if (NV == 5)
        asm volatile("ds_read_b64_tr_b16 %0, %14\n\tds_read_b64_tr_b16 %1, %14 offset:2112\n\tds_read_b64_tr_b16 %2, %15\n\tds_read_b64_tr_b16 %3, %15 offset:2112\n\t"
                     "ds_read_b64_tr_b16 %4, %16\n\tds_read_b64_tr_b16 %5, %16 offset:704\n\tds_read_b64_tr_b16 %6, %16 offset:32\n\tds_read_b64_tr_b16 %7, %16 offset:736\n\t"
                     "ds_read_b64_tr_b16 %8, %16 offset:64\n\tds_read_b64_tr_b16 %9, %16 offset:768\n\tds_read_b64_tr_b16 %10, %16 offset:96\n\tds_read_b64_tr_b16 %11, %16 offset:800\n\t"
                     "ds_read_b64_tr_b16 %12, %16 offset:128\n\tds_read_b64_tr_b16 %13, %16 offset:832\n\ts_waitcnt lgkmcnt(0)"
                     : "=&v"(x0), "=&v"(y0), "=&v"(x1), "=&v"(y1), "=&v"(p0), "=&v"(q0), "=&v"(p1), "=&v"(q1), "=&v"(p2), "=&v"(q2), "=&v"(p3), "=&v"(q3), "=&v"(p4), "=&v"(q4)
                     : "v"(ka0), "v"(ka1), "v"(va) : "memory");
    else {
        asm volatile("ds_read_b64_tr_b16 %0, %12\n\tds_read_b64_tr_b16 %1, %12 offset:2112\n\tds_read_b64_tr_b16 %2, %13\n\tds_read_b64_tr_b16 %3, %13 offset:2112\n\t"
                     "ds_read_b64_tr_b16 %4, %14\n\tds_read_b64_tr_b16 %5, %14 offset:704\n\tds_read_b64_tr_b16 %6, %14 offset:32\n\tds_read_b64_tr_b16 %7, %14 offset:736\n\t"
                     "ds_read_b64_tr_b16 %8, %14 offset:64\n\tds_read_b64_tr_b16 %9, %14 offset:768\n\tds_read_b64_tr_b16 %10, %14 offset:96\n\tds_read_b64_tr_b16 %11, %14 offset:800\n\ts_waitcnt lgkmcnt(0)"
                     : "=&v"(x0), "=&v"(y0), "=&v"(x1), "=&v"(y1), "=&v"(p0), "=&v"(q0), "=&v"(p1), "=&v"(q1), "=&v"(p2), "=&v"(q2), "=&v"(p3), "=&v"(q3)
                     : "v"(ka0), "v"(ka1), "v"(va) : "memory");
        p4 = p3; q4 = q3; }
    af[0] = __builtin_shufflevector(x0, y0, 0, 1, 2, 3, 4, 5, 6, 7); af[1] = __builtin_shufflevector(x1, y1, 0, 1, 2, 3, 4, 5, 6, 7);
    bv[0] = __builtin_shufflevector(p0, q0, 0, 1, 2, 3, 4, 5, 6, 7); bv[1] = __builtin_shufflevector(p1, q1, 0, 1, 2, 3, 4, 5, 6, 7); bv[2] = __builtin_shufflevector(p2, q2, 0, 1, 2, 3, 4, 5, 6, 7);
    bv[3] = __builtin_shufflevector(p3, q3, 0, 1, 2, 3, 4, 5, 6, 7); bv[4] = __builtin_shufflevector(p4, q4, 0, 1, 2, 3, 4, 5, 6, 7);
}
static_assert(4 * KPB == 2112 && 4 * VPB == 704, "tr_state_frags hard-codes the row-group strides");

template <int KIND>
__device__ __forceinline__ void scan0_unit(const Args& a, LAS unsigned char* lds, int b, int hd, int dir, int sl, size_t hs_off) {
    constexpr int NE = KIND == 0 ? 5 : 4;
    const int tid0 = threadIdx.x, w = __builtin_amdgcn_readfirstlane(tid0 >> 6);
    const int mt = w >> 1, np = w & 1;
    const bf16_t* P = (const bf16_t*)(a.ws + WS_PROJ);
    const bf16_t *Qg, *K1g, *K2g, *Vg; int pitchQ;
    if (KIND == 0) { const bf16_t* QK = (const bf16_t*)((unsigned char*)a.out + DO_QKC); Qg = QK + hd * 256; K1g = QK + 1024 + hd * 256; K2g = K1g; pitchQ = 2048; Vg = P + 2048 + hd * 512 + sl * 64; }
    else { Qg = (const bf16_t*)(a.ws + WS_G + (size_t)dir * G_STRIDE) + hd * 256; K1g = (const bf16_t*)(a.ws + WS_G + (size_t)(2 + dir) * G_STRIDE) + hd * 256; K2g = (const bf16_t*)(a.ws + WS_G + (size_t)(4 + dir) * G_STRIDE) + hd * 256; pitchQ = 1024; Vg = P + 8192 + hd * 512 + sl * 64; }
    const float* SM = (const float*)((unsigned char*)a.out + DO_SMALL);
    const float* ETg = (const float*)(a.ws + WS_G + G_ETOT) + ((size_t)((dir * 2 + b) * NCH)) * 1024 + hd * 256;
    bf16_t* Og = (bf16_t*)(a.ws + hs_off + (size_t)dir * HS_STRIDE0) + KIND * 2048 + hd * 512 + sl * 64;
    const unsigned ldsb = (unsigned)(size_t)lds;
    f32x4 accC[2][NE];
#pragma unroll
    for (int mi = 0; mi < 2; ++mi)
#pragma unroll
        for (int ni = 0; ni < NE; ++ni) accC[mi][ni] = (f32x4){0.f, 0.f, 0.f, 0.f};
    for (int i = tid0; i < 42240 / 4; i += 512) ((LAS unsigned*)(lds + S0_CT))[i] = 0u;
    float m_prev = 0.f;
    float gbi = 0.f, gbf = 0.f;
    if (KIND == 0) { gbi = a.in[I_EVGB][(dir ? 2 : 0) * 4 + hd]; gbf = a.in[I_EVGB][(dir ? 3 : 1) * 4 + hd]; }
    const int gci = (dir ? 2 : 0) * 4 + hd, gcf = (dir ? 3 : 1) * 4 + hd;
#define PROWN(nn, i) (dir ? (TP - 1 - (64 * (nn) + (i))) : (64 * (nn) + (i)))
    u32x4 pk1[4], pk2[4], pv; float pgi = 0.f, pgf = 0.f, pet = 0.f; bf16x8 Qf[8];
#define PREFETCH_KV(nn) do { const size_t crow = (size_t)(b * TP + (dir ? TP - 64 - 64 * (nn) : 64 * (nn))); \
        const char* kb1 = (const char*)K1g + crow * pitchQ * 2; const char* kb2 = (const char*)K2g + crow * pitchQ * 2; \
        _Pragma("unroll") for (int k = 0; k < 4; ++k) { pk1[k] = *(const u32x4*)(kb1 + voK[k]); if (KIND == 1) pk2[k] = *(const u32x4*)(kb2 + voK[k]); } \
        pv = *(const u32x4*)((const char*)Vg + crow * NPROJ0 * 2 + voV); \
        if (KIND == 0) { const char* gb = (const char*)SM + crow * 256; pgi = *(const float*)(gb + voG + gci * 4); pgf = *(const float*)(gb + voG + gcf * 4); } \
        if (KIND == 1 && tid < 256) pet = ETg[(size_t)(nn) * 1024 + tid]; \
    } while (0)
#define PREFETCH_Q(nn) do { const size_t crow = (size_t)(b * TP + (dir ? TP - 64 - 64 * (nn) : 64 * (nn))); const char* qb = (const char*)Qg + crow * pitchQ * 2; \
        _Pragma("unroll") for (int ks = 0; ks < 8; ++ks) Qf[ks] = *(const bf16x8*)(qb + voQ + 64 * ks); } while (0)
    __syncthreads();
    for (int n = 0; n < NCH; ++n) {
        int tidv = tid0; asm volatile("" : "+v"(tidv));
        const int tid = tidv, lane = tid & 63, g = lane >> 4, l15 = lane & 15, q4 = l15 >> 2, p4 = lane & 3;
    unsigned voK[4];
#pragma unroll
    for (int k = 0; k < 4; ++k) { const int id = tid + 512 * k, i = id >> 5, c8 = id & 31; voK[k] = (unsigned)((dir ? 63 - i : i) * pitchQ * 2 + c8 * 16); }
    const unsigned voV = (unsigned)((dir ? 63 - (tid >> 3) : (tid >> 3)) * NPROJ0 * 2 + (tid & 7) * 16);
    const unsigned voG = (unsigned)((dir ? 63 - lane : lane) * 256);
    const unsigned voQ = (unsigned)((dir ? 63 - (16 * mt + l15) : (16 * mt + l15)) * pitchQ * 2 + 16 * g);
        if (n == 0) { PREFETCH_KV(0); PREFETCH_Q(0); }
        LAS float* gv = (LAS float*)(lds + S0_GV + w * 1024);
        float Bt = 0.f, bvec = 0.f, winter = 0.f, floorv = 0.f, wsl = 0.f, decay = 1.f, B63 = 0.f, tot = 0.f;
        if (KIND == 0) { const int p = PROWN(n, lane);
            const bool pad = p < PADF; const float li = pad ? NEGV : pgi + gbi, lf = pad ? 0.f : logsigf_(pgf + gbf);
            const float cum = wave_scan_sum(lf);
            bvec = li - cum; const float pm = wave_scan_max(bvec);
            Bt = fmaxf(m_prev, pm); winter = __expf(m_prev - Bt); floorv = __expf(-(cum + Bt));
            gv[lane] = Bt; gv[64 + lane] = bvec; gv[128 + lane] = winter; gv[192 + lane] = floorv;
            B63 = __shfl(Bt, 63); tot = __shfl(cum, 63); decay = __expf(m_prev - B63); wsl = __expf(bvec - B63); }
#pragma unroll
        for (int k = 0; k < 4; ++k) { const int id = tid + 512 * k, i = id >> 5, c8 = id & 31;
            *(LAS u32x4*)(lds + S0_K1 + i * KPB + c8 * 16) = pk1[k];
            if (KIND == 1) *(LAS u32x4*)(lds + S0_K2 + i * KPB + c8 * 16) = pk2[k]; }
        { const int i = tid >> 3, c8 = tid & 7;
            *(LAS u32x4*)(lds + S0_V + i * VPB + c8 * 16) = pv;
            if (KIND == 0) { const float s = __shfl(wsl, i);
                u32x4 o; o.x = cvt_pk_bf16(__uint_as_float(pv.x << 16) * s, __uint_as_float(pv.x & 0xffff0000u) * s); o.y = cvt_pk_bf16(__uint_as_float(pv.y << 16) * s, __uint_as_float(pv.y & 0xffff0000u) * s);
                o.z = cvt_pk_bf16(__uint_as_float(pv.z << 16) * s, __uint_as_float(pv.z & 0xffff0000u) * s); o.w = cvt_pk_bf16(__uint_as_float(pv.w << 16) * s, __uint_as_float(pv.w & 0xffff0000u) * s);
                *(LAS u32x4*)(lds + S0_VW + i * VPB + c8 * 16) = o;
                if (c8 < 2) { const float s1 = c8 == 0 ? 1.0f : 0.f;
                    *(LAS u32x4*)(lds + S0_V + i * VPB + 128 + c8 * 16) = (u32x4){cvt_pk_bf16(s1, 0.f), 0u, 0u, 0u};
                    *(LAS u32x4*)(lds + S0_VW + i * VPB + 128 + c8 * 16) = (u32x4){cvt_pk_bf16(s1 * s, 0.f), 0u, 0u, 0u}; } } }
        if (KIND == 1 && tid < 256) ((LAS float*)(lds + S0_ET))[tid] = pet;
        __syncthreads();
        { const int nn = n + 1 < NCH ? n + 1 : n; PREFETCH_KV(nn); }
        f32x4 sacc[2], oacc[3];
#pragma unroll
        for (int j = 0; j < 2; ++j) sacc[j] = (f32x4){0.f, 0.f, 0.f, 0.f};
#pragma unroll
        for (int j = 0; j < 3; ++j) oacc[j] = (f32x4){0.f, 0.f, 0.f, 0.f};
#pragma unroll
        for (int ks = 0; ks < 8; ++ks) {
#pragma unroll
            for (int j = 0; j < 2; ++j) { const int nt = 2 * np + j;
                const bf16x8 kf = *(const LAS bf16x8*)(lds + S0_K1 + (16 * nt + l15) * KPB + (32 * ks + 8 * g) * 2);
                sacc[j] = MFMA16(Qf[ks], kf, sacc[j]);
                const bf16x8 cf = *(const LAS bf16x8*)(lds + S0_CT + (16 * nt + l15) * KPB + (32 * ks + 8 * g) * 2);
                oacc[j] = MFMA16(Qf[ks], cf, oacc[j]); }
            if (KIND == 0) { const bf16x8 cf = *(const LAS bf16x8*)(lds + S0_CT + (64 + l15) * KPB + (32 * ks + 8 * g) * 2); oacc[2] = MFMA16(Qf[ks], cf, oacc[2]); }
            }
        __builtin_amdgcn_sched_barrier(0);
        { const int nn = n + 1 < NCH ? n + 1 : n; PREFETCH_Q(nn); }
        __builtin_amdgcn_sched_barrier(0);
#pragma unroll
        for (int j = 0; j < 2; ++j) { const int s = 16 * (2 * np + j) + l15; const float b_s = KIND == 0 ? gv[64 + s] : 0.f;
            f32x4 bt4 = (f32x4){0.f, 0.f, 0.f, 0.f}; if (KIND == 0) bt4 = *(const LAS f32x4*)(gv + 16 * mt + 4 * g);
#pragma unroll
            for (int rr = 0; rr < 4; ++rr) { const int t = 16 * mt + 4 * g + rr; float val;
                if (KIND == 0) val = s <= t ? sacc[j][rr] * __expf(b_s - bt4[rr]) : 0.f;
                else val = s <= t ? sacc[j][rr] : 0.f;
                *(LAS unsigned short*)(lds + S0_SS + t * SPB + s * 2) = f2bf(val); } }
        __syncthreads();
#pragma unroll
        for (int mi = 0; mi < 2; ++mi) {
            f32x4 sc;
            if (KIND == 0) sc = (f32x4){decay, decay, decay, decay};
            else sc = *(const LAS f32x4*)(lds + S0_ET + (16 * (2 * w + mi) + 4 * g) * 4);
#pragma unroll
            for (int ni = 0; ni < NE; ++ni) accC[mi][ni] = accC[mi][ni] * sc; }
#pragma unroll
        for (int ks = 0; ks < 2; ++ks) {
            const unsigned rowb = (unsigned)(32 * ks + 8 * g + q4);
            bf16x8 af[2], bv[5];
            { const unsigned kb = ldsb + (KIND == 0 ? S0_K1 : S0_K2) + rowb * KPB + 8 * p4; const unsigned vb = ldsb + (KIND == 0 ? S0_VW : S0_V) + rowb * VPB + 8 * p4;
                tr_state_frags<NE>(kb + 32 * (2 * w), kb + 32 * (2 * w + 1), vb, af, bv); }
#pragma unroll
            for (int mi = 0; mi < 2; ++mi)
#pragma unroll
                for (int ni = 0; ni < NE; ++ni) accC[mi][ni] = MFMA16(af[mi], bv[ni], accC[mi][ni]); }
#pragma unroll
        for (int mi = 0; mi < 2; ++mi)
#pragma unroll
            for (int ni = 0; ni < NE; ++ni) { u32x2 o; o.x = cvt_pk_bf16(accC[mi][ni][0], accC[mi][ni][1]); o.y = cvt_pk_bf16(accC[mi][ni][2], accC[mi][ni][3]);
                *(LAS u32x2*)(lds + S0_CT + (16 * ni + l15) * KPB + (16 * (2 * w + mi) + 4 * g) * 2) = o; }
        if (KIND == 0) { const f32x4 wi4 = *(const LAS f32x4*)(gv + 128 + 16 * mt + 4 * g);
#pragma unroll
            for (int j = 0; j < 3; ++j) oacc[j] = oacc[j] * wi4; }
#pragma unroll
        for (int ks = 0; ks < 2; ++ks) { const bf16x8 sf = *(const LAS bf16x8*)(lds + S0_SS + (16 * mt + l15) * SPB + (32 * ks + 8 * g) * 2);
            const unsigned vb = ldsb + S0_V + (unsigned)(32 * ks + 8 * g + q4) * VPB + 8 * p4;
            if (KIND == 0) { bf16x8 vf[3]; const unsigned ad[3] = {vb + 32 * (2 * np), vb + 32 * (2 * np + 1), vb + 128}; tr_frags3<4 * VPB>(ad, vf);
                oacc[0] = MFMA16(sf, vf[0], oacc[0]); oacc[1] = MFMA16(sf, vf[1], oacc[1]); oacc[2] = MFMA16(sf, vf[2], oacc[2]); }
            else { bf16x8 vf[2]; const unsigned ad[2] = {vb + 32 * (2 * np), vb + 32 * (2 * np + 1)}; tr_frags2<4 * VPB>(ad, vf);
                oacc[0] = MFMA16(sf, vf[0], oacc[0]); oacc[1] = MFMA16(sf, vf[1], oacc[1]); } }
#pragma unroll
        for (int rr = 0; rr < 4; ++rr) { const int t = 16 * mt + 4 * g + rr; const size_t r = (size_t)(b * TP + PROWN(n, t));
            float inv = 1.f;
            if (KIND == 0) { const float fl = gv[192 + t], den = __shfl(oacc[2][rr], g * 16); inv = __builtin_amdgcn_rcpf(fmaxf(fabsf(den), fl)); }
#pragma unroll
            for (int j = 0; j < 2; ++j) Og[r * D + 16 * (2 * np + j) + l15] = f2bf(oacc[j][rr] * inv); }
        if (KIND == 0) m_prev = tot + B63;
        __syncthreads();
    }
#undef PREFETCH_KV
#undef PREFETCH_Q
#undef PROWN
}

constexpr int S1_BT = 0, S1_A = 104960, S1_COMP = 146944, S1_HP = 149504;
constexpr int APB = 656;
__device__ __forceinline__ void scan1_unit(const Args& a, LAS unsigned char* lds, int b, int nb, int dir, int q) {
    const int tid0 = threadIdx.x, w = __builtin_amdgcn_readfirstlane(tid0 >> 6);
    const int mt = w >> 1, par = (w ^ (w >> 2)) & 1, nj = par ? 2 : 3, j0 = par * 3;
    const bf16_t* U = (const bf16_t*)(a.ws + WS_G) + nb * 320; const bf16_t* WRI = (const bf16_t*)(a.ws + WS_W + W_RI);
    bf16_t* Og = (bf16_t*)(a.ws + WS_HS + (size_t)dir * HS_STRIDE1) + nb * 320 + q * 80;
    for (int id = tid0; id < 160 * 40; id += 512) { const int row = id / 40, pc = id % 40, which = row / 80, col = 80 * q + row % 80;
        *(LAS u32x4*)(lds + S1_BT + row * APB + pc * 16) = *(const u32x4*)(WRI + ((size_t)(((dir * 16 + nb) * 2 + which) * 320 + col)) * 320 + pc * 8); }
    if (tid0 < 160) ((LAS float*)(lds + S1_HP))[tid0] = 0.f;
    float br[3], bi[3], sp[3];
    { const int l15 = tid0 & 15;
#pragma unroll
        for (int jj = 0; jj < 3; ++jj) { const int col = 16 * ((j0 + jj) < 5 ? (j0 + jj) : 4) + l15, gc = dir * DR + nb * 320 + q * 80 + col;
            br[jj] = a.in[I_ODBR][gc]; bi[jj] = a.in[I_ODBI][gc]; sp[jj] = -8.0f * softplusf_(-a.in[I_ODLAM][gc]); } }
    u32x4 pa[5];
#define PROW1(tt, i) (dir ? (TP - 1 - (64 * (tt) + (i))) : (64 * (tt) + (i)))
#define PREF1(tt) do { const size_t crow = (size_t)(b * TP + (dir ? TP - 64 - 64 * (tt) : 64 * (tt))); const char* ub = (const char*)U + crow * DR * 2; \
        _Pragma("unroll") for (int k = 0; k < 5; ++k) pa[k] = *(const u32x4*)(ub + voA[k]); } while (0)
    __syncthreads();
    for (int ti = 0; ti < NCH; ++ti) {
        int tidv = tid0; asm volatile("" : "+v"(tidv));
        const int tid = tidv, lane = tid & 63, g = lane >> 4, l15 = lane & 15;
        unsigned voA[5];
#pragma unroll
        for (int k = 0; k < 5; ++k) { const int id = tid + 512 * k, i = id / 40, pc = id % 40; voA[k] = (unsigned)((dir ? 63 - i : i) * DR * 2 + pc * 16); }
        if (ti == 0) PREF1(0);
#pragma unroll
        for (int k = 0; k < 5; ++k) { const int id = tid + 512 * k, i = id / 40, pc = id % 40; *(LAS u32x4*)(lds + S1_A + i * APB + pc * 16) = pa[k]; }
        __syncthreads();
        { const int tn = ti + 1 < NCH ? ti + 1 : ti; PREF1(tn); }
        f32x4 racc[3], iacc[3];
#pragma unroll
        for (int jj = 0; jj < 3; ++jj) { racc[jj] = (f32x4){0.f, 0.f, 0.f, 0.f}; iacc[jj] = (f32x4){0.f, 0.f, 0.f, 0.f}; }
#pragma unroll
        for (int ks = 0; ks < 10; ++ks) { const bf16x8 af = *(const LAS bf16x8*)(lds + S1_A + (16 * mt + l15) * APB + (32 * ks + 8 * g) * 2);
#pragma unroll
            for (int jj = 0; jj < 3; ++jj) if (jj < nj) { const int j = j0 + jj;
                const bf16x8 bfr = *(const LAS bf16x8*)(lds + S1_BT + (16 * j + l15) * APB + (32 * ks + 8 * g) * 2);
                const bf16x8 bfi = *(const LAS bf16x8*)(lds + S1_BT + (80 + 16 * j + l15) * APB + (32 * ks + 8 * g) * 2);
                racc[jj] = MFMA16(af, bfr, racc[jj]); iacc[jj] = MFMA16(af, bfi, iacc[jj]); }
            }
        float Ap[3][4], Hp[3][4];
#pragma unroll
        for (int jj = 0; jj < 3; ++jj) if (jj < nj) { const int col = 16 * (j0 + jj) + l15;
            float A = 1.f, Hh = 0.f;
#pragma unroll
            for (int rr = 0; rr < 4; ++rr) { const int t = 16 * mt + 4 * g + rr; const bool pad = PROW1(ti, t) < PADF;
                const float rg = sigmoidf_(racc[jj][rr] + br[jj]), ig = sigmoidf_(iacc[jj][rr] + bi[jj]);
                const float la = rg * sp[jj]; float av = __expf(la);
                const float x2 = 2.0f * la; const float m2 = x2 > -0.03f ? -x2 * (1.0f + x2 * (0.5f + x2 * (1.0f / 6.0f))) : 1.0f - av * av;
                const float mult = __builtin_amdgcn_sqrtf(fmaxf(0.f, m2));
                const float uval = bf2f(*(const LAS unsigned short*)(lds + S1_A + t * APB + (80 * q + col) * 2));
                float inp = mult * ig * uval; if (pad) { av = 1.f; inp = 0.f; }
                Hh = av * Hh + inp; A = av * A; Ap[jj][rr] = A; Hp[jj][rr] = Hh; }
            const float cA = Ap[jj][3], cH = Hp[jj][3];
            float gA = 1.f, gH = 0.f, mA = 1.f, mH = 0.f;
#pragma unroll
            for (int gg = 0; gg < 4; ++gg) { const float xa = __shfl(cA, gg * 16 + l15), xh = __shfl(cH, gg * 16 + l15);
                if (gg < g) { gH = xa * gH + xh; gA = xa * gA; }
                mH = xa * mH + xh; mA = xa * mA; }
#pragma unroll
            for (int rr = 0; rr < 4; ++rr) { Hp[jj][rr] = Hp[jj][rr] + Ap[jj][rr] * gH; Ap[jj][rr] = Ap[jj][rr] * gA; }
            if (g == 0) *(LAS f32x2*)(lds + S1_COMP + (mt * 80 + col) * 8) = (f32x2){mA, mH};
        }
        __syncthreads();
#pragma unroll
        for (int jj = 0; jj < 3; ++jj) if (jj < nj) { const int col = 16 * (j0 + jj) + l15;
            float hp = ((LAS float*)(lds + S1_HP))[(ti & 1) * 80 + col];
#pragma unroll
            for (int mm = 0; mm < 3; ++mm) if (mm < mt) { const f32x2 c = *(const LAS f32x2*)(lds + S1_COMP + (mm * 80 + col) * 8); hp = c[0] * hp + c[1]; }
#pragma unroll
            for (int rr = 0; rr < 4; ++rr) { const int t = 16 * mt + 4 * g + rr; const size_t r = (size_t)(b * TP + PROW1(ti, t));
                Og[r * DR + col] = f2bf(Hp[jj][rr] + Ap[jj][rr] * hp); }
            if (mt == 3 && g == 0) { const f32x2 c = *(const LAS f32x2*)(lds + S1_COMP + (3 * 80 + col) * 8); ((LAS float*)(lds + S1_HP))[((ti + 1) & 1) * 80 + col] = c[0] * hp + c[1]; }
        }
    }
#undef PROW1
#undef PREF1
    __syncthreads();
}

#ifndef SPLIT_G1
#define SPLIT_G1 false
#endif
#ifndef SPLIT_G3
#define SPLIT_G3 false
#endif
#ifndef SPLIT_UP
#define SPLIT_UP true
#endif
constexpr int NPH = 21;
__global__ void __launch_bounds__(512, 2) fwd_kernel(Args a) {
    extern __shared__ __attribute__((aligned(16))) unsigned char lds_raw[];
    LAS unsigned char* lds = (LAS unsigned char*)lds_raw;
    const int tid = threadIdx.x, lane = tid & 63, wave = __builtin_amdgcn_readfirstlane(tid >> 6);
    const int G = gridDim.x, bid = blockIdx.x, gw = bid * 8 + wave, NGW = G * 8;
    if (tid < 4) ((LAS unsigned*)(lds + LDS_XB))[tid] = 0u;
    __syncthreads();
    XcdBarrier bar; bar.bar = (unsigned*)(a.ws + WS_CTL) + CW_BAR; bar.x = 0; bar.st = nullptr;
#if MK_FUSED
    bar = xcd_barrier_post((unsigned*)(a.ws + WS_CTL) + CW_BAR, (volatile LAS unsigned*)(lds + LDS_XB));
#endif
    const int lo = a.ph_lo, hi = a.ph_hi;
#ifndef ONLY
#define ONLY -1
#endif
#define XN ((bf16_t*)((unsigned char*)a.out + DO_XN))
#define SMALL ((float*)((unsigned char*)a.out + DO_SMALL))
#define PROJ ((bf16_t*)(a.ws + WS_PROJ))
#define H ((float*)(a.ws + WS_H))
#define WIN ((const bf16_t*)(a.ws + WS_W + W_IN))
#define scr ((LAS float*)(lds + wave * 16896))
#define tab ((LAS int*)(lds + LDS_TAB))
#define IN(k) ((ONLY < 0 || ONLY == (k)) && lo <= (k) && (k) < hi)
#define SEAM(k) do { if (MK_FUSED && IN(k) && IN((k) + 1)) xcd_barrier(bar); } while (0)

    if (IN(0)) { conv_layer0(a, gw, NGW, scr, lane); p0_rows(a, gw, NGW, lane); }
    SEAM(0);
    if (IN(1)) { pg8::Gemm g{XN, WIN, D, D, D, (float*)(a.ws + WS_HS)}; pg8::StaticOrder S0; S0.init(MP, NW0, G, bid); pg8::SplitTail<pg8::StaticOrder> S; S.init(S0, G, bid, SPLIT_G1);
        pg8::EpiProj E{PROJ, NPROJ0, NPROJ0 / 256, SMALL}; pg8::gemm_phase(lds, g, S, E); pg8::split_reduce(lds, g, S, E, (unsigned*)(a.ws + WS_CTL) + CW_TK2); }
    SEAM(1);
    if (IN(2)) { qkconv_rows(a, gw, NGW, lane); gla_pre_units(a, lds, bid, G); }
    SEAM(2);
    if (IN(3)) { for (int u = bid; u < 256; u += G) { const int grp = u & 31, sl = u >> 5, kind = grp & 1, dir = (grp >> 1) & 1, hd = (grp >> 2) & 3, b = grp >> 4;
            if (kind == 0) scan0_unit<0>(a, lds, b, hd, dir, sl, (a.flags & 2) ? WS_H : WS_HS); else scan0_unit<1>(a, lds, b, hd, dir, sl, (a.flags & 2) ? WS_H : WS_HS); } }
    SEAM(3);
    if (IN(4)) headnorm_rows(a, gw, NGW, lane);
    SEAM(4);
    if (IN(5)) { pg8::Gemm g{(const bf16_t*)(a.ws + WS_HS), (const bf16_t*)(a.ws + WS_W + W_OUT0), D, D, D, nullptr}; pg8::TailSplitOrder S; S.init(G, bid); pg8::EpiResAdd E{H, D, (float*)((unsigned char*)a.out + DO_PART)}; pg8::gemm_phase(lds, g, S, E);
        tail_reduce(a, lds, bid, G, (unsigned*)(a.ws + WS_CTL) + CW_TKT); }
    SEAM(5);
#define MOE_PHASES(P, layer) \
    if (IN(P)) route_rows(a, lds, wave, layer, gw, NGW, lane); \
    SEAM((P) + 1); \
    if (IN((P) + 2)) { const unsigned* cn = (const unsigned*)(a.ws + WS_CTL) + CW_CNT + (layer) * 64; build_tab(tab, cn); \
        pg8::Gemm g{XN, (const bf16_t*)(a.ws + WS_W + W_UP), D, D, D, (float*)(a.ws + XS_OFF)}; pg8::MoeOrder S0{tab, 2, G, bid, (const int*)((unsigned char*)a.out + DO_LTOK) + (size_t)(layer) * NEXP * LCAP, cn}; \
        pg8::SplitTail<pg8::MoeOrder> S; S.init(S0, G, bid, SPLIT_UP); \
        pg8::EpiMoeUp E{(bf16_t*)(a.ws + HID_OFF), (const float*)((unsigned char*)a.out + DO_LW) + (size_t)(layer) * NEXP * LCAP, (const float*)((unsigned char*)a.out + DO_LRS) + (size_t)(layer) * NEXP * LCAP, cn}; \
        pg8::gemm_phase<pg8::EpiMoeUp, pg8::SplitTail<pg8::MoeOrder>, true>(lds, g, S, E); pg8::split_reduce(lds, g, S, E, (unsigned*)(a.ws + WS_CTL) + CW_TK2 + 16384 + (layer) * 8192); } \
    SEAM((P) + 2); \
    if (IN((P) + 3)) { const unsigned* cn = (const unsigned*)(a.ws + WS_CTL) + CW_CNT + (layer) * 64; build_tab(tab, cn); \
        pg8::Gemm g{(const bf16_t*)(a.ws + HID_OFF), (const bf16_t*)(a.ws + WS_W + W_DN), DEXP, DEXP, DEXP, nullptr}; pg8::MoeOrder S{tab, 16, G, bid, (const int*)((unsigned char*)a.out + DO_LTOK) + (size_t)(layer) * NEXP * LCAP, cn}; \
        pg8::EpiMoeDn E{(bf16_t*)(a.ws + WS_HS), (const int*)((unsigned char*)a.out + DO_LTOK) + (size_t)(layer) * NEXP * LCAP, cn}; pg8::gemm_phase(lds, g, S, E); } \
    SEAM((P) + 3);
    MOE_PHASES(6, 0)
    if (IN(10)) { conv_layer1(a, gw, NGW, scr, lane); p8_rows(a, gw, NGW, lane); }
    SEAM(10);
    if (IN(11)) { pg8::Gemm g{XN, WIN, D, D, D, (float*)(a.ws + WS_HS)}; pg8::StaticOrder S0; S0.init(MP, NPROJ1, G, bid); pg8::SplitTail<pg8::StaticOrder> S; S.init(S0, G, bid, SPLIT_G3);
        pg8::EpiProj E{PROJ, NPROJ1, NPROJ1 / 256, nullptr}; pg8::gemm_phase(lds, g, S, E); pg8::split_reduce(lds, g, S, E, (unsigned*)(a.ws + WS_CTL) + CW_TK2 + 8192); }
    SEAM(11);
    if (IN(12)) uconv_rows(a, gw, NGW, lane);
    SEAM(12);
    if (IN(13)) { for (int u = bid; u < 256; u += G) { const int grp = u & 63, q = u >> 6, dir = grp & 1, nb = (grp >> 1) & 15, b = grp >> 5; scan1_unit(a, lds, b, nb, dir, q); } }
    SEAM(13);
    if (IN(14)) rglru_combine_rows(a, gw, NGW, lane);
    SEAM(14);
    if (IN(15)) { pg8::Gemm g{(const bf16_t*)(a.ws + WS_HS), (const bf16_t*)(a.ws + WS_W + W_OUT1), DR, DR, DR, nullptr}; pg8::TailSplitOrder S; S.init(G, bid); pg8::EpiResAdd E{H, D, (float*)((unsigned char*)a.out + DO_PART)}; pg8::gemm_phase(lds, g, S, E);
        tail_reduce(a, lds, bid, G, (unsigned*)(a.ws + WS_CTL) + CW_TKT + 16 * 64); }
    SEAM(15);
    MOE_PHASES(16, 1)
#ifndef PROBE
#define PROBE 0
#endif
#if PROBE == 9
    if (IN(20)) { const unsigned* s1 = (const unsigned*)(a.ws + WS_HS); const unsigned* s2 = (const unsigned*)(a.ws + WS_H); unsigned cntd = 0;
        for (size_t i = (size_t)bid * 512 + threadIdx.x; i < (size_t)MR * D; i += (size_t)G * 512) { const unsigned x = s1[i], y = s2[i]; cntd += ((x & 0xffffu) != (y & 0xffffu)) + ((x >> 16) != (y >> 16)); }
        cntd = (unsigned)wave_sum((float)cntd); if (lane == 0 && cntd) atomicAdd((unsigned*)(a.ws + WS_CTL) + 32768, cntd); }
    if (lo == 21) { const unsigned c = *((const unsigned*)(a.ws + WS_CTL) + 32768);
        for (size_t i = (size_t)bid * 512 + threadIdx.x; i < (size_t)NBATCH * SEQ * D; i += (size_t)G * 512) a.out[i] = (i == 0) ? sqrtf(67108864.0f * (float)c) : 0.f; }
#elif PROBE
    if (IN(20)) { const bf16_t* src = (const bf16_t*)(a.ws + (PROBE == 1 ? WS_PROJ : PROBE == 2 ? WS_G : PROBE == 3 ? WS_HS : PROBE == 4 ? (WS_HS + HS_STRIDE0) : PROBE == 7 ? (WS_PROJ + (size_t)134217728) : PROBE == 8 ? (WS_PROJ + (size_t)268435456) : WS_PROJ));
        for (size_t i = (size_t)bid * 512 + threadIdx.x; i < (size_t)NBATCH * SEQ * D; i += (size_t)G * 512) a.out[i] = bf2f(src[i]); }
#else
    if (IN(20)) pfinal_rows(a, gw, NGW, lane, a.flags & 1);
#endif
#undef IN
#undef SEAM
#undef MOE_PHASES
#undef XN
#undef SMALL
#undef PROJ
#undef H
#undef WIN
#undef scr
#undef tab
}

extern "C" void kernel_launch(void* const* d_in, const int* in_sizes, int n_in, void* d_out, int out_size, void* d_ws, size_t ws_size, hipStream_t stream) {
    static int grid = 0;
    if (grid == 0) {
        if (n_in != 29 || out_size != NBATCH * SEQ * D || ws_size < WS_END) { fprintf(stderr, "kernel_launch: unexpected problem: n_in %d out %d a.ws %zu (need %zu)\n", n_in, out_size, ws_size, (size_t)WS_END); grid = -1; return; }
        int dev = 0, cus = 0, per_cu = 0;
        if (hipGetDevice(&dev) != hipSuccess || hipDeviceGetAttribute(&cus, hipDeviceAttributeMultiprocessorCount, dev) != hipSuccess) { grid = -1; return; }
        if (hipFuncSetAttribute((const void*)fwd_kernel, hipFuncAttributeMaxDynamicSharedMemorySize, LDS_BYTES) != hipSuccess) { fprintf(stderr, "kernel_launch: hipFuncSetAttribute failed\n"); grid = -1; return; }
        if (hipOccupancyMaxActiveBlocksPerMultiprocessor(&per_cu, (const void*)fwd_kernel, 512, LDS_BYTES) != hipSuccess || per_cu < 1) fprintf(stderr, "kernel_launch: occupancy query says %d\n", per_cu);
        (void)hipGetLastError();
        grid = cus > 256 ? 256 : cus;
    }
    if (grid < 0) return;
    (void)in_sizes;
    if (hipMemsetAsync((char*)d_ws + WS_CTL, 0, CTL_BYTES, stream) != hipSuccess) return;
    Args a{};
    for (int i = 0; i < 29; ++i) a.in[i] = (const float*)d_in[i];
    a.out = (float*)d_out; a.ws = (unsigned char*)d_ws;
#if MK_FUSED
    a.ph_lo = 0; a.ph_hi = NPH; a.flags = 1;
    hipLaunchKernelGGL(fwd_kernel, dim3(grid), dim3(512), LDS_BYTES, stream, a);
#else
#ifndef DBG_STOP
#define DBG_STOP 20
#endif
    a.flags = (DBG_STOP >= 10) ? 1 : 0;
#if PROBE == 9
    for (int p = 0; p < 4; ++p) { a.ph_lo = p; a.ph_hi = p + 1; a.flags = 0; hipLaunchKernelGGL(fwd_kernel, dim3(grid), dim3(512), LDS_BYTES, stream, a); }
    a.ph_lo = 3; a.ph_hi = 4; a.flags = 2; hipLaunchKernelGGL(fwd_kernel, dim3(grid), dim3(512), LDS_BYTES, stream, a);
    a.ph_lo = 20; a.ph_hi = 21; a.flags = 0; hipLaunchKernelGGL(fwd_kernel, dim3(grid), dim3(512), LDS_BYTES, stream, a);
    a.ph_lo = 21; a.ph_hi = 22; hipLaunchKernelGGL(fwd_kernel, dim3(grid), dim3(512), LDS_BYTES, stream, a);
#else
#ifndef DUP
#define DUP -1
#endif
    for (int p = 0; p < NPH; ++p) { if (p >= DBG_STOP && p != 20) continue; a.ph_lo = p; a.ph_hi = p + 1; hipLaunchKernelGGL(fwd_kernel, dim3(grid), dim3(512), LDS_BYTES, stream, a);
        if (p == DUP) hipLaunchKernelGGL(fwd_kernel, dim3(grid), dim3(512), LDS_BYTES, stream, a); }
#endif
#endif
}
```

```cpp
#include <hip/hip_runtime.h>
#include <cstdio>
#include <cstdint>

#ifndef GEMM_SP2
#define GEMM_SP2 1
#endif
#ifndef SCAN0_PRE
#define SCAN0_PRE 1
#endif
#ifndef MK_FUSED
#define MK_FUSED 1
#endif

#define LAS __attribute__((address_space(3)))
typedef unsigned short bf16_t;
typedef short bf16x8 __attribute__((ext_vector_type(8)));
typedef short s16x4 __attribute__((ext_vector_type(4)));
typedef float f32x4 __attribute__((ext_vector_type(4)));
typedef float f32x2 __attribute__((ext_vector_type(2)));
typedef unsigned u32x4 __attribute__((ext_vector_type(4)));
typedef unsigned u32x2 __attribute__((ext_vector_type(2)));

constexpr int D = 4096, NBATCH = 2, SEQ = 8192, NMETA = 16, TP = 8256  , NCH = 129, PADF = 48;
constexpr int MR = NBATCH * TP;
constexpr int MP = 16640;
constexpr int NPROJ0 = 12288, NW0 = 12544, NPROJ1 = 10240, DR = 5120;
constexpr int NEXP = 32, DEXP = 256, SLOTS = 41216  , LCAP = 16416  ;
constexpr float EPS = 1e-6f;
constexpr float NEGV = -1e30f;

constexpr size_t MiB = 1u << 20;
constexpr size_t WS_CTL = 0, CTL_BYTES = 1 * MiB;
constexpr size_t WS_W = 1 * MiB;
constexpr size_t W_IN = 0, W_OUT0 = 98 * MiB, W_OUT1 = 80 * MiB, W_RI = 120 * MiB, W_UP = 134 * MiB, W_DN = 262 * MiB, W_RT = 326 * MiB;
constexpr size_t WS_H = 329 * MiB;
constexpr size_t WS_PROJ = 589 * MiB;
constexpr size_t WS_HS = 979 * MiB;
constexpr size_t WS_G = 1304 * MiB;
constexpr size_t WS_END = 1502 * MiB;
constexpr size_t XS_OFF = WS_G  , HID_OFF = WS_PROJ + 322 * MiB;
constexpr size_t HS_STRIDE0 = (size_t)MP * 4096 * 2, HS_STRIDE1 = (size_t)MP * DR * 2;
constexpr size_t G_STRIDE = (size_t)MP * 1024 * 2, G_ETOT = 195 * MiB;
constexpr size_t SP_OFF = WS_HS + 262 * MiB  , GV_OFF = WS_HS + 296 * MiB  ;
constexpr size_t DO_XN = 0, DO_QKC = 130 * MiB, DO_SMALL = 195 * MiB, DO_LTOK = 200 * MiB, DO_LW = 205 * MiB, DO_SDST = 210 * MiB, DO_SW = 211 * MiB, DO_LRS = 212 * MiB, DO_SRS = 217 * MiB, DO_PART = 218 * MiB;
constexpr int CW_Q = 24576  , CW_BAR = 4096, CW_CNT = 16384, CW_TKT = 20480, CW_TK2 = 32768  ;

constexpr int LDS_BYTES = 159744;
constexpr int LDS_XB = LDS_BYTES - 16;
constexpr int LDS_TAB = LDS_BYTES - 16 - 2048;

__device__ __forceinline__ float bf2f(unsigned short b) { return __uint_as_float(((unsigned)b) << 16); }
typedef __bf16 bf16v2 __attribute__((ext_vector_type(2)));
__device__ __forceinline__ unsigned cvt_pk_bf16(float lo, float hi) { const f32x2 v = {lo, hi}; return __builtin_bit_cast(unsigned, __builtin_convertvector(v, bf16v2)); }
__device__ __forceinline__ unsigned short f2bf(float f) { return (unsigned short)(cvt_pk_bf16(f, 0.f) & 0xffffu); }
__device__ __forceinline__ float sigmoidf_(float x) { return __builtin_amdgcn_rcpf(1.0f + __expf(-x)); }
__device__ __forceinline__ float siluf_(float x) { return x * sigmoidf_(x); }
__device__ __forceinline__ float logsigf_(float x) { return fminf(x, 0.f) - __logf(1.0f + __expf(-fabsf(x))); }
__device__ __forceinline__ float softplusf_(float x) { return fmaxf(x, 0.f) + log1pf(__expf(-fabsf(x))); }
__device__ __forceinline__ float gelu_tanhf_(float x) { const float u = 0.7978845608028654f * (x + 0.044715f * x * x * x); const float t = 1.0f - 2.0f * __builtin_amdgcn_rcpf(__expf(2.0f * u) + 1.0f); return 0.5f * x * (1.0f + t); }
__device__ __forceinline__ float wave_sum(float v) {
#pragma unroll
    for (int o = 1; o < 64; o <<= 1) v += __shfl_xor(v, o);
    return v;
}
__device__ __forceinline__ bool row_valid(int r) { if (r >= MR) return false; const int p = r >= TP ? r - TP : r; return p >= PADF; }
__device__ __forceinline__ s16x4 tr_read(unsigned lds_addr) { s16x4 r; asm volatile("ds_read_b64_tr_b16 %0, %1\n\ts_waitcnt lgkmcnt(0)" : "=&v"(r) : "v"(lds_addr) : "memory"); return r; }
__device__ __forceinline__ bf16x8 tr_frag(unsigned a0, unsigned a1) {
    s16x4 x, y; asm volatile("ds_read_b64_tr_b16 %0, %2\n\tds_read_b64_tr_b16 %1, %3\n\ts_waitcnt lgkmcnt(0)" : "=&v"(x), "=&v"(y) : "v"(a0), "v"(a1) : "memory");
    bf16x8 r; r[0] = x[0]; r[1] = x[1]; r[2] = x[2]; r[3] = x[3]; r[4] = y[0]; r[5] = y[1]; r[6] = y[2]; r[7] = y[3]; return r;
}
#define MFMA16(a, b, c) __builtin_amdgcn_mfma_f32_16x16x32_bf16((a), (b), (c), 0, 0, 0)

namespace pg8 {
constexpr int BM = 256, BK = 64, HALF = 128, HTB = HALF * BK * 2, STAGE_BYTES = 8 * HTB, NXCD = 8, WGM = 8;
__host__ __device__ __forceinline__ int lds_byte(int r, int c) { const int st = (r >> 4) * 2 + (c >> 5), rr = r & 15, cc = c & 31, ob = rr * 64 + cc * 2; return st * 1024 + (ob ^ (((ob >> 9) & 1) << 5)); }
__host__ __device__ __forceinline__ void stage_rc(int b, int& R, int& C) { const int st = b / 1024, sb = b % 1024, swz = sb ^ (((sb >> 9) & 1) << 5); R = (st >> 1) * 16 + swz / 64; C = (st & 1) * 32 + (swz % 64) / 2; }
__host__ __device__ __forceinline__ int perm32(int rho) { const int n = rho >> 4, i = rho & 15; return 8 * (i >> 2) + 4 * n + (i & 3); }
struct Unit { int pm, pn, kq, ex, pos0, sidx; };
constexpr int KSPLIT = 8;
struct Gemm { const bf16_t* A; const bf16_t* Bt; int lda, ldb, K; float* slab; };
struct StaticOrder {
    int nM, nN, nwg, G, c;
    __device__ __forceinline__ int arow(const Unit&, int) const { return 0; }
    __device__ void init(int M, int N, int G_, int c_) { nM = M / BM; nN = N / BM; nwg = nM * nN; G = G_; c = c_; }
    __device__ int count() const { return nwg; }
    __device__ bool next(int i, Unit& u) const { const long L = (long)i * G + c; if (L >= nwg) return false; unit_of((int)L, u); return true; }
    __device__ void unit_of(int L, Unit& u) const {
        int wgid = L; { const int q = nwg / NXCD, r = nwg % NXCD, xcd = wgid % NXCD, off = wgid / NXCD; wgid = (xcd < r ? xcd * (q + 1) : r * (q + 1) + (xcd - r) * q) + off; }
        const int nig = WGM * nN, gid = wgid / nig, fm = gid * WGM, gsz = (nM - fm) < WGM ? (nM - fm) : WGM;
        u.pm = fm + ((wgid % nig) % gsz); u.pn = (wgid % nig) / gsz; u.kq = -1; u.sidx = 0;
    }
};
struct TailSplitOrder {
    StaticOrder so; int G, c, base;
    __device__ void init(int G_, int c_) { so.init(64 * BM, 16 * BM, G_, c_); G = G_; c = c_; base = ((so.nwg + G - 1) / G) * G; }
    __device__ bool next(int i, Unit& u) const {
        if (so.next(i, u)) return true;
        const int L = i * G + c - base; if (L < 0 || L >= 16 * KSPLIT) return false;
        u.pm = 64; u.pn = L / KSPLIT; u.kq = L % KSPLIT; u.sidx = 0; return true;
    }
};
struct MoeOrder {
    const LAS int* tab; int npn, G, c; const int* ltok; const unsigned* cnt;
    __device__ int count() const { return __builtin_amdgcn_readfirstlane(tab[0]) * npn; }
    __device__ bool next(int i, Unit& u) const { const int L = i * G + c; if (L >= count()) return false; unit_of(L, u); return true; }
    __device__ void unit_of(int L, Unit& u) const {
        const int pm = L / npn, ct = L % npn, ex = __builtin_amdgcn_readfirstlane(tab[64 + pm]);
        u.pm = pm; u.pn = ex * npn + ct; u.kq = -1; u.sidx = 0; u.ex = ex; u.pos0 = (pm - __builtin_amdgcn_readfirstlane(tab[1 + ex])) * BM;
    }
    __device__ __forceinline__ int arow(const Unit& u, int s) const { const int pos = u.pos0 + s; return pos < tab[256 + u.ex] ? (ltok[(size_t)u.ex * LCAP + pos] >> 1) : 0; }
};
struct NoGather { };

template <class Base> struct SplitTail {
    Base base; int U, F, G, c;
    __device__ void init(const Base& b, int G_, int c_, bool enable) { base = b; G = G_; c = c_; U = b.count(); F = enable ? (U / G) * G : U; }
    __device__ bool next(int i, Unit& u) const {
        const int L = i * G + c;
        if (L < F) { base.unit_of(L, u); return true; }
        const int Ls = L - F; if (Ls >= (U - F) * KSPLIT) return false;
        base.unit_of(F + Ls / KSPLIT, u); u.kq = Ls % KSPLIT; u.sidx = Ls / KSPLIT; return true;
    }
    __device__ __forceinline__ int arow(const Unit& u, int s) const { return base.arow(u, s); }
};
template <class Epi, class Sched, bool GATHER = false>
__device__ __forceinline__ void gemm_phase(LAS unsigned char* lds, const Gemm g, const Sched& S, const Epi& E) {
    const int tid = threadIdx.x, wid = __builtin_amdgcn_readfirstlane(tid >> 6), lane = tid & 63, wr = wid >> 2, wc = wid & 3, fr = lane & 15, fq = lane >> 4;
    int K = g.K; asm volatile("" : "+s"(K));
    const int ntfull = K / BK, ntsplit = K / (BK * KSPLIT); const size_t ksl = (size_t)(K / KSPLIT) * 2;
    unsigned voffA[2], voffB[2]; int pR[2], pC[2];
#pragma unroll
    for (int i = 0; i < 2; ++i) { int R, C; stage_rc(tid * 16 + i * 8192, R, C); const int Rb = Epi::PERM ? ((R & ~31) + perm32(R & 31)) : R; pR[i] = R; pC[i] = C;
        voffA[i] = (unsigned)(R * g.lda + C) * 2u; voffB[i] = (unsigned)(Rb * g.ldb + C) * 2u; }
    unsigned gvo[2][2], ngvo[2][2];
#define PG8_GVO(dst, unit) do { _Pragma("unroll") for (int _h = 0; _h < 2; ++_h) _Pragma("unroll") for (int _i = 0; _i < 2; ++_i) dst[_h][_i] = (unsigned)(S.arow(unit, _h * HALF + pR[_i]) * g.lda + pC[_i]) * 2u; \
        asm volatile("" : "+v"(dst[0][0]), "+v"(dst[0][1]), "+v"(dst[1][0]), "+v"(dst[1][1])); } while (0)
    const size_t kstep = (size_t)(BK * 2);
    const size_t hstepA = (size_t)HALF * g.lda * 2, hstepB = (size_t)HALF * g.ldb * 2;
    const size_t tstepA = 2 * hstepA, tstepB = 2 * hstepB;
    const unsigned ldsw = (unsigned)wid * 1024u;
    const int aoff = lds_byte(wr * 64 + fr, fq * 8), boff = lds_byte(wc * 32 + fr, fq * 8);
#define PG8_SA(b, h) (((b) * 2 + (h)) * HTB)
#define PG8_SB(b, h) ((4 + (b) * 2 + (h)) * HTB)
#define PG8_STAGE(bufoff, gbase, voff) do { _Pragma("unroll") for (int _i = 0; _i < 2; ++_i) \
        __builtin_amdgcn_global_load_lds((const unsigned*)((const char*)(gbase) + (voff)[_i]), (LAS unsigned*)(lds + (bufoff) + ldsw + _i * 8192), 16, 0, 0); } while (0)
#define PG8_LDA(dst, b, h) do { _Pragma("unroll") for (int m = 0; m < 4; ++m) _Pragma("unroll") for (int k = 0; k < 2; ++k) dst[m][k] = *(const LAS bf16x8*)(lds + PG8_SA(b, h) + aoff + m * 2048 + k * 1024); } while (0)
#define PG8_LDB(dst, b, h) do { _Pragma("unroll") for (int n = 0; n < 2; ++n) _Pragma("unroll") for (int k = 0; k < 2; ++k) dst[n][k] = *(const LAS bf16x8*)(lds + PG8_SB(b, h) + boff + n * 2048 + k * 1024); } while (0)
#define PG8_MMA(ai, bj, At, Bt) do { __builtin_amdgcn_s_setprio(1); _Pragma("unroll") for (int m = 0; m < 4; ++m) _Pragma("unroll") for (int n = 0; n < 2; ++n) _Pragma("unroll") for (int k = 0; k < 2; ++k) \
        acc[ai][bj][m][n] = __builtin_amdgcn_mfma_f32_16x16x32_bf16(Bt[n][k], At[m][k], acc[ai][bj][m][n], 0, 0, 0); __builtin_amdgcn_s_setprio(0); } while (0)
#define PG8_WAIT_V(n) asm volatile("s_waitcnt vmcnt(" #n ")" ::: "memory")
#define PG8_WAIT_L(n) asm volatile("s_waitcnt lgkmcnt(" #n ")" ::: "memory")
#define PG8_BAR __builtin_amdgcn_s_barrier()
#define PG8_SCHED __builtin_amdgcn_sched_barrier(0)
    Unit cur, nxt; int ui = 0;
    if (!S.next(0, cur)) return;
    f32x4 acc[2][2][4][2];
#pragma unroll
    for (int a = 0; a < 2; ++a)
#pragma unroll
        for (int b = 0; b < 2; ++b)
#pragma unroll
            for (int m = 0; m < 4; ++m)
#pragma unroll
                for (int n = 0; n < 2; ++n) acc[a][b][m][n] = (f32x4){0.f, 0.f, 0.f, 0.f};
    bf16x8 At[4][2], B0[2][2], B1[2][2];
    const char* cA = (const char*)g.A + (size_t)cur.pm * tstepA + (cur.kq < 0 ? (size_t)0 : cur.kq * ksl); const char* cB = (const char*)g.Bt + (size_t)cur.pn * tstepB + (cur.kq < 0 ? (size_t)0 : cur.kq * ksl);
    const char* gA = (const char*)g.A + (cur.kq < 0 ? (size_t)0 : cur.kq * ksl);
    if constexpr (GATHER) { PG8_GVO(gvo, cur); }
#if GEMM_SP2
    PG8_STAGE(PG8_SB(0, 0), cB, voffB); PG8_STAGE(PG8_SB(0, 1), cB + hstepB, voffB);
    if constexpr (GATHER) { PG8_STAGE(PG8_SA(0, 0), gA, gvo[0]); PG8_STAGE(PG8_SA(0, 1), gA, gvo[1]); } else { PG8_STAGE(PG8_SA(0, 0), cA, voffA); PG8_STAGE(PG8_SA(0, 1), cA + hstepA, voffA); }
    if (wr == 1) PG8_BAR;
    PG8_WAIT_V(2); PG8_BAR;
    PG8_STAGE(PG8_SB(1, 0), cB + kstep, voffB); if constexpr (GATHER) PG8_STAGE(PG8_SA(1, 0), gA + kstep, gvo[0]); else PG8_STAGE(PG8_SA(1, 0), cA + kstep, voffA);
    PG8_STAGE(PG8_SB(1, 1), cB + hstepB + kstep, voffB);
    PG8_WAIT_V(6); PG8_BAR;
#else
    PG8_STAGE(PG8_SB(0, 0), cB, voffB); if constexpr (GATHER) PG8_STAGE(PG8_SA(0, 0), gA, gvo[0]); else PG8_STAGE(PG8_SA(0, 0), cA, voffA);
    PG8_STAGE(PG8_SB(0, 1), cB + hstepB, voffB); if constexpr (GATHER) PG8_STAGE(PG8_SA(0, 1), gA, gvo[1]); else PG8_STAGE(PG8_SA(0, 1), cA + hstepA, voffA);
    if (wr == 1) PG8_BAR;
    PG8_WAIT_V(4); PG8_BAR;
    PG8_STAGE(PG8_SB(1, 0), cB + kstep, voffB); if constexpr (GATHER) PG8_STAGE(PG8_SA(1, 0), gA + kstep, gvo[0]); else PG8_STAGE(PG8_SA(1, 0), cA + kstep, voffA);
    PG8_STAGE(PG8_SB(1, 1), cB + hstepB + kstep, voffB);
    PG8_WAIT_V(6); PG8_BAR;
#endif
    for (;;) {
        const bool has_next = S.next(ui + 1, nxt);
        const char* nA = has_next ? (const char*)g.A + (size_t)nxt.pm * tstepA + (nxt.kq < 0 ? (size_t)0 : nxt.kq * ksl) : cA; const char* nB = has_next ? (const char*)g.Bt + (size_t)nxt.pn * tstepB + (nxt.kq < 0 ? (size_t)0 : nxt.kq * ksl) : cB;
        const int nt = cur.kq < 0 ? ntfull : ntsplit;
        const char* ngA = (const char*)g.A + ((has_next && nxt.kq >= 0) ? nxt.kq * ksl : (size_t)0); if (!has_next) ngA = gA;
        if constexpr (GATHER) { if (has_next) { PG8_GVO(ngvo, nxt); } else {
#pragma unroll
            for (int _h = 0; _h < 2; ++_h) { ngvo[_h][0] = gvo[_h][0]; ngvo[_h][1] = gvo[_h][1]; } } }
        for (int t = 0; t < nt; t += 2) {
            const bool last = (t == nt - 2);
            const char* a1 = cA + (size_t)(t + 1) * kstep;
            const char* a2 = last ? nA : cA + (size_t)(t + 2) * kstep; const char* b2 = last ? nB : cB + (size_t)(t + 2) * kstep;
            const char* a3 = a2 + kstep; const char* b3 = b2 + kstep;
#define PG8_STA11() do { if constexpr (GATHER) PG8_STAGE(PG8_SA(1, 1), gA + (size_t)(t + 1) * kstep, gvo[1]); else PG8_STAGE(PG8_SA(1, 1), a1 + hstepA, voffA); } while (0)
#define PG8_STA00() do { if constexpr (GATHER) { const unsigned v2[2] = {last ? ngvo[0][0] : gvo[0][0], last ? ngvo[0][1] : gvo[0][1]}; PG8_STAGE(PG8_SA(0, 0), last ? ngA : gA + (size_t)(t + 2) * kstep, v2); } else PG8_STAGE(PG8_SA(0, 0), a2, voffA); } while (0)
#define PG8_STA01() do { if constexpr (GATHER) { const unsigned v2[2] = {last ? ngvo[1][0] : gvo[1][0], last ? ngvo[1][1] : gvo[1][1]}; PG8_STAGE(PG8_SA(0, 1), last ? ngA : gA + (size_t)(t + 2) * kstep, v2); } else PG8_STAGE(PG8_SA(0, 1), a2 + hstepA, voffA); } while (0)
#define PG8_STA10() do { if constexpr (GATHER) { const unsigned v2[2] = {last ? ngvo[0][0] : gvo[0][0], last ? ngvo[0][1] : gvo[0][1]}; PG8_STAGE(PG8_SA(1, 0), (last ? ngA : gA + (size_t)(t + 2) * kstep) + kstep, v2); } else PG8_STAGE(PG8_SA(1, 0), a3, voffA); } while (0)
#if GEMM_SP2
            PG8_LDB(B0, 0, 0); PG8_LDB(B1, 0, 1); PG8_SCHED; PG8_LDA(At, 0, 0); PG8_STA11();
            PG8_WAIT_V(8); PG8_WAIT_L(0); PG8_BAR; PG8_MMA(0, 0, At, B0); PG8_MMA(0, 1, At, B1); PG8_BAR; PG8_SCHED;
            PG8_LDA(At, 0, 1); PG8_STAGE(PG8_SB(0, 0), b2, voffB); PG8_STAGE(PG8_SB(0, 1), b2 + hstepB, voffB); PG8_STA00();
            PG8_WAIT_V(8); PG8_WAIT_L(0); PG8_BAR; PG8_MMA(1, 0, At, B0); PG8_MMA(1, 1, At, B1); PG8_BAR; PG8_SCHED;
            PG8_LDB(B0, 1, 0); PG8_LDB(B1, 1, 1); PG8_SCHED; PG8_LDA(At, 1, 0); PG8_STA01();
            PG8_WAIT_V(8); PG8_WAIT_L(0); PG8_BAR; PG8_MMA(0, 0, At, B0); PG8_MMA(0, 1, At, B1); PG8_BAR; PG8_SCHED;
            PG8_LDA(At, 1, 1); PG8_STAGE(PG8_SB(1, 0), b3, voffB); PG8_STAGE(PG8_SB(1, 1), b3 + hstepB, voffB); PG8_STA10();
            PG8_WAIT_V(8); PG8_WAIT_L(0); PG8_BAR; PG8_MMA(1, 0, At, B0); PG8_MMA(1, 1, At, B1); PG8_BAR; PG8_SCHED;
#else
            PG8_LDB(B0, 0, 0); PG8_SCHED; PG8_LDA(At, 0, 0); PG8_STA11();
            PG8_WAIT_L(8); PG8_BAR; PG8_WAIT_L(0); PG8_MMA(0, 0, At, B0); PG8_BAR; PG8_SCHED;
            PG8_LDB(B1, 0, 1); PG8_STAGE(PG8_SB(0, 0), b2, voffB);
            PG8_BAR; PG8_WAIT_L(0); PG8_MMA(0, 1, At, B1); PG8_BAR;
            PG8_LDA(At, 0, 1); PG8_STA00();
            PG8_BAR; PG8_WAIT_L(0); PG8_MMA(1, 0, At, B0); PG8_BAR; PG8_SCHED;
            PG8_STAGE(PG8_SB(0, 1), b2 + hstepB, voffB);
            PG8_WAIT_V(6); PG8_BAR; PG8_MMA(1, 1, At, B1); PG8_BAR;
            PG8_LDB(B0, 1, 0); PG8_SCHED; PG8_LDA(At, 1, 0); PG8_STA01();
            PG8_WAIT_L(8); PG8_BAR; PG8_WAIT_L(0); PG8_MMA(0, 0, At, B0); PG8_BAR; PG8_SCHED;
            PG8_LDB(B1, 1, 1); PG8_STAGE(PG8_SB(1, 0), b3, voffB);
            PG8_BAR; PG8_WAIT_L(0); PG8_MMA(0, 1, At, B1); PG8_BAR;
            PG8_LDA(At, 1, 1); PG8_STA10();
            PG8_BAR; PG8_WAIT_L(0); PG8_MMA(1, 0, At, B0); PG8_BAR; PG8_SCHED;
            PG8_STAGE(PG8_SB(1, 1), b3 + hstepB, voffB);
            PG8_WAIT_V(6); PG8_BAR; PG8_MMA(1, 1, At, B1); PG8_BAR;
#endif
#undef PG8_STA11
#undef PG8_STA00
#undef PG8_STA01
#undef PG8_STA10
        }
#if GEMM_SP2
        if (wr == 0) PG8_BAR;
#endif
        if (g.slab != nullptr && cur.kq >= 0) {
            float* sl = g.slab + ((size_t)cur.sidx * KSPLIT + cur.kq) * 65536 + tid * 4;
#pragma unroll
            for (int a = 0; a < 2; ++a)
#pragma unroll
                for (int b = 0; b < 2; ++b)
#pragma unroll
                    for (int m = 0; m < 4; ++m)
#pragma unroll
                        for (int n = 0; n < 2; ++n) *(f32x4*)(sl + (((a * 2 + b) * 4 + m) * 2 + n) * 2048) = acc[a][b][m][n];
        } else E(acc, cur, wr, wc, fr, fq);
        if (!has_next) break;
#pragma unroll
        for (int a = 0; a < 2; ++a)
#pragma unroll
            for (int b = 0; b < 2; ++b)
#pragma unroll
                for (int m = 0; m < 4; ++m)
#pragma unroll
                    for (int n = 0; n < 2; ++n) acc[a][b][m][n] = (f32x4){0.f, 0.f, 0.f, 0.f};
        cur = nxt; cA = nA; cB = nB; gA = ngA; ++ui;
        if constexpr (GATHER) {
#pragma unroll
            for (int _h = 0; _h < 2; ++_h) { gvo[_h][0] = ngvo[_h][0]; gvo[_h][1] = ngvo[_h][1]; } }
#if GEMM_SP2
        if (wr == 1) PG8_BAR;
#endif
    }
    PG8_WAIT_V(0);
#if !GEMM_SP2
    if (wr == 0) PG8_BAR;
#endif
    PG8_BAR;
#undef PG8_GVO
#undef PG8_SA
#undef PG8_SB
#undef PG8_STAGE
#undef PG8_LDA
#undef PG8_LDB
#undef PG8_MMA
#undef PG8_WAIT_V
#undef PG8_WAIT_L
#undef PG8_BAR
#undef PG8_SCHED
}
template <class Epi, class Sched>
__device__ __forceinline__ void split_reduce(LAS unsigned char* lds, const Gemm g, const Sched& S, const Epi& E, unsigned* tickets) {
    const int tid = threadIdx.x, wid = __builtin_amdgcn_readfirstlane(tid >> 6), lane = tid & 63, wr = wid >> 2, wc = wid & 3, fr = lane & 15, fq = lane >> 4;
    asm volatile("s_waitcnt vmcnt(0)" ::: "memory");
    __syncthreads();
    if (tid == 0) {
        __builtin_amdgcn_fence(__ATOMIC_RELEASE, "agent");
        asm volatile("s_waitcnt vmcnt(0)" ::: "memory");
        for (int i = 0; ; ++i) { Unit u; if (!S.next(i, u)) break; if (u.kq < 0) continue; __hip_atomic_fetch_add(tickets + 64 * u.sidx, 1u, __ATOMIC_RELAXED, __HIP_MEMORY_SCOPE_AGENT); }
    }
    for (int i = 0; ; ++i) { Unit u; if (!S.next(i, u)) break; if (u.kq < 0) continue;
        if (tid == 0) { while (__hip_atomic_load(tickets + 64 * u.sidx, __ATOMIC_RELAXED, __HIP_MEMORY_SCOPE_AGENT) < (unsigned)KSPLIT) __builtin_amdgcn_s_sleep(2);
            __builtin_amdgcn_fence(__ATOMIC_ACQUIRE, "agent"); asm volatile("s_waitcnt vmcnt(0)" ::: "memory"); }
        __syncthreads();
        const int only = u.kq;
        f32x4 t[2][2];
#pragma unroll
        for (int b = 0; b < 2; ++b)
#pragma unroll
            for (int n = 0; n < 2; ++n) t[b][n] = (f32x4){0.f, 0.f, 0.f, 0.f};
        const float* sl0 = g.slab + (size_t)u.sidx * KSPLIT * 65536 + tid * 4 + (size_t)((only >> 2) * 16 + (only & 3) * 2) * 2048;
        f32x4 ld[KSPLIT][2][2];
#pragma unroll
        for (int s = 0; s < KSPLIT; ++s)
#pragma unroll
            for (int b = 0; b < 2; ++b)
#pragma unroll
                for (int n = 0; n < 2; ++n) ld[s][b][n] = *(const f32x4*)(sl0 + (size_t)s * 65536 + (b * 8 + n) * 2048);
#pragma unroll
        for (int s = 0; s < KSPLIT; ++s)
#pragma unroll
            for (int b = 0; b < 2; ++b)
#pragma unroll
                for (int n = 0; n < 2; ++n) t[b][n] = t[b][n] + ld[s][b][n];
        f32x4 acc[2][2][4][2];
#pragma unroll
        for (int a = 0; a < 2; ++a)
#pragma unroll
            for (int b = 0; b < 2; ++b)
#pragma unroll
                for (int m = 0; m < 4; ++m)
#pragma unroll
                    for (int n = 0; n < 2; ++n) acc[a][b][m][n] = (a * 4 + m == only) ? t[b][n] : (f32x4){0.f, 0.f, 0.f, 0.f};
        u.kq = -1;
        Epi E2 = E; E2.only = only;
        E2(acc, u, wr, wc, fr, fq);
    }
}
struct EpiProj {
    static constexpr bool PERM = true;
    bf16_t* O; int ldc; int npn_main; float* side; int only = -1;
    __device__ __forceinline__ void operator()(const f32x4 (&acc)[2][2][4][2], const Unit& u, int wr, int wc, int fr, int fq) const {
        const int row0 = u.pm * BM + wr * 64 + fr;
        if (u.pn < npn_main) {
            const int col0 = u.pn * BM + wc * 32 + 8 * fq;
#pragma unroll
            for (int ai = 0; ai < 2; ++ai)
#pragma unroll
                for (int m = 0; m < 4; ++m) { if (only >= 0 && only != ai * 4 + m) continue; bf16_t* rowp = O + (size_t)(row0 + ai * HALF + m * 16) * ldc + col0;
#pragma unroll
                    for (int bj = 0; bj < 2; ++bj) { const f32x4 v0 = acc[ai][bj][m][0], v1 = acc[ai][bj][m][1];
                        u32x4 w; w.x = cvt_pk_bf16(v0[0], v0[1]); w.y = cvt_pk_bf16(v0[2], v0[3]); w.z = cvt_pk_bf16(v1[0], v1[1]); w.w = cvt_pk_bf16(v1[2], v1[3]);
                        __builtin_nontemporal_store(w, (u32x4*)(rowp + bj * HALF)); } }
        } else if (wc < 2) {
            const int col0 = wc * 32 + 8 * fq;
#pragma unroll
            for (int ai = 0; ai < 2; ++ai)
#pragma unroll
                for (int m = 0; m < 4; ++m) { if (only >= 0 && only != ai * 4 + m) continue; float* rowp = side + (size_t)(row0 + ai * HALF + m * 16) * 64 + col0;
                    *(f32x4*)(rowp) = acc[ai][0][m][0]; *(f32x4*)(rowp + 4) = acc[ai][0][m][1]; }
        }
    }
};
struct EpiResAdd {
    static constexpr bool PERM = false;
    bf16_t* y2; int ldc; float* part;
    __device__ __forceinline__ void operator()(const f32x4 (&acc)[2][2][4][2], const Unit& u, int wr, int wc, int fr, int fq) const {
        const int col0 = u.pn * BM + wc * 32 + 4 * fq;
        if (u.kq < 0) { const int row0 = u.pm * BM + wr * 64 + fr;
#pragma unroll
            for (int ai = 0; ai < 2; ++ai)
#pragma unroll
                for (int m = 0; m < 4; ++m) { const size_t ro = (size_t)(row0 + ai * HALF + m * 16) * ldc + col0;
#pragma unroll
                    for (int bj = 0; bj < 2; ++bj)
#pragma unroll
                        for (int n = 0; n < 2; ++n) { const f32x4 v = acc[ai][bj][m][n]; u32x2 w; w.x = cvt_pk_bf16(v[0], v[1]); w.y = cvt_pk_bf16(v[2], v[3]); *(u32x2*)(y2 + ro + bj * HALF + n * 16) = w; } }
        } else { const int row0 = u.kq * BM + wr * 64 + fr;
#pragma unroll
            for (int ai = 0; ai < 2; ++ai)
#pragma unroll
                for (int m = 0; m < 4; ++m) { float* rowp = part + (size_t)(row0 + ai * HALF + m * 16) * ldc + col0;
#pragma unroll
                    for (int bj = 0; bj < 2; ++bj)
#pragma unroll
                        for (int n = 0; n < 2; ++n) *(f32x4*)(rowp + bj * HALF + n * 16) = acc[ai][bj][m][n]; }
        }
    }
};
struct EpiMoeUp {
    static constexpr bool PERM = true;
    bf16_t* hid; const float* lw; const float* lrs; const LAS int* tab; int only = -1;
    __device__ __forceinline__ void operator()(const f32x4 (&acc)[2][2][4][2], const Unit& u, int wr, int wc, int fr, int fq) const {
        const int r0 = wr * 64 + fr, col0 = (u.pn & 1) * 128 + wc * 32 + 8 * fq; const int n_e = tab[256 + u.ex];
        float rsv[8], wtv[8];
#pragma unroll
        for (int q = 0; q < 8; ++q) { const int pos = u.pos0 + r0 + (q >> 2) * HALF + (q & 3) * 16; const int pc = pos < n_e ? pos : 0;
            rsv[q] = lrs[(size_t)u.ex * LCAP + pc]; wtv[q] = lw[(size_t)u.ex * LCAP + pc]; if (pos >= n_e) { rsv[q] = 0.f; wtv[q] = 0.f; } }
#pragma unroll
        for (int ai = 0; ai < 2; ++ai)
#pragma unroll
            for (int m = 0; m < 4; ++m) { if (only >= 0 && only != ai * 4 + m) continue; const int s = r0 + ai * HALF + m * 16; const float rs = rsv[ai * 4 + m], wt = wtv[ai * 4 + m] * rs;
                float o[8];
#pragma unroll
                for (int n = 0; n < 2; ++n)
#pragma unroll
                    for (int j = 0; j < 4; ++j) o[n * 4 + j] = siluf_(acc[ai][0][m][n][j] * rs) * acc[ai][1][m][n][j] * wt;
                u32x4 w; w.x = cvt_pk_bf16(o[0], o[1]); w.y = cvt_pk_bf16(o[2], o[3]); w.z = cvt_pk_bf16(o[4], o[5]); w.w = cvt_pk_bf16(o[6], o[7]);
                *(u32x4*)(hid + (size_t)(u.pm * BM + s) * DEXP + col0) = w; }
    }
};
struct EpiMoeDn {
    static constexpr bool PERM = true;
    bf16_t* y; const int* ltok; const LAS int* tab;
    __device__ __forceinline__ void operator()(const f32x4 (&acc)[2][2][4][2], const Unit& u, int wr, int wc, int fr, int fq) const {
        const int r0 = wr * 64 + fr, col0 = (u.pn & 15) * BM + wc * 32 + 8 * fq; const int n_e = tab[256 + u.ex];
        int tokv[8];
#pragma unroll
        for (int q = 0; q < 8; ++q) { const int pos = u.pos0 + r0 + (q >> 2) * HALF + (q & 3) * 16; tokv[q] = ltok[(size_t)u.ex * LCAP + (pos < n_e ? pos : 0)]; if (pos >= n_e) tokv[q] = -1; }
#pragma unroll
        for (int ai = 0; ai < 2; ++ai)
#pragma unroll
            for (int m = 0; m < 4; ++m) { const int tok = tokv[ai * 4 + m];
                if (tok >= 0) { bf16_t* rowp = y + ((size_t)(tok & 1) * MP + (tok >> 1)) * D + col0;
#pragma unroll
                    for (int bj = 0; bj < 2; ++bj) { const f32x4 v0 = acc[ai][bj][m][0], v1 = acc[ai][bj][m][1];
                        u32x4 w; w.x = cvt_pk_bf16(v0[0], v0[1]); w.y = cvt_pk_bf16(v0[2], v0[3]); w.z = cvt_pk_bf16(v1[0], v1[1]); w.w = cvt_pk_bf16(v1[2], v1[3]);
                        __builtin_nontemporal_store(w, (u32x4*)(rowp + bj * HALF)); } } }
    }
};
}

#define XB_TMO      128
#define XB_XCNT(j)  (256  + 64 * (j))
#define XB_XSUB(j)  (1280 + 64 * (j))
#define XB_XGEN(j)  (2304 + 64 * (j))
#define XB_TOP      3328
#define XB_TOPGEN   3392
#define XCD_BAR_WORDS 3456
#define XB_SPIN_CAP (1u << 18)
__device__ __forceinline__ unsigned xb_ld(unsigned* p)              { return __hip_atomic_load(p, __ATOMIC_RELAXED, __HIP_MEMORY_SCOPE_AGENT); }
__device__ __forceinline__ unsigned xb_add(unsigned* p, unsigned v) { return __hip_atomic_fetch_add(p, v, __ATOMIC_RELAXED, __HIP_MEMORY_SCOPE_AGENT); }
__device__ __forceinline__ unsigned xb_xcc_id() { return (unsigned)__builtin_amdgcn_s_getreg((3 << 11) | 20) & 0xFu; }
#define XB_SPIN(cond, bar) do { unsigned _sp = 0; while (cond) { __builtin_amdgcn_s_sleep(1); \
    if ((++_sp & 255u) == 0u) { if (xb_ld(&(bar)[XB_TMO])) break; if (_sp > XB_SPIN_CAP) { atomicAdd(&(bar)[XB_TMO], 1u); break; } } } } while (0)
struct XcdBarrier { unsigned* bar; unsigned x; volatile LAS unsigned* st; };
__device__ __forceinline__ XcdBarrier xcd_barrier_post(unsigned* bar, volatile LAS unsigned* st) {
    XcdBarrier b; b.bar = bar; b.x = xb_xcc_id(); b.st = st;
    if (threadIdx.x == 0) (void)xb_add(&bar[XB_XCNT(b.x)], 1u);
    return b;
}
__device__ __forceinline__ void xcd_barrier_complete(unsigned* bar, unsigned x, unsigned& nloc, unsigned& nx) {
    const unsigned G = gridDim.x * gridDim.y * gridDim.z;
    unsigned sum, cnt, mine, sp = 0u;
    for (;;) {
        sum = 0u; cnt = 0u; mine = 0u;
#pragma unroll
        for (unsigned j = 0; j < 16; ++j) { const unsigned c = xb_ld(&bar[XB_XCNT(j)]); sum += c; cnt += (c > 0u) ? 1u : 0u; mine = (j == x) ? c : mine; }
        if (sum == G) break;
        __builtin_amdgcn_s_sleep(1);
        if ((++sp & 255u) == 0u) { if (xb_ld(&bar[XB_TMO])) break; if (sp > XB_SPIN_CAP) { atomicAdd(&bar[XB_TMO], 1u); break; } }
    }
    nloc = mine > 0u ? mine : 1u; nx = cnt > 0u ? cnt : 1u;
}
__device__ __forceinline__ void xcd_barrier(const XcdBarrier& b) {
    asm volatile("s_waitcnt vmcnt(0)" ::: "memory");
    __syncthreads();
    if (threadIdx.x == 0) {
        unsigned* bar = b.bar;
        __builtin_amdgcn_s_waitcnt(0);
        unsigned nloc = b.st[0], nx = b.st[1];
        if (nloc == 0u) { xcd_barrier_complete(bar, b.x, nloc, nx); b.st[0] = nloc; b.st[1] = nx; }
        const unsigned old = xb_add(&bar[XB_XSUB(b.x)], 1u);
        const unsigned gen = old / nloc;
        if (old + 1u == (gen + 1u) * nloc) {
            __builtin_amdgcn_fence(__ATOMIC_RELEASE, "agent");
            asm volatile("s_waitcnt vmcnt(0)" ::: "memory");
            const unsigned og = xb_add(&bar[XB_TOP], 1u);
            const unsigned tg = og / nx;
            if (og + 1u == (tg + 1u) * nx) xb_add(&bar[XB_TOPGEN], 1u);
            else XB_SPIN(xb_ld(&bar[XB_TOPGEN]) == tg, bar);
            __builtin_amdgcn_fence(__ATOMIC_ACQUIRE, "agent");
            xb_add(&bar[XB_XGEN(b.x)], 1u);
            asm volatile("s_waitcnt vmcnt(0)" ::: "memory");
        } else {
            XB_SPIN(xb_ld(&bar[XB_XGEN(b.x)]) == gen, bar);
            __builtin_amdgcn_fence(__ATOMIC_ACQUIRE, "agent");
            asm volatile("s_waitcnt vmcnt(0)" ::: "memory");
        }
    }
    __syncthreads();
}

struct Args { const float* in[29]; float* out; unsigned char* ws; int ph_lo, ph_hi, flags, pad; };
enum { I_X = 0, I_META, I_MIXN, I_FFNN, I_FINN, I_EVWIN, I_EVGB, I_EVQKC, I_EVLRUP, I_EVLRB, I_EVNA, I_EVNB, I_EVWOUT, I_ODWIN, I_ODCONV, I_ODCONVB, I_ODWR, I_ODBR, I_ODWI, I_ODBI, I_ODLAM, I_ODWOUT,
       I_MWG, I_MBG, I_MWE, I_MBE, I_MW1, I_MW3, I_MW2 };


#define LDS_WAIT() asm volatile("s_waitcnt lgkmcnt(0)" ::: "memory")

template <bool NT = false>
__device__ __forceinline__ void tr_item(const float* Wc, size_t ldw, bf16_t* WT, size_t ldt, int k0, int n0, LAS float* scr, int lane) {
    const int c4 = (lane & 15) * 4;
#pragma unroll 8
    for (int i = 0; i < 16; ++i) { const int kk = 4 * i + (lane >> 4); const f32x4 v = Wc ? __builtin_nontemporal_load((const f32x4*)(Wc + (size_t)(k0 + kk) * ldw)) : (f32x4){0.f, 0.f, 0.f, 0.f};
        LAS float* d = scr + kk * 65 + c4; d[0] = v[0]; d[1] = v[1]; d[2] = v[2]; d[3] = v[3]; }
    LDS_WAIT();
    const int c = lane & 7;
#pragma unroll
    for (int j = 0; j < 8; ++j) { const int n = (lane >> 3) + 8 * j; const LAS float* s = scr + (8 * c) * 65 + n;
        u32x4 o; o.x = cvt_pk_bf16(s[0 * 65], s[1 * 65]); o.y = cvt_pk_bf16(s[2 * 65], s[3 * 65]); o.z = cvt_pk_bf16(s[4 * 65], s[5 * 65]); o.w = cvt_pk_bf16(s[6 * 65], s[7 * 65]);
        if (NT) __builtin_nontemporal_store(o, (u32x4*)(WT + (size_t)(n0 + n) * ldt + k0 + 8 * c)); else *(u32x4*)(WT + (size_t)(n0 + n) * ldt + k0 + 8 * c) = o; }
    LDS_WAIT();
}
constexpr int MOE_ITEMS = 32 * 64 * 8 + 32 * 4 * 64, OD_ITEMS = 64 * 160 + 80 * 64 + 64 * 25, QBATCH = 4;
__device__ __forceinline__ void moe_item(const Args& a, int layer, int it, LAS float* scr, int lane) {
    unsigned char* wsw = a.ws + WS_W; constexpr int I_UP = 32 * 64 * 8; const int c4 = (lane & 15) * 4;
    if (it < I_UP) { const int e = it >> 9, r = it & 511, kb = r >> 3, nb = r & 7; const int n = 64 * nb;
        const float* src = ((n & 255) < 128 ? a.in[I_MW1] : a.in[I_MW3]) + ((size_t)(layer * NEXP + e)) * 4096 * 256 + ((n >> 8) * 128 + (n & 127)) + c4;
        tr_item<true>(src, 256, (bf16_t*)(wsw + W_UP) + (size_t)e * 512 * 4096, 4096, 64 * kb, 64 * nb, scr, lane);
    } else { const int r0 = it - I_UP, e = r0 >> 8, r = r0 & 255, kb = r >> 6, nb = r & 63;
        const float* src = a.in[I_MW2] + ((size_t)(layer * NEXP + e)) * 256 * 4096 + 64 * nb + c4;
        tr_item<true>(src, 4096, (bf16_t*)(wsw + W_DN) + (size_t)e * 4096 * 256, 256, 64 * kb, 64 * nb, scr, lane); }
}
__device__ __forceinline__ void od_item(const Args& a, int it, LAS float* scr, int lane) {
    unsigned char* wsw = a.ws + WS_W; constexpr int I_A = 64 * 160, I_B = 80 * 64; const int c4 = (lane & 15) * 4;
    if (it < I_A) { const int kb = it / 160, nb = it % 160;
        tr_item<true>(a.in[I_ODWIN] + 64 * nb + c4, NPROJ1, (bf16_t*)(wsw + W_IN), 4096, 64 * kb, 64 * nb, scr, lane);
    } else if (it < I_A + I_B) { const int r = it - I_A, kb = r >> 6, nb = r & 63;
        tr_item<true>(a.in[I_ODWOUT] + 64 * nb + c4, 4096, (bf16_t*)(wsw + W_OUT1), DR, 64 * kb, 64 * nb, scr, lane);
    } else { const int r = it - I_A - I_B, mm = r / 25, q = r % 25, kb = q / 5, nb = q % 5;
        const float* src = ((mm & 1) ? a.in[I_ODWI] : a.in[I_ODWR]) + (size_t)(mm >> 1) * 320 * 320 + 64 * nb + c4;
        tr_item<true>(src, 320, (bf16_t*)(wsw + W_RI) + (size_t)mm * 320 * 320, 320, 64 * kb, 64 * nb, scr, lane); }
}
__device__ __forceinline__ void queue_moe(const Args& a, int layer, unsigned* q, LAS float* scr, int lane) {
    for (;;) { int base = 0; if (lane == 0) base = (int)__hip_atomic_fetch_add(q, (unsigned)QBATCH, __ATOMIC_RELAXED, __HIP_MEMORY_SCOPE_AGENT);
        base = __builtin_amdgcn_readfirstlane(base); if (base >= MOE_ITEMS) break;
        for (int it = base; it < base + QBATCH && it < MOE_ITEMS; ++it) moe_item(a, layer, it, scr, lane); }
}
__device__ __forceinline__ void queue_od(const Args& a, unsigned* q, LAS float* scr, int lane) {
    for (;;) { int base = 0; if (lane == 0) base = (int)__hip_atomic_fetch_add(q, (unsigned)QBATCH, __ATOMIC_RELAXED, __HIP_MEMORY_SCOPE_AGENT);
        base = __builtin_amdgcn_readfirstlane(base); if (base >= OD_ITEMS) break;
        for (int it = base; it < base + QBATCH && it < OD_ITEMS; ++it) od_item(a, it, scr, lane); }
}
__device__ __forceinline__ void router_table(const Args& a, int layer, int gw, int NGW, int lane) {
    bf16_t* rth = (bf16_t*)(a.ws + WS_W + W_RT); bf16_t* rtl = rth + 48 * D; const float* gf = a.in[I_FFNN] + layer * D;
    for (int i = gw * 64 + lane; i < 48 * D; i += NGW * 64) { const int j = i >> 12, d = i & 4095;
        const float w = j < 4 ? a.in[I_MWG][((size_t)layer * D + d) * 4 + j] : (j < 36 ? a.in[I_MWE][((size_t)layer * D + d) * 32 + (j - 4)] : 0.f);
        const float v = gf[d] * w; const unsigned short hi = f2bf(v); rth[i] = hi; rtl[i] = f2bf(v - bf2f(hi)); }
}
__device__ __forceinline__ void conv_layer0(const Args& a, int gw, int NGW, LAS float* scr, int lane) {
    unsigned char* wsw = a.ws + WS_W;
    constexpr int NBLK = NW0 / 64, I_A = 64 * NBLK, I_B = 64 * 64;
    const int c4 = (lane & 15) * 4;
    for (int it = gw; it < I_A + I_B; it += NGW) {
        if (it < I_A) { const int kb = it / NBLK, nb = it % NBLK; const int n = 64 * nb + c4;
            const int col = n < 6144 ? n : (n < 12288 ? n + 16 : (n < 12304 ? 6144 + (n - 12288) : (n < 12336 ? n : -1)));
            tr_item(col >= 0 ? a.in[I_EVWIN] + col : nullptr, 12336, (bf16_t*)(wsw + W_IN), 4096, 64 * kb, 64 * nb, scr, lane);
        } else { const int r = it - I_A, kb = r >> 6, nb = r & 63;
            tr_item(a.in[I_EVWOUT] + 64 * nb + c4, 4096, (bf16_t*)(wsw + W_OUT0), 4096, 64 * kb, 64 * nb, scr, lane); }
    }
}

__device__ __forceinline__ void load_row(const float* p, int lane, f32x4 (&v)[16]) {
#pragma unroll
    for (int j = 0; j < 16; ++j) v[j] = *(const f32x4*)(p + (j * 64 + lane) * 4);
}
__device__ __forceinline__ void load_row_nt(const float* p, int lane, f32x4 (&v)[16]) {
#pragma unroll
    for (int j = 0; j < 16; ++j) v[j] = __builtin_nontemporal_load((const f32x4*)(p + (j * 64 + lane) * 4));
}
__device__ __forceinline__ float row_ss(const f32x4 (&v)[16]) { float s = 0.f;
#pragma unroll
    for (int j = 0; j < 16; ++j) s += (v[j][0] * v[j][0] + v[j][1] * v[j][1]) + (v[j][2] * v[j][2] + v[j][3] * v[j][3]);
    return wave_sum(s); }
__device__ __forceinline__ void store_row_bf16_scaled(bf16_t* o, const f32x4 (&v)[16], float rstd, const float* g, int lane) {
#pragma unroll
    for (int j = 0; j < 16; ++j) { const f32x4 gg = *(const f32x4*)(g + (j * 64 + lane) * 4);
        u32x2 w; w.x = cvt_pk_bf16(v[j][0] * rstd * gg[0], v[j][1] * rstd * gg[1]); w.y = cvt_pk_bf16(v[j][2] * rstd * gg[2], v[j][3] * rstd * gg[3]);
        *(u32x2*)(o + (j * 64 + lane) * 4) = w; }
}
__device__ __forceinline__ void zero_row_bf16(bf16_t* o, int lane) {
#pragma unroll
    for (int j = 0; j < 8; ++j) *(u32x4*)(o + (j * 64 + lane) * 8) = (u32x4){0u, 0u, 0u, 0u};
}
__device__ __forceinline__ void load_row_bf16(const bf16_t* y, int lane, f32x4 (&v)[16]) {
#pragma unroll
    for (int j = 0; j < 16; ++j) { const u32x2 w = *(const u32x2*)(y + (j * 64 + lane) * 4);
        v[j] = (f32x4){__uint_as_float(w.x << 16), __uint_as_float(w.x & 0xffff0000u), __uint_as_float(w.y << 16), __uint_as_float(w.y & 0xffff0000u)}; }
}
__device__ __forceinline__ void store_row_bf16(bf16_t* o, const f32x4 (&v)[16], int lane) {
#pragma unroll
    for (int j = 0; j < 16; ++j) { u32x2 w; w.x = cvt_pk_bf16(v[j][0], v[j][1]); w.y = cvt_pk_bf16(v[j][2], v[j][3]); __builtin_nontemporal_store(w, (u32x2*)(o + (j * 64 + lane) * 4)); }
}
__device__ __forceinline__ void add_y(f32x4 (&v)[16], const bf16_t* y, int lane) {
#pragma unroll
    for (int j = 0; j < 16; ++j) { const u32x2 w = *(const u32x2*)(y + (j * 64 + lane) * 4);
        v[j][0] += __uint_as_float(w.x << 16); v[j][1] += __uint_as_float(w.x & 0xffff0000u); v[j][2] += __uint_as_float(w.y << 16); v[j][3] += __uint_as_float(w.y & 0xffff0000u); }
}

__device__ __forceinline__ void p0_rows(const Args& a, int gw, int NGW, int lane) {
    float* H = (float*)(a.ws + WS_H); bf16_t* XN = (bf16_t*)((unsigned char*)a.out + DO_XN);
    for (int r = gw; r < MP; r += NGW) {
        if (row_valid(r)) { const int b = r >= TP ? 1 : 0, p = r - b * TP;
            const float* src = p < 64 ? a.in[I_META] + (size_t)(p - PADF) * D : a.in[I_X] + ((size_t)b * SEQ + (p - 64)) * D;
            f32x4 v[16]; load_row_nt(src, lane, v); const float rstd = rsqrtf(row_ss(v) * (1.0f / D) + EPS);
            if (r >= 16384) {
#pragma unroll
                for (int j = 0; j < 16; ++j) *(f32x4*)(H + (size_t)r * D + (j * 64 + lane) * 4) = v[j]; }
            store_row_bf16_scaled(XN + (size_t)r * D, v, rstd, a.in[I_MIXN], lane);
        } else {
            if (r >= 16384) {
#pragma unroll
                for (int j = 0; j < 16; ++j) *(f32x4*)(H + (size_t)r * D + (j * 64 + lane) * 4) = (f32x4){0.f, 0.f, 0.f, 0.f}; }
            zero_row_bf16(XN + (size_t)r * D, lane); }
    }
}
__device__ __forceinline__ void p8_rows(const Args& a, int gw, int NGW, int lane) {
    float* H = (float*)(a.ws + WS_H); bf16_t* XN = (bf16_t*)((unsigned char*)a.out + DO_XN); const bf16_t* Y = (const bf16_t*)(a.ws + WS_HS);
    for (int r = gw; r < MP; r += NGW) {
        if (row_valid(r)) { f32x4 v[16];
            if (r < 16384) { const int b = r >= TP ? 1 : 0, p = r - b * TP;
                const float* px = (p < 64 ? a.in[I_META] + (size_t)(p - PADF) * D : a.in[I_X] + ((size_t)b * SEQ + (p - 64)) * D) + lane * 4;
                const size_t o_ = (size_t)r * D + lane * 4; const bf16_t* p2 = (const bf16_t*)(a.ws + WS_PROJ) + o_; const bf16_t* pa_ = Y + o_; const bf16_t* pb_ = Y + (size_t)MP * D + o_;
                u32x2 r2[16], ra[16], rb[16];
#pragma unroll
                for (int j = 0; j < 16; ++j) { v[j] = __builtin_nontemporal_load((const f32x4*)(px + j * 256)); r2[j] = __builtin_nontemporal_load((const u32x2*)(p2 + j * 256)); ra[j] = __builtin_nontemporal_load((const u32x2*)(pa_ + j * 256)); rb[j] = __builtin_nontemporal_load((const u32x2*)(pb_ + j * 256)); }
#pragma unroll
                for (int j = 0; j < 16; ++j) {
                    v[j] = v[j] + (f32x4){__uint_as_float(r2[j].x << 16), __uint_as_float(r2[j].x & 0xffff0000u), __uint_as_float(r2[j].y << 16), __uint_as_float(r2[j].y & 0xffff0000u)};
                    v[j] = v[j] + (f32x4){__uint_as_float(ra[j].x << 16), __uint_as_float(ra[j].x & 0xffff0000u), __uint_as_float(ra[j].y << 16), __uint_as_float(ra[j].y & 0xffff0000u)};
                    v[j] = v[j] + (f32x4){__uint_as_float(rb[j].x << 16), __uint_as_float(rb[j].x & 0xffff0000u), __uint_as_float(rb[j].y << 16), __uint_as_float(rb[j].y & 0xffff0000u)}; } }
            else { load_row(H + (size_t)r * D, lane, v); add_y(v, Y + (size_t)r * D, lane); add_y(v, Y + ((size_t)MP + r) * D, lane); }
            const float rstd = rsqrtf(row_ss(v) * (1.0f / D) + EPS);
            if (r < 16384) store_row_bf16((bf16_t*)H + (size_t)r * D, v, lane);
            else {
#pragma unroll
                for (int j = 0; j < 16; ++j) *(f32x4*)(H + (size_t)r * D + (j * 64 + lane) * 4) = v[j]; }
            store_row_bf16_scaled(XN + (size_t)r * D, v, rstd, a.in[I_MIXN] + D, lane);
        } else zero_row_bf16(XN + (size_t)r * D, lane);
    }
}
__device__ __forceinline__ void pfinal_rows(const Args& a, int gw, int NGW, int lane, int addy) {
    const float* H = (const float*)(a.ws + WS_H); const bf16_t* Y = (const bf16_t*)(a.ws + WS_HS);
    constexpr int NMAIN = SEQ + (16384 - TP - 64);
    if (addy) {
        u32x2 rh[16], r2[16], ra[16], rb[16];
#define PF_LOADS(ii) do { const int b_ = (ii) >> 13, r_ = b_ * TP + 64 + ((ii) & (SEQ - 1)); const size_t o_ = (size_t)r_ * D + lane * 4; \
            const bf16_t* ph = (const bf16_t*)H + o_; const bf16_t* p2 = (const bf16_t*)(a.ws + WS_PROJ) + o_; const bf16_t* pa_ = Y + o_; const bf16_t* pb_ = Y + (size_t)MP * D + o_; \
            _Pragma("unroll") for (int j = 0; j < 16; ++j) { rh[j] = __builtin_nontemporal_load((const u32x2*)(ph + j * 256)); r2[j] = __builtin_nontemporal_load((const u32x2*)(p2 + j * 256)); ra[j] = __builtin_nontemporal_load((const u32x2*)(pa_ + j * 256)); rb[j] = __builtin_nontemporal_load((const u32x2*)(pb_ + j * 256)); } } while (0)
        int i = gw; if (i < NMAIN) PF_LOADS(i);
        while (i < NMAIN) {
            f32x4 v[16];
#pragma unroll
            for (int j = 0; j < 16; ++j) {
                v[j] = (f32x4){__uint_as_float(rh[j].x << 16), __uint_as_float(rh[j].x & 0xffff0000u), __uint_as_float(rh[j].y << 16), __uint_as_float(rh[j].y & 0xffff0000u)};
                v[j] = v[j] + (f32x4){__uint_as_float(r2[j].x << 16), __uint_as_float(r2[j].x & 0xffff0000u), __uint_as_float(r2[j].y << 16), __uint_as_float(r2[j].y & 0xffff0000u)};
                v[j] = v[j] + (f32x4){__uint_as_float(ra[j].x << 16), __uint_as_float(ra[j].x & 0xffff0000u), __uint_as_float(ra[j].y << 16), __uint_as_float(ra[j].y & 0xffff0000u)};
                v[j] = v[j] + (f32x4){__uint_as_float(rb[j].x << 16), __uint_as_float(rb[j].x & 0xffff0000u), __uint_as_float(rb[j].y << 16), __uint_as_float(rb[j].y & 0xffff0000u)}; }
            const int inext = i + NGW;
            const float rstd = rsqrtf(row_ss(v) * (1.0f / D) + EPS);
#pragma unroll
            for (int j = 0; j < 16; ++j) { const f32x4 gg = *(const f32x4*)(a.in[I_FINN] + (j * 64 + lane) * 4);
                __builtin_nontemporal_store((f32x4){v[j][0] * rstd * gg[0], v[j][1] * rstd * gg[1], v[j][2] * rstd * gg[2], v[j][3] * rstd * gg[3]}, (f32x4*)(a.out + (size_t)i * D + (j * 64 + lane) * 4)); }
            if (inext < NMAIN) PF_LOADS(inext);
            i = inext; }
#undef PF_LOADS
    }
    for (int i = (addy ? NMAIN : 0) + gw; i < NBATCH * SEQ; i += NGW) { const int b = i >> 13, t = i & (SEQ - 1), r = b * TP + 64 + t;
        f32x4 v[16]; if (r < 16384) load_row_bf16((const bf16_t*)H + (size_t)r * D, lane, v); else load_row(H + (size_t)r * D, lane, v);
        if (addy) { add_y(v, Y + (size_t)r * D, lane); add_y(v, Y + ((size_t)MP + r) * D, lane); }
        const float rstd = rsqrtf(row_ss(v) * (1.0f / D) + EPS);
#pragma unroll
        for (int j = 0; j < 16; ++j) { const f32x4 gg = *(const f32x4*)(a.in[I_FINN] + (j * 64 + lane) * 4);
            *(f32x4*)(a.out + (size_t)i * D + (j * 64 + lane) * 4) = (f32x4){v[j][0] * rstd * gg[0], v[j][1] * rstd * gg[1], v[j][2] * rstd * gg[2], v[j][3] * rstd * gg[3]}; }
    }
}

__device__ __forceinline__ void route_one(const float (&lg)[36], const float* bg, const float* be, int& e1, int& e2, float& w1, float& w2) {
    float gl[4];
#pragma unroll
    for (int g = 0; g < 4; ++g) gl[g] = lg[g] + bg[g];
    int gi = 0; float gm = gl[0];
#pragma unroll
    for (int g = 1; g < 4; ++g) if (gl[g] > gm) { gm = gl[g]; gi = g; }
    float gs = 0.f;
#pragma unroll
    for (int g = 0; g < 4; ++g) gs += __expf(gl[g] - gm);
    const float gval = 1.0f / gs;
    float el[8];
#pragma unroll
    for (int e = 0; e < 8; ++e) { float x = lg[4 + e] + be[e];
#pragma unroll
        for (int g = 1; g < 4; ++g) { const float y = lg[4 + g * 8 + e] + be[g * 8 + e]; x = (gi == g) ? y : x; }
        el[e] = x; }
    int i1 = 0; float m1 = el[0];
#pragma unroll
    for (int e = 1; e < 8; ++e) if (el[e] > m1) { m1 = el[e]; i1 = e; }
    int i2 = -1; float m2 = -3.0e38f;
#pragma unroll
    for (int e = 0; e < 8; ++e) if (e != i1 && el[e] > m2) { m2 = el[e]; i2 = e; }
    const float p2 = __expf(m2 - m1), s = 1.0f / (1.0f + p2);
    e1 = gi * 8 + i1; e2 = gi * 8 + i2; w1 = s * gval; w2 = p2 * s * gval;
}
__device__ __forceinline__ void route_rows(const Args& a, LAS unsigned char* lds, int wave, int layer, int gw, int NGW, int lane) {
    float* H = (float*)(a.ws + WS_H); bf16_t* XN = (bf16_t*)((unsigned char*)a.out + DO_XN); const bf16_t* Y2 = (const bf16_t*)(a.ws + WS_PROJ);
    const bf16_t* rth = (const bf16_t*)(a.ws + WS_W + W_RT); const bf16_t* rtl = rth + 48 * D; const float* gf = a.in[I_FFNN] + layer * D;
    const float* bg = a.in[I_MBG] + layer * 4; const float* be = a.in[I_MBE] + layer * 32;
    unsigned* cnt = (unsigned*)(a.ws + WS_CTL) + CW_CNT + layer * 2048;
    int* ltok = (int*)((unsigned char*)a.out + DO_LTOK) + (size_t)layer * NEXP * LCAP; float* lw = (float*)((unsigned char*)a.out + DO_LW) + (size_t)layer * NEXP * LCAP;
    float* lrs = (float*)((unsigned char*)a.out + DO_LRS) + (size_t)layer * NEXP * LCAP;
    const int g = lane >> 4, l15 = lane & 15;
    LAS float* lgs = (LAS float*)lds;
    const int G = NGW >> 3, bid = gw >> 3;
    for (int r = gw; r < MP; r += NGW) { const int grp = r >> 4; const bool skip = grp < 3 || (grp >= 516 && grp < 519) || grp >= 1032;
        if (skip) zero_row_bf16(XN + (size_t)r * D, lane); }
    for (int round = 0; round * G < 1026; ++round) {
        const int t = round * G + bid; const bool act = t < 1026; const int task = t < 513 ? 3 + t : 519 + (t - 513);
        f32x4 acc[3]; acc[0] = acc[1] = acc[2] = (f32x4){0.f, 0.f, 0.f, 0.f};
        float ss = 0.f;
        if (act) {
            const int row = task * 16 + l15; const int k0 = 512 * wave;
            bf16_t* xp = XN + (size_t)row * D + 8 * g + k0; const float* gp = gf + 8 * g + k0;
            const bf16_t* bh = rth + (size_t)l15 * D + 8 * g + k0; const bf16_t* bl = rtl + (size_t)l15 * D + 8 * g + k0;
            LAS unsigned char* hb = lds + 32768 + wave * 8704;
            float* hsrc = H + (size_t)(task * 16 + (lane >> 5)) * D + k0 + (lane & 31) * 4; const bool fromx = layer == 0 && task < 1024;
            const bf16_t* ysrc = Y2 + (size_t)(task * 16 + (lane >> 5)) * D + k0 + (lane & 31) * 4;
            const bool hb16 = layer == 1 && task < 1024;
            const bf16_t* hbsrc = (const bf16_t*)H + (size_t)(task * 16 + (lane >> 5)) * D + k0 + (lane & 31) * 4;
            const bool addy = task < 1024;
            f32x4 R[8]; u32x2 Yv[8], Hv[8];
#define RT_LOAD(stg) do { _Pragma("unroll") for (int i = 0; i < 8; ++i) { const float* hs = hsrc + (size_t)(2 * i) * D; \
                if (fromx) { const int r = task * 16 + 2 * i + (lane >> 5), b = r >= TP ? 1 : 0, p = r - b * TP; hs = (p < 64 ? a.in[I_META] + (size_t)(p - PADF) * D : a.in[I_X] + ((size_t)b * SEQ + (p - 64)) * D) + k0 + (lane & 31) * 4; } \
                if (hb16) Hv[i] = *(const u32x2*)(hbsrc + (size_t)(2 * i) * D + 128 * (stg));        \
                else R[i] = __builtin_nontemporal_load((const f32x4*)(hs + 128 * (stg)));        \
                Yv[i] = addy ? *(const u32x2*)(ysrc + (size_t)(2 * i) * D + 128 * (stg)) : (u32x2){0u, 0u}; } } while (0)
#define RT_SUM(stg) do { if (hb16) { _Pragma("unroll") for (int i = 0; i < 8; ++i) R[i] = (f32x4){__uint_as_float(Hv[i].x << 16), __uint_as_float(Hv[i].x & 0xffff0000u), __uint_as_float(Hv[i].y << 16), __uint_as_float(Hv[i].y & 0xffff0000u)}; } \
            if (addy) { _Pragma("unroll") for (int i = 0; i < 8; ++i) { R[i][0] += __uint_as_float(Yv[i].x << 16); R[i][1] += __uint_as_float(Yv[i].x & 0xffff0000u); R[i][2] += __uint_as_float(Yv[i].y << 16); R[i][3] += __uint_as_float(Yv[i].y & 0xffff0000u); \
                } } } while (0)
            RT_LOAD(0);
#pragma unroll 1
            for (int st = 0; st < 4; ++st) {
                RT_SUM(st);
#pragma unroll
                for (int i = 0; i < 8; ++i) *(LAS f32x4*)(hb + (2 * i + (lane >> 5)) * 544 + (lane & 31) * 16) = R[i];
                LDS_WAIT();
                if (st + 1 < 4) RT_LOAD(st + 1);
#pragma unroll
                for (int kk = 0; kk < 4; ++kk) { const int ks = 4 * st + kk;
                    const f32x4 h0 = *(const LAS f32x4*)(hb + l15 * 544 + (32 * kk + 8 * g) * 4), h1 = *(const LAS f32x4*)(hb + l15 * 544 + (32 * kk + 8 * g + 4) * 4);
                    const f32x4 g0 = *(const f32x4*)(gp + 32 * ks), g1 = *(const f32x4*)(gp + 32 * ks + 4);
                    ss += (h0[0] * h0[0] + h0[1] * h0[1]) + (h0[2] * h0[2] + h0[3] * h0[3]) + (h1[0] * h1[0] + h1[1] * h1[1]) + (h1[2] * h1[2] + h1[3] * h1[3]);
                    u32x4 xo; xo.x = cvt_pk_bf16(h0[0] * g0[0], h0[1] * g0[1]); xo.y = cvt_pk_bf16(h0[2] * g0[2], h0[3] * g0[3]); xo.z = cvt_pk_bf16(h1[0] * g1[0], h1[1] * g1[1]); xo.w = cvt_pk_bf16(h1[2] * g1[2], h1[3] * g1[3]);
                    *(u32x4*)(xp + 32 * ks) = xo;
                    u32x4 hi; hi.x = cvt_pk_bf16(h0[0], h0[1]); hi.y = cvt_pk_bf16(h0[2], h0[3]); hi.z = cvt_pk_bf16(h1[0], h1[1]); hi.w = cvt_pk_bf16(h1[2], h1[3]);
                    u32x4 lo; lo.x = cvt_pk_bf16(h0[0] - __uint_as_float(hi.x << 16), h0[1] - __uint_as_float(hi.x & 0xffff0000u)); lo.y = cvt_pk_bf16(h0[2] - __uint_as_float(hi.y << 16), h0[3] - __uint_as_float(hi.y & 0xffff0000u));
                    lo.z = cvt_pk_bf16(h1[0] - __uint_as_float(hi.z << 16), h1[1] - __uint_as_float(hi.z & 0xffff0000u)); lo.w = cvt_pk_bf16(h1[2] - __uint_as_float(hi.w << 16), h1[3] - __uint_as_float(hi.w & 0xffff0000u));
                    const bf16x8 ahi = __builtin_bit_cast(bf16x8, hi), alo = __builtin_bit_cast(bf16x8, lo);
#pragma unroll
                    for (int nt = 0; nt < 3; ++nt) { const bf16x8 wh = *(const bf16x8*)(bh + (size_t)nt * 16 * D + 32 * ks), wl = *(const bf16x8*)(bl + (size_t)nt * 16 * D + 32 * ks);
                        acc[nt] = MFMA16(ahi, wh, acc[nt]); acc[nt] = MFMA16(ahi, wl, acc[nt]); acc[nt] = MFMA16(alo, wh, acc[nt]); }
                }
                LDS_WAIT();
            }
#undef RT_LOAD
#undef RT_SUM
            if (wave) { LAS float* pw = lgs + 1024 + (wave - 1) * 832;
#pragma unroll
                for (int nt = 0; nt < 3; ++nt)
#pragma unroll
                    for (int rr = 0; rr < 4; ++rr) pw[(nt * 4 + rr) * 64 + lane] = acc[nt][rr];
                pw[12 * 64 + lane] = ss; }
        }
        __syncthreads();
        if (act && wave == 0) {
#pragma unroll 1
            for (int w = 0; w < 7; ++w) { const LAS float* pw = lgs + 1024 + w * 832;
#pragma unroll
                for (int nt = 0; nt < 3; ++nt)
#pragma unroll
                    for (int rr = 0; rr < 4; ++rr) acc[nt][rr] += pw[(nt * 4 + rr) * 64 + lane];
                ss += pw[12 * 64 + lane]; }
            ss += __shfl_xor(ss, 16); ss += __shfl_xor(ss, 32);
            const float rstd = rsqrtf(ss * (1.0f / D) + EPS);
            if (g == 0) lgs[800 + l15] = rstd;
#pragma unroll
            for (int nt = 0; nt < 3; ++nt)
#pragma unroll
                for (int rr = 0; rr < 4; ++rr) lgs[(4 * g + rr) * 49 + 16 * nt + l15] = acc[nt][rr];
            LDS_WAIT();
            if (lane < 16) { const int r = task * 16 + lane;
                if (row_valid(r)) { const float rs = lgs[800 + lane]; float lg[36];
#pragma unroll
                    for (int j = 0; j < 36; ++j) lg[j] = lgs[lane * 49 + j] * rs;
                    int e1, e2; float w1, w2; route_one(lg, bg, be, e1, e2, w1, w2);
                    const unsigned p1 = atomicAdd(&cnt[64 * e1], 1u); const unsigned p2 = atomicAdd(&cnt[64 * e2], 1u);
                    ltok[(size_t)e1 * LCAP + p1] = r * 2; lw[(size_t)e1 * LCAP + p1] = w1; lrs[(size_t)e1 * LCAP + p1] = rs;
                    ltok[(size_t)e2 * LCAP + p2] = r * 2 + 1; lw[(size_t)e2 * LCAP + p2] = w2; lrs[(size_t)e2 * LCAP + p2] = rs; } }
        }
        __syncthreads();
    }
}
__device__ __forceinline__ void build_tab(LAS int* tab, const unsigned* cnt) {
    if (threadIdx.x < 64) { const int lane = threadIdx.x;
        const int c = lane < NEXP ? (int)__hip_atomic_load(cnt + 64 * lane, __ATOMIC_RELAXED, __HIP_MEMORY_SCOPE_AGENT) : 0; const int nt = (c + 255) >> 8;
        int incl = nt;
#pragma unroll
        for (int o = 1; o < 32; o <<= 1) { const int t = __shfl_up(incl, o); if (lane >= o) incl += t; }
        const int start = incl - nt;
        if (lane < NEXP) { tab[1 + lane] = start; tab[256 + lane] = c; for (int k = 0; k < nt; ++k) tab[64 + start + k] = lane; }
        if (lane == NEXP - 1) tab[0] = incl; }
    __syncthreads();
}

template <int MODE>
__device__ __forceinline__ void dwconv_segments(const bf16_t* src, int sld, bf16_t* dst, int dld, const float* w, int wld, const float* bias, int nchunk, int gw, int NGW, int lane) {
    const int SEG = (MP * nchunk + NGW - 1) / NGW, nseg = (MP + SEG - 1) / SEG;
    for (int task = gw; task < nseg * nchunk; task += NGW) {
        const int chunk = task % nchunk, r0 = (task / nchunk) * SEG, c = chunk * 512 + lane * 8;
        float wt[4][8], bs[8];
#pragma unroll
        for (int t = 0; t < 4; ++t) { const f32x4 w0 = *(const f32x4*)(w + t * wld + c), w1 = *(const f32x4*)(w + t * wld + c + 4);
            wt[t][0] = w0[0]; wt[t][1] = w0[1]; wt[t][2] = w0[2]; wt[t][3] = w0[3]; wt[t][4] = w1[0]; wt[t][5] = w1[1]; wt[t][6] = w1[2]; wt[t][7] = w1[3]; }
#pragma unroll
        for (int j = 0; j < 8; ++j) bs[j] = MODE == 1 ? bias[c + j] : 0.f;
        const float sc = (MODE == 0 && c >= 1024) ? 0.0625f : 1.0f;
        const u32x4 z = (u32x4){0u, 0u, 0u, 0u};
        u32x4 x0 = r0 >= 2 ? __builtin_nontemporal_load((const u32x4*)(src + (size_t)(r0 - 2) * sld + c)) : z, x1 = r0 >= 1 ? __builtin_nontemporal_load((const u32x4*)(src + (size_t)(r0 - 1) * sld + c)) : z, x2 = __builtin_nontemporal_load((const u32x4*)(src + (size_t)r0 * sld + c));
#pragma unroll 4
        for (int i = 0; i < SEG && r0 + i < MP; ++i) { const int r = r0 + i;
            const u32x4 x3 = r + 1 < MP ? __builtin_nontemporal_load((const u32x4*)(src + (size_t)(r + 1) * sld + c)) : z;
            u32x4 o = z;
            if (row_valid(r)) { float acc[8];
#pragma unroll
                for (int j = 0; j < 8; ++j) acc[j] = bs[j];
                const u32x4 xs[4] = {x0, x1, x2, x3};
#pragma unroll
                for (int t = 0; t < 4; ++t) { acc[0] += __uint_as_float(xs[t].x << 16) * wt[t][0]; acc[1] += __uint_as_float(xs[t].x & 0xffff0000u) * wt[t][1]; acc[2] += __uint_as_float(xs[t].y << 16) * wt[t][2]; acc[3] += __uint_as_float(xs[t].y & 0xffff0000u) * wt[t][3];
                    acc[4] += __uint_as_float(xs[t].z << 16) * wt[t][4]; acc[5] += __uint_as_float(xs[t].z & 0xffff0000u) * wt[t][5]; acc[6] += __uint_as_float(xs[t].w << 16) * wt[t][6]; acc[7] += __uint_as_float(xs[t].w & 0xffff0000u) * wt[t][7]; }
                if (MODE == 0) {
#pragma unroll
                    for (int j = 0; j < 8; ++j) acc[j] = siluf_(acc[j]) * sc; }
                o.x = cvt_pk_bf16(acc[0], acc[1]); o.y = cvt_pk_bf16(acc[2], acc[3]); o.z = cvt_pk_bf16(acc[4], acc[5]); o.w = cvt_pk_bf16(acc[6], acc[7]); }
            *(u32x4*)(dst + (size_t)r * dld + c) = o;
            x0 = x1; x1 = x2; x2 = x3; }
    }
}
__device__ __forceinline__ void qkconv_rows(const Args& a, int gw, int NGW, int lane) {
    const bf16_t* P = (const bf16_t*)(a.ws + WS_PROJ); bf16_t* Q = (bf16_t*)((unsigned char*)a.out + DO_QKC); const float* cw = a.in[I_EVQKC];
    for (int r = gw; r < MP; r += NGW) {
        if (!row_valid(r)) {
#pragma unroll
            for (int k = 0; k < 4; ++k) *(u32x4*)(Q + (size_t)r * 2048 + k * 512 + lane * 8) = (u32x4){0u, 0u, 0u, 0u};
            continue; }
#pragma unroll
        for (int k = 0; k < 4; ++k) { const int c = k * 512 + lane * 8; float acc[8];
#pragma unroll
            for (int j = 0; j < 8; ++j) acc[j] = 0.f;
#pragma unroll
            for (int t = 0; t < 4; ++t) { const int rr = r + t - 2; const u32x4 raw = *(const u32x4*)(P + (size_t)rr * NPROJ0 + c);
                const f32x4 w0 = *(const f32x4*)(cw + t * 2048 + c), w1 = *(const f32x4*)(cw + t * 2048 + c + 4);
                acc[0] += __uint_as_float(raw.x << 16) * w0[0]; acc[1] += __uint_as_float(raw.x & 0xffff0000u) * w0[1]; acc[2] += __uint_as_float(raw.y << 16) * w0[2]; acc[3] += __uint_as_float(raw.y & 0xffff0000u) * w0[3];
                acc[4] += __uint_as_float(raw.z << 16) * w1[0]; acc[5] += __uint_as_float(raw.z & 0xffff0000u) * w1[1]; acc[6] += __uint_as_float(raw.w << 16) * w1[2]; acc[7] += __uint_as_float(raw.w & 0xffff0000u) * w1[3]; }
            const float sc = c >= 1024 ? 0.0625f : 1.0f;
#pragma unroll
            for (int j = 0; j < 8; ++j) acc[j] = siluf_(acc[j]) * sc;
            u32x4 o; o.x = cvt_pk_bf16(acc[0], acc[1]); o.y = cvt_pk_bf16(acc[2], acc[3]); o.z = cvt_pk_bf16(acc[4], acc[5]); o.w = cvt_pk_bf16(acc[6], acc[7]);
            *(u32x4*)(Q + (size_t)r * 2048 + c) = o; }
    }
}
__device__ __forceinline__ void gla_pre_units(const Args& a, LAS unsigned char* lds, int bid, int nblk) {
    const bf16_t* P = (const bf16_t*)(a.ws + WS_PROJ); const float* SM = (const float*)((unsigned char*)a.out + DO_SMALL);
    LAS unsigned short* tq = (LAS unsigned short*)lds; LAS unsigned short* tk = (LAS unsigned short*)(lds + 32768); LAS unsigned short* tk2 = (LAS unsigned short*)(lds + 65536);
    LAS float* lrbs = (LAS float*)(lds + 98304); LAS float* toth = (LAS float*)(lds + 98304 + 4096);
    const int tid = threadIdx.x, c = tid & 255, half = tid >> 8;
    for (int u = bid < 0 ? NBATCH * NCH * 8 : bid; u < NBATCH * NCH * 8; u += nblk) {
        const int dir = u & 1, hd = (u >> 1) & 3, n = (u >> 3) % NCH, b = (u >> 3) / NCH;
        bf16_t* GQ = (bf16_t*)(a.ws + WS_G + (size_t)dir * G_STRIDE); bf16_t* GK1 = (bf16_t*)(a.ws + WS_G + (size_t)(2 + dir) * G_STRIDE); bf16_t* GK2 = (bf16_t*)(a.ws + WS_G + (size_t)(4 + dir) * G_STRIDE);
        float* ET = (float*)(a.ws + WS_G + G_ETOT);
#pragma unroll
        for (int k = 0; k < 4; ++k) { const int id = tid + 512 * k, i = id >> 5, c8 = id & 31; const int pp = 64 * n + i, p = dir ? (TP - 1 - pp) : pp; const size_t r = (size_t)(b * TP + p);
            *(LAS u32x4*)(lds + i * 512 + c8 * 16) = __builtin_nontemporal_load((const u32x4*)(P + r * NPROJ0 + 6144 + hd * 256 + c8 * 8));
            *(LAS u32x4*)(lds + 32768 + i * 512 + c8 * 16) = __builtin_nontemporal_load((const u32x4*)(P + r * NPROJ0 + 7168 + hd * 256 + c8 * 8)); }
        if (tid < 256) { const int i = tid >> 2, q4 = tid & 3; const int pp = 64 * n + i, p = dir ? (TP - 1 - pp) : pp;
            *(LAS f32x4*)(lrbs + i * 16 + q4 * 4) = *(const f32x4*)(SM + (size_t)(b * TP + p) * 64 + 16 + dir * 16 + q4 * 4); }
        float up[16];
#pragma unroll
        for (int rr = 0; rr < 16; ++rr) up[rr] = a.in[I_EVLRUP][(size_t)(dir * 16 + rr) * 1024 + hd * 256 + c];
        const float bias = a.in[I_EVLRB][dir * 1024 + hd * 256 + c];
        __syncthreads();
        float cumv[32]; float run = 0.f;
#pragma unroll
        for (int ii = 0; ii < 32; ++ii) { const int i = half * 32 + ii; const int pp = 64 * n + i, p = dir ? (TP - 1 - pp) : pp;
            float x = bias;
#pragma unroll
            for (int q4 = 0; q4 < 4; ++q4) { const f32x4 l = *(const LAS f32x4*)(lrbs + i * 16 + q4 * 4); x += l[0] * up[q4 * 4] + l[1] * up[q4 * 4 + 1] + l[2] * up[q4 * 4 + 2] + l[3] * up[q4 * 4 + 3]; }
            const float la = p < PADF ? 0.f : logsigf_(x) * 0.0625f; run += la; cumv[ii] = run; }
        toth[half * 256 + c] = run;
        __syncthreads();
        const float off = half ? toth[c] : 0.f, tot = toth[c] + toth[256 + c];
#pragma unroll
        for (int ii = 0; ii < 32; ++ii) { const int i = half * 32 + ii; const float cum = cumv[ii] + off;
            const float q = bf2f(tq[i * 256 + c]), k = bf2f(tk[i * 256 + c]);
            tq[i * 256 + c] = f2bf(q * 0.0625f * __expf(cum)); tk[i * 256 + c] = f2bf(k * __expf(-cum)); tk2[i * 256 + c] = f2bf(k * __expf(tot - cum)); }
        if (half == 0) ET[((size_t)((dir * 2 + b) * NCH + n)) * 1024 + hd * 256 + c] = __expf(tot);
        __syncthreads();
#if SCAN0_PRE
        {
            const int wv = tid >> 6, ln = tid & 63, g = ln >> 4, l15 = ln & 15, mt = wv >> 1, np = wv & 1;
            f32x4 sa[2]; sa[0] = sa[1] = (f32x4){0.f, 0.f, 0.f, 0.f};
#pragma unroll
            for (int ks = 0; ks < 8; ++ks) { const bf16x8 qf = *(const LAS bf16x8*)(lds + (16 * mt + l15) * 512 + (32 * ks + 8 * g) * 2);
#pragma unroll
                for (int j = 0; j < 2; ++j) { const bf16x8 kf = *(const LAS bf16x8*)(lds + 32768 + (16 * (2 * np + j) + l15) * 512 + (32 * ks + 8 * g) * 2); sa[j] = MFMA16(qf, kf, sa[j]); } }
            bf16_t* sp = (bf16_t*)(a.ws + SP_OFF) + ((size_t)(16 + (b * 4 + hd) * 2 + dir) * NCH + n) * 4096;
#pragma unroll
            for (int j = 0; j < 2; ++j) { const int s = 16 * (2 * np + j) + l15;
#pragma unroll
                for (int rr = 0; rr < 4; ++rr) { const int t = 16 * mt + 4 * g + rr; sp[t * 64 + s] = f2bf(s <= t ? sa[j][rr] : 0.f); } } }
#endif
#pragma unroll
        for (int k = 0; k < 4; ++k) { const int id = tid + 512 * k, i = id >> 5, c8 = id & 31; const int pp = 64 * n + i, p = dir ? (TP - 1 - pp) : pp; const size_t r = (size_t)(b * TP + p);
            *(u32x4*)(GQ + r * 1024 + hd * 256 + c8 * 8) = *(const LAS u32x4*)(lds + i * 512 + c8 * 16);
#if !SCAN0_PRE
            *(u32x4*)(GK1 + r * 1024 + hd * 256 + c8 * 8) = *(const LAS u32x4*)(lds + 32768 + i * 512 + c8 * 16);
#endif
            *(u32x4*)(GK2 + r * 1024 + hd * 256 + c8 * 8) = *(const LAS u32x4*)(lds + 65536 + i * 512 + c8 * 16); }
        __syncthreads();
    }
}
__device__ __forceinline__ void headnorm_rows(const Args& a, int gw, int NGW, int lane) {
    bf16_t* HF = (bf16_t*)(a.ws + WS_HS); bf16_t* HO = (a.flags & 8) ? (bf16_t*)(a.ws + WS_G) : HF; const bf16_t* HB = (const bf16_t*)(a.ws + WS_HS + HS_STRIDE0); const bf16_t* P = (const bf16_t*)(a.ws + WS_PROJ);
    for (int r = gw; r < MP; r += NGW) {
        if (!row_valid(r)) { zero_row_bf16(HO + (size_t)r * D, lane); continue; }
#pragma unroll
        for (int hg = 0; hg < 8; ++hg) { const int col = hg * 512 + lane * 8;
            const u32x4 f = __builtin_nontemporal_load((const u32x4*)(HF + (size_t)r * D + col)), bb = __builtin_nontemporal_load((const u32x4*)(HB + (size_t)r * D + col));
            const u32x4 gt = __builtin_nontemporal_load((const u32x4*)(P + (size_t)r * NPROJ0 + (hg < 4 ? 4096 + col : 10240 + (col - 2048))));
            const float* nw = hg < 4 ? a.in[I_EVNA] + col : a.in[I_EVNB] + (col - 2048);
            float s[8], gv[8];
            const unsigned fw[4] = {f.x, f.y, f.z, f.w}, bw[4] = {bb.x, bb.y, bb.z, bb.w}, gw4[4] = {gt.x, gt.y, gt.z, gt.w};
#pragma unroll
            for (int j = 0; j < 4; ++j) { s[2 * j] = __uint_as_float(fw[j] << 16) + __uint_as_float(bw[j] << 16); s[2 * j + 1] = __uint_as_float(fw[j] & 0xffff0000u) + __uint_as_float(bw[j] & 0xffff0000u);
                gv[2 * j] = __uint_as_float(gw4[j] << 16); gv[2 * j + 1] = __uint_as_float(gw4[j] & 0xffff0000u); }
            float ss = 0.f;
#pragma unroll
            for (int j = 0; j < 8; ++j) ss += s[j] * s[j];
            const float rstd = rsqrtf(wave_sum(ss) * (1.0f / 512.0f) + EPS);
            const f32x4 n0 = *(const f32x4*)nw, n1 = *(const f32x4*)(nw + 4); const float nn[8] = {n0[0], n0[1], n0[2], n0[3], n1[0], n1[1], n1[2], n1[3]};
            float o[8];
#pragma unroll
            for (int j = 0; j < 8; ++j) { const float gate = hg < 4 ? sigmoidf_(gv[j]) : siluf_(gv[j]); o[j] = gate * s[j] * rstd * nn[j]; }
            u32x4 w; w.x = cvt_pk_bf16(o[0], o[1]); w.y = cvt_pk_bf16(o[2], o[3]); w.z = cvt_pk_bf16(o[4], o[5]); w.w = cvt_pk_bf16(o[6], o[7]);
            *(u32x4*)(HO + (size_t)r * D + col) = w; }
    }
}
__device__ __forceinline__ void uconv_rows(const Args& a, int gw, int NGW, int lane) {
    const bf16_t* P = (const bf16_t*)(a.ws + WS_PROJ); bf16_t* U = (bf16_t*)(a.ws + WS_G); const float* cw = a.in[I_ODCONV]; const float* cb = a.in[I_ODCONVB];
    for (int r = gw; r < MP; r += NGW) {
        const bool v = row_valid(r);
#pragma unroll
        for (int k = 0; k < 10; ++k) { const int c = k * 512 + lane * 8;
            if (!v) { *(u32x4*)(U + (size_t)r * DR + c) = (u32x4){0u, 0u, 0u, 0u}; continue; }
            const f32x4 b0 = *(const f32x4*)(cb + c), b1 = *(const f32x4*)(cb + c + 4);
            float acc[8] = {b0[0], b0[1], b0[2], b0[3], b1[0], b1[1], b1[2], b1[3]};
#pragma unroll
            for (int t = 0; t < 4; ++t) { const int rr = r + t - 2; const u32x4 raw = *(const u32x4*)(P + (size_t)rr * NPROJ1 + DR + c);
                const f32x4 w0 = *(const f32x4*)(cw + t * DR + c), w1 = *(const f32x4*)(cw + t * DR + c + 4);
                acc[0] += __uint_as_float(raw.x << 16) * w0[0]; acc[1] += __uint_as_float(raw.x & 0xffff0000u) * w0[1]; acc[2] += __uint_as_float(raw.y << 16) * w0[2]; acc[3] += __uint_as_float(raw.y & 0xffff0000u) * w0[3];
                acc[4] += __uint_as_float(raw.z << 16) * w1[0]; acc[5] += __uint_as_float(raw.z & 0xffff0000u) * w1[1]; acc[6] += __uint_as_float(raw.w << 16) * w1[2]; acc[7] += __uint_as_float(raw.w & 0xffff0000u) * w1[3]; }
            u32x4 o; o.x = cvt_pk_bf16(acc[0], acc[1]); o.y = cvt_pk_bf16(acc[2], acc[3]); o.z = cvt_pk_bf16(acc[4], acc[5]); o.w = cvt_pk_bf16(acc[6], acc[7]);
            *(u32x4*)(U + (size_t)r * DR + c) = o; }
    }
}
__device__ __forceinline__ void rglru_combine_rows(const Args& a, int gw, int NGW, int lane) {
    bf16_t* HF = (bf16_t*)(a.ws + WS_HS); bf16_t* HO = (a.flags & 8) ? (bf16_t*)(a.ws + WS_G) : HF; const bf16_t* HB = (const bf16_t*)(a.ws + WS_HS + HS_STRIDE1); const bf16_t* P = (const bf16_t*)(a.ws + WS_PROJ);
    for (int r = gw; r < MP; r += NGW) {
        const bool v = row_valid(r);
#pragma unroll
        for (int k = 0; k < 10; ++k) { const int c = k * 512 + lane * 8;
            if (!v) { *(u32x4*)(HO + (size_t)r * DR + c) = (u32x4){0u, 0u, 0u, 0u}; continue; }
            const u32x4 f = __builtin_nontemporal_load((const u32x4*)(HF + (size_t)r * DR + c)), bb = __builtin_nontemporal_load((const u32x4*)(HB + (size_t)r * DR + c)), gt = __builtin_nontemporal_load((const u32x4*)(P + (size_t)r * NPROJ1 + c));
            const unsigned fw[4] = {f.x, f.y, f.z, f.w}, bw[4] = {bb.x, bb.y, bb.z, bb.w}, gw4[4] = {gt.x, gt.y, gt.z, gt.w};
            float o[8];
#pragma unroll
            for (int j = 0; j < 4; ++j) { o[2 * j] = gelu_tanhf_(__uint_as_float(gw4[j] << 16)) * (__uint_as_float(fw[j] << 16) + __uint_as_float(bw[j] << 16));
                o[2 * j + 1] = gelu_tanhf_(__uint_as_float(gw4[j] & 0xffff0000u)) * (__uint_as_float(fw[j] & 0xffff0000u) + __uint_as_float(bw[j] & 0xffff0000u)); }
            u32x4 w; w.x = cvt_pk_bf16(o[0], o[1]); w.y = cvt_pk_bf16(o[2], o[3]); w.z = cvt_pk_bf16(o[4], o[5]); w.w = cvt_pk_bf16(o[6], o[7]);
            *(u32x4*)(HO + (size_t)r * DR + c) = w; }
    }
}

__device__ __forceinline__ void tail_reduce(const Args& a, LAS unsigned char* lds, int bid, int G, unsigned* tickets) {
    const int base = ((1024 + G - 1) / G) * G; const int L0 = bid + ((base - bid + G - 1) / G) * G - base;
    asm volatile("s_waitcnt vmcnt(0)" ::: "memory");
    __syncthreads();
    if (threadIdx.x == 0) {
        __builtin_amdgcn_fence(__ATOMIC_RELEASE, "agent");
        asm volatile("s_waitcnt vmcnt(0)" ::: "memory");
        for (int L = L0; L < 16 * pg8::KSPLIT; L += G) __hip_atomic_fetch_add(tickets + 64 * (L / pg8::KSPLIT), 1u, __ATOMIC_RELAXED, __HIP_MEMORY_SCOPE_AGENT);
    }
    for (int L = L0; L < 16 * pg8::KSPLIT; L += G) {
        const int ct = L / pg8::KSPLIT, kq = L % pg8::KSPLIT;
        if (threadIdx.x == 0) { while (__hip_atomic_load(tickets + 64 * ct, __ATOMIC_RELAXED, __HIP_MEMORY_SCOPE_AGENT) < (unsigned)pg8::KSPLIT) __builtin_amdgcn_s_sleep(2);
            __builtin_amdgcn_fence(__ATOMIC_ACQUIRE, "agent"); asm volatile("s_waitcnt vmcnt(0)" ::: "memory"); }
        __syncthreads();
        float* H = (float*)(a.ws + WS_H); const float* PART = (const float*)((unsigned char*)a.out + DO_PART);
        for (int i = threadIdx.x; i < 16 * 64; i += 512) { const int r = kq * 16 + (i >> 6), c4 = (i & 63) * 4 + ct * 256;
            f32x4 h = *(const f32x4*)(H + (size_t)(16384 + r) * D + c4); f32x4 p[pg8::KSPLIT];
#pragma unroll
            for (int s = 0; s < pg8::KSPLIT; ++s) p[s] = *(const f32x4*)(PART + ((size_t)(s * 256 + r)) * D + c4);
#pragma unroll
            for (int s = 0; s < pg8::KSPLIT; ++s) h = h + p[s];
            *(f32x4*)(H + (size_t)(16384 + r) * D + c4) = h; }
    }
}

constexpr int S0_K1 = 0, S0_K2 = 34816, S0_V = 69632, S0_VW = 80896, S0_SS = 92160, S0_CT = 102400, S0_ET = 145920, S0_GV = 146944;
constexpr int KPB = 544  , VPB = 176  , SPB = 160  ;
template <int OFF> __device__ __forceinline__ void tr_frags2(const unsigned (&ad)[2], bf16x8 (&fr)[2]) {
    s16x4 x0, y0, x1, y1;
    asm volatile("ds_read_b64_tr_b16 %0, %4\n\tds_read_b64_tr_b16 %1, %4 offset:%6\n\tds_read_b64_tr_b16 %2, %5\n\tds_read_b64_tr_b16 %3, %5 offset:%6\n\ts_waitcnt lgkmcnt(0)"
                 : "=&v"(x0), "=&v"(y0), "=&v"(x1), "=&v"(y1) : "v"(ad[0]), "v"(ad[1]), "i"(OFF) : "memory");
    fr[0] = __builtin_shufflevector(x0, y0, 0, 1, 2, 3, 4, 5, 6, 7); fr[1] = __builtin_shufflevector(x1, y1, 0, 1, 2, 3, 4, 5, 6, 7);
}
template <int OFF> __device__ __forceinline__ void tr_frags3(const unsigned (&ad)[3], bf16x8 (&fr)[3]) {
    s16x4 x0, y0, x1, y1, x2, y2;
    asm volatile("ds_read_b64_tr_b16 %0, %6\n\tds_read_b64_tr_b16 %1, %6 offset:%9\n\tds_read_b64_tr_b16 %2, %7\n\tds_read_b64_tr_b16 %3, %7 offset:%9\n\tds_read_b64_tr_b16 %4, %8\n\tds_read_b64_tr_b16 %5, %8 offset:%9\n\ts_waitcnt lgkmcnt(0)"
                 : "=&v"(x0), "=&v"(y0), "=&v"(x1), "=&v"(y1), "=&v"(x2), "=&v"(y2) : "v"(ad[0]), "v"(ad[1]), "v"(ad[2]), "i"(OFF) : "memory");
    fr[0] = __builtin_shufflevector(x0, y0, 0, 1, 2, 3, 4, 5, 6, 7); fr[1] = __builtin_shufflevector(x1, y1, 0, 1, 2, 3, 4, 5, 6, 7); fr[2] = __builtin_shufflevector(x2, y2, 0, 1, 2, 3, 4, 5, 6, 7);
}

template <int CTRL, int ROWMASK> __device__ __forceinline__ float dpp_f(float old, float src) {
    return __int_as_float(__builtin_amdgcn_update_dpp(__float_as_int(old), __float_as_int(src), CTRL, ROWMASK, 0xf, false)); }
__device__ __forceinline__ float wave_scan_sum(float v) {
    v += dpp_f<0x111, 0xf>(0.f, v); v += dpp_f<0x112, 0xf>(0.f, v); v += dpp_f<0x114, 0xf>(0.f, v); v += dpp_f<0x118, 0xf>(0.f, v);
    v += dpp_f<0x142, 0xa>(0.f, v); v += dpp_f<0x143, 0xc>(0.f, v); return v; }
__device__ __forceinline__ float wave_scan_max(float v) {
    const float ID = -3.0e38f;
    v = fmaxf(v, dpp_f<0x111, 0xf>(ID, v)); v = fmaxf(v, dpp_f<0x112, 0xf>(ID, v)); v = fmaxf(v, dpp_f<0x114, 0xf>(ID, v)); v = fmaxf(v, dpp_f<0x118, 0xf>(ID, v));
    v = fmaxf(v, dpp_f<0x142, 0xa>(ID, v)); v = fmaxf(v, dpp_f<0x143, 0xc>(ID, v)); return v; }
template <int NV> __device__ __forceinline__ void tr_state_frags(unsigned ka0, unsigned ka1, unsigned va, bf16x8 (&af)[2], bf16x8 (&bv)[5]) {
    s16x4 x0, y0, x1, y1, p0, q0, p1, q1, p2, q2, p3, q3, p4, q4;
    if (NV == 5)
        asm volatile("ds_read_b64_tr_b16 %0, %14\n\tds_read_b64_tr_b16 %1, %14 offset:2176\n\tds_read_b64_tr_b16 %2, %15\n\tds_read_b64_tr_b16 %3, %15 offset:2176\n\t"
                     "ds_read_b64_tr_b16 %4, %16\n\tds_read_b64_tr_b16 %5, %16 offset:704\n\tds_read_b64_tr_b16 %6, %16 offset:32\n\tds_read_b64_tr_b16 %7, %16 offset:736\n\t"
                     "ds_read_b64_tr_b16 %8, %16 offset:64\n\tds_read_b64_tr_b16 %9, %16 offset:768\n\tds_read_b64_tr_b16 %10, %16 offset:96\n\tds_read_b64_tr_b16 %11, %16 offset:800\n\t"
                     "ds_read_b64_tr_b16 %12, %16 offset:128\n\tds_read_b64_tr_b16 %13, %16 offset:832\n\ts_waitcnt lgkmcnt(0)"
                     : "=&v"(x0), "=&v"(y0), "=&v"(x1), "=&v"(y1), "=&v"(p0), "=&v"(q0), "=&v"(p1), "=&v"(q1), "=&v"(p2), "=&v"(q2), "=&v"(p3), "=&v"(q3), "=&v"(p4), "=&v"(q4)
                     : "v"(ka0), "v"(ka1), "v"(va) : "memory");
    else {
        asm volatile("ds_read_b64_tr_b16 %0, %12\n\tds_read_b64_tr_b16 %1, %12 offset:2176\n\tds_read_b64_tr_b16 %2, %13\n\tds_read_b64_tr_b16 %3, %13 offset:2176\n\t"
                     "ds_read_b64_tr_b16 %4, %14\n\tds_read_b64_tr_b16 %5, %14 offset:704\n\tds_read_b64_tr_b16 %6, %14 offset:32\n\tds_read_b64_tr_b16 %7, %14 offset:736\n\t"
                     "ds_read_b64_tr_b16 %8, %14 offset:64\n\tds_read_b64_tr_b16 %9, %14 offset:768\n\tds_read_b64_tr_b16 %10, %14 offset:96\n\tds_read_b64_tr_b16 %11, %14 offset:800\n\ts_waitcnt lgkmcnt(0)"
                     : "=&v"(x0), "=&v"(y0), "=&v"(x1), "=&v"(y1), "=&v"(p0), "=&v"(q0), "=&v"(p1), "=&v"(q1), "=&v"(p2), "=&v"(q2), "=&v"(p3), "=&v"(q3)
                     : "v"(ka0), "v"(ka1), "v"(va) : "memory");
        p4 = p3; q4 = q3; }
    af[0] = __builtin_shufflevector(x0, y0, 0, 1, 2, 3, 4, 5, 6, 7); af[1] = __builtin_shufflevector(x1, y1, 0, 1, 2, 3, 4, 5, 6, 7);
    bv[0] = __builtin_shufflevector(p0, q0, 0, 1, 2, 3, 4, 5, 6, 7); bv[1] = __builtin_shufflevector(p1, q1, 0, 1, 2, 3, 4, 5, 6, 7); bv[2] = __builtin_shufflevector(p2, q2, 0, 1, 2, 3, 4, 5, 6, 7);
    bv[3] = __builtin_shufflevector(p3, q3, 0, 1, 2, 3, 4, 5, 6, 7); bv[4] = __builtin_shufflevector(p4, q4, 0, 1, 2, 3, 4, 5, 6, 7);
}
static_assert(4 * KPB == 2176 && 4 * VPB == 704, "tr_state_frags hard-codes the row-group strides");

template <int KIND, int ABL>
__device__ __forceinline__ void scan0_unit(const Args& a, LAS unsigned char* lds, int b, int hd, int dir, int sl, size_t hs_off) {
    constexpr int NE = KIND == 0 ? 5 : 4;
    const int tid0 = threadIdx.x, w = __builtin_amdgcn_readfirstlane(tid0 >> 6);
    const int mt = w >> 1, np = w & 1;
    const bf16_t* P = (const bf16_t*)(a.ws + WS_PROJ);
    const bf16_t *Qg, *K1g, *K2g, *Vg; int pitchQ;
    if (KIND == 0) { const bf16_t* QK = (const bf16_t*)((unsigned char*)a.out + DO_QKC); Qg = QK + hd * 256; K1g = QK + 1024 + hd * 256; K2g = K1g; pitchQ = 2048; Vg = P + 2048 + hd * 512 + sl * 64; }
    else { Qg = (const bf16_t*)(a.ws + WS_G + (size_t)dir * G_STRIDE) + hd * 256; K1g = (const bf16_t*)(a.ws + WS_G + (size_t)(2 + dir) * G_STRIDE) + hd * 256; K2g = (const bf16_t*)(a.ws + WS_G + (size_t)(4 + dir) * G_STRIDE) + hd * 256; pitchQ = 1024; Vg = P + 8192 + hd * 512 + sl * 64; }
    const float* SM = (const float*)((unsigned char*)a.out + DO_SMALL);
    const float* ETg = (const float*)(a.ws + WS_G + G_ETOT) + ((size_t)((dir * 2 + b) * NCH)) * 1024 + hd * 256;
    bf16_t* Og = ABL ? (bf16_t*)((unsigned char*)a.out + DO_PART) + KIND * 2048 + hd * 512 + sl * 64 : (bf16_t*)(a.ws + hs_off + (size_t)dir * HS_STRIDE0) + KIND * 2048 + hd * 512 + sl * 64;
    const unsigned ldsb = (unsigned)(size_t)lds;
    f32x4 accC[2][NE];
#pragma unroll
    for (int mi = 0; mi < 2; ++mi)
#pragma unroll
        for (int ni = 0; ni < NE; ++ni) accC[mi][ni] = (f32x4){0.f, 0.f, 0.f, 0.f};
    for (int i = tid0; i < 80 * KPB / 4; i += 512) ((LAS unsigned*)(lds + S0_CT))[i] = 0u;
    float m_prev = 0.f;
    float gbi = 0.f, gbf = 0.f;
    if (KIND == 0) { gbi = a.in[I_EVGB][(dir ? 2 : 0) * 4 + hd]; gbf = a.in[I_EVGB][(dir ? 3 : 1) * 4 + hd]; }
    const int gci = (dir ? 2 : 0) * 4 + hd, gcf = (dir ? 3 : 1) * 4 + hd;
#define PROWN(nn, i) (dir ? (TP - 1 - (64 * (nn) + (i))) : (64 * (nn) + (i)))
    u32x4 pk1[4], pk2[4], pv; float pgi = 0.f, pgf = 0.f, pet = 0.f; bf16x8 Qf[8];
#define PREFETCH_KV(nn) do { const size_t crow = (size_t)(b * TP + (dir ? TP - 64 - 64 * (nn) : 64 * (nn))); \
        const char* kb1 = (const char*)K1g + crow * pitchQ * 2; const char* kb2 = (const char*)K2g + crow * pitchQ * 2; \
        _Pragma("unroll") for (int k = 0; k < 4; ++k) { pk1[k] = *(const u32x4*)(kb1 + voK[k]); if (KIND == 1) pk2[k] = *(const u32x4*)(kb2 + voK[k]); } \
        pv = *(const u32x4*)((const char*)Vg + crow * NPROJ0 * 2 + voV); \
        if (KIND == 0) { const char* gb = (const char*)SM + crow * 256; pgi = *(const float*)(gb + voG + gci * 4); pgf = *(const float*)(gb + voG + gcf * 4); } \
        if (KIND == 1 && tid < 256) pet = ETg[(size_t)(nn) * 1024 + tid]; \
    } while (0)
#define PREFETCH_Q(nn) do { const size_t crow = (size_t)(b * TP + (dir ? TP - 64 - 64 * (nn) : 64 * (nn))); const char* qb = (const char*)Qg + crow * pitchQ * 2; \
        _Pragma("unroll") for (int ks = 0; ks < 8; ++ks) Qf[ks] = *(const bf16x8*)(qb + voQ + 64 * ks); } while (0)
    __syncthreads();
    for (int n = 0; n < NCH; ++n) {
        int tidv = tid0; asm volatile("" : "+v"(tidv));
        const int tid = tidv, lane = tid & 63, g = lane >> 4, l15 = lane & 15, q4 = l15 >> 2, p4 = lane & 3;
    unsigned voK[4];
#pragma unroll
    for (int k = 0; k < 4; ++k) { const int id = tid + 512 * k, i = id >> 5, c8 = id & 31; voK[k] = (unsigned)((dir ? 63 - i : i) * pitchQ * 2 + c8 * 16); }
    const unsigned voV = (unsigned)((dir ? 63 - (tid >> 3) : (tid >> 3)) * NPROJ0 * 2 + (tid & 7) * 16);
    const unsigned voG = (unsigned)((dir ? 63 - lane : lane) * 256);
    const unsigned voQ = (unsigned)((dir ? 63 - (16 * mt + l15) : (16 * mt + l15)) * pitchQ * 2 + 16 * g);
        if (n == 0) { PREFETCH_KV(0); PREFETCH_Q(0); }
        LAS float* gv = (LAS float*)(lds + S0_GV + w * 1024);
        float Bt = 0.f, bvec = 0.f, winter = 0.f, floorv = 0.f, wsl = 0.f, decay = 1.f, B63 = 0.f, tot = 0.f;
        if (KIND == 0) { const int p = PROWN(n, lane);
            const bool pad = p < PADF; const float li = pad ? NEGV : pgi + gbi, lf = pad ? 0.f : logsigf_(pgf + gbf);
            const float cum = (ABL & 16) ? lf : wave_scan_sum(lf);
            bvec = li - cum; const float pm = (ABL & 16) ? bvec : wave_scan_max(bvec);
            Bt = fmaxf(m_prev, pm); winter = __expf(m_prev - Bt); floorv = __expf(-(cum + Bt));
            gv[lane] = Bt; gv[64 + lane] = bvec; gv[128 + lane] = winter; gv[192 + lane] = floorv;
            B63 = __shfl(Bt, 63); tot = __shfl(cum, 63); decay = __expf(m_prev - B63); wsl = __expf(bvec - B63); }
#pragma unroll
        for (int k = 0; k < 4; ++k) { const int id = tid + 512 * k, i = id >> 5, c8 = id & 31;
            *(LAS u32x4*)(lds + S0_K1 + i * KPB + c8 * 16) = pk1[k];
            if (KIND == 1) *(LAS u32x4*)(lds + S0_K2 + i * KPB + c8 * 16) = pk2[k]; }
        { const int i = tid >> 3, c8 = tid & 7;
            *(LAS u32x4*)(lds + S0_V + i * VPB + c8 * 16) = pv;
            if (KIND == 0) { const float s = __shfl(wsl, i);
                u32x4 o; o.x = cvt_pk_bf16(__uint_as_float(pv.x << 16) * s, __uint_as_float(pv.x & 0xffff0000u) * s); o.y = cvt_pk_bf16(__uint_as_float(pv.y << 16) * s, __uint_as_float(pv.y & 0xffff0000u) * s);
                o.z = cvt_pk_bf16(__uint_as_float(pv.z << 16) * s, __uint_as_float(pv.z & 0xffff0000u) * s); o.w = cvt_pk_bf16(__uint_as_float(pv.w << 16) * s, __uint_as_float(pv.w & 0xffff0000u) * s);
                *(LAS u32x4*)(lds + S0_VW + i * VPB + c8 * 16) = o;
                if (c8 < 2) { const float s1 = c8 == 0 ? 1.0f : 0.f;
                    *(LAS u32x4*)(lds + S0_V + i * VPB + 128 + c8 * 16) = (u32x4){cvt_pk_bf16(s1, 0.f), 0u, 0u, 0u};
                    *(LAS u32x4*)(lds + S0_VW + i * VPB + 128 + c8 * 16) = (u32x4){cvt_pk_bf16(s1 * s, 0.f), 0u, 0u, 0u}; } } }
        if (KIND == 1 && tid < 256) ((LAS float*)(lds + S0_ET))[tid] = pet;
        __syncthreads();
        { const int nn = n + 1 < NCH ? n + 1 : n; PREFETCH_KV(nn); }
        f32x4 sacc[2], oacc[3];
#pragma unroll
        for (int j = 0; j < 2; ++j) sacc[j] = (f32x4){0.f, 0.f, 0.f, 0.f};
#pragma unroll
        for (int j = 0; j < 3; ++j) oacc[j] = (f32x4){0.f, 0.f, 0.f, 0.f};
        if (!(ABL & 1))
#pragma unroll
        for (int ks = 0; ks < 8; ++ks) {
#pragma unroll
            for (int j = 0; j < 2; ++j) { const int nt = 2 * np + j;
                const bf16x8 kf = (ABL & 64) ? Qf[(ks + 1) & 7] : *(const LAS bf16x8*)(lds + S0_K1 + (16 * nt + l15) * KPB + (32 * ks + 8 * g) * 2);
                sacc[j] = MFMA16(Qf[ks], kf, sacc[j]);
                const bf16x8 cf = (ABL & 64) ? Qf[(ks + 2) & 7] : *(const LAS bf16x8*)(lds + S0_CT + (16 * nt + l15) * KPB + (32 * ks + 8 * g) * 2);
                oacc[j] = MFMA16(Qf[ks], cf, oacc[j]); }
            if (KIND == 0) { const bf16x8 cf = (ABL & 64) ? Qf[(ks + 3) & 7] : *(const LAS bf16x8*)(lds + S0_CT + (64 + l15) * KPB + (32 * ks + 8 * g) * 2); oacc[2] = MFMA16(Qf[ks], cf, oacc[2]); }
            }
        __builtin_amdgcn_sched_barrier(0);
        { const int nn = n + 1 < NCH ? n + 1 : n; PREFETCH_Q(nn); }
        __builtin_amdgcn_sched_barrier(0);
        if (!(ABL & 2))
#pragma unroll
        for (int j = 0; j < 2; ++j) { const int s = 16 * (2 * np + j) + l15; const float b_s = KIND == 0 ? gv[64 + s] : 0.f;
            f32x4 bt4 = (f32x4){0.f, 0.f, 0.f, 0.f}; if (KIND == 0) bt4 = *(const LAS f32x4*)(gv + 16 * mt + 4 * g);
#pragma unroll
            for (int rr = 0; rr < 4; ++rr) { const int t = 16 * mt + 4 * g + rr; float val;
                if (KIND == 0) val = s <= t ? sacc[j][rr] * __expf(b_s - bt4[rr]) : 0.f;
                else val = s <= t ? sacc[j][rr] : 0.f;
                *(LAS unsigned short*)(lds + S0_SS + t * SPB + s * 2) = f2bf(val); } }
        __syncthreads();
#pragma unroll
        for (int mi = 0; mi < 2; ++mi) {
            f32x4 sc;
            if (KIND == 0) sc = (f32x4){decay, decay, decay, decay};
            else sc = *(const LAS f32x4*)(lds + S0_ET + (16 * (2 * w + mi) + 4 * g) * 4);
#pragma unroll
            for (int ni = 0; ni < NE; ++ni) accC[mi][ni] = accC[mi][ni] * sc; }
        if (!(ABL & 4))
#pragma unroll
        for (int ks = 0; ks < 2; ++ks) {
            const unsigned rowb = (unsigned)(32 * ks + 8 * g + q4);
            bf16x8 af[2], bv[5];
            { const unsigned kb = ldsb + (KIND == 0 ? S0_K1 : S0_K2) + rowb * KPB + 8 * p4; const unsigned vb = ldsb + (KIND == 0 ? S0_VW : S0_V) + rowb * VPB + 8 * p4;
                tr_state_frags<NE>(kb + 32 * (2 * w), kb + 32 * (2 * w + 1), vb, af, bv); }
#pragma unroll
            for (int mi = 0; mi < 2; ++mi)
#pragma unroll
                for (int ni = 0; ni < NE; ++ni) accC[mi][ni] = MFMA16(af[mi], bv[ni], accC[mi][ni]); }
#pragma unroll
        for (int mi = 0; mi < 2; ++mi)
#pragma unroll
            for (int ni = 0; ni < NE; ++ni) { u32x2 o; o.x = cvt_pk_bf16(accC[mi][ni][0], accC[mi][ni][1]); o.y = cvt_pk_bf16(accC[mi][ni][2], accC[mi][ni][3]);
                *(LAS u32x2*)(lds + S0_CT + (16 * ni + l15) * KPB + (16 * (2 * w + mi) + 4 * g) * 2) = o; }
        if (KIND == 0) { const f32x4 wi4 = *(const LAS f32x4*)(gv + 128 + 16 * mt + 4 * g);
#pragma unroll
            for (int j = 0; j < 3; ++j) oacc[j] = oacc[j] * wi4; }
        if (!(ABL & 8))
#pragma unroll
        for (int ks = 0; ks < 2; ++ks) { const bf16x8 sf = *(const LAS bf16x8*)(lds + S0_SS + (16 * mt + l15) * SPB + (32 * ks + 8 * g) * 2);
            const unsigned vb = ldsb + S0_V + (unsigned)(32 * ks + 8 * g + q4) * VPB + 8 * p4;
            if (KIND == 0) { bf16x8 vf[3]; const unsigned ad[3] = {vb + 32 * (2 * np), vb + 32 * (2 * np + 1), vb + 128}; tr_frags3<4 * VPB>(ad, vf);
                oacc[0] = MFMA16(sf, vf[0], oacc[0]); oacc[1] = MFMA16(sf, vf[1], oacc[1]); oacc[2] = MFMA16(sf, vf[2], oacc[2]); }
            else { bf16x8 vf[2]; const unsigned ad[2] = {vb + 32 * (2 * np), vb + 32 * (2 * np + 1)}; tr_frags2<4 * VPB>(ad, vf);
                oacc[0] = MFMA16(sf, vf[0], oacc[0]); oacc[1] = MFMA16(sf, vf[1], oacc[1]); } }
#pragma unroll
        for (int rr = 0; rr < 4; ++rr) { const int t = 16 * mt + 4 * g + rr; const size_t r = ABL ? (size_t)((n & 15) * 64 + t) : (size_t)(b * TP + PROWN(n, t));
            float inv = 1.f;
            if (KIND == 0) { const float fl = gv[192 + t], den = __shfl(oacc[2][rr], g * 16); inv = __builtin_amdgcn_rcpf(fmaxf(fabsf(den), fl)); }
#pragma unroll
            for (int j = 0; j < 2; ++j) Og[r * D + 16 * (2 * np + j) + l15] = f2bf(oacc[j][rr] * inv); }
        if (KIND == 0) m_prev = tot + B63;
        __syncthreads();
    }
#undef PREFETCH_KV
#undef PREFETCH_Q
#undef PROWN
}


__device__ __forceinline__ void mlstm_gate_seq(const Args& a, int seq, int lane) {
    const int b = seq >> 3, hd = (seq >> 1) & 3, dir = seq & 1;
    const float* SM = (const float*)((unsigned char*)a.out + DO_SMALL); float* GVp = (float*)(a.ws + GV_OFF) + (size_t)seq * NCH * 384;
    const int gci = (dir ? 2 : 0) * 4 + hd, gcf = (dir ? 3 : 1) * 4 + hd; const float gbi = a.in[I_EVGB][gci], gbf = a.in[I_EVGB][gcf];
    float m_prev = 0.f;
    float pgi, pgf; { const int p = dir ? (TP - 1 - lane) : lane; const size_t r = (size_t)(b * TP + p); pgi = SM[r * 64 + gci]; pgf = SM[r * 64 + gcf]; }
    for (int n = 0; n < NCH; ++n) {
        const int p = dir ? (TP - 1 - (64 * n + lane)) : (64 * n + lane); const bool pad = p < PADF;
        const float li = pad ? NEGV : pgi + gbi, lf = pad ? 0.f : logsigf_(pgf + gbf);
        if (n + 1 < NCH) { const int p1 = dir ? (TP - 1 - (64 * (n + 1) + lane)) : (64 * (n + 1) + lane); const size_t r = (size_t)(b * TP + p1); pgi = SM[r * 64 + gci]; pgf = SM[r * 64 + gcf]; }
        const float cum = wave_scan_sum(lf); const float bvec = li - cum; const float pm = wave_scan_max(bvec);
        const float Bt = fmaxf(m_prev, pm), winter = __expf(m_prev - Bt), floorv = __expf(-(cum + Bt));
        const float B63 = __shfl(Bt, 63), tot = __shfl(cum, 63), decay = __expf(m_prev - B63), wsl = __expf(bvec - B63);
        float* o = GVp + (size_t)n * 384;
        o[lane] = winter; o[64 + lane] = floorv; o[128 + lane] = wsl; o[192 + lane] = decay; o[256 + lane] = Bt; o[320 + lane] = bvec;
        m_prev = tot + B63;
    }
}
__device__ __forceinline__ void mlstm_scores(const Args& a, int gw, int NGW, int lane) {
    const bf16_t* QK = (const bf16_t*)((unsigned char*)a.out + DO_QKC); const float* GVb = (const float*)(a.ws + GV_OFF); bf16_t* SPb = (bf16_t*)(a.ws + SP_OFF);
    const int g = lane >> 4, l15 = lane & 15;
    for (int it = gw; it < 16 * NCH * 8; it += NGW) {
        const int seq = it / (NCH * 8), rem = it % (NCH * 8), n = rem >> 3, mt = (rem >> 1) & 3, np = rem & 1;
        const int b = seq >> 3, hd = (seq >> 1) & 3, dir = seq & 1;
        const int pt = dir ? (TP - 1 - (64 * n + 16 * mt + l15)) : (64 * n + 16 * mt + l15);
        const bf16_t* qp = QK + (size_t)(b * TP + pt) * 2048 + hd * 256 + 8 * g;
        const bf16_t* kp[2];
#pragma unroll
        for (int j = 0; j < 2; ++j) { const int ps = dir ? (TP - 1 - (64 * n + 16 * (2 * np + j) + l15)) : (64 * n + 16 * (2 * np + j) + l15); kp[j] = QK + (size_t)(b * TP + ps) * 2048 + 1024 + hd * 256 + 8 * g; }
        f32x4 sacc[2]; sacc[0] = sacc[1] = (f32x4){0.f, 0.f, 0.f, 0.f};
#pragma unroll
        for (int ks = 0; ks < 8; ++ks) { const bf16x8 qf = *(const bf16x8*)(qp + 32 * ks);
#pragma unroll
            for (int j = 0; j < 2; ++j) { const bf16x8 kf = *(const bf16x8*)(kp[j] + 32 * ks); sacc[j] = MFMA16(qf, kf, sacc[j]); } }
        const float* gvp = GVb + ((size_t)seq * NCH + n) * 384; const f32x4 bt4 = *(const f32x4*)(gvp + 256 + 16 * mt + 4 * g);
        bf16_t* sp = SPb + ((size_t)seq * NCH + n) * 4096;
#pragma unroll
        for (int j = 0; j < 2; ++j) { const int s = 16 * (2 * np + j) + l15; const float b_s = gvp[320 + s];
#pragma unroll
            for (int rr = 0; rr < 4; ++rr) { const int t = 16 * mt + 4 * g + rr; const float val = s <= t ? sacc[j][rr] * __expf(b_s - bt4[rr]) : 0.f; sp[t * 64 + s] = f2bf(val); } }
    }
}
constexpr int P_K = 0, P_V = 34816, P_VB = 64 * VPB, P_SS = P_V + 2 * P_VB, P_SB = 64 * SPB, P_CT = P_SS + 2 * P_SB, P_CTB = 66 * KPB;
static_assert(P_CT + 2 * P_CTB <= LDS_TAB, "scan0p LDS map");
template <int KIND>
__device__ __forceinline__ void scan0p_unit(const Args& a, LAS unsigned char* lds, int b, int hd, int dir, int sl) {
    constexpr int NE = KIND == 0 ? 5 : 4;
    const int tid0 = threadIdx.x, w = __builtin_amdgcn_readfirstlane(tid0 >> 6);
    const int mt = w >> 1, np = w & 1, seq = (b * 4 + hd) * 2 + dir;
    const bf16_t* P = (const bf16_t*)(a.ws + WS_PROJ);
    const bf16_t *Qg, *Kg, *Vg; int pitchQ;
    if (KIND == 0) { const bf16_t* QK = (const bf16_t*)((unsigned char*)a.out + DO_QKC); Qg = QK + hd * 256; Kg = QK + 1024 + hd * 256; pitchQ = 2048; Vg = P + 2048 + hd * 512 + sl * 64; }
    else { Qg = (const bf16_t*)(a.ws + WS_G + (size_t)dir * G_STRIDE) + hd * 256; Kg = (const bf16_t*)(a.ws + WS_G + (size_t)(4 + dir) * G_STRIDE) + hd * 256; pitchQ = 1024; Vg = P + 8192 + hd * 512 + sl * 64; }
    const char* SPg = (const char*)((const bf16_t*)(a.ws + SP_OFF) + ((size_t)(KIND * 16 + seq) * NCH) * 4096);
    const float* GVg = (const float*)(a.ws + GV_OFF) + (size_t)seq * NCH * 384;
    const float* ETg = (const float*)(a.ws + WS_G + G_ETOT) + ((size_t)((dir * 2 + b) * NCH)) * 1024 + hd * 256;
    bf16_t* Og = (bf16_t*)(a.ws + WS_HS + (size_t)dir * HS_STRIDE0) + KIND * 2048 + hd * 512 + sl * 64;
    const unsigned ldsb = (unsigned)(size_t)lds;
    f32x4 accC[2][NE];
#pragma unroll
    for (int mi = 0; mi < 2; ++mi)
#pragma unroll
        for (int ni = 0; ni < NE; ++ni) accC[mi][ni] = (f32x4){0.f, 0.f, 0.f, 0.f};
    for (int i = tid0; i < 2 * P_CTB / 4; i += 512) ((LAS unsigned*)(lds + P_CT))[i] = 0u;
    if (KIND == 0 && tid0 < 256) { const int i = tid0 >> 2, c8 = tid0 & 1, bf = (tid0 >> 1) & 1;
        *(LAS u32x4*)(lds + P_V + bf * P_VB + i * VPB + 128 + c8 * 16) = (u32x4){cvt_pk_bf16(c8 == 0 ? 1.0f : 0.f, 0.f), 0u, 0u, 0u}; }
    u32x4 pk[4], pv, ps; f32x4 pws4 = (f32x4){0.f, 0.f, 0.f, 0.f}, pwi4 = pws4, pfl4 = pws4, pet0 = pws4, pet1 = pws4; float pdec = 1.f; bf16x8 Qf[8];
#define CROW(nn) ((size_t)(b * TP + (dir ? TP - 64 - 64 * (nn) : 64 * (nn))))
#define PF_VS(nn) do { pv = __builtin_nontemporal_load((const u32x4*)((const char*)Vg + CROW(nn) * NPROJ0 * 2 + voV)); ps = *(const u32x4*)(SPg + (size_t)(nn) * 8192 + voS); } while (0)
#define PF_K(nn) do { const char* kb = (const char*)Kg + CROW(nn) * pitchQ * 2; _Pragma("unroll") for (int k = 0; k < 4; ++k) pk[k] = *(const u32x4*)(kb + voK[k]); \
        if (KIND == 0) { const float* gp = GVg + (size_t)(nn) * 384 + 128 + (lane >> 2); pws4 = (f32x4){gp[0], gp[16], gp[32], gp[48]}; } } while (0)
#define PF_G(nn) do { if (KIND == 0) { const float* gp = GVg + (size_t)(nn) * 384; pwi4 = *(const f32x4*)(gp + 16 * mt + 4 * g); pfl4 = *(const f32x4*)(gp + 64 + 16 * mt + 4 * g); pdec = gp[192]; } \
        else { const float* ep = ETg + (size_t)(nn) * 1024 + 32 * w + 4 * g; pet0 = *(const f32x4*)ep; pet1 = *(const f32x4*)(ep + 16); } } while (0)
#define PF_Q(nn) do { const char* qb = (const char*)Qg + CROW(nn) * pitchQ * 2; _Pragma("unroll") for (int ks = 0; ks < 8; ++ks) Qf[ks] = *(const bf16x8*)(qb + voQ + 64 * ks); } while (0)
#define STAGE_VS(buf) do { const int i_ = tid >> 3, c8_ = tid & 7; *(LAS u32x4*)(lds + P_V + (buf) * P_VB + i_ * VPB + c8_ * 16) = pv; *(LAS u32x4*)(lds + P_SS + (buf) * P_SB + i_ * SPB + c8_ * 16) = ps; } while (0)
#define WRITE_K() do { _Pragma("unroll") for (int k = 0; k < 4; ++k) { u32x4 o = pk[k]; \
            if (KIND == 0) { const float s_ = pws4[k]; o.x = cvt_pk_bf16(__uint_as_float(o.x << 16) * s_, __uint_as_float(o.x & 0xffff0000u) * s_); o.y = cvt_pk_bf16(__uint_as_float(o.y << 16) * s_, __uint_as_float(o.y & 0xffff0000u) * s_); \
                o.z = cvt_pk_bf16(__uint_as_float(o.z << 16) * s_, __uint_as_float(o.z & 0xffff0000u) * s_); o.w = cvt_pk_bf16(__uint_as_float(o.w << 16) * s_, __uint_as_float(o.w & 0xffff0000u) * s_); } \
            *(LAS u32x4*)(lds + P_K + (16 * k + (lane >> 2)) * KPB + 64 * w + 16 * (lane & 3)) = o; } } while (0)
#define PROWN(nn, i) (dir ? (TP - 1 - (64 * (nn) + (i))) : (64 * (nn) + (i)))
    for (int n = 0; n < NCH; ++n) {
        int tidv = tid0; asm volatile("" : "+v"(tidv));
        const int tid = tidv, lane = tid & 63, g = lane >> 4, l15 = lane & 15, q4 = l15 >> 2, p4 = lane & 3;
        unsigned voK[4];
#pragma unroll
        for (int k = 0; k < 4; ++k) { const int i = 16 * k + (lane >> 2); voK[k] = (unsigned)((dir ? 63 - i : i) * pitchQ * 2 + 64 * w + 16 * (lane & 3)); }
        const unsigned voV = (unsigned)((dir ? 63 - (tid >> 3) : (tid >> 3)) * NPROJ0 * 2 + (tid & 7) * 16);
        const unsigned voS = (unsigned)((tid >> 3) * 128 + (tid & 7) * 16);
        const unsigned voQ = (unsigned)((dir ? 63 - (16 * mt + l15) : (16 * mt + l15)) * pitchQ * 2 + 16 * g);
        if (n == 0) { PF_VS(0); PF_K(0); PF_G(0); PF_Q(0); STAGE_VS(0); WRITE_K(); PF_VS(1); PF_K(1); }
        __syncthreads();
        const int cur = n & 1, ctr = P_CT + cur * P_CTB, ctw = P_CT + (cur ^ 1) * P_CTB, vcur = P_V + cur * P_VB, scur = P_SS + cur * P_SB;
        const float decay = pdec; const f32x4 wi4 = pwi4, fl4 = pfl4, sc0 = pet0, sc1 = pet1;
        if (n + 1 < NCH) STAGE_VS(cur ^ 1);
        { const int n2 = n + 2 < NCH ? n + 2 : NCH - 1, n1 = n + 1 < NCH ? n + 1 : NCH - 1; PF_VS(n2); PF_G(n1); }
        f32x4 oacc[3];
#pragma unroll
        for (int j = 0; j < 3; ++j) oacc[j] = (f32x4){0.f, 0.f, 0.f, 0.f};
#pragma unroll
        for (int ks = 0; ks < 8; ++ks) {
#pragma unroll
            for (int j = 0; j < 2; ++j) { const bf16x8 cf = *(const LAS bf16x8*)(lds + ctr + (16 * (2 * np + j) + l15) * KPB + (32 * ks + 8 * g) * 2); oacc[j] = MFMA16(Qf[ks], cf, oacc[j]); }
            if (KIND == 0) { const bf16x8 cf = *(const LAS bf16x8*)(lds + ctr + (l15 == 0 ? 64 : 65) * KPB + (32 * ks + 8 * g) * 2); oacc[2] = MFMA16(Qf[ks], cf, oacc[2]); } }
        __builtin_amdgcn_sched_barrier(0);
        { const int n1 = n + 1 < NCH ? n + 1 : NCH - 1; PF_Q(n1); }
        __builtin_amdgcn_sched_barrier(0);
#pragma unroll
        for (int mi = 0; mi < 2; ++mi) {
            f32x4 sc;
            if (KIND == 0) sc = (f32x4){decay, decay, decay, decay}; else sc = mi == 0 ? sc0 : sc1;
#pragma unroll
            for (int ni = 0; ni < NE; ++ni) accC[mi][ni] = accC[mi][ni] * sc; }
#pragma unroll
        for (int ks = 0; ks < 2; ++ks) {
            const unsigned rowb = (unsigned)(32 * ks + 8 * g + q4);
            bf16x8 af[2], bv[5];
            { const unsigned kb = ldsb + P_K + rowb * KPB + 8 * p4; const unsigned vb = ldsb + vcur + rowb * VPB + 8 * p4;
                tr_state_frags<NE>(kb + 32 * (2 * w), kb + 32 * (2 * w + 1), vb, af, bv); }
#pragma unroll
            for (int mi = 0; mi < 2; ++mi)
#pragma unroll
                for (int ni = 0; ni < NE; ++ni) accC[mi][ni] = MFMA16(af[mi], bv[ni], accC[mi][ni]); }
#pragma unroll
        for (int mi = 0; mi < 2; ++mi)
#pragma unroll
            for (int ni = 0; ni < NE; ++ni) { u32x2 o; o.x = cvt_pk_bf16(accC[mi][ni][0], accC[mi][ni][1]); o.y = cvt_pk_bf16(accC[mi][ni][2], accC[mi][ni][3]);
                if (ni < 4 || l15 == 0) *(LAS u32x2*)(lds + ctw + (16 * ni + l15) * KPB + (16 * (2 * w + mi) + 4 * g) * 2) = o; }
        if (n + 1 < NCH) WRITE_K();
        { const int n2 = n + 2 < NCH ? n + 2 : NCH - 1; PF_K(n2); }
        if (KIND == 0) {
#pragma unroll
            for (int j = 0; j < 3; ++j) oacc[j] = oacc[j] * wi4; }
#pragma unroll
        for (int ks = 0; ks < 2; ++ks) { const bf16x8 sf = *(const LAS bf16x8*)(lds + scur + (16 * mt + l15) * SPB + (32 * ks + 8 * g) * 2);
            const unsigned vb = ldsb + vcur + (unsigned)(32 * ks + 8 * g + q4) * VPB + 8 * p4;
            if (KIND == 0) { bf16x8 vf[3]; const unsigned ad[3] = {vb + 32 * (2 * np), vb + 32 * (2 * np + 1), vb + 128}; tr_frags3<4 * VPB>(ad, vf);
                oacc[0] = MFMA16(sf, vf[0], oacc[0]); oacc[1] = MFMA16(sf, vf[1], oacc[1]); oacc[2] = MFMA16(sf, vf[2], oacc[2]); }
            else { bf16x8 vf[2]; const unsigned ad[2] = {vb + 32 * (2 * np), vb + 32 * (2 * np + 1)}; tr_frags2<4 * VPB>(ad, vf);
                oacc[0] = MFMA16(sf, vf[0], oacc[0]); oacc[1] = MFMA16(sf, vf[1], oacc[1]); } }
#pragma unroll
        for (int rr = 0; rr < 4; ++rr) { const int t = 16 * mt + 4 * g + rr; const size_t r = (size_t)(b * TP + PROWN(n, t));
            float inv = 1.f;
            if (KIND == 0) { const float den = __shfl(oacc[2][rr], g * 16); inv = __builtin_amdgcn_rcpf(fmaxf(fabsf(den), fl4[rr])); }
#pragma unroll
            for (int j = 0; j < 2; ++j) Og[r * D + 16 * (2 * np + j) + l15] = f2bf(oacc[j][rr] * inv); }
    }
    __syncthreads();
#undef CROW
#undef PF_VS
#undef PF_K
#undef PF_G
#undef PF_Q
#undef STAGE_VS
#undef WRITE_K
#undef PROWN
}

constexpr int APB = 672;
constexpr int S1_BT = 0, S1_A = 96 * APB, S1_AB = 64 * APB, S1_COMP = S1_A + 2 * S1_AB, S1_HP = S1_COMP + 2 * 2560;
static_assert(S1_HP + 640 <= LDS_TAB, "scan1 LDS map");
template <int ABL, int NJ>
__device__ __forceinline__ void scan1_body(const Args& a, LAS unsigned char* lds, int b, int nb, int dir, int q) {
    const int tid0 = threadIdx.x, w = __builtin_amdgcn_readfirstlane(tid0 >> 6);
    constexpr int nj = NJ, par = NJ == 3 ? 0 : 1, j0 = par * 3; const int mt = w >> 1;
    const bf16_t* U = (const bf16_t*)(a.ws + WS_G) + nb * 320; const bf16_t* WRI = (const bf16_t*)(a.ws + WS_W + W_RI);
    bf16_t* Og = (bf16_t*)(a.ws + WS_HS + (size_t)dir * HS_STRIDE1) + nb * 320 + q * 80;
    for (int id = tid0; id < 96 * 40; id += 512) { const int row = id / 40, pc = id % 40, which = row / 48, jc = (row % 48) >> 4, col = 80 * q + 16 * (jc == 2 ? 4 : jc + 1) + (row & 15);
        *(LAS u32x4*)(lds + S1_BT + row * APB + pc * 16) = *(const u32x4*)(WRI + ((size_t)(((dir * 16 + nb) * 2 + which) * 320 + col)) * 320 + pc * 8); }
    if (tid0 < 160) ((LAS float*)(lds + S1_HP))[tid0] = 0.f;
    float br[3], bi[3], sp[3];
    { const int l15 = tid0 & 15;
#pragma unroll
        for (int jj = 0; jj < 3; ++jj) { const int col = 16 * ((j0 + jj) < 5 ? (j0 + jj) : 4) + l15, gc = dir * DR + nb * 320 + q * 80 + col;
            br[jj] = a.in[I_ODBR][gc]; bi[jj] = a.in[I_ODBI][gc]; sp[jj] = -8.0f * softplusf_(-a.in[I_ODLAM][gc]); } }
    u32x4 pa[5];
    bf16x8 rbr[10], rbi[10];
    { const int l15 = tid0 & 15, g = (tid0 & 63) >> 4;
        const bf16_t* wr_ = WRI + ((size_t)(((dir * 16 + nb) * 2 + 0) * 320 + 80 * q + 16 * j0 + l15)) * 320 + 8 * g; const bf16_t* wi_ = wr_ + (size_t)320 * 320;
#pragma unroll
        for (int ks = 0; ks < 10; ++ks) { rbr[ks] = *(const bf16x8*)(wr_ + 32 * ks); rbi[ks] = *(const bf16x8*)(wi_ + 32 * ks); } }
#define PROW1(tt, i) (dir ? (TP - 1 - (64 * (tt) + (i))) : (64 * (tt) + (i)))
#define PREF1(tt) do { const size_t crow = (size_t)(b * TP + (dir ? TP - 64 - 64 * (tt) : 64 * (tt))); const char* ub = (const char*)U + crow * DR * 2; \
        _Pragma("unroll") for (int k = 0; k < 5; ++k) pa[k] = *(const u32x4*)(ub + voA[k]); } while (0)
#define STAGE1(buf) do { _Pragma("unroll") for (int k = 0; k < 5; ++k) { const int id = tid + 512 * k, i = id / 40, pc = id % 40; *(LAS u32x4*)(lds + S1_A + (buf) * S1_AB + i * APB + pc * 16) = pa[k]; } } while (0)
    for (int ti = 0; ti < NCH; ++ti) {
        int tidv = tid0; asm volatile("" : "+v"(tidv));
        const int tid = tidv, lane = tid & 63, g = lane >> 4, l15 = lane & 15;
        unsigned voA[5];
#pragma unroll
        for (int k = 0; k < 5; ++k) { const int id = tid + 512 * k, i = id / 40, pc = id % 40; voA[k] = (unsigned)((dir ? 63 - i : i) * DR * 2 + pc * 16); }
        const int cur = ti & 1;
        if (ti == 0) { PREF1(0); STAGE1(0); PREF1(1); __syncthreads(); }
        if (ti + 1 < NCH) STAGE1(cur ^ 1);
        { const int tn = ti + 2 < NCH ? ti + 2 : NCH - 1; PREF1(tn); }
        const int abase = S1_A + cur * S1_AB;
        f32x4 racc[3], iacc[3];
#pragma unroll
        for (int jj = 0; jj < 3; ++jj) { racc[jj] = (f32x4){0.f, 0.f, 0.f, 0.f}; iacc[jj] = (f32x4){0.f, 0.f, 0.f, 0.f}; }
        {
            bf16x8 fa[2], fr_[2][3], fi_[2][3];
#define S1_LOADF(buf, ks) do { fa[buf] = *(const LAS bf16x8*)(lds + abase + (16 * mt + l15) * APB + (32 * (ks) + 8 * g) * 2); \
                _Pragma("unroll") for (int jj = 1; jj < nj; ++jj) { const int jc = par ? 2 : jj - 1; \
                    fr_[buf][jj] = *(const LAS bf16x8*)(lds + S1_BT + (16 * jc + l15) * APB + (32 * (ks) + 8 * g) * 2); \
                    fi_[buf][jj] = *(const LAS bf16x8*)(lds + S1_BT + (48 + 16 * jc + l15) * APB + (32 * (ks) + 8 * g) * 2); } } while (0)
            S1_LOADF(0, 0);
#pragma unroll
            for (int ks = 0; ks < 10; ++ks) { const int cb = ks & 1;
                if (ks + 1 < 10) { if (cb) S1_LOADF(0, ks + 1); else S1_LOADF(1, ks + 1); }
                __builtin_amdgcn_sched_barrier(0);
                racc[0] = MFMA16(fa[cb], rbr[ks], racc[0]); iacc[0] = MFMA16(fa[cb], rbi[ks], iacc[0]);
#pragma unroll
                for (int jj = 1; jj < nj; ++jj) { racc[jj] = MFMA16(fa[cb], fr_[cb][jj], racc[jj]); iacc[jj] = MFMA16(fa[cb], fi_[cb][jj], iacc[jj]); }
                __builtin_amdgcn_sched_barrier(0); }
#undef S1_LOADF
        }
        float Ap[3][4], Hp[3][4];
#pragma unroll
        for (int jj = 0; jj < 3; ++jj) if (jj < nj) { const int col = 16 * (j0 + jj) + l15;
            float A = 1.f, Hh = 0.f;
#pragma unroll
            for (int rr = 0; rr < 4; ++rr) { const int t = 16 * mt + 4 * g + rr; const bool pad = PROW1(ti, t) < PADF;
                float rg, ig, av, mult;
                rg = sigmoidf_(racc[jj][rr] + br[jj]); ig = sigmoidf_(iacc[jj][rr] + bi[jj]);
                const float la = rg * sp[jj]; av = __expf(la);
                const float x2 = 2.0f * la; const float m2 = x2 > -0.03f ? -x2 * (1.0f + x2 * (0.5f + x2 * (1.0f / 6.0f))) : 1.0f - av * av;
                mult = __builtin_amdgcn_sqrtf(fmaxf(0.f, m2));
                const float uval = bf2f(*(const LAS unsigned short*)(lds + abase + t * APB + (80 * q + col) * 2));
                float inp = mult * ig * uval; if (pad) { av = 1.f; inp = 0.f; }
                Hh = av * Hh + inp; A = av * A; Ap[jj][rr] = A; Hp[jj][rr] = Hh; }
            const float cA = Ap[jj][3], cH = Hp[jj][3];
            float gA = 1.f, gH = 0.f, mA = 1.f, mH = 0.f;
#pragma unroll
            for (int gg = 0; gg < 4; ++gg) { const float xa = __shfl(cA, gg * 16 + l15), xh = __shfl(cH, gg * 16 + l15);
                if (gg < g) { gH = xa * gH + xh; gA = xa * gA; }
                mH = xa * mH + xh; mA = xa * mA; }
#pragma unroll
            for (int rr = 0; rr < 4; ++rr) { Hp[jj][rr] = Hp[jj][rr] + Ap[jj][rr] * gH; Ap[jj][rr] = Ap[jj][rr] * gA; }
            if (g == 0) *(LAS f32x2*)(lds + S1_COMP + cur * 2560 + (mt * 80 + col) * 8) = (f32x2){mA, mH};
        }
        __syncthreads();
#pragma unroll
        for (int jj = 0; jj < 3; ++jj) if (jj < nj) { const int col = 16 * (j0 + jj) + l15;
            float hp = ((LAS float*)(lds + S1_HP))[cur * 80 + col];
#pragma unroll
            for (int mm = 0; mm < 3; ++mm) if (mm < mt) { const f32x2 c = *(const LAS f32x2*)(lds + S1_COMP + cur * 2560 + (mm * 80 + col) * 8); hp = c[0] * hp + c[1]; }
#pragma unroll
            for (int rr = 0; rr < 4; ++rr) { const int t = 16 * mt + 4 * g + rr; const size_t r = (size_t)(b * TP + PROW1(ti, t));
                Og[r * DR + col] = f2bf(Hp[jj][rr] + Ap[jj][rr] * hp); }
            if (mt == 3 && g == 0) { const f32x2 c = *(const LAS f32x2*)(lds + S1_COMP + cur * 2560 + (3 * 80 + col) * 8); ((LAS float*)(lds + S1_HP))[(cur ^ 1) * 80 + col] = c[0] * hp + c[1]; }
        }
    }
#undef PROW1
#undef PREF1
#undef STAGE1
    __syncthreads();
}

template <int ABL>
__device__ __forceinline__ void scan1_unit(const Args& a, LAS unsigned char* lds, int b, int nb, int dir, int q) {
    const int w = __builtin_amdgcn_readfirstlane((int)threadIdx.x >> 6);
    if (((w ^ (w >> 2)) & 1) == 0) scan1_body<ABL, 3>(a, lds, b, nb, dir, q); else scan1_body<ABL, 2>(a, lds, b, nb, dir, q);
}


#ifndef ABLV
#define ABLV 0
#endif
#ifndef SPLIT_G1
#define SPLIT_G1 false
#endif
#ifndef SPLIT_G3
#define SPLIT_G3 false
#endif
#ifndef SPLIT_UP
#define SPLIT_UP true
#endif
constexpr int NPH = 22;
__global__ void __launch_bounds__(512, 2) __attribute__((amdgpu_waves_per_eu(2, 2))) fwd_kernel(Args a) {
    extern __shared__ __attribute__((aligned(16))) unsigned char lds_raw[];
    LAS unsigned char* lds = (LAS unsigned char*)lds_raw;
    const int tid = threadIdx.x, lane = tid & 63, wave = __builtin_amdgcn_readfirstlane(tid >> 6);
    const int G = gridDim.x, bid = blockIdx.x, gw = bid * 8 + wave, NGW = G * 8;
    const int bq = (G & 7) == 0 ? (bid & 7) * (G >> 3) + (bid >> 3) : bid;
    if (tid < 4) ((LAS unsigned*)(lds + LDS_XB))[tid] = 0u;
    __syncthreads();
    XcdBarrier bar; bar.bar = (unsigned*)(a.ws + WS_CTL) + CW_BAR; bar.x = 0; bar.st = nullptr;
#if MK_FUSED
    bar = xcd_barrier_post((unsigned*)(a.ws + WS_CTL) + CW_BAR, (volatile LAS unsigned*)(lds + LDS_XB));
#endif
    const int lo = a.ph_lo, hi = a.ph_hi;
#ifndef ONLY
#define ONLY -1
#endif
#define XN ((bf16_t*)((unsigned char*)a.out + DO_XN))
#define SMALL ((float*)((unsigned char*)a.out + DO_SMALL))
#define PROJ ((bf16_t*)(a.ws + WS_PROJ))
#define H ((float*)(a.ws + WS_H))
#define WIN ((const bf16_t*)(a.ws + WS_W + W_IN))
#define scr ((LAS float*)(lds + wave * 16896))
#define tab ((LAS int*)(lds + LDS_TAB))
#define IN(k) ((ONLY < 0 || ONLY == (k)) && lo <= (k) && (k) < hi)
#ifndef TIMEPH
#define TIMEPH -1
#endif
#ifndef REPMASK
#define REPMASK 0u
#endif
#define REPS(k) for (int rep_ = 0; rep_ < (((REPMASK >> (k)) & 1u) ? 2 : 1); ++rep_, ((rep_ < (((REPMASK >> (k)) & 1u) ? 2 : 1)) ? xcd_barrier(bar) : (void)0))
#ifndef AMPMASK
#define AMPMASK 0ull
#endif
#define AMPPT(k) do { if (AMPMASK) { if (tid == 0) { const unsigned long long now = __builtin_amdgcn_s_memrealtime(); \
            if ((AMPMASK >> (k)) & 1ull) amp_acc += now - amp_prev;        \
            amp_prev = now; } } } while (0)
#define SEAM(k) do { if (MK_FUSED && IN(k) && IN((k) + 1)) xcd_barrier(bar); AMPPT(k); \
        if (TIMEPH >= 0 && bid == 0 && tid == 0) ((unsigned long long*)(a.ws + WS_CTL + 512 * 1024))[(k) + 1] = __builtin_amdgcn_s_memrealtime(); } while (0)
    unsigned long long amp_prev = AMPMASK ? __builtin_amdgcn_s_memrealtime() : 0ull, amp_acc = 0ull;

    if (TIMEPH >= 0 && bid == 0 && tid == 0) ((unsigned long long*)(a.ws + WS_CTL + 512 * 1024))[0] = __builtin_amdgcn_s_memrealtime();
    if (IN(0)) { conv_layer0(a, gw, NGW, scr, lane); router_table(a, 0, gw, NGW, lane); p0_rows(a, gw, NGW, lane); }
    SEAM(0);
    if (IN(1)) { pg8::Gemm g{XN, WIN, D, D, D, nullptr}; pg8::StaticOrder S; S.init(MP, NW0, G, bid); pg8::EpiProj E{PROJ, NPROJ0, NPROJ0 / 256, SMALL}; pg8::gemm_phase(lds, g, S, E);
        queue_moe(a, 0, (unsigned*)(a.ws + WS_CTL) + CW_Q, scr, lane); }
    SEAM(1);
    if (IN(2)) { dwconv_segments<0>(PROJ, NPROJ0, (bf16_t*)((unsigned char*)a.out + DO_QKC), 2048, a.in[I_EVQKC], 2048, nullptr, 4, gw, NGW, lane);
#if SCAN0_PRE
        if (G > 32) { if (bid < 16) { if (wave == 0) mlstm_gate_seq(a, bid, lane); gla_pre_units(a, lds, -1, G - 16); } else gla_pre_units(a, lds, bid - 16, G - 16); }
        else { if (wave == 0) for (int sq = bid; sq < 16; sq += G) mlstm_gate_seq(a, sq, lane); gla_pre_units(a, lds, bid, G); }
#else
        gla_pre_units(a, lds, bid, G);
#endif
    }
    SEAM(2);
#if SCAN0_PRE
    if (IN(21)) mlstm_scores(a, gw, NGW, lane);
    if (MK_FUSED && IN(21) && IN(3)) xcd_barrier(bar);
    AMPPT(21);
#endif
    if (IN(3)) REPS(3) { for (int u = bid; u < 256; u += G) { const int grp = u & 31, sl = u >> 5, kind = grp & 1, dir = (grp >> 1) & 1, hd = (grp >> 2) & 3, b = grp >> 4;
            if (a.flags & 4) { if (kind == 0) scan0_unit<0, ABLV>(a, lds, b, hd, dir, sl, WS_H); else scan0_unit<1, ABLV>(a, lds, b, hd, dir, sl, WS_H); }
#if SCAN0_PRE
            else if (kind == 0) scan0p_unit<0>(a, lds, b, hd, dir, sl); else scan0p_unit<1>(a, lds, b, hd, dir, sl); } }
#else
            else if (kind == 0) scan0_unit<0, 0>(a, lds, b, hd, dir, sl, (a.flags & 2) ? WS_H : WS_HS); else scan0_unit<1, 0>(a, lds, b, hd, dir, sl, (a.flags & 2) ? WS_H : WS_HS); } }
#endif
    SEAM(3);
    if (IN(4)) REPS(4) headnorm_rows(a, gw, NGW, lane);
    SEAM(4);
    if (IN(5)) { pg8::Gemm g{(const bf16_t*)(a.ws + WS_HS), (const bf16_t*)(a.ws + WS_W + W_OUT0), D, D, D, nullptr}; pg8::TailSplitOrder S; S.init(G, bid); pg8::EpiResAdd E{PROJ, D, (float*)((unsigned char*)a.out + DO_PART)}; pg8::gemm_phase(lds, g, S, E);
        tail_reduce(a, lds, bid, G, (unsigned*)(a.ws + WS_CTL) + CW_TKT); }
    SEAM(5);
#define MOE_PHASES(P, layer) \
    if (IN(P)) route_rows(a, lds, wave, layer, gw, NGW, lane); \
    SEAM((P) + 1); \
    if (IN((P) + 2)) { const unsigned* cn = (const unsigned*)(a.ws + WS_CTL) + CW_CNT + (layer) * 2048; build_tab(tab, cn); \
        pg8::Gemm g{XN, (const bf16_t*)(a.ws + WS_W + W_UP), D, D, D, (float*)(a.ws + XS_OFF)}; pg8::MoeOrder S0{tab, 2, G, bq, (const int*)((unsigned char*)a.out + DO_LTOK) + (size_t)(layer) * NEXP * LCAP, cn}; \
        pg8::SplitTail<pg8::MoeOrder> S; S.init(S0, G, bq, SPLIT_UP); \
        pg8::EpiMoeUp E{(bf16_t*)(a.ws + HID_OFF), (const float*)((unsigned char*)a.out + DO_LW) + (size_t)(layer) * NEXP * LCAP, (const float*)((unsigned char*)a.out + DO_LRS) + (size_t)(layer) * NEXP * LCAP, tab}; \
        pg8::gemm_phase<pg8::EpiMoeUp, pg8::SplitTail<pg8::MoeOrder>, true>(lds, g, S, E); pg8::split_reduce(lds, g, S, E, (unsigned*)(a.ws + WS_CTL) + CW_TK2 + 16384 + (layer) * 8192); \
        if ((layer) == 0) { __syncthreads(); queue_od(a, (unsigned*)(a.ws + WS_CTL) + CW_Q + 64, scr, lane); } } \
    SEAM((P) + 2); \
    if (IN((P) + 3)) REPS((P) + 3) { const unsigned* cn = (const unsigned*)(a.ws + WS_CTL) + CW_CNT + (layer) * 2048; build_tab(tab, cn); \
        pg8::Gemm g{(const bf16_t*)(a.ws + HID_OFF), (const bf16_t*)(a.ws + WS_W + W_DN), DEXP, DEXP, DEXP, nullptr}; pg8::MoeOrder S{tab, 16, G, bq, (const int*)((unsigned char*)a.out + DO_LTOK) + (size_t)(layer) * NEXP * LCAP, cn}; \
        pg8::EpiMoeDn E{(bf16_t*)(a.ws + WS_HS), (const int*)((unsigned char*)a.out + DO_LTOK) + (size_t)(layer) * NEXP * LCAP, tab}; pg8::gemm_phase(lds, g, S, E); } \
    SEAM((P) + 3);
    MOE_PHASES(6, 0)
    if (IN(10)) { router_table(a, 1, gw, NGW, lane); p8_rows(a, gw, NGW, lane); }
    SEAM(10);
    if (IN(11)) { pg8::Gemm g{XN, WIN, D, D, D, (float*)(a.ws + WS_HS)}; pg8::StaticOrder S0; S0.init(MP, NPROJ1, G, bid); pg8::SplitTail<pg8::StaticOrder> S; S.init(S0, G, bid, SPLIT_G3);
        pg8::EpiProj E{PROJ, NPROJ1, NPROJ1 / 256, nullptr}; pg8::gemm_phase(lds, g, S, E); pg8::split_reduce(lds, g, S, E, (unsigned*)(a.ws + WS_CTL) + CW_TK2 + 8192);
        __syncthreads(); queue_moe(a, 1, (unsigned*)(a.ws + WS_CTL) + CW_Q + 128, scr, lane); }
    SEAM(11);
    if (IN(12)) REPS(12) dwconv_segments<1>(PROJ + DR, NPROJ1, (bf16_t*)(a.ws + WS_G), DR, a.in[I_ODCONV], DR, a.in[I_ODCONVB], 10, gw, NGW, lane);
    SEAM(12);
    if (IN(13)) REPS(13) { for (int u = bid; u < 256; u += G) { const int grp = u & 63, q = u >> 6, dir = grp & 1, nb = (grp >> 1) & 15, b = grp >> 5; if (a.flags & 4) scan1_unit<ABLV>(a, lds, b, nb, dir, q); else scan1_unit<0>(a, lds, b, nb, dir, q); } }
    SEAM(13);
    if (IN(14)) REPS(14) rglru_combine_rows(a, gw, NGW, lane);
    SEAM(14);
    if (IN(15)) { pg8::Gemm g{(const bf16_t*)(a.ws + WS_HS), (const bf16_t*)(a.ws + WS_W + W_OUT1), DR, DR, DR, nullptr}; pg8::TailSplitOrder S; S.init(G, bid); pg8::EpiResAdd E{PROJ, D, (float*)((unsigned char*)a.out + DO_PART)}; pg8::gemm_phase(lds, g, S, E);
        tail_reduce(a, lds, bid, G, (unsigned*)(a.ws + WS_CTL) + CW_TKT + 16 * 64); }
    SEAM(15);
    MOE_PHASES(16, 1)
#ifndef PROBE
#define PROBE 0
#endif
#if TIMEPH >= 0
    if (IN(20)) { const unsigned long long* ts = (const unsigned long long*)(a.ws + WS_CTL + 512 * 1024); const float us = (float)(ts[TIMEPH + 1] - ts[TIMEPH]) * 0.01f;
        for (size_t i = (size_t)bid * 512 + threadIdx.x; i < (size_t)NBATCH * SEQ * D; i += (size_t)G * 512) a.out[i] = (i == 0) ? sqrtf(67108864.0f * us) : 0.f; }
#elif PROBE == 9
    if (IN(20)) { const unsigned* s1 = (const unsigned*)(a.ws + WS_HS); const unsigned* s2 = (const unsigned*)(a.ws + WS_H); unsigned cntd = 0;
        for (size_t i = (size_t)bid * 512 + threadIdx.x; i < (size_t)MR * D; i += (size_t)G * 512) { const unsigned x = s1[i], y = s2[i]; cntd += ((x & 0xffffu) != (y & 0xffffu)) + ((x >> 16) != (y >> 16)); }
        cntd = (unsigned)wave_sum((float)cntd); if (lane == 0 && cntd) atomicAdd((unsigned*)(a.ws + WS_CTL) + 32768, cntd); }
    if (lo == 21) { const unsigned c = *((const unsigned*)(a.ws + WS_CTL) + 32768);
        for (size_t i = (size_t)bid * 512 + threadIdx.x; i < (size_t)NBATCH * SEQ * D; i += (size_t)G * 512) a.out[i] = (i == 0) ? sqrtf(67108864.0f * (float)c) : 0.f; }
#elif PROBE
    if (IN(20)) { const bf16_t* src = (const bf16_t*)(a.ws + (PROBE == 1 ? WS_PROJ : PROBE == 2 ? WS_G : PROBE == 3 ? WS_HS : PROBE == 4 ? (WS_HS + HS_STRIDE0) : PROBE == 7 ? (WS_PROJ + (size_t)134217728) : PROBE == 8 ? (WS_PROJ + (size_t)268435456) : WS_PROJ));
        for (size_t i = (size_t)bid * 512 + threadIdx.x; i < (size_t)NBATCH * SEQ * D; i += (size_t)G * 512) a.out[i] = bf2f(src[i]); }
#else
    if (IN(20)) REPS(20) pfinal_rows(a, gw, NGW, lane, a.flags & 1);
#endif
    if (AMPMASK) { if (MK_FUSED) xcd_barrier(bar); AMPPT(20); if (bid == 0 && tid == 0) { const unsigned long long tgt = __builtin_amdgcn_s_memrealtime() + amp_acc; while (__builtin_amdgcn_s_memrealtime() < tgt) __builtin_amdgcn_s_sleep(8); } }
#undef IN
#undef SEAM
#undef MOE_PHASES
#undef XN
#undef SMALL
#undef PROJ
#undef H
#undef WIN
#undef scr
#undef tab
}

extern "C" void kernel_launch(void* const* d_in, const int* in_sizes, int n_in, void* d_out, int out_size, void* d_ws, size_t ws_size, hipStream_t stream) {
    static int grid = 0;
    if (grid == 0) {
        if (n_in != 29 || out_size != NBATCH * SEQ * D || ws_size < WS_END) { fprintf(stderr, "kernel_launch: unexpected problem: n_in %d out %d a.ws %zu (need %zu)\n", n_in, out_size, ws_size, (size_t)WS_END); grid = -1; return; }
        int dev = 0, cus = 0, per_cu = 0;
        if (hipGetDevice(&dev) != hipSuccess || hipDeviceGetAttribute(&cus, hipDeviceAttributeMultiprocessorCount, dev) != hipSuccess) { grid = -1; return; }
        if (hipFuncSetAttribute((const void*)fwd_kernel, hipFuncAttributeMaxDynamicSharedMemorySize, LDS_BYTES) != hipSuccess) { fprintf(stderr, "kernel_launch: hipFuncSetAttribute failed\n"); grid = -1; return; }
        if (hipOccupancyMaxActiveBlocksPerMultiprocessor(&per_cu, (const void*)fwd_kernel, 512, LDS_BYTES) != hipSuccess || per_cu < 1) fprintf(stderr, "kernel_launch: occupancy query says %d\n", per_cu);
        (void)hipGetLastError();
        grid = cus > 256 ? 256 : cus;
    }
    if (grid < 0) return;
    (void)in_sizes;
    if (hipMemsetAsync((char*)d_ws + WS_CTL, 0, CTL_BYTES, stream) != hipSuccess) return;
    Args a{};
    for (int i = 0; i < 29; ++i) a.in[i] = (const float*)d_in[i];
    a.out = (float*)d_out; a.ws = (unsigned char*)d_ws;
#if MK_FUSED
    a.ph_lo = 0; a.ph_hi = NPH; a.flags = 1;
    hipLaunchKernelGGL(fwd_kernel, dim3(grid), dim3(512), LDS_BYTES, stream, a);
#else
#ifndef DBG_STOP
#define DBG_STOP 20
#endif
    a.flags = (DBG_STOP >= 10) ? 1 : 0;
#if PROBE == 9
    for (int p = 0; p < 4; ++p) { a.ph_lo = p; a.ph_hi = p + 1; a.flags = 0; hipLaunchKernelGGL(fwd_kernel, dim3(grid), dim3(512), LDS_BYTES, stream, a); }
    a.ph_lo = 3; a.ph_hi = 4; a.flags = 2; hipLaunchKernelGGL(fwd_kernel, dim3(grid), dim3(512), LDS_BYTES, stream, a);
    a.ph_lo = 20; a.ph_hi = 21; a.flags = 0; hipLaunchKernelGGL(fwd_kernel, dim3(grid), dim3(512), LDS_BYTES, stream, a);
    a.ph_lo = 21; a.ph_hi = 22; hipLaunchKernelGGL(fwd_kernel, dim3(grid), dim3(512), LDS_BYTES, stream, a);
#else
#ifndef DUP
#define DUP -1
#endif
#ifndef DUPB
#define DUPB -1
#endif
    for (int q = 0; q < NPH; ++q) { const int p = q < 3 ? q : (q == 3 ? 21 : q - 1); if (p == 21 && !SCAN0_PRE) continue; if (p >= DBG_STOP && p != 20) continue; a.ph_lo = p; a.ph_hi = p + 1;
        if (p == DUPB) { a.flags |= 8; hipLaunchKernelGGL(fwd_kernel, dim3(grid), dim3(512), LDS_BYTES, stream, a); a.flags &= ~8; }
        hipLaunchKernelGGL(fwd_kernel, dim3(grid), dim3(512), LDS_BYTES, stream, a);
        if (p == DUP) { if (ABLV) a.flags |= 4; hipLaunchKernelGGL(fwd_kernel, dim3(grid), dim3(512), LDS_BYTES, stream, a); a.flags &= ~4; } }
#endif
#endif
}
```

```cpp
#include <hip/hip_runtime.h>
#include <cstdio>
#include <cstdint>

#ifndef GEMM_SP2
#define GEMM_SP2 1
#endif
#ifndef SCAN0_PRE
#define SCAN0_PRE 1
#endif
#ifndef MK_FUSED
#define MK_FUSED 1
#endif

#define LAS __attribute__((address_space(3)))
typedef unsigned short bf16_t;
typedef short bf16x8 __attribute__((ext_vector_type(8)));
typedef short s16x4 __attribute__((ext_vector_type(4)));
typedef float f32x4 __attribute__((ext_vector_type(4)));
typedef float f32x2 __attribute__((ext_vector_type(2)));
typedef unsigned u32x4 __attribute__((ext_vector_type(4)));
typedef unsigned u32x2 __attribute__((ext_vector_type(2)));

constexpr int D = 4096, NBATCH = 2, SEQ = 8192, NMETA = 16, TP = 8256  , NCH = 129, PADF = 48;
constexpr int MR = NBATCH * TP;
constexpr int MP = 16640;
constexpr int NPROJ0 = 12288, NW0 = 12544, NPROJ1 = 10240, DR = 5120;
constexpr int NEXP = 32, DEXP = 256, SLOTS = 41216  , LCAP = 16416  ;
constexpr float EPS = 1e-6f;
constexpr float NEGV = -1e30f;

constexpr size_t MiB = 1u << 20;
constexpr size_t WS_CTL = 0, CTL_BYTES = 1 * MiB;
constexpr size_t WS_W = 1 * MiB;
constexpr size_t W_IN = 0, W_OUT0 = 98 * MiB, W_OUT1 = 80 * MiB, W_RI = 120 * MiB, W_UP = 134 * MiB, W_DN = 262 * MiB, W_RT = 326 * MiB;
constexpr size_t WS_H = 329 * MiB;
constexpr size_t WS_PROJ = 589 * MiB;
constexpr size_t WS_HS = 979 * MiB;
constexpr size_t WS_G = 1304 * MiB;
constexpr size_t WS_END = 1502 * MiB;
constexpr size_t XS_OFF = WS_G  , HID_OFF = WS_PROJ + 322 * MiB;
constexpr size_t HS_STRIDE0 = (size_t)MP * 4096 * 2, HS_STRIDE1 = (size_t)MP * DR * 2;
constexpr size_t G_STRIDE = (size_t)MP * 1024 * 2, G_ETOT = 195 * MiB;
constexpr size_t SP_OFF = WS_HS + 262 * MiB  , GV_OFF = WS_HS + 296 * MiB  ;
constexpr size_t DO_XN = 0, DO_QKC = 130 * MiB, DO_SMALL = 195 * MiB, DO_LTOK = 200 * MiB, DO_LW = 205 * MiB, DO_SDST = 210 * MiB, DO_SW = 211 * MiB, DO_LRS = 212 * MiB, DO_SRS = 217 * MiB, DO_PART = 218 * MiB;
constexpr int CW_Q = 24576  , CW_BAR = 4096, CW_CNT = 16384, CW_TKT = 20480, CW_TK2 = 32768  ;

constexpr int LDS_BYTES = 159744;
constexpr int LDS_XB = LDS_BYTES - 16;
constexpr int LDS_TAB = LDS_BYTES - 16 - 2048;

__device__ __forceinline__ float bf2f(unsigned short b) { return __uint_as_float(((unsigned)b) << 16); }
typedef __bf16 bf16v2 __attribute__((ext_vector_type(2)));
__device__ __forceinline__ unsigned cvt_pk_bf16(float lo, float hi) { const f32x2 v = {lo, hi}; return __builtin_bit_cast(unsigned, __builtin_convertvector(v, bf16v2)); }
__device__ __forceinline__ unsigned short f2bf(float f) { return (unsigned short)(cvt_pk_bf16(f, 0.f) & 0xffffu); }
__device__ __forceinline__ float sigmoidf_(float x) { return __builtin_amdgcn_rcpf(1.0f + __expf(-x)); }
__device__ __forceinline__ float siluf_(float x) { return x * sigmoidf_(x); }
__device__ __forceinline__ float logsigf_(float x) { return fminf(x, 0.f) - __logf(1.0f + __expf(-fabsf(x))); }
__device__ __forceinline__ float softplusf_(float x) { return fmaxf(x, 0.f) + log1pf(__expf(-fabsf(x))); }
__device__ __forceinline__ float gelu_tanhf_(float x) { const float u = 0.7978845608028654f * (x + 0.044715f * x * x * x); const float t = 1.0f - 2.0f * __builtin_amdgcn_rcpf(__expf(2.0f * u) + 1.0f); return 0.5f * x * (1.0f + t); }
__device__ __forceinline__ float wave_sum(float v) {
#pragma unroll
    for (int o = 1; o < 64; o <<= 1) v += __shfl_xor(v, o);
    return v;
}
__device__ __forceinline__ bool row_valid(int r) { if (r >= MR) return false; const int p = r >= TP ? r - TP : r; return p >= PADF; }
__device__ __forceinline__ s16x4 tr_read(unsigned lds_addr) { s16x4 r; asm volatile("ds_read_b64_tr_b16 %0, %1\n\ts_waitcnt lgkmcnt(0)" : "=&v"(r) : "v"(lds_addr) : "memory"); return r; }
__device__ __forceinline__ bf16x8 tr_frag(unsigned a0, unsigned a1) {
    s16x4 x, y; asm volatile("ds_read_b64_tr_b16 %0, %2\n\tds_read_b64_tr_b16 %1, %3\n\ts_waitcnt lgkmcnt(0)" : "=&v"(x), "=&v"(y) : "v"(a0), "v"(a1) : "memory");
    bf16x8 r; r[0] = x[0]; r[1] = x[1]; r[2] = x[2]; r[3] = x[3]; r[4] = y[0]; r[5] = y[1]; r[6] = y[2]; r[7] = y[3]; return r;
}
#define MFMA16(a, b, c) __builtin_amdgcn_mfma_f32_16x16x32_bf16((a), (b), (c), 0, 0, 0)

namespace pg8 {
constexpr int BM = 256, BK = 64, HALF = 128, HTB = HALF * BK * 2, STAGE_BYTES = 8 * HTB, NXCD = 8, WGM = 8;
__host__ __device__ __forceinline__ int lds_byte(int r, int c) { const int st = (r >> 4) * 2 + (c >> 5), rr = r & 15, cc = c & 31, ob = rr * 64 + cc * 2; return st * 1024 + (ob ^ (((ob >> 9) & 1) << 5)); }
__host__ __device__ __forceinline__ void stage_rc(int b, int& R, int& C) { const int st = b / 1024, sb = b % 1024, swz = sb ^ (((sb >> 9) & 1) << 5); R = (st >> 1) * 16 + swz / 64; C = (st & 1) * 32 + (swz % 64) / 2; }
__host__ __device__ __forceinline__ int perm32(int rho) { const int n = rho >> 4, i = rho & 15; return 8 * (i >> 2) + 4 * n + (i & 3); }
struct Unit { int pm, pn, kq, ex, pos0, sidx; };
constexpr int KSPLIT = 8;
struct Gemm { const bf16_t* A; const bf16_t* Bt; int lda, ldb, K; float* slab; };
struct StaticOrder {
    static constexpr int KS = KSPLIT;
    int nM, nN, nwg, G, c;
    __device__ __forceinline__ int arow(const Unit&, int) const { return 0; }
    __device__ __forceinline__ bool skip1(const Unit& u) const { return u.pm * BM + HALF >= MR; }
    __device__ void init(int M, int N, int G_, int c_) { nM = M / BM; nN = N / BM; nwg = nM * nN; G = G_; c = c_; }
    __device__ int count() const { return nwg; }
    __device__ bool next(int i, Unit& u) const { const long L = (long)i * G + c; if (L >= nwg) return false; unit_of((int)L, u); return true; }
    __device__ void unit_of(int L, Unit& u) const {
        int wgid = L; { const int q = nwg / NXCD, r = nwg % NXCD, xcd = wgid % NXCD, off = wgid / NXCD; wgid = (xcd < r ? xcd * (q + 1) : r * (q + 1) + (xcd - r) * q) + off; }
        const int nig = WGM * nN, gid = wgid / nig, fm = gid * WGM, gsz = (nM - fm) < WGM ? (nM - fm) : WGM;
        u.pm = fm + ((wgid % nig) % gsz); u.pn = (wgid % nig) / gsz; u.kq = -1; u.sidx = 0;
    }
};
struct TailSplitOrder {
    static constexpr int KS = KSPLIT;
    StaticOrder so; int G, c, base;
    __device__ __forceinline__ bool skip1(const Unit& u) const { return u.pm * BM + HALF >= MR; }
    __device__ void init(int G_, int c_) { so.init(64 * BM, 16 * BM, G_, c_); G = G_; c = c_; base = ((so.nwg + G - 1) / G) * G; }
    __device__ bool next(int i, Unit& u) const {
        if (so.next(i, u)) return true;
        const int L = i * G + c - base; if (L < 0 || L >= 16 * KSPLIT) return false;
        u.pm = 64; u.pn = L / KSPLIT; u.kq = L % KSPLIT; u.sidx = 0; return true;
    }
};
struct MoeOrder {
    static constexpr int KS = KSPLIT;
    __device__ __forceinline__ bool skip1(const Unit& u) const { return __builtin_amdgcn_readfirstlane(tab[256 + u.ex]) - u.pos0 <= HALF; }
    const LAS int* tab; int npn, G, c; const int* ltok; const unsigned* cnt;
    __device__ int count() const { return __builtin_amdgcn_readfirstlane(tab[0]) * npn; }
    __device__ bool next(int i, Unit& u) const { const int L = i * G + c; if (L >= count()) return false; unit_of(L, u); return true; }
    __device__ void unit_of(int L, Unit& u) const {
        const int pm = L / npn, ct = L % npn, ex = __builtin_amdgcn_readfirstlane(tab[64 + pm]);
        u.pm = pm; u.pn = ex * npn + ct; u.kq = -1; u.sidx = 0; u.ex = ex; u.pos0 = (pm - __builtin_amdgcn_readfirstlane(tab[1 + ex])) * BM;
    }
    __device__ __forceinline__ int arow(const Unit& u, int s) const { const int pos = u.pos0 + s; return pos < tab[256 + u.ex] ? (ltok[(size_t)u.ex * LCAP + pos] >> 1) : 0; }
};
struct NoGather { };

template <class Base> struct SplitTail {
    static constexpr int KS = 4;
    Base base; int U, F, G, c;
    __device__ void init(const Base& b, int G_, int c_, bool enable) { base = b; G = G_; c = c_; U = b.count(); F = enable ? (U / G) * G : U; }
    __device__ bool next(int i, Unit& u) const {
        const int L = i * G + c;
        if (L < F) { base.unit_of(L, u); return true; }
        const int Ls = L - F; if (Ls >= (U - F) * KS) return false;
        base.unit_of(F + Ls / KS, u); u.kq = Ls % KS; u.sidx = Ls / KS; return true;
    }
    __device__ __forceinline__ int arow(const Unit& u, int s) const { return base.arow(u, s); }
    __device__ __forceinline__ bool skip1(const Unit& u) const { return base.skip1(u); }
};
template <class Epi, class Sched, bool GATHER = false>
__device__ __forceinline__ void gemm_phase(LAS unsigned char* lds, const Gemm g, const Sched& S, const Epi& E) {
    const int tid = threadIdx.x, wid = __builtin_amdgcn_readfirstlane(tid >> 6), lane = tid & 63, wr = wid >> 2, wc = wid & 3, fr = lane & 15, fq = lane >> 4;
    int K = g.K; asm volatile("" : "+s"(K));
    const int ntfull = K / BK, ntsplit = K / (BK * Sched::KS); const size_t ksl = (size_t)(K / Sched::KS) * 2;
    unsigned voffA[2], voffB[2]; int pR[2], pC[2];
#pragma unroll
    for (int i = 0; i < 2; ++i) { int R, C; stage_rc(tid * 16 + i * 8192, R, C); const int Rb = Epi::PERM ? ((R & ~31) + perm32(R & 31)) : R; pR[i] = R; pC[i] = C;
        voffA[i] = (unsigned)(R * g.lda + C) * 2u; voffB[i] = (unsigned)(Rb * g.ldb + C) * 2u; }
    unsigned gvo[2][2], ngvo[2][2];
#define PG8_GVO(dst, unit) do { _Pragma("unroll") for (int _h = 0; _h < 2; ++_h) _Pragma("unroll") for (int _i = 0; _i < 2; ++_i) dst[_h][_i] = (unsigned)(S.arow(unit, _h * HALF + pR[_i]) * g.lda + pC[_i]) * 2u; \
        asm volatile("" : "+v"(dst[0][0]), "+v"(dst[0][1]), "+v"(dst[1][0]), "+v"(dst[1][1])); } while (0)
    const size_t kstep = (size_t)(BK * 2);
    const size_t hstepA = (size_t)HALF * g.lda * 2, hstepB = (size_t)HALF * g.ldb * 2;
    const size_t tstepA = 2 * hstepA, tstepB = 2 * hstepB;
    const unsigned ldsw = (unsigned)wid * 1024u;
    const int aoff = lds_byte(wr * 64 + fr, fq * 8), boff = lds_byte(wc * 32 + fr, fq * 8);
#define PG8_SA(b, h) (((b) * 2 + (h)) * HTB)
#define PG8_SB(b, h) ((4 + (b) * 2 + (h)) * HTB)
#define PG8_STAGE(bufoff, gbase, voff) do { _Pragma("unroll") for (int _i = 0; _i < 2; ++_i) \
        __builtin_amdgcn_global_load_lds((const unsigned*)((const char*)(gbase) + (voff)[_i]), (LAS unsigned*)(lds + (bufoff) + ldsw + _i * 8192), 16, 0, 0); } while (0)
#define PG8_LDA(dst, b, h) do { _Pragma("unroll") for (int m = 0; m < 4; ++m) _Pragma("unroll") for (int k = 0; k < 2; ++k) dst[m][k] = *(const LAS bf16x8*)(lds + PG8_SA(b, h) + aoff + m * 2048 + k * 1024); } while (0)
#define PG8_LDB(dst, b, h) do { _Pragma("unroll") for (int n = 0; n < 2; ++n) _Pragma("unroll") for (int k = 0; k < 2; ++k) dst[n][k] = *(const LAS bf16x8*)(lds + PG8_SB(b, h) + boff + n * 2048 + k * 1024); } while (0)
#define PG8_MMA(ai, bj, At, Bt) do { __builtin_amdgcn_s_setprio(1); _Pragma("unroll") for (int m = 0; m < 4; ++m) _Pragma("unroll") for (int n = 0; n < 2; ++n) _Pragma("unroll") for (int k = 0; k < 2; ++k) \
        acc[ai][bj][m][n] = __builtin_amdgcn_mfma_f32_16x16x32_bf16(Bt[n][k], At[m][k], acc[ai][bj][m][n], 0, 0, 0); __builtin_amdgcn_s_setprio(0); } while (0)
#define PG8_WAIT_V(n) asm volatile("s_waitcnt vmcnt(" #n ")" ::: "memory")
#define PG8_WAIT_L(n) asm volatile("s_waitcnt lgkmcnt(" #n ")" ::: "memory")
#define PG8_BAR __builtin_amdgcn_s_barrier()
#define PG8_SCHED __builtin_amdgcn_sched_barrier(0)
    Unit cur, nxt; int ui = 0;
    if (!S.next(0, cur)) return;
    f32x4 acc[2][2][4][2];
#pragma unroll
    for (int a = 0; a < 2; ++a)
#pragma unroll
        for (int b = 0; b < 2; ++b)
#pragma unroll
            for (int m = 0; m < 4; ++m)
#pragma unroll
                for (int n = 0; n < 2; ++n) acc[a][b][m][n] = (f32x4){0.f, 0.f, 0.f, 0.f};
    bf16x8 At[4][2], B0[2][2], B1[2][2];
    const char* cA = (const char*)g.A + (size_t)cur.pm * tstepA + (cur.kq < 0 ? (size_t)0 : cur.kq * ksl); const char* cB = (const char*)g.Bt + (size_t)cur.pn * tstepB + (cur.kq < 0 ? (size_t)0 : cur.kq * ksl);
    const char* gA = (const char*)g.A + (cur.kq < 0 ? (size_t)0 : cur.kq * ksl);
    if constexpr (GATHER) { PG8_GVO(gvo, cur); }
#if GEMM_SP2
    PG8_STAGE(PG8_SB(0, 0), cB, voffB); PG8_STAGE(PG8_SB(0, 1), cB + hstepB, voffB);
    if constexpr (GATHER) { PG8_STAGE(PG8_SA(0, 0), gA, gvo[0]); PG8_STAGE(PG8_SA(0, 1), gA, gvo[1]); } else { PG8_STAGE(PG8_SA(0, 0), cA, voffA); PG8_STAGE(PG8_SA(0, 1), cA + hstepA, voffA); }
    if (wr == 1) PG8_BAR;
    PG8_WAIT_V(2); PG8_BAR;
    PG8_STAGE(PG8_SB(1, 0), cB + kstep, voffB); if constexpr (GATHER) PG8_STAGE(PG8_SA(1, 0), gA + kstep, gvo[0]); else PG8_STAGE(PG8_SA(1, 0), cA + kstep, voffA);
    PG8_STAGE(PG8_SB(1, 1), cB + hstepB + kstep, voffB);
    PG8_WAIT_V(6); PG8_BAR;
#else
    PG8_STAGE(PG8_SB(0, 0), cB, voffB); if constexpr (GATHER) PG8_STAGE(PG8_SA(0, 0), gA, gvo[0]); else PG8_STAGE(PG8_SA(0, 0), cA, voffA);
    PG8_STAGE(PG8_SB(0, 1), cB + hstepB, voffB); if constexpr (GATHER) PG8_STAGE(PG8_SA(0, 1), gA, gvo[1]); else PG8_STAGE(PG8_SA(0, 1), cA + hstepA, voffA);
    if (wr == 1) PG8_BAR;
    PG8_WAIT_V(4); PG8_BAR;
    PG8_STAGE(PG8_SB(1, 0), cB + kstep, voffB); if constexpr (GATHER) PG8_STAGE(PG8_SA(1, 0), gA + kstep, gvo[0]); else PG8_STAGE(PG8_SA(1, 0), cA + kstep, voffA);
    PG8_STAGE(PG8_SB(1, 1), cB + hstepB + kstep, voffB);
    PG8_WAIT_V(6); PG8_BAR;
#endif
    for (;;) {
        const bool has_next = S.next(ui + 1, nxt);
        const char* nA = has_next ? (const char*)g.A + (size_t)nxt.pm * tstepA + (nxt.kq < 0 ? (size_t)0 : nxt.kq * ksl) : cA; const char* nB = has_next ? (const char*)g.Bt + (size_t)nxt.pn * tstepB + (nxt.kq < 0 ? (size_t)0 : nxt.kq * ksl) : cB;
        const int nt = cur.kq < 0 ? ntfull : ntsplit;
        const bool sk1 = S.skip1(cur);
        const char* ngA = (const char*)g.A + ((has_next && nxt.kq >= 0) ? nxt.kq * ksl : (size_t)0); if (!has_next) ngA = gA;
        if constexpr (GATHER) { if (has_next) { PG8_GVO(ngvo, nxt); } else {
#pragma unroll
            for (int _h = 0; _h < 2; ++_h) { ngvo[_h][0] = gvo[_h][0]; ngvo[_h][1] = gvo[_h][1]; } } }
        for (int t = 0; t < nt; t += 2) {
            const bool last = (t == nt - 2);
            const char* a1 = cA + (size_t)(t + 1) * kstep;
            const char* a2 = last ? nA : cA + (size_t)(t + 2) * kstep; const char* b2 = last ? nB : cB + (size_t)(t + 2) * kstep;
            const char* a3 = a2 + kstep; const char* b3 = b2 + kstep;
#define PG8_STA11() do { if constexpr (GATHER) PG8_STAGE(PG8_SA(1, 1), gA + (size_t)(t + 1) * kstep, gvo[1]); else PG8_STAGE(PG8_SA(1, 1), a1 + hstepA, voffA); } while (0)
#define PG8_STA00() do { if constexpr (GATHER) { const unsigned v2[2] = {last ? ngvo[0][0] : gvo[0][0], last ? ngvo[0][1] : gvo[0][1]}; PG8_STAGE(PG8_SA(0, 0), last ? ngA : gA + (size_t)(t + 2) * kstep, v2); } else PG8_STAGE(PG8_SA(0, 0), a2, voffA); } while (0)
#define PG8_STA01() do { if constexpr (GATHER) { const unsigned v2[2] = {last ? ngvo[1][0] : gvo[1][0], last ? ngvo[1][1] : gvo[1][1]}; PG8_STAGE(PG8_SA(0, 1), last ? ngA : gA + (size_t)(t + 2) * kstep, v2); } else PG8_STAGE(PG8_SA(0, 1), a2 + hstepA, voffA); } while (0)
#define PG8_STA10() do { if constexpr (GATHER) { const unsigned v2[2] = {last ? ngvo[0][0] : gvo[0][0], last ? ngvo[0][1] : gvo[0][1]}; PG8_STAGE(PG8_SA(1, 0), (last ? ngA : gA + (size_t)(t + 2) * kstep) + kstep, v2); } else PG8_STAGE(PG8_SA(1, 0), a3, voffA); } while (0)
#if GEMM_SP2
            PG8_LDB(B0, 0, 0); PG8_LDB(B1, 0, 1); PG8_SCHED; PG8_LDA(At, 0, 0); PG8_STA11();
            PG8_WAIT_V(8); PG8_WAIT_L(0); PG8_BAR; PG8_MMA(0, 0, At, B0); PG8_MMA(0, 1, At, B1); PG8_BAR; PG8_SCHED;
            PG8_LDA(At, 0, 1); PG8_STAGE(PG8_SB(0, 0), b2, voffB); PG8_STAGE(PG8_SB(0, 1), b2 + hstepB, voffB); PG8_STA00();
            PG8_WAIT_V(8); PG8_WAIT_L(0); PG8_BAR; if (!sk1) { PG8_MMA(1, 0, At, B0); PG8_MMA(1, 1, At, B1); } PG8_BAR; PG8_SCHED;
            PG8_LDB(B0, 1, 0); PG8_LDB(B1, 1, 1); PG8_SCHED; PG8_LDA(At, 1, 0); PG8_STA01();
            PG8_WAIT_V(8); PG8_WAIT_L(0); PG8_BAR; PG8_MMA(0, 0, At, B0); PG8_MMA(0, 1, At, B1); PG8_BAR; PG8_SCHED;
            PG8_LDA(At, 1, 1); PG8_STAGE(PG8_SB(1, 0), b3, voffB); PG8_STAGE(PG8_SB(1, 1), b3 + hstepB, voffB); PG8_STA10();
            PG8_WAIT_V(8); PG8_WAIT_L(0); PG8_BAR; if (!sk1) { PG8_MMA(1, 0, At, B0); PG8_MMA(1, 1, At, B1); } PG8_BAR; PG8_SCHED;
#else
            PG8_LDB(B0, 0, 0); PG8_SCHED; PG8_LDA(At, 0, 0); PG8_STA11();
            PG8_WAIT_L(8); PG8_BAR; PG8_WAIT_L(0); PG8_MMA(0, 0, At, B0); PG8_BAR; PG8_SCHED;
            PG8_LDB(B1, 0, 1); PG8_STAGE(PG8_SB(0, 0), b2, voffB);
            PG8_BAR; PG8_WAIT_L(0); PG8_MMA(0, 1, At, B1); PG8_BAR;
            PG8_LDA(At, 0, 1); PG8_STA00();
            PG8_BAR; PG8_WAIT_L(0); PG8_MMA(1, 0, At, B0); PG8_BAR; PG8_SCHED;
            PG8_STAGE(PG8_SB(0, 1), b2 + hstepB, voffB);
            PG8_WAIT_V(6); PG8_BAR; PG8_MMA(1, 1, At, B1); PG8_BAR;
            PG8_LDB(B0, 1, 0); PG8_SCHED; PG8_LDA(At, 1, 0); PG8_STA01();
            PG8_WAIT_L(8); PG8_BAR; PG8_WAIT_L(0); PG8_MMA(0, 0, At, B0); PG8_BAR; PG8_SCHED;
            PG8_LDB(B1, 1, 1); PG8_STAGE(PG8_SB(1, 0), b3, voffB);
            PG8_BAR; PG8_WAIT_L(0); PG8_MMA(0, 1, At, B1); PG8_BAR;
            PG8_LDA(At, 1, 1); PG8_STA10();
            PG8_BAR; PG8_WAIT_L(0); PG8_MMA(1, 0, At, B0); PG8_BAR; PG8_SCHED;
            PG8_STAGE(PG8_SB(1, 1), b3 + hstepB, voffB);
            PG8_WAIT_V(6); PG8_BAR; PG8_MMA(1, 1, At, B1); PG8_BAR;
#endif
#undef PG8_STA11
#undef PG8_STA00
#undef PG8_STA01
#undef PG8_STA10
        }
#if GEMM_SP2
        if (wr == 0) PG8_BAR;
#endif
        if (g.slab != nullptr && cur.kq >= 0) {
            float* sl = g.slab + ((size_t)cur.sidx * Sched::KS + cur.kq) * 65536 + tid * 4;
#pragma unroll
            for (int a = 0; a < 2; ++a)
#pragma unroll
                for (int b = 0; b < 2; ++b)
#pragma unroll
                    for (int m = 0; m < 4; ++m)
#pragma unroll
                        for (int n = 0; n < 2; ++n) *(f32x4*)(sl + (((a * 2 + b) * 4 + m) * 2 + n) * 2048) = acc[a][b][m][n];
        } else E(acc, cur, wr, wc, fr, fq);
        if (!has_next) break;
#pragma unroll
        for (int a = 0; a < 2; ++a)
#pragma unroll
            for (int b = 0; b < 2; ++b)
#pragma unroll
                for (int m = 0; m < 4; ++m)
#pragma unroll
                    for (int n = 0; n < 2; ++n) acc[a][b][m][n] = (f32x4){0.f, 0.f, 0.f, 0.f};
        cur = nxt; cA = nA; cB = nB; gA = ngA; ++ui;
        if constexpr (GATHER) {
#pragma unroll
            for (int _h = 0; _h < 2; ++_h) { gvo[_h][0] = ngvo[_h][0]; gvo[_h][1] = ngvo[_h][1]; } }
#if GEMM_SP2
        if (wr == 1) PG8_BAR;
#endif
    }
    PG8_WAIT_V(0);
#if !GEMM_SP2
    if (wr == 0) PG8_BAR;
#endif
    PG8_BAR;
#undef PG8_GVO
#undef PG8_SA
#undef PG8_SB
#undef PG8_STAGE
#undef PG8_LDA
#undef PG8_LDB
#undef PG8_MMA
#undef PG8_WAIT_V
#undef PG8_WAIT_L
#undef PG8_BAR
#undef PG8_SCHED
}
template <class Epi, class Sched>
__device__ __forceinline__ void split_reduce(LAS unsigned char* lds, const Gemm g, const Sched& S, const Epi& E, unsigned* tickets) {
    const int tid = threadIdx.x, wid = __builtin_amdgcn_readfirstlane(tid >> 6), lane = tid & 63, wr = wid >> 2, wc = wid & 3, fr = lane & 15, fq = lane >> 4;
    asm volatile("s_waitcnt vmcnt(0)" ::: "memory");
    __syncthreads();
    if (tid == 0) {
        __builtin_amdgcn_fence(__ATOMIC_RELEASE, "agent");
        asm volatile("s_waitcnt vmcnt(0)" ::: "memory");
        for (int i = 0; ; ++i) { Unit u; if (!S.next(i, u)) break; if (u.kq < 0) continue; __hip_atomic_fetch_add(tickets + 64 * u.sidx, 1u, __ATOMIC_RELAXED, __HIP_MEMORY_SCOPE_AGENT); }
    }
    for (int i = 0; ; ++i) { Unit u; if (!S.next(i, u)) break; if (u.kq < 0) continue;
        if (tid == 0) { while (__hip_atomic_load(tickets + 64 * u.sidx, __ATOMIC_RELAXED, __HIP_MEMORY_SCOPE_AGENT) < (unsigned)Sched::KS) __builtin_amdgcn_s_sleep(2);
            __builtin_amdgcn_fence(__ATOMIC_ACQUIRE, "agent"); asm volatile("s_waitcnt vmcnt(0)" ::: "memory"); }
        __syncthreads();
        const int kq0 = u.kq; u.kq = -1;
#pragma unroll 1
        for (int pp = 0; pp < 8 / Sched::KS; ++pp) {
        const int only = kq0 * (8 / Sched::KS) + pp;
        f32x4 t[2][2];
#pragma unroll
        for (int b = 0; b < 2; ++b)
#pragma unroll
            for (int n = 0; n < 2; ++n) t[b][n] = (f32x4){0.f, 0.f, 0.f, 0.f};
        const float* sl0 = g.slab + (size_t)u.sidx * Sched::KS * 65536 + tid * 4 + (size_t)((only >> 2) * 16 + (only & 3) * 2) * 2048;
        f32x4 ld[Sched::KS][2][2];
#pragma unroll
        for (int s = 0; s < Sched::KS; ++s)
#pragma unroll
            for (int b = 0; b < 2; ++b)
#pragma unroll
                for (int n = 0; n < 2; ++n) ld[s][b][n] = __builtin_nontemporal_load((const f32x4*)(sl0 + (size_t)s * 65536 + (b * 8 + n) * 2048));
#pragma unroll
        for (int s = 0; s < Sched::KS; ++s)
#pragma unroll
            for (int b = 0; b < 2; ++b)
#pragma unroll
                for (int n = 0; n < 2; ++n) t[b][n] = t[b][n] + ld[s][b][n];
        f32x4 acc[2][2][4][2];
#pragma unroll
        for (int a = 0; a < 2; ++a)
#pragma unroll
            for (int b = 0; b < 2; ++b)
#pragma unroll
                for (int m = 0; m < 4; ++m)
#pragma unroll
                    for (int n = 0; n < 2; ++n) acc[a][b][m][n] = (a * 4 + m == only) ? t[b][n] : (f32x4){0.f, 0.f, 0.f, 0.f};
        Epi E2 = E; E2.only = only;
        E2(acc, u, wr, wc, fr, fq);
        }
    }
}
struct EpiProj {
    static constexpr bool PERM = true;
    bf16_t* O; int ldc; int npn_main; float* side; int only = -1;
    __device__ __forceinline__ void operator()(const f32x4 (&acc)[2][2][4][2], const Unit& u, int wr, int wc, int fr, int fq) const {
        const int row0 = u.pm * BM + wr * 64 + fr;
        if (u.pn < npn_main) {
            const int col0 = u.pn * BM + wc * 32 + 8 * fq;
#pragma unroll
            for (int ai = 0; ai < 2; ++ai)
#pragma unroll
                for (int m = 0; m < 4; ++m) { if (only >= 0 && only != ai * 4 + m) continue; bf16_t* rowp = O + (size_t)(row0 + ai * HALF + m * 16) * ldc + col0;
#pragma unroll
                    for (int bj = 0; bj < 2; ++bj) { const f32x4 v0 = acc[ai][bj][m][0], v1 = acc[ai][bj][m][1];
                        u32x4 w; w.x = cvt_pk_bf16(v0[0], v0[1]); w.y = cvt_pk_bf16(v0[2], v0[3]); w.z = cvt_pk_bf16(v1[0], v1[1]); w.w = cvt_pk_bf16(v1[2], v1[3]);
                        __builtin_nontemporal_store(w, (u32x4*)(rowp + bj * HALF)); } }
        } else if (wc < 2) {
            const int col0 = wc * 32 + 8 * fq;
#pragma unroll
            for (int ai = 0; ai < 2; ++ai)
#pragma unroll
                for (int m = 0; m < 4; ++m) { if (only >= 0 && only != ai * 4 + m) continue; float* rowp = side + (size_t)(row0 + ai * HALF + m * 16) * 64 + col0;
                    *(f32x4*)(rowp) = acc[ai][0][m][0]; *(f32x4*)(rowp + 4) = acc[ai][0][m][1]; }
        }
    }
};
struct EpiResAdd {
    static constexpr bool PERM = false;
    bf16_t* y2; int ldc; float* part;
    __device__ __forceinline__ void operator()(const f32x4 (&acc)[2][2][4][2], const Unit& u, int wr, int wc, int fr, int fq) const {
        const int col0 = u.pn * BM + wc * 32 + 4 * fq;
        if (u.kq < 0) { const int row0 = u.pm * BM + wr * 64 + fr;
#pragma unroll
            for (int ai = 0; ai < 2; ++ai)
#pragma unroll
                for (int m = 0; m < 4; ++m) { const size_t ro = (size_t)(row0 + ai * HALF + m * 16) * ldc + col0;
#pragma unroll
                    for (int bj = 0; bj < 2; ++bj)
#pragma unroll
                        for (int n = 0; n < 2; ++n) { const f32x4 v = acc[ai][bj][m][n]; u32x2 w; w.x = cvt_pk_bf16(v[0], v[1]); w.y = cvt_pk_bf16(v[2], v[3]); *(u32x2*)(y2 + ro + bj * HALF + n * 16) = w; } }
        } else { const int row0 = u.kq * BM + wr * 64 + fr;
#pragma unroll
            for (int ai = 0; ai < 2; ++ai)
#pragma unroll
                for (int m = 0; m < 4; ++m) { float* rowp = part + (size_t)(row0 + ai * HALF + m * 16) * ldc + col0;
#pragma unroll
                    for (int bj = 0; bj < 2; ++bj)
#pragma unroll
                        for (int n = 0; n < 2; ++n) *(f32x4*)(rowp + bj * HALF + n * 16) = acc[ai][bj][m][n]; }
        }
    }
};
struct EpiMoeUp {
    static constexpr bool PERM = true;
    bf16_t* hid; const float* lw; const float* lrs; const LAS int* tab; int only = -1;
    __device__ __forceinline__ void operator()(const f32x4 (&acc)[2][2][4][2], const Unit& u, int wr, int wc, int fr, int fq) const {
        const int r0 = wr * 64 + fr, col0 = (u.pn & 1) * 128 + wc * 32 + 8 * fq; const int n_e = tab[256 + u.ex];
        float rsv[8], wtv[8];
#pragma unroll
        for (int q = 0; q < 8; ++q) { const int pos = u.pos0 + r0 + (q >> 2) * HALF + (q & 3) * 16; const int pc = pos < n_e ? pos : 0;
            rsv[q] = lrs[(size_t)u.ex * LCAP + pc]; wtv[q] = lw[(size_t)u.ex * LCAP + pc]; if (pos >= n_e) { rsv[q] = 0.f; wtv[q] = 0.f; } }
#pragma unroll
        for (int ai = 0; ai < 2; ++ai)
#pragma unroll
            for (int m = 0; m < 4; ++m) { if (only >= 0 && only != ai * 4 + m) continue; const int s = r0 + ai * HALF + m * 16; const float rs = rsv[ai * 4 + m], wt = wtv[ai * 4 + m] * rs;
                float o[8];
#pragma unroll
                for (int n = 0; n < 2; ++n)
#pragma unroll
                    for (int j = 0; j < 4; ++j) o[n * 4 + j] = siluf_(acc[ai][0][m][n][j] * rs) * acc[ai][1][m][n][j] * wt;
                u32x4 w; w.x = cvt_pk_bf16(o[0], o[1]); w.y = cvt_pk_bf16(o[2], o[3]); w.z = cvt_pk_bf16(o[4], o[5]); w.w = cvt_pk_bf16(o[6], o[7]);
                *(u32x4*)(hid + (size_t)(u.pm * BM + s) * DEXP + col0) = w; }
    }
};
struct EpiMoeDn {
    static constexpr bool PERM = true;
    bf16_t* y; const int* ltok; const LAS int* tab;
    __device__ __forceinline__ void operator()(const f32x4 (&acc)[2][2][4][2], const Unit& u, int wr, int wc, int fr, int fq) const {
        const int r0 = wr * 64 + fr, col0 = (u.pn & 15) * BM + wc * 32 + 8 * fq; const int n_e = tab[256 + u.ex];
        int tokv[8];
#pragma unroll
        for (int q = 0; q < 8; ++q) { const int pos = u.pos0 + r0 + (q >> 2) * HALF + (q & 3) * 16; tokv[q] = ltok[(size_t)u.ex * LCAP + (pos < n_e ? pos : 0)]; if (pos >= n_e) tokv[q] = -1; }
#pragma unroll
        for (int ai = 0; ai < 2; ++ai)
#pragma unroll
            for (int m = 0; m < 4; ++m) { const int tok = tokv[ai * 4 + m];
                if (tok >= 0) { bf16_t* rowp = y + ((size_t)(tok & 1) * MP + (tok >> 1)) * D + col0;
#pragma unroll
                    for (int bj = 0; bj < 2; ++bj) { const f32x4 v0 = acc[ai][bj][m][0], v1 = acc[ai][bj][m][1];
                        u32x4 w; w.x = cvt_pk_bf16(v0[0], v0[1]); w.y = cvt_pk_bf16(v0[2], v0[3]); w.z = cvt_pk_bf16(v1[0], v1[1]); w.w = cvt_pk_bf16(v1[2], v1[3]);
                        *(u32x4*)(rowp + bj * HALF) = w; } } }
    }
};
}

#define XB_TMO      128
#define XB_XCNT(j)  (256  + 64 * (j))
#define XB_XSUB(j)  (1280 + 64 * (j))
#define XB_XGEN(j)  (2304 + 64 * (j))
#define XB_TOP      3328
#define XB_TOPGEN   3392
#define XCD_BAR_WORDS 3456
#define XB_SPIN_CAP (1u << 18)
__device__ __forceinline__ unsigned xb_ld(unsigned* p)              { return __hip_atomic_load(p, __ATOMIC_RELAXED, __HIP_MEMORY_SCOPE_AGENT); }
__device__ __forceinline__ unsigned xb_add(unsigned* p, unsigned v) { return __hip_atomic_fetch_add(p, v, __ATOMIC_RELAXED, __HIP_MEMORY_SCOPE_AGENT); }
__device__ __forceinline__ unsigned xb_xcc_id() { return (unsigned)__builtin_amdgcn_s_getreg((3 << 11) | 20) & 0xFu; }
#define XB_SPIN(cond, bar) do { unsigned _sp = 0; while (cond) { __builtin_amdgcn_s_sleep(1); \
    if ((++_sp & 255u) == 0u) { if (xb_ld(&(bar)[XB_TMO])) break; if (_sp > XB_SPIN_CAP) { atomicAdd(&(bar)[XB_TMO], 1u); break; } } } } while (0)
struct XcdBarrier { unsigned* bar; unsigned x; volatile LAS unsigned* st; };
__device__ __forceinline__ XcdBarrier xcd_barrier_post(unsigned* bar, volatile LAS unsigned* st) {
    XcdBarrier b; b.bar = bar; b.x = xb_xcc_id(); b.st = st;
    if (threadIdx.x == 0) (void)xb_add(&bar[XB_XCNT(b.x)], 1u);
    return b;
}
__device__ __forceinline__ void xcd_barrier_complete(unsigned* bar, unsigned x, unsigned& nloc, unsigned& nx) {
    const unsigned G = gridDim.x * gridDim.y * gridDim.z;
    unsigned sum, cnt, mine, sp = 0u;
    for (;;) {
        sum = 0u; cnt = 0u; mine = 0u;
#pragma unroll
        for (unsigned j = 0; j < 16; ++j) { const unsigned c = xb_ld(&bar[XB_XCNT(j)]); sum += c; cnt += (c > 0u) ? 1u : 0u; mine = (j == x) ? c : mine; }
        if (sum == G) break;
        __builtin_amdgcn_s_sleep(1);
        if ((++sp & 255u) == 0u) { if (xb_ld(&bar[XB_TMO])) break; if (sp > XB_SPIN_CAP) { atomicAdd(&bar[XB_TMO], 1u); break; } }
    }
    nloc = mine > 0u ? mine : 1u; nx = cnt > 0u ? cnt : 1u;
}
__device__ __forceinline__ void xcd_barrier(const XcdBarrier& b) {
    asm volatile("s_waitcnt vmcnt(0)" ::: "memory");
    __syncthreads();
    if (threadIdx.x == 0) {
        unsigned* bar = b.bar;
        __builtin_amdgcn_s_waitcnt(0);
        unsigned nloc = b.st[0], nx = b.st[1];
        if (nloc == 0u) { xcd_barrier_complete(bar, b.x, nloc, nx); b.st[0] = nloc; b.st[1] = nx; }
        const unsigned old = xb_add(&bar[XB_XSUB(b.x)], 1u);
        const unsigned gen = old / nloc;
        if (old + 1u == (gen + 1u) * nloc) {
            __builtin_amdgcn_fence(__ATOMIC_RELEASE, "agent");
            asm volatile("s_waitcnt vmcnt(0)" ::: "memory");
            const unsigned og = xb_add(&bar[XB_TOP], 1u);
            const unsigned tg = og / nx;
            if (og + 1u == (tg + 1u) * nx) xb_add(&bar[XB_TOPGEN], 1u);
            else XB_SPIN(xb_ld(&bar[XB_TOPGEN]) == tg, bar);
            __builtin_amdgcn_fence(__ATOMIC_ACQUIRE, "agent");
            xb_add(&bar[XB_XGEN(b.x)], 1u);
            asm volatile("s_waitcnt vmcnt(0)" ::: "memory");
        } else {
            XB_SPIN(xb_ld(&bar[XB_XGEN(b.x)]) == gen, bar);
            __builtin_amdgcn_fence(__ATOMIC_ACQUIRE, "agent");
            asm volatile("s_waitcnt vmcnt(0)" ::: "memory");
        }
    }
    __syncthreads();
}

struct Args { const float* in[29]; float* out; unsigned char* ws; int ph_lo, ph_hi, flags, pad; };
enum { I_X = 0, I_META, I_MIXN, I_FFNN, I_FINN, I_EVWIN, I_EVGB, I_EVQKC, I_EVLRUP, I_EVLRB, I_EVNA, I_EVNB, I_EVWOUT, I_ODWIN, I_ODCONV, I_ODCONVB, I_ODWR, I_ODBR, I_ODWI, I_ODBI, I_ODLAM, I_ODWOUT,
       I_MWG, I_MBG, I_MWE, I_MBE, I_MW1, I_MW3, I_MW2 };


#define LDS_WAIT() asm volatile("s_waitcnt lgkmcnt(0)" ::: "memory")

struct TrJob { const float* Wc; size_t ldw; bf16_t* WT; size_t ldt; int k0, n0; };
__device__ __forceinline__ void tr_load(const TrJob& j, int lane, f32x4 (&v)[16]) {
#pragma unroll
    for (int i = 0; i < 16; ++i) { const int kk = 4 * i + (lane >> 4); v[i] = j.Wc ? __builtin_nontemporal_load((const f32x4*)(j.Wc + (size_t)(j.k0 + kk) * j.ldw)) : (f32x4){0.f, 0.f, 0.f, 0.f}; }
}
template <bool NT = false>
__device__ __forceinline__ void tr_finish(const TrJob& j, const f32x4 (&v)[16], LAS float* scr, int lane) {
    const int c4 = (lane & 15) * 4;
#pragma unroll
    for (int i = 0; i < 16; ++i) { const int kk = 4 * i + (lane >> 4); LAS float* d = scr + kk * 65 + c4; d[0] = v[i][0]; d[1] = v[i][1]; d[2] = v[i][2]; d[3] = v[i][3]; }
    LDS_WAIT();
    const int c = lane & 7;
#pragma unroll
    for (int jn = 0; jn < 8; ++jn) { const int n = (lane >> 3) + 8 * jn; const LAS float* s = scr + (8 * c) * 65 + n;
        u32x4 o; o.x = cvt_pk_bf16(s[0 * 65], s[1 * 65]); o.y = cvt_pk_bf16(s[2 * 65], s[3 * 65]); o.z = cvt_pk_bf16(s[4 * 65], s[5 * 65]); o.w = cvt_pk_bf16(s[6 * 65], s[7 * 65]);
        if (NT) __builtin_nontemporal_store(o, (u32x4*)(j.WT + (size_t)(j.n0 + n) * j.ldt + j.k0 + 8 * c)); else *(u32x4*)(j.WT + (size_t)(j.n0 + n) * j.ldt + j.k0 + 8 * c) = o; }
    LDS_WAIT();
}
template <bool NT = false>
__device__ __forceinline__ void tr_item(const float* Wc, size_t ldw, bf16_t* WT, size_t ldt, int k0, int n0, LAS float* scr, int lane) {
    const TrJob j{Wc, ldw, WT, ldt, k0, n0}; f32x4 v[16]; tr_load(j, lane, v); tr_finish<NT>(j, v, scr, lane);
}
constexpr int MOE_ITEMS = 32 * 64 * 8 + 32 * 4 * 64, OD_ITEMS = 64 * 160 + 80 * 64 + 64 * 25, QBATCH = 4;
__device__ __forceinline__ void moe_item(const Args& a, int layer, int it, LAS float* scr, int lane) {
    unsigned char* wsw = a.ws + WS_W; constexpr int I_UP = 32 * 64 * 8; const int c4 = (lane & 15) * 4;
    if (it < I_UP) { const int e = it >> 9, r = it & 511, kb = r >> 3, nb = r & 7; const int n = 64 * nb;
        const float* src = ((n & 255) < 128 ? a.in[I_MW1] : a.in[I_MW3]) + ((size_t)(layer * NEXP + e)) * 4096 * 256 + ((n >> 8) * 128 + (n & 127)) + c4;
        tr_item<true>(src, 256, (bf16_t*)(wsw + W_UP) + (size_t)e * 512 * 4096, 4096, 64 * kb, 64 * nb, scr, lane);
    } else { const int r0 = it - I_UP, e = r0 >> 8, r = r0 & 255, kb = r >> 6, nb = r & 63;
        const float* src = a.in[I_MW2] + ((size_t)(layer * NEXP + e)) * 256 * 4096 + 64 * nb + c4;
        tr_item<true>(src, 4096, (bf16_t*)(wsw + W_DN) + (size_t)e * 4096 * 256, 256, 64 * kb, 64 * nb, scr, lane); }
}
__device__ __forceinline__ void od_item(const Args& a, int it, LAS float* scr, int lane) {
    unsigned char* wsw = a.ws + WS_W; constexpr int I_A = 64 * 160, I_B = 80 * 64; const int c4 = (lane & 15) * 4;
    if (it < I_A) { const int kb = it / 160, nb = it % 160;
        tr_item<true>(a.in[I_ODWIN] + 64 * nb + c4, NPROJ1, (bf16_t*)(wsw + W_IN), 4096, 64 * kb, 64 * nb, scr, lane);
    } else if (it < I_A + I_B) { const int r = it - I_A, kb = r >> 6, nb = r & 63;
        tr_item<true>(a.in[I_ODWOUT] + 64 * nb + c4, 4096, (bf16_t*)(wsw + W_OUT1), DR, 64 * kb, 64 * nb, scr, lane);
    } else { const int r = it - I_A - I_B, mm = r / 25, q = r % 25, kb = q / 5, nb = q % 5;
        const float* src = ((mm & 1) ? a.in[I_ODWI] : a.in[I_ODWR]) + (size_t)(mm >> 1) * 320 * 320 + 64 * nb + c4;
        tr_item<true>(src, 320, (bf16_t*)(wsw + W_RI) + (size_t)mm * 320 * 320, 320, 64 * kb, 64 * nb, scr, lane); }
}
__device__ __forceinline__ TrJob moe_job(const Args& a, int layer, int it, int lane) {
    unsigned char* wsw = a.ws + WS_W; constexpr int I_UP = 32 * 64 * 8; const int c4 = (lane & 15) * 4;
    if (it < I_UP) { const int e = it >> 9, r = it & 511, kb = r >> 3, nb = r & 7; const int n = 64 * nb;
        const float* src = ((n & 255) < 128 ? a.in[I_MW1] : a.in[I_MW3]) + ((size_t)(layer * NEXP + e)) * 4096 * 256 + ((n >> 8) * 128 + (n & 127)) + c4;
        return TrJob{src, 256, (bf16_t*)(wsw + W_UP) + (size_t)e * 512 * 4096, 4096, 64 * kb, 64 * nb}; }
    const int r0 = it - I_UP, e = r0 >> 8, r = r0 & 255, kb = r >> 6, nb = r & 63;
    return TrJob{a.in[I_MW2] + ((size_t)(layer * NEXP + e)) * 256 * 4096 + 64 * nb + c4, 4096, (bf16_t*)(wsw + W_DN) + (size_t)e * 4096 * 256, 256, 64 * kb, 64 * nb};
}
__device__ __forceinline__ void queue_moe(const Args& a, int layer, unsigned* q, LAS float* scr, int lane) {
    int nbase = 0; if (lane == 0) nbase = (int)__hip_atomic_fetch_add(q, (unsigned)QBATCH, __ATOMIC_RELAXED, __HIP_MEMORY_SCOPE_AGENT);
    for (;;) { const int base = __builtin_amdgcn_readfirstlane(nbase); if (base >= MOE_ITEMS) break;
        if (lane == 0) nbase = (int)__hip_atomic_fetch_add(q, (unsigned)QBATCH, __ATOMIC_RELAXED, __HIP_MEMORY_SCOPE_AGENT);
        const int n = (MOE_ITEMS - base) < QBATCH ? (MOE_ITEMS - base) : QBATCH;
        f32x4 v0[16], v1[16]; TrJob j0 = moe_job(a, layer, base, lane), j1 = j0; tr_load(j0, lane, v0);
#pragma unroll 1
        for (int k = 0; k < n; k += 2) {
            if (k + 1 < n) { j1 = moe_job(a, layer, base + k + 1, lane); tr_load(j1, lane, v1); }
            tr_finish<true>(j0, v0, scr, lane);
            if (k + 1 < n) { if (k + 2 < n) { j0 = moe_job(a, layer, base + k + 2, lane); tr_load(j0, lane, v0); }
                tr_finish<true>(j1, v1, scr, lane); } } }
}
constexpr int OD_BITE_MAX = 64 * 160;
__device__ __forceinline__ void queue_od_some(const Args& a, unsigned* qb, LAS float* scr, int lane, int nbatch) {
    for (int bb = 0; bb < nbatch; ++bb) { int base = 0; if (lane == 0) base = (int)__hip_atomic_fetch_add(qb, (unsigned)QBATCH, __ATOMIC_RELAXED, __HIP_MEMORY_SCOPE_AGENT);
        base = __builtin_amdgcn_readfirstlane(base); if (base >= OD_BITE_MAX) break;
        for (int it = base; it < base + QBATCH; ++it) od_item(a, it, scr, lane); }
}
__device__ __forceinline__ void queue_od(const Args& a, unsigned* q, const unsigned* qb, LAS float* scr, int lane) {
    int done = (int)__hip_atomic_load(qb, __ATOMIC_RELAXED, __HIP_MEMORY_SCOPE_AGENT); done = __builtin_amdgcn_readfirstlane(done); if (done > OD_BITE_MAX) done = OD_BITE_MAX;
    for (;;) { int base = 0; if (lane == 0) base = (int)__hip_atomic_fetch_add(q, (unsigned)QBATCH, __ATOMIC_RELAXED, __HIP_MEMORY_SCOPE_AGENT);
        base = __builtin_amdgcn_readfirstlane(base) + done; if (base >= OD_ITEMS) break;
        for (int it = base; it < base + QBATCH && it < OD_ITEMS; ++it) od_item(a, it, scr, lane); }
}
__device__ __forceinline__ void router_table(const Args& a, int layer, int gw, int NGW, int lane) {
    bf16_t* rth = (bf16_t*)(a.ws + WS_W + W_RT); bf16_t* rtl = rth + 48 * D; const float* gf = a.in[I_FFNN] + layer * D;
    for (int i = gw * 64 + lane; i < 48 * D; i += NGW * 64) { const int j = i >> 12, d = i & 4095;
        const float w = j < 4 ? a.in[I_MWG][((size_t)layer * D + d) * 4 + j] : (j < 36 ? a.in[I_MWE][((size_t)layer * D + d) * 32 + (j - 4)] : 0.f);
        const float v = gf[d] * w; const unsigned short hi = f2bf(v); rth[i] = hi; rtl[i] = f2bf(v - bf2f(hi)); }
}
__device__ __forceinline__ void conv_layer0(const Args& a, int gw, int NGW, LAS float* scr, int lane) {
    unsigned char* wsw = a.ws + WS_W;
    constexpr int NBLK = NW0 / 64, I_A = 64 * NBLK, I_B = 64 * 64;
    const int c4 = (lane & 15) * 4;
    for (int it = gw; it < I_A + I_B; it += NGW) {
        if (it < I_A) { static_assert(NBLK % 4 == 0, "4-wide column blocks");
            const int st = it >> 6, wi = it & 63, kb = (st / (NBLK / 4)) * 16 + (wi >> 2), nb = (st % (NBLK / 4)) * 4 + (wi & 3); const int n = 64 * nb + c4;
            const int col = n < 6144 ? n : (n < 12288 ? n + 16 : (n < 12304 ? 6144 + (n - 12288) : (n < 12336 ? n : -1)));
            tr_item(col >= 0 ? a.in[I_EVWIN] + col : nullptr, 12336, (bf16_t*)(wsw + W_IN), 4096, 64 * kb, 64 * nb, scr, lane);
        } else { const int r = it - I_A, st = r >> 6, wi = r & 63, kb = (st >> 4) * 16 + (wi >> 2), nb = (st & 15) * 4 + (wi & 3);
            tr_item<true>(a.in[I_EVWOUT] + 64 * nb + c4, 4096, (bf16_t*)(wsw + W_OUT0), 4096, 64 * kb, 64 * nb, scr, lane); }
    }
}

__device__ __forceinline__ void load_row(const float* p, int lane, f32x4 (&v)[16]) {
#pragma unroll
    for (int j = 0; j < 16; ++j) v[j] = *(const f32x4*)(p + (j * 64 + lane) * 4);
}
__device__ __forceinline__ void load_row_nt(const float* p, int lane, f32x4 (&v)[16]) {
#pragma unroll
    for (int j = 0; j < 16; ++j) v[j] = __builtin_nontemporal_load((const f32x4*)(p + (j * 64 + lane) * 4));
}
__device__ __forceinline__ float row_ss(const f32x4 (&v)[16]) { float s = 0.f;
#pragma unroll
    for (int j = 0; j < 16; ++j) s += (v[j][0] * v[j][0] + v[j][1] * v[j][1]) + (v[j][2] * v[j][2] + v[j][3] * v[j][3]);
    return wave_sum(s); }
__device__ __forceinline__ void store_row_bf16_scaled(bf16_t* o, const f32x4 (&v)[16], float rstd, const float* g, int lane) {
#pragma unroll
    for (int j = 0; j < 16; ++j) { const f32x4 gg = *(const f32x4*)(g + (j * 64 + lane) * 4);
        u32x2 w; w.x = cvt_pk_bf16(v[j][0] * rstd * gg[0], v[j][1] * rstd * gg[1]); w.y = cvt_pk_bf16(v[j][2] * rstd * gg[2], v[j][3] * rstd * gg[3]);
        *(u32x2*)(o + (j * 64 + lane) * 4) = w; }
}
__device__ __forceinline__ void zero_row_bf16(bf16_t* o, int lane) {
#pragma unroll
    for (int j = 0; j < 8; ++j) *(u32x4*)(o + (j * 64 + lane) * 8) = (u32x4){0u, 0u, 0u, 0u};
}
__device__ __forceinline__ void load_row_bf16(const bf16_t* y, int lane, f32x4 (&v)[16]) {
#pragma unroll
    for (int j = 0; j < 16; ++j) { const u32x2 w = *(const u32x2*)(y + (j * 64 + lane) * 4);
        v[j] = (f32x4){__uint_as_float(w.x << 16), __uint_as_float(w.x & 0xffff0000u), __uint_as_float(w.y << 16), __uint_as_float(w.y & 0xffff0000u)}; }
}
__device__ __forceinline__ void store_row_bf16(bf16_t* o, const f32x4 (&v)[16], int lane) {
#pragma unroll
    for (int j = 0; j < 16; ++j) { u32x2 w; w.x = cvt_pk_bf16(v[j][0], v[j][1]); w.y = cvt_pk_bf16(v[j][2], v[j][3]); __builtin_nontemporal_store(w, (u32x2*)(o + (j * 64 + lane) * 4)); }
}
__device__ __forceinline__ void add_y(f32x4 (&v)[16], const bf16_t* y, int lane) {
#pragma unroll
    for (int j = 0; j < 16; ++j) { const u32x2 w = *(const u32x2*)(y + (j * 64 + lane) * 4);
        v[j][0] += __uint_as_float(w.x << 16); v[j][1] += __uint_as_float(w.x & 0xffff0000u); v[j][2] += __uint_as_float(w.y << 16); v[j][3] += __uint_as_float(w.y & 0xffff0000u); }
}

__device__ __forceinline__ void p0_rows(const Args& a, int gw, int NGW, int lane) {
    float* H = (float*)(a.ws + WS_H); bf16_t* XN = (bf16_t*)((unsigned char*)a.out + DO_XN);
    for (int r = gw; r < MP; r += NGW) {
        if (row_valid(r)) { const int b = r >= TP ? 1 : 0, p = r - b * TP;
            const float* src = p < 64 ? a.in[I_META] + (size_t)(p - PADF) * D : a.in[I_X] + ((size_t)b * SEQ + (p - 64)) * D;
            f32x4 v[16]; load_row_nt(src, lane, v); const float rstd = rsqrtf(row_ss(v) * (1.0f / D) + EPS);
            if (r >= 16384) {
#pragma unroll
                for (int j = 0; j < 16; ++j) *(f32x4*)(H + (size_t)r * D + (j * 64 + lane) * 4) = v[j]; }
            store_row_bf16_scaled(XN + (size_t)r * D, v, rstd, a.in[I_MIXN], lane);
        } else {
            if (r >= 16384) {
#pragma unroll
                for (int j = 0; j < 16; ++j) *(f32x4*)(H + (size_t)r * D + (j * 64 + lane) * 4) = (f32x4){0.f, 0.f, 0.f, 0.f}; }
            zero_row_bf16(XN + (size_t)r * D, lane); }
    }
}
__device__ __forceinline__ void p8_rows(const Args& a, int gw, int NGW, int lane) {
    float* H = (float*)(a.ws + WS_H); bf16_t* XN = (bf16_t*)((unsigned char*)a.out + DO_XN); const bf16_t* Y = (const bf16_t*)(a.ws + WS_HS);
    for (int r = gw; r < MP; r += NGW) {
        if (row_valid(r)) { f32x4 v[16];
            if (r < 16384) { const int b = r >= TP ? 1 : 0, p = r - b * TP;
                const float* px = (p < 64 ? a.in[I_META] + (size_t)(p - PADF) * D : a.in[I_X] + ((size_t)b * SEQ + (p - 64)) * D) + lane * 4;
                const size_t o_ = (size_t)r * D + lane * 4; const bf16_t* p2 = (const bf16_t*)(a.ws + WS_PROJ) + o_; const bf16_t* pa_ = Y + o_; const bf16_t* pb_ = Y + (size_t)MP * D + o_;
                u32x2 r2[16], ra[16], rb[16];
#pragma unroll
                for (int j = 0; j < 16; ++j) { v[j] = __builtin_nontemporal_load((const f32x4*)(px + j * 256)); r2[j] = __builtin_nontemporal_load((const u32x2*)(p2 + j * 256)); ra[j] = __builtin_nontemporal_load((const u32x2*)(pa_ + j * 256)); rb[j] = __builtin_nontemporal_load((const u32x2*)(pb_ + j * 256)); }
#pragma unroll
                for (int j = 0; j < 16; ++j) {
                    v[j] = v[j] + (f32x4){__uint_as_float(r2[j].x << 16), __uint_as_float(r2[j].x & 0xffff0000u), __uint_as_float(r2[j].y << 16), __uint_as_float(r2[j].y & 0xffff0000u)};
                    v[j] = v[j] + (f32x4){__uint_as_float(ra[j].x << 16), __uint_as_float(ra[j].x & 0xffff0000u), __uint_as_float(ra[j].y << 16), __uint_as_float(ra[j].y & 0xffff0000u)};
                    v[j] = v[j] + (f32x4){__uint_as_float(rb[j].x << 16), __uint_as_float(rb[j].x & 0xffff0000u), __uint_as_float(rb[j].y << 16), __uint_as_float(rb[j].y & 0xffff0000u)}; } }
            else { load_row(H + (size_t)r * D, lane, v); add_y(v, Y + (size_t)r * D, lane); add_y(v, Y + ((size_t)MP + r) * D, lane); }
            const float rstd = rsqrtf(row_ss(v) * (1.0f / D) + EPS);
            if (r < 16384) store_row_bf16((bf16_t*)H + (size_t)r * D, v, lane);
            else {
#pragma unroll
                for (int j = 0; j < 16; ++j) *(f32x4*)(H + (size_t)r * D + (j * 64 + lane) * 4) = v[j]; }
            store_row_bf16_scaled(XN + (size_t)r * D, v, rstd, a.in[I_MIXN] + D, lane);
        } else zero_row_bf16(XN + (size_t)r * D, lane);
    }
}
__device__ __forceinline__ void pfinal_rows(const Args& a, int gw, int NGW, int lane, int addy) {
    const float* H = (const float*)(a.ws + WS_H); const bf16_t* Y = (const bf16_t*)(a.ws + WS_HS);
    constexpr int NMAIN = SEQ + (16384 - TP - 64);
    if (addy) {
        u32x2 rh[16], r2[16], ra[16], rb[16];
#define PF_LOADS(ii) do { const int b_ = (ii) >> 13, r_ = b_ * TP + 64 + ((ii) & (SEQ - 1)); const size_t o_ = (size_t)r_ * D + lane * 4; \
            const bf16_t* ph = (const bf16_t*)H + o_; const bf16_t* p2 = (const bf16_t*)(a.ws + WS_PROJ) + o_; const bf16_t* pa_ = Y + o_; const bf16_t* pb_ = Y + (size_t)MP * D + o_; \
            _Pragma("unroll") for (int j = 0; j < 16; ++j) { rh[j] = __builtin_nontemporal_load((const u32x2*)(ph + j * 256)); r2[j] = __builtin_nontemporal_load((const u32x2*)(p2 + j * 256)); ra[j] = __builtin_nontemporal_load((const u32x2*)(pa_ + j * 256)); rb[j] = __builtin_nontemporal_load((const u32x2*)(pb_ + j * 256)); } } while (0)
        int i = gw; if (i < NMAIN) PF_LOADS(i);
        while (i < NMAIN) {
            f32x4 v[16];
#pragma unroll
            for (int j = 0; j < 16; ++j) {
                v[j] = (f32x4){__uint_as_float(rh[j].x << 16), __uint_as_float(rh[j].x & 0xffff0000u), __uint_as_float(rh[j].y << 16), __uint_as_float(rh[j].y & 0xffff0000u)};
                v[j] = v[j] + (f32x4){__uint_as_float(r2[j].x << 16), __uint_as_float(r2[j].x & 0xffff0000u), __uint_as_float(r2[j].y << 16), __uint_as_float(r2[j].y & 0xffff0000u)};
                v[j] = v[j] + (f32x4){__uint_as_float(ra[j].x << 16), __uint_as_float(ra[j].x & 0xffff0000u), __uint_as_float(ra[j].y << 16), __uint_as_float(ra[j].y & 0xffff0000u)};
                v[j] = v[j] + (f32x4){__uint_as_float(rb[j].x << 16), __uint_as_float(rb[j].x & 0xffff0000u), __uint_as_float(rb[j].y << 16), __uint_as_float(rb[j].y & 0xffff0000u)}; }
            const int inext = i + NGW;
            const float rstd = rsqrtf(row_ss(v) * (1.0f / D) + EPS);
#pragma unroll
            for (int j = 0; j < 16; ++j) { const f32x4 gg = *(const f32x4*)(a.in[I_FINN] + (j * 64 + lane) * 4);
                __builtin_nontemporal_store((f32x4){v[j][0] * rstd * gg[0], v[j][1] * rstd * gg[1], v[j][2] * rstd * gg[2], v[j][3] * rstd * gg[3]}, (f32x4*)(a.out + (size_t)i * D + (j * 64 + lane) * 4)); }
            if (inext < NMAIN) PF_LOADS(inext);
            i = inext; }
#undef PF_LOADS
    }
    for (int i = (addy ? NMAIN : 0) + gw; i < NBATCH * SEQ; i += NGW) { const int b = i >> 13, t = i & (SEQ - 1), r = b * TP + 64 + t;
        f32x4 v[16]; if (r < 16384) load_row_bf16((const bf16_t*)H + (size_t)r * D, lane, v); else load_row(H + (size_t)r * D, lane, v);
        if (addy) { add_y(v, Y + (size_t)r * D, lane); add_y(v, Y + ((size_t)MP + r) * D, lane); }
        const float rstd = rsqrtf(row_ss(v) * (1.0f / D) + EPS);
#pragma unroll
        for (int j = 0; j < 16; ++j) { const f32x4 gg = *(const f32x4*)(a.in[I_FINN] + (j * 64 + lane) * 4);
            *(f32x4*)(a.out + (size_t)i * D + (j * 64 + lane) * 4) = (f32x4){v[j][0] * rstd * gg[0], v[j][1] * rstd * gg[1], v[j][2] * rstd * gg[2], v[j][3] * rstd * gg[3]}; }
    }
}

__device__ __forceinline__ void route_one(const float (&lg)[36], const float* bg, const float* be, int& e1, int& e2, float& w1, float& w2) {
    float gl[4];
#pragma unroll
    for (int g = 0; g < 4; ++g) gl[g] = lg[g] + bg[g];
    int gi = 0; float gm = gl[0];
#pragma unroll
    for (int g = 1; g < 4; ++g) if (gl[g] > gm) { gm = gl[g]; gi = g; }
    float gs = 0.f;
#pragma unroll
    for (int g = 0; g < 4; ++g) gs += __expf(gl[g] - gm);
    const float gval = 1.0f / gs;
    float el[8];
#pragma unroll
    for (int e = 0; e < 8; ++e) { float x = lg[4 + e] + be[e];
#pragma unroll
        for (int g = 1; g < 4; ++g) { const float y = lg[4 + g * 8 + e] + be[g * 8 + e]; x = (gi == g) ? y : x; }
        el[e] = x; }
    int i1 = 0; float m1 = el[0];
#pragma unroll
    for (int e = 1; e < 8; ++e) if (el[e] > m1) { m1 = el[e]; i1 = e; }
    int i2 = -1; float m2 = -3.0e38f;
#pragma unroll
    for (int e = 0; e < 8; ++e) if (e != i1 && el[e] > m2) { m2 = el[e]; i2 = e; }
    const float p2 = __expf(m2 - m1), s = 1.0f / (1.0f + p2);
    e1 = gi * 8 + i1; e2 = gi * 8 + i2; w1 = s * gval; w2 = p2 * s * gval;
}
__device__ __forceinline__ void route_rows(const Args& a, LAS unsigned char* lds, int wave, int layer, int gw, int NGW, int lane) {
    float* H = (float*)(a.ws + WS_H); bf16_t* XN = (bf16_t*)((unsigned char*)a.out + DO_XN); const bf16_t* Y2 = (const bf16_t*)(a.ws + WS_PROJ);
    const bf16_t* rth = (const bf16_t*)(a.ws + WS_W + W_RT); const bf16_t* rtl = rth + 48 * D; const float* gf = a.in[I_FFNN] + layer * D;
    const float* bg = a.in[I_MBG] + layer * 4; const float* be = a.in[I_MBE] + layer * 32;
    unsigned* cnt = (unsigned*)(a.ws + WS_CTL) + CW_CNT + layer * 2048;
    int* ltok = (int*)((unsigned char*)a.out + DO_LTOK) + (size_t)layer * NEXP * LCAP; float* lw = (float*)((unsigned char*)a.out + DO_LW) + (size_t)layer * NEXP * LCAP;
    float* lrs = (float*)((unsigned char*)a.out + DO_LRS) + (size_t)layer * NEXP * LCAP;
    const int g = lane >> 4, l15 = lane & 15;
    LAS float* lgs = (LAS float*)lds;
    const int G = NGW >> 3, bid = gw >> 3;
    for (int r = gw; r < MP; r += NGW) { const int grp = r >> 4; const bool skip = grp < 3 || (grp >= 516 && grp < 519) || grp >= 1032;
        if (skip) zero_row_bf16(XN + (size_t)r * D, lane); }
    const int k0 = 512 * wave;
    int task = 0; bool act = false, fromx = false, hb16 = false, addy = false; float* hsrc = H; const bf16_t* ysrc = Y2; const bf16_t* hbsrc = (const bf16_t*)H;
    f32x4 R[8]; u32x2 Yv[8], Hv[8];
#define RT_SETUP(rnd) do { const int t_ = (rnd) * G + bid; act = t_ < 1026; task = t_ < 513 ? 3 + t_ : 519 + (t_ - 513); if (!act) task = 3; \
        hsrc = H + (size_t)(task * 16 + (lane >> 5)) * D + k0 + (lane & 31) * 4; fromx = layer == 0 && task < 1024;     \
        ysrc = Y2 + (size_t)(task * 16 + (lane >> 5)) * D + k0 + (lane & 31) * 4; \
        hb16 = layer == 1 && task < 1024;        \
        hbsrc = (const bf16_t*)H + (size_t)(task * 16 + (lane >> 5)) * D + k0 + (lane & 31) * 4; \
        addy = task < 1024;        } while (0)
#define RT_LOAD(stg) do { _Pragma("unroll") for (int i = 0; i < 8; ++i) { const float* hs = hsrc + (size_t)(2 * i) * D; \
                if (fromx) { const int r = task * 16 + 2 * i + (lane >> 5), b = r >= TP ? 1 : 0, p = r - b * TP; hs = (p < 64 ? a.in[I_META] + (size_t)(p - PADF) * D : a.in[I_X] + ((size_t)b * SEQ + (p - 64)) * D) + k0 + (lane & 31) * 4; } \
                if (hb16) Hv[i] = __builtin_nontemporal_load((const u32x2*)(hbsrc + (size_t)(2 * i) * D + 128 * (stg)));        \
                else R[i] = __builtin_nontemporal_load((const f32x4*)(hs + 128 * (stg)));        \
                Yv[i] = addy ? __builtin_nontemporal_load((const u32x2*)(ysrc + (size_t)(2 * i) * D + 128 * (stg))) : (u32x2){0u, 0u}; } } while (0)
#define RT_SUM(stg) do { if (hb16) { _Pragma("unroll") for (int i = 0; i < 8; ++i) R[i] = (f32x4){__uint_as_float(Hv[i].x << 16), __uint_as_float(Hv[i].x & 0xffff0000u), __uint_as_float(Hv[i].y << 16), __uint_as_float(Hv[i].y & 0xffff0000u)}; } \
            if (addy) { _Pragma("unroll") for (int i = 0; i < 8; ++i) { R[i][0] += __uint_as_float(Yv[i].x << 16); R[i][1] += __uint_as_float(Yv[i].x & 0xffff0000u); R[i][2] += __uint_as_float(Yv[i].y << 16); R[i][3] += __uint_as_float(Yv[i].y & 0xffff0000u); \
                } } } while (0)
    RT_SETUP(0); if (act) RT_LOAD(0);
    for (int round = 0; round * G < 1026; ++round) {
        const bool cact = act; const int ctask = task;
        if (layer == 0 && round == 4 && !cact) queue_od_some(a, (unsigned*)(a.ws + WS_CTL) + CW_Q + 192, (LAS float*)(lds + wave * 16896), lane, 1);
        f32x4 acc[3]; acc[0] = acc[1] = acc[2] = (f32x4){0.f, 0.f, 0.f, 0.f};
        float ss = 0.f;
        if (cact) {
            const int row = ctask * 16 + l15;
            bf16_t* xp = XN + (size_t)row * D + 8 * g + k0; const float* gp = gf + 8 * g + k0;
            const bf16_t* bh = rth + (size_t)l15 * D + 8 * g + k0; const bf16_t* bl = rtl + (size_t)l15 * D + 8 * g + k0;
            LAS unsigned char* hb = lds + 32768 + wave * 8704;
#pragma unroll 1
            for (int st = 0; st < 4; ++st) {
                RT_SUM(st);
#pragma unroll
                for (int i = 0; i < 8; ++i) *(LAS f32x4*)(hb + (2 * i + (lane >> 5)) * 544 + (lane & 31) * 16) = R[i];
                LDS_WAIT();
                if (st + 1 < 4) RT_LOAD(st + 1);
#pragma unroll
                for (int kk = 0; kk < 4; ++kk) { const int ks = 4 * st + kk;
                    const f32x4 h0 = *(const LAS f32x4*)(hb + l15 * 544 + (32 * kk + 8 * g) * 4), h1 = *(const LAS f32x4*)(hb + l15 * 544 + (32 * kk + 8 * g + 4) * 4);
                    const f32x4 g0 = *(const f32x4*)(gp + 32 * ks), g1 = *(const f32x4*)(gp + 32 * ks + 4);
                    ss += (h0[0] * h0[0] + h0[1] * h0[1]) + (h0[2] * h0[2] + h0[3] * h0[3]) + (h1[0] * h1[0] + h1[1] * h1[1]) + (h1[2] * h1[2] + h1[3] * h1[3]);
                    u32x4 xo; xo.x = cvt_pk_bf16(h0[0] * g0[0], h0[1] * g0[1]); xo.y = cvt_pk_bf16(h0[2] * g0[2], h0[3] * g0[3]); xo.z = cvt_pk_bf16(h1[0] * g1[0], h1[1] * g1[1]); xo.w = cvt_pk_bf16(h1[2] * g1[2], h1[3] * g1[3]);
                    *(u32x4*)(xp + 32 * ks) = xo;
                    u32x4 hi; hi.x = cvt_pk_bf16(h0[0], h0[1]); hi.y = cvt_pk_bf16(h0[2], h0[3]); hi.z = cvt_pk_bf16(h1[0], h1[1]); hi.w = cvt_pk_bf16(h1[2], h1[3]);
                    u32x4 lo; lo.x = cvt_pk_bf16(h0[0] - __uint_as_float(hi.x << 16), h0[1] - __uint_as_float(hi.x & 0xffff0000u)); lo.y = cvt_pk_bf16(h0[2] - __uint_as_float(hi.y << 16), h0[3] - __uint_as_float(hi.y & 0xffff0000u));
                    lo.z = cvt_pk_bf16(h1[0] - __uint_as_float(hi.z << 16), h1[1] - __uint_as_float(hi.z & 0xffff0000u)); lo.w = cvt_pk_bf16(h1[2] - __uint_as_float(hi.w << 16), h1[3] - __uint_as_float(hi.w & 0xffff0000u));
                    const bf16x8 ahi = __builtin_bit_cast(bf16x8, hi), alo = __builtin_bit_cast(bf16x8, lo);
#pragma unroll
                    for (int nt = 0; nt < 3; ++nt) { const bf16x8 wh = *(const bf16x8*)(bh + (size_t)nt * 16 * D + 32 * ks), wl = *(const bf16x8*)(bl + (size_t)nt * 16 * D + 32 * ks);
                        acc[nt] = MFMA16(ahi, wh, acc[nt]); acc[nt] = MFMA16(ahi, wl, acc[nt]); acc[nt] = MFMA16(alo, wh, acc[nt]); }
                }
                LDS_WAIT();
            }
            if (wave) { LAS float* pw = lgs + 1024 + (wave - 1) * 832;
#pragma unroll
                for (int nt = 0; nt < 3; ++nt)
#pragma unroll
                    for (int rr = 0; rr < 4; ++rr) pw[(nt * 4 + rr) * 64 + lane] = acc[nt][rr];
                pw[12 * 64 + lane] = ss; }
        }
        RT_SETUP(round + 1); if (act) RT_LOAD(0);
        LDS_WAIT(); __builtin_amdgcn_s_barrier();
        if (cact && wave == 0) {
#pragma unroll 1
            for (int w = 0; w < 7; ++w) { const LAS float* pw = lgs + 1024 + w * 832;
#pragma unroll
                for (int nt = 0; nt < 3; ++nt)
#pragma unroll
                    for (int rr = 0; rr < 4; ++rr) acc[nt][rr] += pw[(nt * 4 + rr) * 64 + lane];
                ss += pw[12 * 64 + lane]; }
            ss += __shfl_xor(ss, 16); ss += __shfl_xor(ss, 32);
            const float rstd = rsqrtf(ss * (1.0f / D) + EPS);
            if (g == 0) lgs[800 + l15] = rstd;
#pragma unroll
            for (int nt = 0; nt < 3; ++nt)
#pragma unroll
                for (int rr = 0; rr < 4; ++rr) lgs[(4 * g + rr) * 49 + 16 * nt + l15] = acc[nt][rr];
            LDS_WAIT();
            if (lane < 16) { const int r = ctask * 16 + lane;
                if (row_valid(r)) { const float rs = lgs[800 + lane]; float lg[36];
#pragma unroll
                    for (int j = 0; j < 36; ++j) lg[j] = lgs[lane * 49 + j] * rs;
                    int e1, e2; float w1, w2; route_one(lg, bg, be, e1, e2, w1, w2);
                    const unsigned p1 = atomicAdd(&cnt[64 * e1], 1u); const unsigned p2 = atomicAdd(&cnt[64 * e2], 1u);
                    ltok[(size_t)e1 * LCAP + p1] = r * 2; lw[(size_t)e1 * LCAP + p1] = w1; lrs[(size_t)e1 * LCAP + p1] = rs;
                    ltok[(size_t)e2 * LCAP + p2] = r * 2 + 1; lw[(size_t)e2 * LCAP + p2] = w2; lrs[(size_t)e2 * LCAP + p2] = rs; } }
        }
        LDS_WAIT(); __builtin_amdgcn_s_barrier();
    }
#undef RT_LOAD
#undef RT_SUM
#undef RT_SETUP
}
__device__ __forceinline__ void build_tab(LAS int* tab, const unsigned* cnt) {
    if (threadIdx.x < 64) { const int lane = threadIdx.x;
        const int c = lane < NEXP ? (int)__hip_atomic_load(cnt + 64 * lane, __ATOMIC_RELAXED, __HIP_MEMORY_SCOPE_AGENT) : 0; const int nt = (c + 255) >> 8;
        int incl = nt;
#pragma unroll
        for (int o = 1; o < 32; o <<= 1) { const int t = __shfl_up(incl, o); if (lane >= o) incl += t; }
        const int start = incl - nt;
        if (lane < NEXP) { tab[1 + lane] = start; tab[256 + lane] = c; for (int k = 0; k < nt; ++k) tab[64 + start + k] = lane; }
        if (lane == NEXP - 1) tab[0] = incl; }
    __syncthreads();
}

template <int MODE>
__device__ __forceinline__ void dwconv_segments(const bf16_t* __restrict__ src, int sld, bf16_t* __restrict__ dst, int dld, const float* __restrict__ w, int wld, const float* __restrict__ bias, int nchunk, int gw, int NGW, int lane) {
    const int SEG = (MP * nchunk + NGW - 1) / NGW, nseg = (MP + SEG - 1) / SEG;
    for (int task = gw; task < nseg * nchunk; task += NGW) {
        const int chunk = task % nchunk, r0 = (task / nchunk) * SEG, c = chunk * 512 + lane * 8;
        float wt[4][8], bs[8];
#pragma unroll
        for (int t = 0; t < 4; ++t) { const f32x4 w0 = *(const f32x4*)(w + t * wld + c), w1 = *(const f32x4*)(w + t * wld + c + 4);
            wt[t][0] = w0[0]; wt[t][1] = w0[1]; wt[t][2] = w0[2]; wt[t][3] = w0[3]; wt[t][4] = w1[0]; wt[t][5] = w1[1]; wt[t][6] = w1[2]; wt[t][7] = w1[3]; }
#pragma unroll
        for (int j = 0; j < 8; ++j) bs[j] = MODE == 1 ? bias[c + j] : 0.f;
        const float sc = (MODE == 0 && c >= 1024) ? 0.0625f : 1.0f;
        const u32x4 z = (u32x4){0u, 0u, 0u, 0u};
        u32x4 x0 = r0 >= 2 ? __builtin_nontemporal_load((const u32x4*)(src + (size_t)(r0 - 2) * sld + c)) : z, x1 = r0 >= 1 ? __builtin_nontemporal_load((const u32x4*)(src + (size_t)(r0 - 1) * sld + c)) : z, x2 = __builtin_nontemporal_load((const u32x4*)(src + (size_t)r0 * sld + c));
#pragma unroll 8
        for (int i = 0; i < SEG && r0 + i < MP; ++i) { const int r = r0 + i;
            const u32x4 x3 = r + 1 < MP ? __builtin_nontemporal_load((const u32x4*)(src + (size_t)(r + 1) * sld + c)) : z;
            u32x4 o = z;
            if (row_valid(r)) { float acc[8];
#pragma unroll
                for (int j = 0; j < 8; ++j) acc[j] = bs[j];
                const u32x4 xs[4] = {x0, x1, x2, x3};
#pragma unroll
                for (int t = 0; t < 4; ++t) { acc[0] += __uint_as_float(xs[t].x << 16) * wt[t][0]; acc[1] += __uint_as_float(xs[t].x & 0xffff0000u) * wt[t][1]; acc[2] += __uint_as_float(xs[t].y << 16) * wt[t][2]; acc[3] += __uint_as_float(xs[t].y & 0xffff0000u) * wt[t][3];
                    acc[4] += __uint_as_float(xs[t].z << 16) * wt[t][4]; acc[5] += __uint_as_float(xs[t].z & 0xffff0000u) * wt[t][5]; acc[6] += __uint_as_float(xs[t].w << 16) * wt[t][6]; acc[7] += __uint_as_float(xs[t].w & 0xffff0000u) * wt[t][7]; }
                if (MODE == 0) {
#pragma unroll
                    for (int j = 0; j < 8; ++j) acc[j] = siluf_(acc[j]) * sc; }
                o.x = cvt_pk_bf16(acc[0], acc[1]); o.y = cvt_pk_bf16(acc[2], acc[3]); o.z = cvt_pk_bf16(acc[4], acc[5]); o.w = cvt_pk_bf16(acc[6], acc[7]); }
            *(u32x4*)(dst + (size_t)r * dld + c) = o;
            x0 = x1; x1 = x2; x2 = x3; }
    }
}
__device__ __forceinline__ void qkconv_rows(const Args& a, int gw, int NGW, int lane) {
    const bf16_t* P = (const bf16_t*)(a.ws + WS_PROJ); bf16_t* Q = (bf16_t*)((unsigned char*)a.out + DO_QKC); const float* cw = a.in[I_EVQKC];
    for (int r = gw; r < MP; r += NGW) {
        if (!row_valid(r)) {
#pragma unroll
            for (int k = 0; k < 4; ++k) *(u32x4*)(Q + (size_t)r * 2048 + k * 512 + lane * 8) = (u32x4){0u, 0u, 0u, 0u};
            continue; }
#pragma unroll
        for (int k = 0; k < 4; ++k) { const int c = k * 512 + lane * 8; float acc[8];
#pragma unroll
            for (int j = 0; j < 8; ++j) acc[j] = 0.f;
#pragma unroll
            for (int t = 0; t < 4; ++t) { const int rr = r + t - 2; const u32x4 raw = *(const u32x4*)(P + (size_t)rr * NPROJ0 + c);
                const f32x4 w0 = *(const f32x4*)(cw + t * 2048 + c), w1 = *(const f32x4*)(cw + t * 2048 + c + 4);
                acc[0] += __uint_as_float(raw.x << 16) * w0[0]; acc[1] += __uint_as_float(raw.x & 0xffff0000u) * w0[1]; acc[2] += __uint_as_float(raw.y << 16) * w0[2]; acc[3] += __uint_as_float(raw.y & 0xffff0000u) * w0[3];
                acc[4] += __uint_as_float(raw.z << 16) * w1[0]; acc[5] += __uint_as_float(raw.z & 0xffff0000u) * w1[1]; acc[6] += __uint_as_float(raw.w << 16) * w1[2]; acc[7] += __uint_as_float(raw.w & 0xffff0000u) * w1[3]; }
            const float sc = c >= 1024 ? 0.0625f : 1.0f;
#pragma unroll
            for (int j = 0; j < 8; ++j) acc[j] = siluf_(acc[j]) * sc;
            u32x4 o; o.x = cvt_pk_bf16(acc[0], acc[1]); o.y = cvt_pk_bf16(acc[2], acc[3]); o.z = cvt_pk_bf16(acc[4], acc[5]); o.w = cvt_pk_bf16(acc[6], acc[7]);
            *(u32x4*)(Q + (size_t)r * 2048 + c) = o; }
    }
}
__device__ __forceinline__ void gla_pre_units(const Args& a, LAS unsigned char* lds, int bid, int nblk) {
    const bf16_t* P = (const bf16_t*)(a.ws + WS_PROJ); const float* SM = (const float*)((unsigned char*)a.out + DO_SMALL);
    LAS unsigned short* tq = (LAS unsigned short*)lds; LAS unsigned short* tk = (LAS unsigned short*)(lds + 32768); LAS unsigned short* tk2 = (LAS unsigned short*)(lds + 65536);
    LAS float* lrbs = (LAS float*)(lds + 98304); LAS float* toth = (LAS float*)(lds + 98304 + 4096);
    const int tid = threadIdx.x, c = tid & 255, half = tid >> 8;
    for (int u = bid < 0 ? NBATCH * NCH * 8 : bid; u < NBATCH * NCH * 8; u += nblk) {
        const int dir = u & 1, hd = (u >> 1) & 3, n = (u >> 3) % NCH, b = (u >> 3) / NCH;
        bf16_t* GQ = (bf16_t*)(a.ws + WS_G + (size_t)dir * G_STRIDE); bf16_t* GK1 = (bf16_t*)(a.ws + WS_G + (size_t)(2 + dir) * G_STRIDE); bf16_t* GK2 = (bf16_t*)(a.ws + WS_G + (size_t)(4 + dir) * G_STRIDE);
        float* ET = (float*)(a.ws + WS_G + G_ETOT);
#pragma unroll
        for (int k = 0; k < 4; ++k) { const int id = tid + 512 * k, i = id >> 5, c8 = id & 31; const int pp = 64 * n + i, p = dir ? (TP - 1 - pp) : pp; const size_t r = (size_t)(b * TP + p);
            *(LAS u32x4*)(lds + i * 512 + c8 * 16) = __builtin_nontemporal_load((const u32x4*)(P + r * NPROJ0 + 6144 + hd * 256 + c8 * 8));
            *(LAS u32x4*)(lds + 32768 + i * 512 + c8 * 16) = __builtin_nontemporal_load((const u32x4*)(P + r * NPROJ0 + 7168 + hd * 256 + c8 * 8)); }
        if (tid < 256) { const int i = tid >> 2, q4 = tid & 3; const int pp = 64 * n + i, p = dir ? (TP - 1 - pp) : pp;
            *(LAS f32x4*)(lrbs + i * 16 + q4 * 4) = *(const f32x4*)(SM + (size_t)(b * TP + p) * 64 + 16 + dir * 16 + q4 * 4); }
        float up[16];
#pragma unroll
        for (int rr = 0; rr < 16; ++rr) up[rr] = a.in[I_EVLRUP][(size_t)(dir * 16 + rr) * 1024 + hd * 256 + c];
        const float bias = a.in[I_EVLRB][dir * 1024 + hd * 256 + c];
        __syncthreads();
        float cumv[32]; float run = 0.f;
#pragma unroll
        for (int ii = 0; ii < 32; ++ii) { const int i = half * 32 + ii; const int pp = 64 * n + i, p = dir ? (TP - 1 - pp) : pp;
            float x = bias;
#pragma unroll
            for (int q4 = 0; q4 < 4; ++q4) { const f32x4 l = *(const LAS f32x4*)(lrbs + i * 16 + q4 * 4); x += l[0] * up[q4 * 4] + l[1] * up[q4 * 4 + 1] + l[2] * up[q4 * 4 + 2] + l[3] * up[q4 * 4 + 3]; }
            const float la = p < PADF ? 0.f : logsigf_(x) * 0.0625f; run += la; cumv[ii] = run; }
        toth[half * 256 + c] = run;
        __syncthreads();
        const float off = half ? toth[c] : 0.f, tot = toth[c] + toth[256 + c];
#pragma unroll
        for (int ii = 0; ii < 32; ++ii) { const int i = half * 32 + ii; const float cum = cumv[ii] + off;
            const float q = bf2f(tq[i * 256 + c]), k = bf2f(tk[i * 256 + c]);
            tq[i * 256 + c] = f2bf(q * 0.0625f * __expf(cum)); tk[i * 256 + c] = f2bf(k * __expf(-cum)); tk2[i * 256 + c] = f2bf(k * __expf(tot - cum)); }
        if (half == 0) ET[((size_t)((dir * 2 + b) * NCH + n)) * 1024 + hd * 256 + c] = __expf(tot);
        __syncthreads();
#if SCAN0_PRE
        {
            const int wv = tid >> 6, ln = tid & 63, g = ln >> 4, l15 = ln & 15, mt = wv >> 1, np = wv & 1;
            f32x4 sa[2]; sa[0] = sa[1] = (f32x4){0.f, 0.f, 0.f, 0.f};
#pragma unroll
            for (int ks = 0; ks < 8; ++ks) { if (2 * np > mt) break;
                const bf16x8 qf = *(const LAS bf16x8*)(lds + (16 * mt + l15) * 512 + (32 * ks + 8 * g) * 2);
#pragma unroll
                for (int j = 0; j < 2; ++j) if (2 * np + j <= mt) { const bf16x8 kf = *(const LAS bf16x8*)(lds + 32768 + (16 * (2 * np + j) + l15) * 512 + (32 * ks + 8 * g) * 2); sa[j] = MFMA16(qf, kf, sa[j]); } }
            bf16_t* sp = (bf16_t*)(a.ws + SP_OFF) + ((size_t)(16 + (b * 4 + hd) * 2 + dir) * NCH + n) * 4096;
#pragma unroll
            for (int j = 0; j < 2; ++j) { const int s = 16 * (2 * np + j) + l15;
#pragma unroll
                for (int rr = 0; rr < 4; ++rr) { const int t = 16 * mt + 4 * g + rr; sp[t * 64 + s] = f2bf(s <= t ? sa[j][rr] : 0.f); } } }
#endif
#pragma unroll
        for (int k = 0; k < 4; ++k) { const int id = tid + 512 * k, i = id >> 5, c8 = id & 31; const int pp = 64 * n + i, p = dir ? (TP - 1 - pp) : pp; const size_t r = (size_t)(b * TP + p);
            *(u32x4*)(GQ + r * 1024 + hd * 256 + c8 * 8) = *(const LAS u32x4*)(lds + i * 512 + c8 * 16);
#if !SCAN0_PRE
            *(u32x4*)(GK1 + r * 1024 + hd * 256 + c8 * 8) = *(const LAS u32x4*)(lds + 32768 + i * 512 + c8 * 16);
#endif
            *(u32x4*)(GK2 + r * 1024 + hd * 256 + c8 * 8) = *(const LAS u32x4*)(lds + 65536 + i * 512 + c8 * 16); }
        __syncthreads();
    }
}
__device__ __forceinline__ void headnorm_rows(const Args& a, int gw, int NGW, int lane) {
    bf16_t* HF = (bf16_t*)(a.ws + WS_HS); bf16_t* HO = (a.flags & 8) ? (bf16_t*)(a.ws + WS_G) : HF; const bf16_t* HB = (const bf16_t*)(a.ws + WS_HS + HS_STRIDE0); const bf16_t* P = (const bf16_t*)(a.ws + WS_PROJ);
    for (int r = gw; r < MP; r += NGW) {
        if (!row_valid(r)) { zero_row_bf16(HO + (size_t)r * D, lane); continue; }
#pragma unroll
        for (int hg = 0; hg < 8; ++hg) { const int col = hg * 512 + lane * 8;
            const u32x4 f = __builtin_nontemporal_load((const u32x4*)(HF + (size_t)r * D + col)), bb = __builtin_nontemporal_load((const u32x4*)(HB + (size_t)r * D + col));
            const u32x4 gt = __builtin_nontemporal_load((const u32x4*)(P + (size_t)r * NPROJ0 + (hg < 4 ? 4096 + col : 10240 + (col - 2048))));
            const float* nw = hg < 4 ? a.in[I_EVNA] + col : a.in[I_EVNB] + (col - 2048);
            float s[8], gv[8];
            const unsigned fw[4] = {f.x, f.y, f.z, f.w}, bw[4] = {bb.x, bb.y, bb.z, bb.w}, gw4[4] = {gt.x, gt.y, gt.z, gt.w};
#pragma unroll
            for (int j = 0; j < 4; ++j) { s[2 * j] = __uint_as_float(fw[j] << 16) + __uint_as_float(bw[j] << 16); s[2 * j + 1] = __uint_as_float(fw[j] & 0xffff0000u) + __uint_as_float(bw[j] & 0xffff0000u);
                gv[2 * j] = __uint_as_float(gw4[j] << 16); gv[2 * j + 1] = __uint_as_float(gw4[j] & 0xffff0000u); }
            float ss = 0.f;
#pragma unroll
            for (int j = 0; j < 8; ++j) ss += s[j] * s[j];
            const float rstd = rsqrtf(wave_sum(ss) * (1.0f / 512.0f) + EPS);
            const f32x4 n0 = *(const f32x4*)nw, n1 = *(const f32x4*)(nw + 4); const float nn[8] = {n0[0], n0[1], n0[2], n0[3], n1[0], n1[1], n1[2], n1[3]};
            float o[8];
#pragma unroll
            for (int j = 0; j < 8; ++j) { const float gate = hg < 4 ? sigmoidf_(gv[j]) : siluf_(gv[j]); o[j] = gate * s[j] * rstd * nn[j]; }
            u32x4 w; w.x = cvt_pk_bf16(o[0], o[1]); w.y = cvt_pk_bf16(o[2], o[3]); w.z = cvt_pk_bf16(o[4], o[5]); w.w = cvt_pk_bf16(o[6], o[7]);
            *(u32x4*)(HO + (size_t)r * D + col) = w; }
    }
}
__device__ __forceinline__ void uconv_rows(const Args& a, int gw, int NGW, int lane) {
    const bf16_t* P = (const bf16_t*)(a.ws + WS_PROJ); bf16_t* U = (bf16_t*)(a.ws + WS_G); const float* cw = a.in[I_ODCONV]; const float* cb = a.in[I_ODCONVB];
    for (int r = gw; r < MP; r += NGW) {
        const bool v = row_valid(r);
#pragma unroll
        for (int k = 0; k < 10; ++k) { const int c = k * 512 + lane * 8;
            if (!v) { *(u32x4*)(U + (size_t)r * DR + c) = (u32x4){0u, 0u, 0u, 0u}; continue; }
            const f32x4 b0 = *(const f32x4*)(cb + c), b1 = *(const f32x4*)(cb + c + 4);
            float acc[8] = {b0[0], b0[1], b0[2], b0[3], b1[0], b1[1], b1[2], b1[3]};
#pragma unroll
            for (int t = 0; t < 4; ++t) { const int rr = r + t - 2; const u32x4 raw = *(const u32x4*)(P + (size_t)rr * NPROJ1 + DR + c);
                const f32x4 w0 = *(const f32x4*)(cw + t * DR + c), w1 = *(const f32x4*)(cw + t * DR + c + 4);
                acc[0] += __uint_as_float(raw.x << 16) * w0[0]; acc[1] += __uint_as_float(raw.x & 0xffff0000u) * w0[1]; acc[2] += __uint_as_float(raw.y << 16) * w0[2]; acc[3] += __uint_as_float(raw.y & 0xffff0000u) * w0[3];
                acc[4] += __uint_as_float(raw.z << 16) * w1[0]; acc[5] += __uint_as_float(raw.z & 0xffff0000u) * w1[1]; acc[6] += __uint_as_float(raw.w << 16) * w1[2]; acc[7] += __uint_as_float(raw.w & 0xffff0000u) * w1[3]; }
            u32x4 o; o.x = cvt_pk_bf16(acc[0], acc[1]); o.y = cvt_pk_bf16(acc[2], acc[3]); o.z = cvt_pk_bf16(acc[4], acc[5]); o.w = cvt_pk_bf16(acc[6], acc[7]);
            *(u32x4*)(U + (size_t)r * DR + c) = o; }
    }
}
__device__ __forceinline__ void rglru_combine_rows(const Args& a, int gw, int NGW, int lane) {
    bf16_t* HF = (bf16_t*)(a.ws + WS_HS); bf16_t* HO = (a.flags & 8) ? (bf16_t*)(a.ws + WS_G) : HF; const bf16_t* HB = (const bf16_t*)(a.ws + WS_HS + HS_STRIDE1); const bf16_t* P = (const bf16_t*)(a.ws + WS_PROJ);
    for (int r = gw; r < MP; r += NGW) {
        const bool v = row_valid(r);
#pragma unroll
        for (int k = 0; k < 10; ++k) { const int c = k * 512 + lane * 8;
            if (!v) { *(u32x4*)(HO + (size_t)r * DR + c) = (u32x4){0u, 0u, 0u, 0u}; continue; }
            const u32x4 f = __builtin_nontemporal_load((const u32x4*)(HF + (size_t)r * DR + c)), bb = __builtin_nontemporal_load((const u32x4*)(HB + (size_t)r * DR + c)), gt = __builtin_nontemporal_load((const u32x4*)(P + (size_t)r * NPROJ1 + c));
            const unsigned fw[4] = {f.x, f.y, f.z, f.w}, bw[4] = {bb.x, bb.y, bb.z, bb.w}, gw4[4] = {gt.x, gt.y, gt.z, gt.w};
            float o[8];
#pragma unroll
            for (int j = 0; j < 4; ++j) { o[2 * j] = gelu_tanhf_(__uint_as_float(gw4[j] << 16)) * (__uint_as_float(fw[j] << 16) + __uint_as_float(bw[j] << 16));
                o[2 * j + 1] = gelu_tanhf_(__uint_as_float(gw4[j] & 0xffff0000u)) * (__uint_as_float(fw[j] & 0xffff0000u) + __uint_as_float(bw[j] & 0xffff0000u)); }
            u32x4 w; w.x = cvt_pk_bf16(o[0], o[1]); w.y = cvt_pk_bf16(o[2], o[3]); w.z = cvt_pk_bf16(o[4], o[5]); w.w = cvt_pk_bf16(o[6], o[7]);
            *(u32x4*)(HO + (size_t)r * DR + c) = w; }
    }
}

__device__ __forceinline__ void tail_reduce(const Args& a, LAS unsigned char* lds, int bid, int G, unsigned* tickets) {
    const int base = ((1024 + G - 1) / G) * G; const int L0 = bid + ((base - bid + G - 1) / G) * G - base;
    asm volatile("s_waitcnt vmcnt(0)" ::: "memory");
    __syncthreads();
    if (threadIdx.x == 0) {
        __builtin_amdgcn_fence(__ATOMIC_RELEASE, "agent");
        asm volatile("s_waitcnt vmcnt(0)" ::: "memory");
        for (int L = L0; L < 16 * pg8::KSPLIT; L += G) __hip_atomic_fetch_add(tickets + 64 * (L / pg8::KSPLIT), 1u, __ATOMIC_RELAXED, __HIP_MEMORY_SCOPE_AGENT);
    }
    for (int L = L0; L < 16 * pg8::KSPLIT; L += G) {
        const int ct = L / pg8::KSPLIT, kq = L % pg8::KSPLIT;
        if (threadIdx.x == 0) { while (__hip_atomic_load(tickets + 64 * ct, __ATOMIC_RELAXED, __HIP_MEMORY_SCOPE_AGENT) < (unsigned)pg8::KSPLIT) __builtin_amdgcn_s_sleep(2);
            __builtin_amdgcn_fence(__ATOMIC_ACQUIRE, "agent"); asm volatile("s_waitcnt vmcnt(0)" ::: "memory"); }
        __syncthreads();
        float* H = (float*)(a.ws + WS_H); const float* PART = (const float*)((unsigned char*)a.out + DO_PART);
        for (int i = threadIdx.x; i < 16 * 64; i += 512) { const int r = kq * 16 + (i >> 6), c4 = (i & 63) * 4 + ct * 256;
            f32x4 h = *(const f32x4*)(H + (size_t)(16384 + r) * D + c4); f32x4 p[pg8::KSPLIT];
#pragma unroll
            for (int s = 0; s < pg8::KSPLIT; ++s) p[s] = __builtin_nontemporal_load((const f32x4*)(PART + ((size_t)(s * 256 + r)) * D + c4));
#pragma unroll
            for (int s = 0; s < pg8::KSPLIT; ++s) h = h + p[s];
            *(f32x4*)(H + (size_t)(16384 + r) * D + c4) = h; }
    }
}

constexpr int S0_K1 = 0, S0_K2 = 34816, S0_V = 69632, S0_VW = 80896, S0_SS = 92160, S0_CT = 102400, S0_ET = 145920, S0_GV = 146944;
constexpr int KPB = 544  , VPB = 176  , SPB = 160  ;
template <int OFF> __device__ __forceinline__ void tr_frags2(const unsigned (&ad)[2], bf16x8 (&fr)[2]) {
    s16x4 x0, y0, x1, y1;
    asm volatile("ds_read_b64_tr_b16 %0, %4\n\tds_read_b64_tr_b16 %1, %4 offset:%6\n\tds_read_b64_tr_b16 %2, %5\n\tds_read_b64_tr_b16 %3, %5 offset:%6\n\ts_waitcnt lgkmcnt(0)"
                 : "=&v"(x0), "=&v"(y0), "=&v"(x1), "=&v"(y1) : "v"(ad[0]), "v"(ad[1]), "i"(OFF) : "memory");
    fr[0] = __builtin_shufflevector(x0, y0, 0, 1, 2, 3, 4, 5, 6, 7); fr[1] = __builtin_shufflevector(x1, y1, 0, 1, 2, 3, 4, 5, 6, 7);
}
template <int OFF> __device__ __forceinline__ void tr_frags3(const unsigned (&ad)[3], bf16x8 (&fr)[3]) {
    s16x4 x0, y0, x1, y1, x2, y2;
    asm volatile("ds_read_b64_tr_b16 %0, %6\n\tds_read_b64_tr_b16 %1, %6 offset:%9\n\tds_read_b64_tr_b16 %2, %7\n\tds_read_b64_tr_b16 %3, %7 offset:%9\n\tds_read_b64_tr_b16 %4, %8\n\tds_read_b64_tr_b16 %5, %8 offset:%9\n\ts_waitcnt lgkmcnt(0)"
                 : "=&v"(x0), "=&v"(y0), "=&v"(x1), "=&v"(y1), "=&v"(x2), "=&v"(y2) : "v"(ad[0]), "v"(ad[1]), "v"(ad[2]), "i"(OFF) : "memory");
    fr[0] = __builtin_shufflevector(x0, y0, 0, 1, 2, 3, 4, 5, 6, 7); fr[1] = __builtin_shufflevector(x1, y1, 0, 1, 2, 3, 4, 5, 6, 7); fr[2] = __builtin_shufflevector(x2, y2, 0, 1, 2, 3, 4, 5, 6, 7);
}

template <int CTRL, int ROWMASK> __device__ __forceinline__ float dpp_f(float old, float src) {
    return __int_as_float(__builtin_amdgcn_update_dpp(__float_as_int(old), __float_as_int(src), CTRL, ROWMASK, 0xf, false)); }
__device__ __forceinline__ float wave_scan_sum(float v) {
    v += dpp_f<0x111, 0xf>(0.f, v); v += dpp_f<0x112, 0xf>(0.f, v); v += dpp_f<0x114, 0xf>(0.f, v); v += dpp_f<0x118, 0xf>(0.f, v);
    v += dpp_f<0x142, 0xa>(0.f, v); v += dpp_f<0x143, 0xc>(0.f, v); return v; }
__device__ __forceinline__ float wave_scan_max(float v) {
    const float ID = -3.0e38f;
    v = fmaxf(v, dpp_f<0x111, 0xf>(ID, v)); v = fmaxf(v, dpp_f<0x112, 0xf>(ID, v)); v = fmaxf(v, dpp_f<0x114, 0xf>(ID, v)); v = fmaxf(v, dpp_f<0x118, 0xf>(ID, v));
    v = fmaxf(v, dpp_f<0x142, 0xa>(ID, v)); v = fmaxf(v, dpp_f<0x143, 0xc>(ID, v)); return v; }
template <int NV> __device__ __forceinline__ void tr_state_frags(unsigned ka0, unsigned ka1, unsigned va, bf16x8 (&af)[2], bf16x8 (&bv)[5]) {
    s16x4 x0, y0, x1, y1, p0, q0, p1, q1, p2, q2, p3, q3, p4, q4;
    if (NV == 5)
        asm volatile("ds_read_b64_tr_b16 %0, %14\n\tds_read_b64_tr_b16 %1, %14 offset:2176\n\tds_read_b64_tr_b16 %2, %15\n\tds_read_b64_tr_b16 %3, %15 offset:2176\n\t"
                     "ds_read_b64_tr_b16 %4, %16\n\tds_read_b64_tr_b16 %5, %16 offset:704\n\tds_read_b64_tr_b16 %6, %16 offset:32\n\tds_read_b64_tr_b16 %7, %16 offset:736\n\t"
                     "ds_read_b64_tr_b16 %8, %16 offset:64\n\tds_read_b64_tr_b16 %9, %16 offset:768\n\tds_read_b64_tr_b16 %10, %16 offset:96\n\tds_read_b64_tr_b16 %11, %16 offset:800\n\t"
                     "ds_read_b64_tr_b16 %12, %16 offset:128\n\tds_read_b64_tr_b16 %13, %16 offset:832\n\ts_waitcnt lgkmcnt(0)"
                     : "=&v"(x0), "=&v"(y0), "=&v"(x1), "=&v"(y1), "=&v"(p0), "=&v"(q0), "=&v"(p1), "=&v"(q1), "=&v"(p2), "=&v"(q2), "=&v"(p3), "=&v"(q3), "=&v"(p4), "=&v"(q4)
                     : "v"(ka0), "v"(ka1), "v"(va) : "memory");
    else {
        asm volatile("ds_read_b64_tr_b16 %0, %12\n\tds_read_b64_tr_b16 %1, %12 offset:2176\n\tds_read_b64_tr_b16 %2, %13\n\tds_read_b64_tr_b16 %3, %13 offset:2176\n\t"
                     "ds_read_b64_tr_b16 %4, %14\n\tds_read_b64_tr_b16 %5, %14 offset:704\n\tds_read_b64_tr_b16 %6, %14 offset:32\n\tds_read_b64_tr_b16 %7, %14 offset:736\n\t"
                     "ds_read_b64_tr_b16 %8, %14 offset:64\n\tds_read_b64_tr_b16 %9, %14 offset:768\n\tds_read_b64_tr_b16 %10, %14 offset:96\n\tds_read_b64_tr_b16 %11, %14 offset:800\n\ts_waitcnt lgkmcnt(0)"
                     : "=&v"(x0), "=&v"(y0), "=&v"(x1), "=&v"(y1), "=&v"(p0), "=&v"(q0), "=&v"(p1), "=&v"(q1), "=&v"(p2), "=&v"(q2), "=&v"(p3), "=&v"(q3)
                     : "v"(ka0), "v"(ka1), "v"(va) : "memory");
        p4 = p3; q4 = q3; }
    af[0] = __builtin_shufflevector(x0, y0, 0, 1, 2, 3, 4, 5, 6, 7); af[1] = __builtin_shufflevector(x1, y1, 0, 1, 2, 3, 4, 5, 6, 7);
    bv[0] = __builtin_shufflevector(p0, q0, 0, 1, 2, 3, 4, 5, 6, 7); bv[1] = __builtin_shufflevector(p1, q1, 0, 1, 2, 3, 4, 5, 6, 7); bv[2] = __builtin_shufflevector(p2, q2, 0, 1, 2, 3, 4, 5, 6, 7);
    bv[3] = __builtin_shufflevector(p3, q3, 0, 1, 2, 3, 4, 5, 6, 7); bv[4] = __builtin_shufflevector(p4, q4, 0, 1, 2, 3, 4, 5, 6, 7);
}
static_assert(4 * KPB == 2176 && 4 * VPB == 704, "tr_state_frags hard-codes the row-group strides");

template <int KIND, int ABL>
__device__ __forceinline__ void scan0_unit(const Args& a, LAS unsigned char* lds, int b, int hd, int dir, int sl, size_t hs_off) {
    constexpr int NE = KIND == 0 ? 5 : 4;
    const int tid0 = threadIdx.x, w = __builtin_amdgcn_readfirstlane(tid0 >> 6);
    const int mt = w >> 1, np = w & 1;
    const bf16_t* P = (const bf16_t*)(a.ws + WS_PROJ);
    const bf16_t *Qg, *K1g, *K2g, *Vg; int pitchQ;
    if (KIND == 0) { const bf16_t* QK = (const bf16_t*)((unsigned char*)a.out + DO_QKC); Qg = QK + hd * 256; K1g = QK + 1024 + hd * 256; K2g = K1g; pitchQ = 2048; Vg = P + 2048 + hd * 512 + sl * 64; }
    else { Qg = (const bf16_t*)(a.ws + WS_G + (size_t)dir * G_STRIDE) + hd * 256; K1g = (const bf16_t*)(a.ws + WS_G + (size_t)(2 + dir) * G_STRIDE) + hd * 256; K2g = (const bf16_t*)(a.ws + WS_G + (size_t)(4 + dir) * G_STRIDE) + hd * 256; pitchQ = 1024; Vg = P + 8192 + hd * 512 + sl * 64; }
    const float* SM = (const float*)((unsigned char*)a.out + DO_SMALL);
    const float* ETg = (const float*)(a.ws + WS_G + G_ETOT) + ((size_t)((dir * 2 + b) * NCH)) * 1024 + hd * 256;
    bf16_t* Og = ABL ? (bf16_t*)((unsigned char*)a.out + DO_PART) + KIND * 2048 + hd * 512 + sl * 64 : (bf16_t*)(a.ws + hs_off + (size_t)dir * HS_STRIDE0) + KIND * 2048 + hd * 512 + sl * 64;
    const unsigned ldsb = (unsigned)(size_t)lds;
    f32x4 accC[2][NE];
#pragma unroll
    for (int mi = 0; mi < 2; ++mi)
#pragma unroll
        for (int ni = 0; ni < NE; ++ni) accC[mi][ni] = (f32x4){0.f, 0.f, 0.f, 0.f};
    for (int i = tid0; i < 80 * KPB / 4; i += 512) ((LAS unsigned*)(lds + S0_CT))[i] = 0u;
    float m_prev = 0.f;
    float gbi = 0.f, gbf = 0.f;
    if (KIND == 0) { gbi = a.in[I_EVGB][(dir ? 2 : 0) * 4 + hd]; gbf = a.in[I_EVGB][(dir ? 3 : 1) * 4 + hd]; }
    const int gci = (dir ? 2 : 0) * 4 + hd, gcf = (dir ? 3 : 1) * 4 + hd;
#define PROWN(nn, i) (dir ? (TP - 1 - (64 * (nn) + (i))) : (64 * (nn) + (i)))
    u32x4 pk1[4], pk2[4], pv; float pgi = 0.f, pgf = 0.f, pet = 0.f; bf16x8 Qf[8];
#define PREFETCH_KV(nn) do { const size_t crow = (size_t)(b * TP + (dir ? TP - 64 - 64 * (nn) : 64 * (nn))); \
        const char* kb1 = (const char*)K1g + crow * pitchQ * 2; const char* kb2 = (const char*)K2g + crow * pitchQ * 2; \
        _Pragma("unroll") for (int k = 0; k < 4; ++k) { pk1[k] = *(const u32x4*)(kb1 + voK[k]); if (KIND == 1) pk2[k] = *(const u32x4*)(kb2 + voK[k]); } \
        pv = *(const u32x4*)((const char*)Vg + crow * NPROJ0 * 2 + voV); \
        if (KIND == 0) { const char* gb = (const char*)SM + crow * 256; pgi = *(const float*)(gb + voG + gci * 4); pgf = *(const float*)(gb + voG + gcf * 4); } \
        if (KIND == 1 && tid < 256) pet = ETg[(size_t)(nn) * 1024 + tid]; \
    } while (0)
#define PREFETCH_Q(nn) do { const size_t crow = (size_t)(b * TP + (dir ? TP - 64 - 64 * (nn) : 64 * (nn))); const char* qb = (const char*)Qg + crow * pitchQ * 2; \
        _Pragma("unroll") for (int ks = 0; ks < 8; ++ks) Qf[ks] = *(const bf16x8*)(qb + voQ + 64 * ks); } while (0)
    __syncthreads();
    for (int n = 0; n < NCH; ++n) {
        int tidv = tid0; asm volatile("" : "+v"(tidv));
        const int tid = tidv, lane = tid & 63, g = lane >> 4, l15 = lane & 15, q4 = l15 >> 2, p4 = lane & 3;
    unsigned voK[4];
#pragma unroll
    for (int k = 0; k < 4; ++k) { const int id = tid + 512 * k, i = id >> 5, c8 = id & 31; voK[k] = (unsigned)((dir ? 63 - i : i) * pitchQ * 2 + c8 * 16); }
    const unsigned voV = (unsigned)((dir ? 63 - (tid >> 3) : (tid >> 3)) * NPROJ0 * 2 + (tid & 7) * 16);
    const unsigned voG = (unsigned)((dir ? 63 - lane : lane) * 256);
    const unsigned voQ = (unsigned)((dir ? 63 - (16 * mt + l15) : (16 * mt + l15)) * pitchQ * 2 + 16 * g);
        if (n == 0) { PREFETCH_KV(0); PREFETCH_Q(0); }
        LAS float* gv = (LAS float*)(lds + S0_GV + w * 1024);
        float Bt = 0.f, bvec = 0.f, winter = 0.f, floorv = 0.f, wsl = 0.f, decay = 1.f, B63 = 0.f, tot = 0.f;
        if (KIND == 0) { const int p = PROWN(n, lane);
            const bool pad = p < PADF; const float li = pad ? NEGV : pgi + gbi, lf = pad ? 0.f : logsigf_(pgf + gbf);
            const float cum = (ABL & 16) ? lf : wave_scan_sum(lf);
            bvec = li - cum; const float pm = (ABL & 16) ? bvec : wave_scan_max(bvec);
            Bt = fmaxf(m_prev, pm); winter = __expf(m_prev - Bt); floorv = __expf(-(cum + Bt));
            gv[lane] = Bt; gv[64 + lane] = bvec; gv[128 + lane] = winter; gv[192 + lane] = floorv;
            B63 = __shfl(Bt, 63); tot = __shfl(cum, 63); decay = __expf(m_prev - B63); wsl = __expf(bvec - B63); }
#pragma unroll
        for (int k = 0; k < 4; ++k) { const int id = tid + 512 * k, i = id >> 5, c8 = id & 31;
            *(LAS u32x4*)(lds + S0_K1 + i * KPB + c8 * 16) = pk1[k];
            if (KIND == 1) *(LAS u32x4*)(lds + S0_K2 + i * KPB + c8 * 16) = pk2[k]; }
        { const int i = tid >> 3, c8 = tid & 7;
            *(LAS u32x4*)(lds + S0_V + i * VPB + c8 * 16) = pv;
            if (KIND == 0) { const float s = __shfl(wsl, i);
                u32x4 o; o.x = cvt_pk_bf16(__uint_as_float(pv.x << 16) * s, __uint_as_float(pv.x & 0xffff0000u) * s); o.y = cvt_pk_bf16(__uint_as_float(pv.y << 16) * s, __uint_as_float(pv.y & 0xffff0000u) * s);
                o.z = cvt_pk_bf16(__uint_as_float(pv.z << 16) * s, __uint_as_float(pv.z & 0xffff0000u) * s); o.w = cvt_pk_bf16(__uint_as_float(pv.w << 16) * s, __uint_as_float(pv.w & 0xffff0000u) * s);
                *(LAS u32x4*)(lds + S0_VW + i * VPB + c8 * 16) = o;
                if (c8 < 2) { const float s1 = c8 == 0 ? 1.0f : 0.f;
                    *(LAS u32x4*)(lds + S0_V + i * VPB + 128 + c8 * 16) = (u32x4){cvt_pk_bf16(s1, 0.f), 0u, 0u, 0u};
                    *(LAS u32x4*)(lds + S0_VW + i * VPB + 128 + c8 * 16) = (u32x4){cvt_pk_bf16(s1 * s, 0.f), 0u, 0u, 0u}; } } }
        if (KIND == 1 && tid < 256) ((LAS float*)(lds + S0_ET))[tid] = pet;
        __syncthreads();
        { const int nn = n + 1 < NCH ? n + 1 : n; PREFETCH_KV(nn); }
        f32x4 sacc[2], oacc[3];
#pragma unroll
        for (int j = 0; j < 2; ++j) sacc[j] = (f32x4){0.f, 0.f, 0.f, 0.f};
#pragma unroll
        for (int j = 0; j < 3; ++j) oacc[j] = (f32x4){0.f, 0.f, 0.f, 0.f};
        if (!(ABL & 1))
#pragma unroll
        for (int ks = 0; ks < 8; ++ks) {
#pragma unroll
            for (int j = 0; j < 2; ++j) { const int nt = 2 * np + j;
                const bf16x8 kf = (ABL & 64) ? Qf[(ks + 1) & 7] : *(const LAS bf16x8*)(lds + S0_K1 + (16 * nt + l15) * KPB + (32 * ks + 8 * g) * 2);
                sacc[j] = MFMA16(Qf[ks], kf, sacc[j]);
                const bf16x8 cf = (ABL & 64) ? Qf[(ks + 2) & 7] : *(const LAS bf16x8*)(lds + S0_CT + (16 * nt + l15) * KPB + (32 * ks + 8 * g) * 2);
                oacc[j] = MFMA16(Qf[ks], cf, oacc[j]); }
            if (KIND == 0) { const bf16x8 cf = (ABL & 64) ? Qf[(ks + 3) & 7] : *(const LAS bf16x8*)(lds + S0_CT + (64 + l15) * KPB + (32 * ks + 8 * g) * 2); oacc[2] = MFMA16(Qf[ks], cf, oacc[2]); }
            }
        __builtin_amdgcn_sched_barrier(0);
        { const int nn = n + 1 < NCH ? n + 1 : n; PREFETCH_Q(nn); }
        __builtin_amdgcn_sched_barrier(0);
        if (!(ABL & 2))
#pragma unroll
        for (int j = 0; j < 2; ++j) { const int s = 16 * (2 * np + j) + l15; const float b_s = KIND == 0 ? gv[64 + s] : 0.f;
            f32x4 bt4 = (f32x4){0.f, 0.f, 0.f, 0.f}; if (KIND == 0) bt4 = *(const LAS f32x4*)(gv + 16 * mt + 4 * g);
#pragma unroll
            for (int rr = 0; rr < 4; ++rr) { const int t = 16 * mt + 4 * g + rr; float val;
                if (KIND == 0) val = s <= t ? sacc[j][rr] * __expf(b_s - bt4[rr]) : 0.f;
                else val = s <= t ? sacc[j][rr] : 0.f;
                *(LAS unsigned short*)(lds + S0_SS + t * SPB + s * 2) = f2bf(val); } }
        __syncthreads();
#pragma unroll
        for (int mi = 0; mi < 2; ++mi) {
            f32x4 sc;
            if (KIND == 0) sc = (f32x4){decay, decay, decay, decay};
            else sc = *(const LAS f32x4*)(lds + S0_ET + (16 * (2 * w + mi) + 4 * g) * 4);
#pragma unroll
            for (int ni = 0; ni < NE; ++ni) accC[mi][ni] = accC[mi][ni] * sc; }
        if (!(ABL & 4))
#pragma unroll
        for (int ks = 0; ks < 2; ++ks) {
            const unsigned rowb = (unsigned)(32 * ks + 8 * g + q4);
            bf16x8 af[2], bv[5];
            { const unsigned kb = ldsb + (KIND == 0 ? S0_K1 : S0_K2) + rowb * KPB + 8 * p4; const unsigned vb = ldsb + (KIND == 0 ? S0_VW : S0_V) + rowb * VPB + 8 * p4;
                tr_state_frags<NE>(kb + 32 * (2 * w), kb + 32 * (2 * w + 1), vb, af, bv); }
#pragma unroll
            for (int mi = 0; mi < 2; ++mi)
#pragma unroll
                for (int ni = 0; ni < NE; ++ni) accC[mi][ni] = MFMA16(af[mi], bv[ni], accC[mi][ni]); }
#pragma unroll
        for (int mi = 0; mi < 2; ++mi)
#pragma unroll
            for (int ni = 0; ni < NE; ++ni) { u32x2 o; o.x = cvt_pk_bf16(accC[mi][ni][0], accC[mi][ni][1]); o.y = cvt_pk_bf16(accC[mi][ni][2], accC[mi][ni][3]);
                *(LAS u32x2*)(lds + S0_CT + (16 * ni + l15) * KPB + (16 * (2 * w + mi) + 4 * g) * 2) = o; }
        if (KIND == 0) { const f32x4 wi4 = *(const LAS f32x4*)(gv + 128 + 16 * mt + 4 * g);
#pragma unroll
            for (int j = 0; j < 3; ++j) oacc[j] = oacc[j] * wi4; }
        if (!(ABL & 8))
#pragma unroll
        for (int ks = 0; ks < 2; ++ks) { const bf16x8 sf = *(const LAS bf16x8*)(lds + S0_SS + (16 * mt + l15) * SPB + (32 * ks + 8 * g) * 2);
            const unsigned vb = ldsb + S0_V + (unsigned)(32 * ks + 8 * g + q4) * VPB + 8 * p4;
            if (KIND == 0) { bf16x8 vf[3]; const unsigned ad[3] = {vb + 32 * (2 * np), vb + 32 * (2 * np + 1), vb + 128}; tr_frags3<4 * VPB>(ad, vf);
                oacc[0] = MFMA16(sf, vf[0], oacc[0]); oacc[1] = MFMA16(sf, vf[1], oacc[1]); oacc[2] = MFMA16(sf, vf[2], oacc[2]); }
            else { bf16x8 vf[2]; const unsigned ad[2] = {vb + 32 * (2 * np), vb + 32 * (2 * np + 1)}; tr_frags2<4 * VPB>(ad, vf);
                oacc[0] = MFMA16(sf, vf[0], oacc[0]); oacc[1] = MFMA16(sf, vf[1], oacc[1]); } }
#pragma unroll
        for (int rr = 0; rr < 4; ++rr) { const int t = 16 * mt + 4 * g + rr; const size_t r = ABL ? (size_t)((n & 15) * 64 + t) : (size_t)(b * TP + PROWN(n, t));
            float inv = 1.f;
            if (KIND == 0) { const float fl = gv[192 + t], den = __shfl(oacc[2][rr], g * 16); inv = __builtin_amdgcn_rcpf(fmaxf(fabsf(den), fl)); }
#pragma unroll
            for (int j = 0; j < 2; ++j) Og[r * D + 16 * (2 * np + j) + l15] = f2bf(oacc[j][rr] * inv); }
        if (KIND == 0) m_prev = tot + B63;
        __syncthreads();
    }
#undef PREFETCH_KV
#undef PREFETCH_Q
#undef PROWN
}


__device__ __forceinline__ void mlstm_gate_seq(const Args& a, int seq, int lane) {
    const int b = seq >> 3, hd = (seq >> 1) & 3, dir = seq & 1;
    const float* SM = (const float*)((unsigned char*)a.out + DO_SMALL); float* GVp = (float*)(a.ws + GV_OFF) + (size_t)seq * NCH * 384;
    const int gci = (dir ? 2 : 0) * 4 + hd, gcf = (dir ? 3 : 1) * 4 + hd; const float gbi = a.in[I_EVGB][gci], gbf = a.in[I_EVGB][gcf];
    float m_prev = 0.f;
    float pgi, pgf; { const int p = dir ? (TP - 1 - lane) : lane; const size_t r = (size_t)(b * TP + p); pgi = SM[r * 64 + gci]; pgf = SM[r * 64 + gcf]; }
    for (int n = 0; n < NCH; ++n) {
        const int p = dir ? (TP - 1 - (64 * n + lane)) : (64 * n + lane); const bool pad = p < PADF;
        const float li = pad ? NEGV : pgi + gbi, lf = pad ? 0.f : logsigf_(pgf + gbf);
        if (n + 1 < NCH) { const int p1 = dir ? (TP - 1 - (64 * (n + 1) + lane)) : (64 * (n + 1) + lane); const size_t r = (size_t)(b * TP + p1); pgi = SM[r * 64 + gci]; pgf = SM[r * 64 + gcf]; }
        const float cum = wave_scan_sum(lf); const float bvec = li - cum; const float pm = wave_scan_max(bvec);
        const float Bt = fmaxf(m_prev, pm), winter = __expf(m_prev - Bt), floorv = __expf(-(cum + Bt));
        const float B63 = __shfl(Bt, 63), tot = __shfl(cum, 63), decay = __expf(m_prev - B63), wsl = __expf(bvec - B63);
        float* o = GVp + (size_t)n * 384;
        o[lane] = winter; o[64 + lane] = floorv; o[128 + lane] = wsl; o[192 + lane] = decay; o[256 + lane] = Bt; o[320 + lane] = bvec;
        m_prev = tot + B63;
    }
}
__device__ __forceinline__ void mlstm_scores(const Args& a, int gw, int NGW, int lane) {
    const bf16_t* QK = (const bf16_t*)((unsigned char*)a.out + DO_QKC); const float* GVb = (const float*)(a.ws + GV_OFF); bf16_t* SPb = (bf16_t*)(a.ws + SP_OFF);
    const int g = lane >> 4, l15 = lane & 15;
    for (int it = gw; it < 16 * NCH * 8; it += NGW) {
        const int seq = it / (NCH * 8), rem = it % (NCH * 8), n = rem >> 3, mt = (rem >> 1) & 3, np = rem & 1;
        const int b = seq >> 3, hd = (seq >> 1) & 3, dir = seq & 1;
        const int pt = dir ? (TP - 1 - (64 * n + 16 * mt + l15)) : (64 * n + 16 * mt + l15);
        const bf16_t* qp = QK + (size_t)(b * TP + pt) * 2048 + hd * 256 + 8 * g;
        const bf16_t* kp[2];
#pragma unroll
        for (int j = 0; j < 2; ++j) { const int ps = dir ? (TP - 1 - (64 * n + 16 * (2 * np + j) + l15)) : (64 * n + 16 * (2 * np + j) + l15); kp[j] = QK + (size_t)(b * TP + ps) * 2048 + 1024 + hd * 256 + 8 * g; }
        f32x4 sacc[2]; sacc[0] = sacc[1] = (f32x4){0.f, 0.f, 0.f, 0.f};
#pragma unroll
        for (int ks = 0; ks < 8; ++ks) { if (2 * np > mt) break;
            const bf16x8 qf = *(const bf16x8*)(qp + 32 * ks);
#pragma unroll
            for (int j = 0; j < 2; ++j) if (2 * np + j <= mt) { const bf16x8 kf = *(const bf16x8*)(kp[j] + 32 * ks); sacc[j] = MFMA16(qf, kf, sacc[j]); } }
        const float* gvp = GVb + ((size_t)seq * NCH + n) * 384; const f32x4 bt4 = *(const f32x4*)(gvp + 256 + 16 * mt + 4 * g);
        bf16_t* sp = SPb + ((size_t)seq * NCH + n) * 4096;
#pragma unroll
        for (int j = 0; j < 2; ++j) { const int s = 16 * (2 * np + j) + l15; const float b_s = gvp[320 + s];
#pragma unroll
            for (int rr = 0; rr < 4; ++rr) { const int t = 16 * mt + 4 * g + rr; const float val = s <= t ? sacc[j][rr] * __expf(b_s - bt4[rr]) : 0.f; sp[t * 64 + s] = f2bf(val); } }
    }
}
constexpr int P_K = 0, P_V = 34816, P_VB = 64 * VPB, P_SS = P_V + 2 * P_VB, P_SB = 64 * SPB, P_CT = P_SS + 2 * P_SB, P_CTB = 66 * KPB;
static_assert(P_CT + 2 * P_CTB <= LDS_TAB, "scan0p LDS map");
template <int KIND>
__device__ __forceinline__ void scan0p_unit(const Args& a, LAS unsigned char* lds, int b, int hd, int dir, int sl) {
    constexpr int NE = KIND == 0 ? 5 : 4;
    const int tid0 = threadIdx.x, w = __builtin_amdgcn_readfirstlane(tid0 >> 6);
    const int mt = w >> 1, np = w & 1, seq = (b * 4 + hd) * 2 + dir;
    const bf16_t* P = (const bf16_t*)(a.ws + WS_PROJ);
    const bf16_t *Qg, *Kg, *Vg; int pitchQ;
    if (KIND == 0) { const bf16_t* QK = (const bf16_t*)((unsigned char*)a.out + DO_QKC); Qg = QK + hd * 256; Kg = QK + 1024 + hd * 256; pitchQ = 2048; Vg = P + 2048 + hd * 512 + sl * 64; }
    else { Qg = (const bf16_t*)(a.ws + WS_G + (size_t)dir * G_STRIDE) + hd * 256; Kg = (const bf16_t*)(a.ws + WS_G + (size_t)(4 + dir) * G_STRIDE) + hd * 256; pitchQ = 1024; Vg = P + 8192 + hd * 512 + sl * 64; }
    const char* SPg = (const char*)((const bf16_t*)(a.ws + SP_OFF) + ((size_t)(KIND * 16 + seq) * NCH) * 4096);
    const float* GVg = (const float*)(a.ws + GV_OFF) + (size_t)seq * NCH * 384;
    const float* ETg = (const float*)(a.ws + WS_G + G_ETOT) + ((size_t)((dir * 2 + b) * NCH)) * 1024 + hd * 256;
    bf16_t* Og = (bf16_t*)(a.ws + WS_HS + (size_t)dir * HS_STRIDE0) + KIND * 2048 + hd * 512 + sl * 64;
    const unsigned ldsb = (unsigned)(size_t)lds;
    f32x4 accC[2][NE];
#pragma unroll
    for (int mi = 0; mi < 2; ++mi)
#pragma unroll
        for (int ni = 0; ni < NE; ++ni) accC[mi][ni] = (f32x4){0.f, 0.f, 0.f, 0.f};
    for (int i = tid0; i < 2 * P_CTB / 4; i += 512) ((LAS unsigned*)(lds + P_CT))[i] = 0u;
    if (KIND == 0 && tid0 < 256) { const int i = tid0 >> 2, c8 = tid0 & 1, bf = (tid0 >> 1) & 1;
        *(LAS u32x4*)(lds + P_V + bf * P_VB + i * VPB + 128 + c8 * 16) = (u32x4){cvt_pk_bf16(c8 == 0 ? 1.0f : 0.f, 0.f), 0u, 0u, 0u}; }
    u32x4 pk[4], pv, ps; f32x4 pws4 = (f32x4){0.f, 0.f, 0.f, 0.f}, pwi4 = pws4, pfl4 = pws4, pet0 = pws4, pet1 = pws4; float pdec = 1.f; bf16x8 Qf[8];
#define CROW(nn) ((size_t)(b * TP + (dir ? TP - 64 - 64 * (nn) : 64 * (nn))))
#define PF_VS(nn) do { pv = __builtin_nontemporal_load((const u32x4*)((const char*)Vg + CROW(nn) * NPROJ0 * 2 + voV)); ps = *(const u32x4*)(SPg + (size_t)(nn) * 8192 + voS); } while (0)
#define PF_K(nn) do { const char* kb = (const char*)Kg + CROW(nn) * pitchQ * 2; _Pragma("unroll") for (int k = 0; k < 4; ++k) pk[k] = *(const u32x4*)(kb + voK[k]); \
        if (KIND == 0) { const float* gp = GVg + (size_t)(nn) * 384 + 128 + (lane >> 2); pws4 = (f32x4){gp[0], gp[16], gp[32], gp[48]}; } } while (0)
#define PF_G(nn) do { if (KIND == 0) { const float* gp = GVg + (size_t)(nn) * 384; pwi4 = *(const f32x4*)(gp + 16 * mt + 4 * g); pfl4 = *(const f32x4*)(gp + 64 + 16 * mt + 4 * g); pdec = gp[192]; } \
        else { const float* ep = ETg + (size_t)(nn) * 1024 + 32 * w + 4 * g; pet0 = *(const f32x4*)ep; pet1 = *(const f32x4*)(ep + 16); } } while (0)
#define PF_Q(nn) do { const char* qb = (const char*)Qg + CROW(nn) * pitchQ * 2; _Pragma("unroll") for (int ks = 0; ks < 8; ++ks) Qf[ks] = *(const bf16x8*)(qb + voQ + 64 * ks); } while (0)
#define STAGE_VS(buf) do { const int i_ = tid >> 3, c8_ = tid & 7; *(LAS u32x4*)(lds + P_V + (buf) * P_VB + i_ * VPB + c8_ * 16) = pv; *(LAS u32x4*)(lds + P_SS + (buf) * P_SB + i_ * SPB + c8_ * 16) = ps; } while (0)
#define WRITE_K() do { _Pragma("unroll") for (int k = 0; k < 4; ++k) { u32x4 o = pk[k]; \
            if (KIND == 0) { const float s_ = pws4[k]; o.x = cvt_pk_bf16(__uint_as_float(o.x << 16) * s_, __uint_as_float(o.x & 0xffff0000u) * s_); o.y = cvt_pk_bf16(__uint_as_float(o.y << 16) * s_, __uint_as_float(o.y & 0xffff0000u) * s_); \
                o.z = cvt_pk_bf16(__uint_as_float(o.z << 16) * s_, __uint_as_float(o.z & 0xffff0000u) * s_); o.w = cvt_pk_bf16(__uint_as_float(o.w << 16) * s_, __uint_as_float(o.w & 0xffff0000u) * s_); } \
            *(LAS u32x4*)(lds + P_K + (16 * k + (lane >> 2)) * KPB + 64 * w + 16 * (lane & 3)) = o; } } while (0)
#define PROWN(nn, i) (dir ? (TP - 1 - (64 * (nn) + (i))) : (64 * (nn) + (i)))
    for (int n = 0; n < NCH; ++n) {
        int tidv = tid0; asm volatile("" : "+v"(tidv));
        const int tid = tidv, lane = tid & 63, g = lane >> 4, l15 = lane & 15, q4 = l15 >> 2, p4 = lane & 3;
        unsigned voK[4];
#pragma unroll
        for (int k = 0; k < 4; ++k) { const int i = 16 * k + (lane >> 2); voK[k] = (unsigned)((dir ? 63 - i : i) * pitchQ * 2 + 64 * w + 16 * (lane & 3)); }
        const unsigned voV = (unsigned)((dir ? 63 - (tid >> 3) : (tid >> 3)) * NPROJ0 * 2 + (tid & 7) * 16);
        const unsigned voS = (unsigned)((tid >> 3) * 128 + (tid & 7) * 16);
        const unsigned voQ = (unsigned)((dir ? 63 - (16 * mt + l15) : (16 * mt + l15)) * pitchQ * 2 + 16 * g);
        if (n == 0) { PF_VS(0); PF_K(0); PF_G(0); PF_Q(0); STAGE_VS(0); WRITE_K(); PF_VS(1); PF_K(1); }
        __syncthreads();
        const int cur = n & 1, ctr = P_CT + cur * P_CTB, ctw = P_CT + (cur ^ 1) * P_CTB, vcur = P_V + cur * P_VB, scur = P_SS + cur * P_SB;
        const float decay = pdec; const f32x4 wi4 = pwi4, fl4 = pfl4, sc0 = pet0, sc1 = pet1;
        if (n + 1 < NCH) STAGE_VS(cur ^ 1);
        { const int n2 = n + 2 < NCH ? n + 2 : NCH - 1, n1 = n + 1 < NCH ? n + 1 : NCH - 1; PF_VS(n2); PF_G(n1); }
        f32x4 oacc[3];
#pragma unroll
        for (int j = 0; j < 3; ++j) oacc[j] = (f32x4){0.f, 0.f, 0.f, 0.f};
#pragma unroll
        for (int ks = 0; ks < 8; ++ks) {
#pragma unroll
            for (int j = 0; j < 2; ++j) { const bf16x8 cf = *(const LAS bf16x8*)(lds + ctr + (16 * (2 * np + j) + l15) * KPB + (32 * ks + 8 * g) * 2); oacc[j] = MFMA16(Qf[ks], cf, oacc[j]); }
            if (KIND == 0) { const bf16x8 cf = *(const LAS bf16x8*)(lds + ctr + (l15 == 0 ? 64 : 65) * KPB + (32 * ks + 8 * g) * 2); oacc[2] = MFMA16(Qf[ks], cf, oacc[2]); } }
        __builtin_amdgcn_sched_barrier(0);
        { const int n1 = n + 1 < NCH ? n + 1 : NCH - 1; PF_Q(n1); }
        __builtin_amdgcn_sched_barrier(0);
#pragma unroll
        for (int mi = 0; mi < 2; ++mi) {
            f32x4 sc;
            if (KIND == 0) sc = (f32x4){decay, decay, decay, decay}; else sc = mi == 0 ? sc0 : sc1;
#pragma unroll
            for (int ni = 0; ni < NE; ++ni) accC[mi][ni] = accC[mi][ni] * sc; }
#pragma unroll
        for (int ks = 0; ks < 2; ++ks) {
            const unsigned rowb = (unsigned)(32 * ks + 8 * g + q4);
            bf16x8 af[2], bv[5];
            { const unsigned kb = ldsb + P_K + rowb * KPB + 8 * p4; const unsigned vb = ldsb + vcur + rowb * VPB + 8 * p4;
                tr_state_frags<NE>(kb + 32 * (2 * w), kb + 32 * (2 * w + 1), vb, af, bv); }
#pragma unroll
            for (int mi = 0; mi < 2; ++mi)
#pragma unroll
                for (int ni = 0; ni < NE; ++ni) accC[mi][ni] = MFMA16(af[mi], bv[ni], accC[mi][ni]); }
#pragma unroll
        for (int mi = 0; mi < 2; ++mi)
#pragma unroll
            for (int ni = 0; ni < NE; ++ni) { u32x2 o; o.x = cvt_pk_bf16(accC[mi][ni][0], accC[mi][ni][1]); o.y = cvt_pk_bf16(accC[mi][ni][2], accC[mi][ni][3]);
                if (ni < 4 || l15 == 0) *(LAS u32x2*)(lds + ctw + (16 * ni + l15) * KPB + (16 * (2 * w + mi) + 4 * g) * 2) = o; }
        if (n + 1 < NCH) WRITE_K();
        { const int n2 = n + 2 < NCH ? n + 2 : NCH - 1; PF_K(n2); }
        if (KIND == 0) {
#pragma unroll
            for (int j = 0; j < 3; ++j) oacc[j] = oacc[j] * wi4; }
#pragma unroll
        for (int ks = 0; ks < 2; ++ks) { const bf16x8 sf = *(const LAS bf16x8*)(lds + scur + (16 * mt + l15) * SPB + (32 * ks + 8 * g) * 2);
            const unsigned vb = ldsb + vcur + (unsigned)(32 * ks + 8 * g + q4) * VPB + 8 * p4;
            if (KIND == 0) { bf16x8 vf[3]; const unsigned ad[3] = {vb + 32 * (2 * np), vb + 32 * (2 * np + 1), vb + 128}; tr_frags3<4 * VPB>(ad, vf);
                oacc[0] = MFMA16(sf, vf[0], oacc[0]); oacc[1] = MFMA16(sf, vf[1], oacc[1]); oacc[2] = MFMA16(sf, vf[2], oacc[2]); }
            else { bf16x8 vf[2]; const unsigned ad[2] = {vb + 32 * (2 * np), vb + 32 * (2 * np + 1)}; tr_frags2<4 * VPB>(ad, vf);
                oacc[0] = MFMA16(sf, vf[0], oacc[0]); oacc[1] = MFMA16(sf, vf[1], oacc[1]); } }
#pragma unroll
        for (int rr = 0; rr < 4; ++rr) { const int t = 16 * mt + 4 * g + rr; const size_t r = (size_t)(b * TP + PROWN(n, t));
            float inv = 1.f;
            if (KIND == 0) { const float den = __shfl(oacc[2][rr], g * 16); inv = __builtin_amdgcn_rcpf(fmaxf(fabsf(den), fl4[rr])); }
#pragma unroll
            for (int j = 0; j < 2; ++j) __builtin_nontemporal_store(f2bf(oacc[j][rr] * inv), Og + r * D + 16 * (2 * np + j) + l15); }
    }
    __syncthreads();
#undef CROW
#undef PF_VS
#undef PF_K
#undef PF_G
#undef PF_Q
#undef STAGE_VS
#undef WRITE_K
#undef PROWN
}

constexpr int APB = 672;
constexpr int S1_BT = 0, S1_A = 96 * APB, S1_AB = 64 * APB, S1_COMP = S1_A + 2 * S1_AB, S1_HP = S1_COMP + 2 * 2560;
static_assert(S1_HP + 640 <= LDS_TAB, "scan1 LDS map");
template <int ABL, int NJ>
__device__ __forceinline__ void scan1_body(const Args& a, LAS unsigned char* lds, int b, int nb, int dir, int q) {
    const int tid0 = threadIdx.x, w = __builtin_amdgcn_readfirstlane(tid0 >> 6);
    constexpr int nj = NJ, par = NJ == 3 ? 0 : 1, j0 = par * 3; const int mt = w >> 1;
    const bf16_t* U = (const bf16_t*)(a.ws + WS_G) + nb * 320; const bf16_t* WRI = (const bf16_t*)(a.ws + WS_W + W_RI);
    bf16_t* Og = (bf16_t*)(a.ws + WS_HS + (size_t)dir * HS_STRIDE1) + nb * 320 + q * 80;
    for (int id = tid0; id < 96 * 40; id += 512) { const int row = id / 40, pc = id % 40, which = row / 48, jc = (row % 48) >> 4, col = 80 * q + 16 * (jc == 2 ? 4 : jc + 1) + (row & 15);
        *(LAS u32x4*)(lds + S1_BT + row * APB + pc * 16) = *(const u32x4*)(WRI + ((size_t)(((dir * 16 + nb) * 2 + which) * 320 + col)) * 320 + pc * 8); }
    if (tid0 < 160) ((LAS float*)(lds + S1_HP))[tid0] = 0.f;
    float br[3], bi[3], sp[3];
    { const int l15 = tid0 & 15;
#pragma unroll
        for (int jj = 0; jj < 3; ++jj) { const int col = 16 * ((j0 + jj) < 5 ? (j0 + jj) : 4) + l15, gc = dir * DR + nb * 320 + q * 80 + col;
            br[jj] = a.in[I_ODBR][gc]; bi[jj] = a.in[I_ODBI][gc]; sp[jj] = -8.0f * softplusf_(-a.in[I_ODLAM][gc]); } }
    u32x4 pa[5];
    bf16x8 rbr[10], rbi[10];
    { const int l15 = tid0 & 15, g = (tid0 & 63) >> 4;
        const bf16_t* wr_ = WRI + ((size_t)(((dir * 16 + nb) * 2 + 0) * 320 + 80 * q + 16 * j0 + l15)) * 320 + 8 * g; const bf16_t* wi_ = wr_ + (size_t)320 * 320;
#pragma unroll
        for (int ks = 0; ks < 10; ++ks) { rbr[ks] = *(const bf16x8*)(wr_ + 32 * ks); rbi[ks] = *(const bf16x8*)(wi_ + 32 * ks); } }
#define PROW1(tt, i) (dir ? (TP - 1 - (64 * (tt) + (i))) : (64 * (tt) + (i)))
#define PREF1(tt) do { const size_t crow = (size_t)(b * TP + (dir ? TP - 64 - 64 * (tt) : 64 * (tt))); const char* ub = (const char*)U + crow * DR * 2; \
        _Pragma("unroll") for (int k = 0; k < 5; ++k) pa[k] = *(const u32x4*)(ub + voA[k]); } while (0)
#define STAGE1(buf) do { _Pragma("unroll") for (int k = 0; k < 5; ++k) { const int id = tid + 512 * k, i = id / 40, pc = id % 40; *(LAS u32x4*)(lds + S1_A + (buf) * S1_AB + i * APB + pc * 16) = pa[k]; } } while (0)
    for (int ti = 0; ti < NCH; ++ti) {
        int tidv = tid0; asm volatile("" : "+v"(tidv));
        const int tid = tidv, lane = tid & 63, g = lane >> 4, l15 = lane & 15;
        unsigned voA[5];
#pragma unroll
        for (int k = 0; k < 5; ++k) { const int id = tid + 512 * k, i = id / 40, pc = id % 40; voA[k] = (unsigned)((dir ? 63 - i : i) * DR * 2 + pc * 16); }
        const int cur = ti & 1;
        if (ti == 0) { PREF1(0); STAGE1(0); PREF1(1); __syncthreads(); }
        if (ti + 1 < NCH) STAGE1(cur ^ 1);
        { const int tn = ti + 2 < NCH ? ti + 2 : NCH - 1; PREF1(tn); }
        const int abase = S1_A + cur * S1_AB;
        f32x4 racc[3], iacc[3];
#pragma unroll
        for (int jj = 0; jj < 3; ++jj) { racc[jj] = (f32x4){0.f, 0.f, 0.f, 0.f}; iacc[jj] = (f32x4){0.f, 0.f, 0.f, 0.f}; }
        {
            bf16x8 fa[2], fr_[2][3], fi_[2][3];
#define S1_LOADF(buf, ks) do { fa[buf] = *(const LAS bf16x8*)(lds + abase + (16 * mt + l15) * APB + (32 * (ks) + 8 * g) * 2); \
                _Pragma("unroll") for (int jj = 1; jj < nj; ++jj) { const int jc = par ? 2 : jj - 1; \
                    fr_[buf][jj] = *(const LAS bf16x8*)(lds + S1_BT + (16 * jc + l15) * APB + (32 * (ks) + 8 * g) * 2); \
                    fi_[buf][jj] = *(const LAS bf16x8*)(lds + S1_BT + (48 + 16 * jc + l15) * APB + (32 * (ks) + 8 * g) * 2); } } while (0)
            S1_LOADF(0, 0);
#pragma unroll
            for (int ks = 0; ks < 10; ++ks) { const int cb = ks & 1;
                if (ks + 1 < 10) { if (cb) S1_LOADF(0, ks + 1); else S1_LOADF(1, ks + 1); }
                __builtin_amdgcn_sched_barrier(0);
                racc[0] = MFMA16(fa[cb], rbr[ks], racc[0]); iacc[0] = MFMA16(fa[cb], rbi[ks], iacc[0]);
#pragma unroll
                for (int jj = 1; jj < nj; ++jj) { racc[jj] = MFMA16(fa[cb], fr_[cb][jj], racc[jj]); iacc[jj] = MFMA16(fa[cb], fi_[cb][jj], iacc[jj]); }
                __builtin_amdgcn_sched_barrier(0); }
#undef S1_LOADF
        }
        float Ap[3][4], Hp[3][4];
#pragma unroll
        for (int jj = 0; jj < 3; ++jj) if (jj < nj) { const int col = 16 * (j0 + jj) + l15;
            float A = 1.f, Hh = 0.f;
#pragma unroll
            for (int rr = 0; rr < 4; ++rr) { const int t = 16 * mt + 4 * g + rr; const bool pad = PROW1(ti, t) < PADF;
                float rg, ig, av, mult;
                rg = sigmoidf_(racc[jj][rr] + br[jj]); ig = sigmoidf_(iacc[jj][rr] + bi[jj]);
                const float la = rg * sp[jj]; av = __expf(la);
                const float x2 = 2.0f * la; const float m2 = x2 > -0.03f ? -x2 * (1.0f + x2 * (0.5f + x2 * (1.0f / 6.0f))) : 1.0f - av * av;
                mult = __builtin_amdgcn_sqrtf(fmaxf(0.f, m2));
                const float uval = bf2f(*(const LAS unsigned short*)(lds + abase + t * APB + (80 * q + col) * 2));
                float inp = mult * ig * uval; if (pad) { av = 1.f; inp = 0.f; }
                Hh = av * Hh + inp; A = av * A; Ap[jj][rr] = A; Hp[jj][rr] = Hh; }
            const float cA = Ap[jj][3], cH = Hp[jj][3];
            float gA = 1.f, gH = 0.f, mA = 1.f, mH = 0.f;
#pragma unroll
            for (int gg = 0; gg < 4; ++gg) { const float xa = __shfl(cA, gg * 16 + l15), xh = __shfl(cH, gg * 16 + l15);
                if (gg < g) { gH = xa * gH + xh; gA = xa * gA; }
                mH = xa * mH + xh; mA = xa * mA; }
#pragma unroll
            for (int rr = 0; rr < 4; ++rr) { Hp[jj][rr] = Hp[jj][rr] + Ap[jj][rr] * gH; Ap[jj][rr] = Ap[jj][rr] * gA; }
            if (g == 0) *(LAS f32x2*)(lds + S1_COMP + cur * 2560 + (mt * 80 + col) * 8) = (f32x2){mA, mH};
        }
        __syncthreads();
#pragma unroll
        for (int jj = 0; jj < 3; ++jj) if (jj < nj) { const int col = 16 * (j0 + jj) + l15;
            float hp = ((LAS float*)(lds + S1_HP))[cur * 80 + col];
#pragma unroll
            for (int mm = 0; mm < 3; ++mm) if (mm < mt) { const f32x2 c = *(const LAS f32x2*)(lds + S1_COMP + cur * 2560 + (mm * 80 + col) * 8); hp = c[0] * hp + c[1]; }
#pragma unroll
            for (int rr = 0; rr < 4; ++rr) { const int t = 16 * mt + 4 * g + rr; const size_t r = (size_t)(b * TP + PROW1(ti, t));
                Og[r * DR + col] = f2bf(Hp[jj][rr] + Ap[jj][rr] * hp); }
            if (mt == 3 && g == 0) { const f32x2 c = *(const LAS f32x2*)(lds + S1_COMP + cur * 2560 + (3 * 80 + col) * 8); ((LAS float*)(lds + S1_HP))[(cur ^ 1) * 80 + col] = c[0] * hp + c[1]; }
        }
    }
#undef PROW1
#undef PREF1
#undef STAGE1
    __syncthreads();
}

template <int ABL>
__device__ __forceinline__ void scan1_unit(const Args& a, LAS unsigned char* lds, int b, int nb, int dir, int q) {
    const int w = __builtin_amdgcn_readfirstlane((int)threadIdx.x >> 6);
    if (((w ^ (w >> 2)) & 1) == 0) scan1_body<ABL, 3>(a, lds, b, nb, dir, q); else scan1_body<ABL, 2>(a, lds, b, nb, dir, q);
}


#ifndef ABLV
#define ABLV 0
#endif
#ifndef SPLIT_G1
#define SPLIT_G1 false
#endif
#ifndef SPLIT_G3
#define SPLIT_G3 false
#endif
#ifndef SPLIT_UP
#define SPLIT_UP true
#endif
constexpr int NPH = 22;
__global__ void __launch_bounds__(512, 2) __attribute__((amdgpu_waves_per_eu(2, 2))) fwd_kernel(Args a) {
    extern __shared__ __attribute__((aligned(16))) unsigned char lds_raw[];
    LAS unsigned char* lds = (LAS unsigned char*)lds_raw;
    const int tid = threadIdx.x, lane = tid & 63, wave = __builtin_amdgcn_readfirstlane(tid >> 6);
    const int G = gridDim.x, bid = blockIdx.x, gw = bid * 8 + wave, NGW = G * 8;
    const int bq = (G & 7) == 0 ? (bid & 7) * (G >> 3) + (bid >> 3) : bid;
    if (tid < 4) ((LAS unsigned*)(lds + LDS_XB))[tid] = 0u;
    __syncthreads();
    XcdBarrier bar; bar.bar = (unsigned*)(a.ws + WS_CTL) + CW_BAR; bar.x = 0; bar.st = nullptr;
#if MK_FUSED
    bar = xcd_barrier_post((unsigned*)(a.ws + WS_CTL) + CW_BAR, (volatile LAS unsigned*)(lds + LDS_XB));
#endif
    const int lo = a.ph_lo, hi = a.ph_hi;
#ifndef ONLY
#define ONLY -1
#endif
#define XN ((bf16_t*)((unsigned char*)a.out + DO_XN))
#define SMALL ((float*)((unsigned char*)a.out + DO_SMALL))
#define PROJ ((bf16_t*)(a.ws + WS_PROJ))
#define H ((float*)(a.ws + WS_H))
#define WIN ((const bf16_t*)(a.ws + WS_W + W_IN))
#define scr ((LAS float*)(lds + wave * 16896))
#define tab ((LAS int*)(lds + LDS_TAB))
#define IN(k) ((ONLY < 0 || ONLY == (k)) && lo <= (k) && (k) < hi)
#ifndef TIMEPH
#define TIMEPH -1
#endif
#ifndef REPMASK
#define REPMASK 0u
#endif
#define REPS(k) for (int rep_ = 0; rep_ < (((REPMASK >> (k)) & 1u) ? 2 : 1); ++rep_, ((rep_ < (((REPMASK >> (k)) & 1u) ? 2 : 1)) ? xcd_barrier(bar) : (void)0))
#ifndef AMPMASK
#define AMPMASK 0ull
#endif
#define AMPPT(k) do { if (AMPMASK) { if (tid == 0) { const unsigned long long now = __builtin_amdgcn_s_memrealtime(); \
            if ((AMPMASK >> (k)) & 1ull) amp_acc += now - amp_prev;        \
            amp_prev = now; } } } while (0)
#define SEAM(k) do { if (MK_FUSED && IN(k) && IN((k) + 1)) xcd_barrier(bar); AMPPT(k); \
        if (TIMEPH >= 0 && bid == 0 && tid == 0) ((unsigned long long*)(a.ws + WS_CTL + 512 * 1024))[(k) + 1] = __builtin_amdgcn_s_memrealtime(); } while (0)
    unsigned long long amp_prev = AMPMASK ? __builtin_amdgcn_s_memrealtime() : 0ull, amp_acc = 0ull;

    if (TIMEPH >= 0 && bid == 0 && tid == 0) ((unsigned long long*)(a.ws + WS_CTL + 512 * 1024))[0] = __builtin_amdgcn_s_memrealtime();
    if (IN(0)) { conv_layer0(a, gw, NGW, scr, lane); router_table(a, 0, gw, NGW, lane); p0_rows(a, gw, NGW, lane); }
    SEAM(0);
    if (IN(1)) { pg8::Gemm g{XN, WIN, D, D, D, nullptr}; pg8::StaticOrder S; S.init(MP, NW0, G, bid); pg8::EpiProj E{PROJ, NPROJ0, NPROJ0 / 256, SMALL}; pg8::gemm_phase(lds, g, S, E);
        queue_moe(a, 0, (unsigned*)(a.ws + WS_CTL) + CW_Q, scr, lane); }
    SEAM(1);
    if (IN(2)) { dwconv_segments<0>(PROJ, NPROJ0, (bf16_t*)((unsigned char*)a.out + DO_QKC), 2048, a.in[I_EVQKC], 2048, nullptr, 4, gw, NGW, lane);
#if SCAN0_PRE
        if (G > 32) { if (bid < 16) { if (wave == 0) mlstm_gate_seq(a, bid, lane); gla_pre_units(a, lds, -1, G - 16); } else gla_pre_units(a, lds, bid - 16, G - 16); }
        else { if (wave == 0) for (int sq = bid; sq < 16; sq += G) mlstm_gate_seq(a, sq, lane); gla_pre_units(a, lds, bid, G); }
#else
        gla_pre_units(a, lds, bid, G);
#endif
    }
    SEAM(2);
#if SCAN0_PRE
    if (IN(21)) mlstm_scores(a, gw, NGW, lane);
    if (MK_FUSED && IN(21) && IN(3)) xcd_barrier(bar);
    AMPPT(21);
#endif
    if (IN(3)) REPS(3) { for (int u = bid; u < 256; u += G) { const int grp = u & 31, sl = u >> 5, kind = grp & 1, dir = (grp >> 1) & 1, hd = (grp >> 2) & 3, b = grp >> 4;
            if (a.flags & 4) { if (kind == 0) scan0_unit<0, ABLV>(a, lds, b, hd, dir, sl, WS_H); else scan0_unit<1, ABLV>(a, lds, b, hd, dir, sl, WS_H); }
#if SCAN0_PRE
            else if (kind == 0) scan0p_unit<0>(a, lds, b, hd, dir, sl); else scan0p_unit<1>(a, lds, b, hd, dir, sl); } }
#else
            else if (kind == 0) scan0_unit<0, 0>(a, lds, b, hd, dir, sl, (a.flags & 2) ? WS_H : WS_HS); else scan0_unit<1, 0>(a, lds, b, hd, dir, sl, (a.flags & 2) ? WS_H : WS_HS); } }
#endif
    SEAM(3);
    if (IN(4)) REPS(4) headnorm_rows(a, gw, NGW, lane);
    SEAM(4);
    if (IN(5)) { pg8::Gemm g{(const bf16_t*)(a.ws + WS_HS), (const bf16_t*)(a.ws + WS_W + W_OUT0), D, D, D, nullptr}; pg8::TailSplitOrder S; S.init(G, bid); pg8::EpiResAdd E{PROJ, D, (float*)((unsigned char*)a.out + DO_PART)}; pg8::gemm_phase(lds, g, S, E);
        if (bid >= 16 * pg8::KSPLIT && G == 256) { __syncthreads(); queue_od_some(a, (unsigned*)(a.ws + WS_CTL) + CW_Q + 192, scr, lane, 1); }
        tail_reduce(a, lds, bid, G, (unsigned*)(a.ws + WS_CTL) + CW_TKT); }
    SEAM(5);
#define MOE_PHASES(P, layer) \
    if (IN(P)) route_rows(a, lds, wave, layer, gw, NGW, lane); \
    SEAM((P) + 1); \
    if (IN((P) + 2)) { const unsigned* cn = (const unsigned*)(a.ws + WS_CTL) + CW_CNT + (layer) * 2048; build_tab(tab, cn); \
        pg8::Gemm g{XN, (const bf16_t*)(a.ws + WS_W + W_UP), D, D, D, (float*)(a.ws + XS_OFF)}; pg8::MoeOrder S0{tab, 2, G, bq, (const int*)((unsigned char*)a.out + DO_LTOK) + (size_t)(layer) * NEXP * LCAP, cn}; \
        pg8::SplitTail<pg8::MoeOrder> S; S.init(S0, G, bq, SPLIT_UP); \
        pg8::EpiMoeUp E{(bf16_t*)(a.ws + HID_OFF), (const float*)((unsigned char*)a.out + DO_LW) + (size_t)(layer) * NEXP * LCAP, (const float*)((unsigned char*)a.out + DO_LRS) + (size_t)(layer) * NEXP * LCAP, tab}; \
        pg8::gemm_phase<pg8::EpiMoeUp, pg8::SplitTail<pg8::MoeOrder>, true>(lds, g, S, E); pg8::split_reduce(lds, g, S, E, (unsigned*)(a.ws + WS_CTL) + CW_TK2 + 16384 + (layer) * 8192); \
        if ((layer) == 0) { __syncthreads(); queue_od(a, (unsigned*)(a.ws + WS_CTL) + CW_Q + 64, (const unsigned*)(a.ws + WS_CTL) + CW_Q + 192, scr, lane); } } \
    SEAM((P) + 2); \
    if (IN((P) + 3)) REPS((P) + 3) { const unsigned* cn = (const unsigned*)(a.ws + WS_CTL) + CW_CNT + (layer) * 2048; if (!(MK_FUSED && IN((P) + 2))) build_tab(tab, cn);        \
        pg8::Gemm g{(const bf16_t*)(a.ws + HID_OFF), (const bf16_t*)(a.ws + WS_W + W_DN), DEXP, DEXP, DEXP, nullptr}; pg8::MoeOrder S{tab, 16, G, bq, (const int*)((unsigned char*)a.out + DO_LTOK) + (size_t)(layer) * NEXP * LCAP, cn}; \
        pg8::EpiMoeDn E{(bf16_t*)(a.ws + WS_HS), (const int*)((unsigned char*)a.out + DO_LTOK) + (size_t)(layer) * NEXP * LCAP, tab}; pg8::gemm_phase(lds, g, S, E); } \
    SEAM((P) + 3);
    MOE_PHASES(6, 0)
    if (IN(10)) { router_table(a, 1, gw, NGW, lane); p8_rows(a, gw, NGW, lane); }
    SEAM(10);
    if (IN(11)) { pg8::Gemm g{XN, WIN, D, D, D, (float*)(a.ws + WS_HS)}; pg8::StaticOrder S0; S0.init(MP, NPROJ1, G, bid); pg8::SplitTail<pg8::StaticOrder> S; S.init(S0, G, bid, SPLIT_G3);
        pg8::EpiProj E{PROJ, NPROJ1, NPROJ1 / 256, nullptr}; pg8::gemm_phase(lds, g, S, E); pg8::split_reduce(lds, g, S, E, (unsigned*)(a.ws + WS_CTL) + CW_TK2 + 8192);
        __syncthreads(); queue_moe(a, 1, (unsigned*)(a.ws + WS_CTL) + CW_Q + 128, scr, lane); }
    SEAM(11);
    if (IN(12)) REPS(12) dwconv_segments<1>(PROJ + DR, NPROJ1, (bf16_t*)(a.ws + WS_G), DR, a.in[I_ODCONV], DR, a.in[I_ODCONVB], 10, gw, NGW, lane);
    SEAM(12);
    if (IN(13)) REPS(13) { for (int u = bid; u < 256; u += G) { const int grp = u & 63, q = u >> 6, dir = grp & 1, nb = (grp >> 1) & 15, b = grp >> 5; if (a.flags & 4) scan1_unit<ABLV>(a, lds, b, nb, dir, q); else scan1_unit<0>(a, lds, b, nb, dir, q); } }
    SEAM(13);
    if (IN(14)) REPS(14) rglru_combine_rows(a, gw, NGW, lane);
    SEAM(14);
    if (IN(15)) { pg8::Gemm g{(const bf16_t*)(a.ws + WS_HS), (const bf16_t*)(a.ws + WS_W + W_OUT1), DR, DR, DR, nullptr}; pg8::TailSplitOrder S; S.init(G, bid); pg8::EpiResAdd E{PROJ, D, (float*)((unsigned char*)a.out + DO_PART)}; pg8::gemm_phase(lds, g, S, E);
        tail_reduce(a, lds, bid, G, (unsigned*)(a.ws + WS_CTL) + CW_TKT + 16 * 64); }
    SEAM(15);
    MOE_PHASES(16, 1)
#ifndef PROBE
#define PROBE 0
#endif
#if TIMEPH >= 0
    if (IN(20)) { const unsigned long long* ts = (const unsigned long long*)(a.ws + WS_CTL + 512 * 1024); const float us = (float)(ts[TIMEPH + 1] - ts[TIMEPH]) * 0.01f;
        for (size_t i = (size_t)bid * 512 + threadIdx.x; i < (size_t)NBATCH * SEQ * D; i += (size_t)G * 512) a.out[i] = (i == 0) ? sqrtf(67108864.0f * us) : 0.f; }
#elif PROBE == 9
    if (IN(20)) { const unsigned* s1 = (const unsigned*)(a.ws + WS_HS); const unsigned* s2 = (const unsigned*)(a.ws + WS_H); unsigned cntd = 0;
        for (size_t i = (size_t)bid * 512 + threadIdx.x; i < (size_t)MR * D; i += (size_t)G * 512) { const unsigned x = s1[i], y = s2[i]; cntd += ((x & 0xffffu) != (y & 0xffffu)) + ((x >> 16) != (y >> 16)); }
        cntd = (unsigned)wave_sum((float)cntd); if (lane == 0 && cntd) atomicAdd((unsigned*)(a.ws + WS_CTL) + 32768, cntd); }
    if (lo == 21) { const unsigned c = *((const unsigned*)(a.ws + WS_CTL) + 32768);
        for (size_t i = (size_t)bid * 512 + threadIdx.x; i < (size_t)NBATCH * SEQ * D; i += (size_t)G * 512) a.out[i] = (i == 0) ? sqrtf(67108864.0f * (float)c) : 0.f; }
#elif PROBE
    if (IN(20)) { const bf16_t* src = (const bf16_t*)(a.ws + (PROBE == 1 ? WS_PROJ : PROBE == 2 ? WS_G : PROBE == 3 ? WS_HS : PROBE == 4 ? (WS_HS + HS_STRIDE0) : PROBE == 7 ? (WS_PROJ + (size_t)134217728) : PROBE == 8 ? (WS_PROJ + (size_t)268435456) : WS_PROJ));
        for (size_t i = (size_t)bid * 512 + threadIdx.x; i < (size_t)NBATCH * SEQ * D; i += (size_t)G * 512) a.out[i] = bf2f(src[i]); }
#else
    if (IN(20)) REPS(20) pfinal_rows(a, gw, NGW, lane, a.flags & 1);
#endif
    if (AMPMASK) { if (MK_FUSED) xcd_barrier(bar); AMPPT(20); if (bid == 0 && tid == 0) { const unsigned long long tgt = __builtin_amdgcn_s_memrealtime() + amp_acc; while (__builtin_amdgcn_s_memrealtime() < tgt) __builtin_amdgcn_s_sleep(8); } }
#undef IN
#undef SEAM
#undef MOE_PHASES
#undef XN
#undef SMALL
#undef PROJ
#undef H
#undef WIN
#undef scr
#undef tab
}

extern "C" void kernel_launch(void* const* d_in, const int* in_sizes, int n_in, void* d_out, int out_size, void* d_ws, size_t ws_size, hipStream_t stream) {
    static int grid = 0;
    if (grid == 0) {
        if (n_in != 29 || out_size != NBATCH * SEQ * D || ws_size < WS_END) { fprintf(stderr, "kernel_launch: unexpected problem: n_in %d out %d a.ws %zu (need %zu)\n", n_in, out_size, ws_size, (size_t)WS_END); grid = -1; return; }
        int dev = 0, cus = 0, per_cu = 0;
        if (hipGetDevice(&dev) != hipSuccess || hipDeviceGetAttribute(&cus, hipDeviceAttributeMultiprocessorCount, dev) != hipSuccess) { grid = -1; return; }
        if (hipFuncSetAttribute((const void*)fwd_kernel, hipFuncAttributeMaxDynamicSharedMemorySize, LDS_BYTES) != hipSuccess) { fprintf(stderr, "kernel_launch: hipFuncSetAttribute failed\n"); grid = -1; return; }
        if (hipOccupancyMaxActiveBlocksPerMultiprocessor(&per_cu, (const void*)fwd_kernel, 512, LDS_BYTES) != hipSuccess || per_cu < 1) fprintf(stderr, "kernel_launch: occupancy query says %d\n", per_cu);
        (void)hipGetLastError();
        grid = cus > 256 ? 256 : cus;
    }
    if (grid < 0) return;
    (void)in_sizes;
    if (hipMemsetAsync((char*)d_ws + WS_CTL, 0, CTL_BYTES, stream) != hipSuccess) return;
    Args a{};
    for (int i = 0; i < 29; ++i) a.in[i] = (const float*)d_in[i];
    a.out = (float*)d_out; a.ws = (unsigned char*)d_ws;
#if MK_FUSED
    a.ph_lo = 0; a.ph_hi = NPH; a.flags = 1;
    hipLaunchKernelGGL(fwd_kernel, dim3(grid), dim3(512), LDS_BYTES, stream, a);
#else
#ifndef DBG_STOP
#define DBG_STOP 20
#endif
    a.flags = (DBG_STOP >= 10) ? 1 : 0;
#if PROBE == 9
    for (int p = 0; p < 4; ++p) { a.ph_lo = p; a.ph_hi = p + 1; a.flags = 0; hipLaunchKernelGGL(fwd_kernel, dim3(grid), dim3(512), LDS_BYTES, stream, a); }
    a.ph_lo = 3; a.ph_hi = 4; a.flags = 2; hipLaunchKernelGGL(fwd_kernel, dim3(grid), dim3(512), LDS_BYTES, stream, a);
    a.ph_lo = 20; a.ph_hi = 21; a.flags = 0; hipLaunchKernelGGL(fwd_kernel, dim3(grid), dim3(512), LDS_BYTES, stream, a);
    a.ph_lo = 21; a.ph_hi = 22; hipLaunchKernelGGL(fwd_kernel, dim3(grid), dim3(512), LDS_BYTES, stream, a);
#else
#ifndef DUP
#define DUP -1
#endif
#ifndef DUPB
#define DUPB -1
#endif
    for (int q = 0; q < NPH; ++q) { const int p = q < 3 ? q : (q == 3 ? 21 : q - 1); if (p == 21 && !SCAN0_PRE) continue; if (p >= DBG_STOP && p != 20) continue; a.ph_lo = p; a.ph_hi = p + 1;
        if (p == DUPB) { a.flags |= 8; hipLaunchKernelGGL(fwd_kernel, dim3(grid), dim3(512), LDS_BYTES, stream, a); a.flags &= ~8; }
        hipLaunchKernelGGL(fwd_kernel, dim3(grid), dim3(512), LDS_BYTES, stream, a);
        if (p == DUP) { if (ABLV) a.flags |= 4; hipLaunchKernelGGL(fwd_kernel, dim3(grid), dim3(512), LDS_BYTES, stream, a); a.flags &= ~4; } }
#endif
#endif
}
```
